# Optimizing an MI355X kernel written in HIP

```python
import math
import jax, jax.numpy as jnp
from jax import lax
import numpy as np

D_MODEL = 1024
BATCH = 2
SEQ = 8192
DEPTH = 2

N_MIXERS = 2
DN_ALPHA = (2 * DEPTH) ** 0.25
DN_BETA = (8 * DEPTH) ** -0.25
LN_EPS = 1e-5
RMS_EPS = 1e-6

NSA_HEADS = 16
NSA_HEAD_DIM = D_MODEL // NSA_HEADS
NSA_KV_GROUPS = 4
NSA_HPG = NSA_HEADS // NSA_KV_GROUPS
NSA_KV_DIM = NSA_KV_GROUPS * NSA_HEAD_DIM
CMP_LEN = 32
CMP_STRIDE = 16
CMP_HIDDEN = 256
SLC_LEN = 64
N_SEL = 16
WINDOW = 512
NSA_QBLOCK = 64
NSA_IN_DIM = D_MODEL + 6 * NSA_KV_DIM + 3 * NSA_HEADS

GLA_HEADS = 4
GLA_KEY_DIM = D_MODEL // 2
GLA_VAL_DIM = D_MODEL
GLA_DK = GLA_KEY_DIM // GLA_HEADS
GLA_DV = GLA_VAL_DIM // GLA_HEADS
GLA_GATE_RANK = 16
GLA_GATE_NORM = 16.0
GLA_CHUNK = 64
GLA_IN_DIM = 2 * GLA_KEY_DIM + 2 * GLA_VAL_DIM + GLA_GATE_RANK

FFN_DENSE = 2816
N_EXPERTS = 8
TOP_K = 2
FFN_EXPERT = 3584

kernel_name = "hybrid_nsa_gla_moe_deepnorm"


def layer_norm(x, g, b):
    xf = x.astype(jnp.float32)
    mu = xf.mean(-1, keepdims=True)
    var = jnp.square(xf - mu).mean(-1, keepdims=True)
    return ((xf - mu) * lax.rsqrt(var + LN_EPS) * g + b).astype(x.dtype)


def alibi_slopes(n):
    return 2.0 ** (-8.0 * (jnp.arange(n, dtype=jnp.float32) + 1.0) / n)


def masked_softmax(s, mask):
    s = jnp.where(mask, s.astype(jnp.float32), -1e30)
    m = s.max(-1, keepdims=True)
    e = jnp.exp(s - m) * mask
    return e / jnp.maximum(e.sum(-1, keepdims=True), 1e-30)


def compress_blocks(blk, pe, w1, w2):
    blk = blk + pe[None, None, :, None, :]
    b, nc, l, g, dk = blk.shape
    flat = blk.transpose(0, 1, 3, 2, 4).reshape(b, nc, g, l * dk)
    return jax.nn.gelu(flat @ w1) @ w2


def nsa_mixer(x, w_in, pe_k, pe_v, wk1, wk2, wv1, wv2, w_o):
    B, T, _ = x.shape
    G, HPG, DK = NSA_KV_GROUPS, NSA_HEAD_DIM and NSA_HPG, NSA_HEAD_DIM
    proj = x @ w_in
    splits = np.cumsum([D_MODEL] + [NSA_KV_DIM] * 6).tolist()
    q, kc, vc, ks, vs, kw, vw, gl = jnp.split(proj, splits, axis=-1)
    q = (q * NSA_HEAD_DIM ** -0.5).reshape(B, T, G, HPG, DK)
    kc, vc, ks, vs, kw, vw = [a.reshape(B, T, G, DK) for a in (kc, vc, ks, vs, kw, vw)]
    gates = jax.nn.sigmoid(gl.astype(jnp.float32)).reshape(B, T, G, HPG, 3)

    n_cmp = (T - CMP_LEN) // CMP_STRIDE + 1
    cmp_idx = np.arange(n_cmp)[:, None] * CMP_STRIDE + np.arange(CMP_LEN)[None, :]
    k_cmp = compress_blocks(kc[:, cmp_idx], pe_k, wk1, wk2)
    v_cmp = compress_blocks(vc[:, cmp_idx], pe_v, wv1, wv2)
    cmp_end = jnp.asarray(cmp_idx[:, -1])

    n_slc = T // SLC_LEN
    n_sel = min(N_SEL, n_slc)
    cs = np.arange(n_cmp) * CMP_STRIDE
    ce = cs + CMP_LEN - 1
    bs = np.arange(n_slc) * SLC_LEN
    be = bs + SLC_LEN - 1
    overlap = jnp.asarray(((cs[:, None] <= be[None]) & (ce[:, None] >= bs[None])).astype(np.float32))
    ks_blk = ks.reshape(B, n_slc, SLC_LEN, G, DK).transpose(0, 3, 1, 2, 4)
    vs_blk = vs.reshape(B, n_slc, SLC_LEN, G, DK).transpose(0, 3, 1, 2, 4)
    slc_start = jnp.arange(n_slc) * SLC_LEN
    jidx = jnp.arange(n_slc)[None, :]

    pad = ((0, 0), (WINDOW, 0), (0, 0), (0, 0))
    kw_pad = jnp.pad(kw, pad)
    vw_pad = jnp.pad(vw, pad)

    slopes = alibi_slopes(NSA_HEADS).reshape(G, HPG)
    bi = jnp.arange(B)[:, None, None, None]
    gi = jnp.arange(G)[None, :, None, None]

    def block(c):
        t0 = c * NSA_QBLOCK
        qb = lax.dynamic_slice_in_dim(q, t0, NSA_QBLOCK, axis=1)
        gb = lax.dynamic_slice_in_dim(gates, t0, NSA_QBLOCK, axis=1)
        tq = t0 + jnp.arange(NSA_QBLOCK)

        dist = tq[:, None] - cmp_end[None, :]
        s = jnp.einsum('bqghd,bngd->bghqn', qb, k_cmp) - slopes[None, :, :, None, None] * dist
        p_cmp = masked_softmax(s, dist >= 0)
        o_cmp = jnp.einsum('bghqn,bngd->bqghd', p_cmp, v_cmp.astype(jnp.float32))

        imp = jnp.einsum('bghqn,nj->bgqj', p_cmp, overlap)
        valid = slc_start[None, :] <= tq[:, None]
        cur = (tq // SLC_LEN)[:, None]
        forced = valid & ((jidx == 0) | (jidx == cur) | (jidx == cur - 1))
        score = jnp.where(forced, 1e9, jnp.where(valid, imp, -1e9))
        _, sel = lax.top_k(score, n_sel)
        kg = ks_blk[bi, gi, sel].reshape(B, G, NSA_QBLOCK, n_sel * SLC_LEN, DK)
        vg = vs_blk[bi, gi, sel].reshape(B, G, NSA_QBLOCK, n_sel * SLC_LEN, DK)
        pos = (sel[..., None] * SLC_LEN + jnp.arange(SLC_LEN)).reshape(B, G, NSA_QBLOCK, n_sel * SLC_LEN)
        dist = tq[None, None, :, None] - pos
        s = jnp.einsum('bqghd,bgqkd->bghqk', qb, kg) - slopes[None, :, :, None, None] * dist[:, :, None]
        p = masked_softmax(s, (dist >= 0)[:, :, None])
        o_slc = jnp.einsum('bghqk,bgqkd->bqghd', p, vg.astype(jnp.float32))

        kwb = lax.dynamic_slice_in_dim(kw_pad, t0, NSA_QBLOCK + WINDOW, axis=1)
        vwb = lax.dynamic_slice_in_dim(vw_pad, t0, NSA_QBLOCK + WINDOW, axis=1)
        kpos = t0 - WINDOW + jnp.arange(NSA_QBLOCK + WINDOW)
        dist = tq[:, None] - kpos[None, :]
        wmask = (dist >= 0) & (dist < WINDOW) & (kpos[None, :] >= 0)
        s = jnp.einsum('bqghd,bkgd->bghqk', qb, kwb) - slopes[None, :, :, None, None] * dist
        p = masked_softmax(s, wmask)
        o_win = jnp.einsum('bghqk,bkgd->bqghd', p, vwb.astype(jnp.float32))

        o = gb[..., 0:1] * o_cmp + gb[..., 1:2] * o_slc + gb[..., 2:3] * o_win
        return o.reshape(B, NSA_QBLOCK, NSA_HEADS * NSA_HEAD_DIM).astype(x.dtype)

    out = lax.map(block, jnp.arange(T // NSA_QBLOCK))
    out = out.transpose(1, 0, 2, 3).reshape(B, T, NSA_HEADS * NSA_HEAD_DIM)
    return out @ w_o


def gla_mixer(x, w_in, w_gate2, b_gate2, head_norm_g, w_o):
    B, T, _ = x.shape
    H, C = GLA_HEADS, GLA_CHUNK
    N = T // C
    proj = x @ w_in
    splits = np.cumsum([GLA_KEY_DIM, GLA_KEY_DIM, GLA_VAL_DIM, GLA_VAL_DIM]).tolist()
    q, k, v, g, a_low = jnp.split(proj, splits, axis=-1)
    log_a = jax.nn.log_sigmoid((a_low @ w_gate2 + b_gate2).astype(jnp.float32)) / GLA_GATE_NORM

    def to_chunks(a, d):
        return a.astype(jnp.float32).reshape(B, N, C, H, d).transpose(1, 0, 3, 2, 4)

    qc = to_chunks(q * GLA_DK ** -0.5, GLA_DK)
    kc = to_chunks(k, GLA_DK)
    vc = to_chunks(v, GLA_DV)
    ac = to_chunks(log_a, GLA_DK)
    causal = jnp.tril(jnp.ones((C, C), dtype=bool))
    ref = C // 2

    def step(S, inp):
        qi, ki, vi, ai = inp
        b = jnp.cumsum(ai, axis=2)
        b_ref = b[:, :, ref:ref + 1]
        b_last = b[:, :, -1:]
        A = jnp.einsum('bhid,bhjd->bhij', qi * jnp.exp(b - b_ref), ki * jnp.exp(b_ref - b))
        A = jnp.where(causal, A, 0.0)
        o = jnp.einsum('bhij,bhje->bhie', A, vi) + jnp.einsum('bhid,bhde->bhie', qi * jnp.exp(b), S)
        S = S * jnp.exp(b_last)[:, :, 0, :, None] + jnp.einsum('bhjd,bhje->bhde', ki * jnp.exp(b_last - b), vi)
        return S, o

    S0 = jnp.zeros((B, H, GLA_DK, GLA_DV), jnp.float32)
    _, o = lax.scan(step, S0, (qc, kc, vc, ac))
    o = o.transpose(1, 0, 3, 2, 4).reshape(B, T, H, GLA_DV)
    o = o * lax.rsqrt(jnp.mean(jnp.square(o), -1, keepdims=True) + RMS_EPS)
    o = o.reshape(B, T, GLA_VAL_DIM) * head_norm_g * jax.nn.silu(g.astype(jnp.float32))
    return o.astype(x.dtype) @ w_o


def swiglu(x, w_gu, w_down):
    a, b = jnp.split(x @ w_gu, 2, axis=-1)
    return (jax.nn.silu(a) * b) @ w_down


def moe_ffn(x, w_router, w_gu, w_down):
    logits = (x @ w_router).astype(jnp.float32)
    top_val, top_idx = lax.top_k(logits, TOP_K)
    w = jax.nn.softmax(top_val, axis=-1)
    gate = jnp.sum(jax.nn.one_hot(top_idx, N_EXPERTS, dtype=jnp.float32) * w[..., None], axis=-2)
    y = jnp.zeros(x.shape, jnp.float32)
    for e in range(N_EXPERTS):
        y = y + gate[..., e:e + 1] * swiglu(x, w_gu[e], w_down[e])
    return y.astype(x.dtype)


def setup_inputs(seed: int = 0) -> dict:
    key = jax.random.key(seed)
    ks = jax.random.split(key, 32)
    nrm = lambda k, shape, scale: jax.random.normal(k, shape, jnp.float32) * scale
    gain = lambda k: 1.0 + nrm(k, (D_MODEL,), 0.02)
    bias = lambda k: nrm(k, (D_MODEL,), 0.02)
    L = CMP_LEN * NSA_HEAD_DIM
    return {
        "x": nrm(ks[0], (BATCH, SEQ, D_MODEL), 1.0),
        "l0_w_in": nrm(ks[1], (D_MODEL, NSA_IN_DIM), D_MODEL ** -0.5),
        "l0_cmp_pe_k": nrm(ks[2], (CMP_LEN, NSA_HEAD_DIM), 0.02),
        "l0_cmp_pe_v": nrm(ks[3], (CMP_LEN, NSA_HEAD_DIM), 0.02),
        "l0_cmp_wk1": nrm(ks[4], (L, CMP_HIDDEN), L ** -0.5),
        "l0_cmp_wk2": nrm(ks[5], (CMP_HIDDEN, NSA_HEAD_DIM), CMP_HIDDEN ** -0.5),
        "l0_cmp_wv1": nrm(ks[6], (L, CMP_HIDDEN), L ** -0.5),
        "l0_cmp_wv2": nrm(ks[7], (CMP_HIDDEN, NSA_HEAD_DIM), CMP_HIDDEN ** -0.5),
        "l0_w_o": nrm(ks[8], (D_MODEL, D_MODEL), DN_BETA * D_MODEL ** -0.5),
        "l0_ln1_g": gain(ks[9]),
        "l0_ln1_b": bias(ks[10]),
        "l0_ffn_w_gu": nrm(ks[11], (D_MODEL, 2 * FFN_DENSE), D_MODEL ** -0.5),
        "l0_ffn_w_down": nrm(ks[12], (FFN_DENSE, D_MODEL), DN_BETA * FFN_DENSE ** -0.5),
        "l0_ln2_g": gain(ks[13]),
        "l0_ln2_b": bias(ks[14]),
        "l1_w_in": nrm(ks[15], (D_MODEL, GLA_IN_DIM), D_MODEL ** -0.5),
        "l1_w_gate2": nrm(ks[16], (GLA_GATE_RANK, GLA_KEY_DIM), GLA_GATE_RANK ** -0.5),
        "l1_b_gate2": nrm(ks[17], (GLA_KEY_DIM,), 0.1),
        "l1_head_norm_g": 1.0 + nrm(ks[18], (GLA_VAL_DIM,), 0.02),
        "l1_w_o": nrm(ks[19], (GLA_VAL_DIM, D_MODEL), DN_BETA * GLA_VAL_DIM ** -0.5),
        "l1_ln1_g": gain(ks[20]),
        "l1_ln1_b": bias(ks[21]),
        "l1_router": nrm(ks[22], (D_MODEL, N_EXPERTS), D_MODEL ** -0.5),
        "l1_moe_w_gu": nrm(ks[23], (N_EXPERTS, D_MODEL, 2 * FFN_EXPERT), D_MODEL ** -0.5),
        "l1_moe_w_down": nrm(ks[24], (N_EXPERTS, FFN_EXPERT, D_MODEL), DN_BETA * FFN_EXPERT ** -0.5),
        "l1_ln2_g": gain(ks[25]),
        "l1_ln2_b": bias(ks[26]),
    }


def reference(x, l0_w_in, l0_cmp_pe_k, l0_cmp_pe_v, l0_cmp_wk1, l0_cmp_wk2, l0_cmp_wv1, l0_cmp_wv2,
              l0_w_o, l0_ln1_g, l0_ln1_b, l0_ffn_w_gu, l0_ffn_w_down, l0_ln2_g, l0_ln2_b,
              l1_w_in, l1_w_gate2, l1_b_gate2, l1_head_norm_g, l1_w_o, l1_ln1_g, l1_ln1_b,
              l1_router, l1_moe_w_gu, l1_moe_w_down, l1_ln2_g, l1_ln2_b):
    token_mixers = [
        lambda h: nsa_mixer(h, l0_w_in, l0_cmp_pe_k, l0_cmp_pe_v, l0_cmp_wk1, l0_cmp_wk2,
                            l0_cmp_wv1, l0_cmp_wv2, l0_w_o),
        lambda h: gla_mixer(h, l1_w_in, l1_w_gate2, l1_b_gate2, l1_head_norm_g, l1_w_o),
    ]
    channel_mixers = [
        lambda h: swiglu(h, l0_ffn_w_gu, l0_ffn_w_down),
        lambda h: moe_ffn(h, l1_router, l1_moe_w_gu, l1_moe_w_down),
    ]
    norms1 = [(l0_ln1_g, l0_ln1_b), (l1_ln1_g, l1_ln1_b)]
    norms2 = [(l0_ln2_g, l0_ln2_b), (l1_ln2_g, l1_ln2_b)]
    for i in range(DEPTH):
        x = layer_norm(DN_ALPHA * x + token_mixers[i % N_MIXERS](x), *norms1[i])
        x = layer_norm(DN_ALPHA * x + channel_mixers[i][(0)] if False else DN_ALPHA * x + channel_mixers[i](x), *norms2[i])
    return x
```

```cpp
#include <hip/hip_runtime.h>
#include <cstdio>
#include <cstdint>
namespace pg8 {
#define PG8_LAS __attribute__((address_space(3)))
typedef unsigned short bf16_t;
typedef short bf16x8 __attribute__((ext_vector_type(8)));
typedef float f32x4 __attribute__((ext_vector_type(4)));
typedef unsigned u32x4 __attribute__((ext_vector_type(4)));
constexpr int BM = 256, BK = 64, HALF = 128, HTB = HALF * BK * 2  , STAGE_BYTES = 8 * HTB, NXCD = 8, WGM = 8;

__host__ __device__ __forceinline__ int lds_byte(int r, int c) { const int st = (r >> 4) * 2 + (c >> 5), rr = r & 15, cc = c & 31, ob = rr * 64 + cc * 2; return st * 1024 + (ob ^ (((ob >> 9) & 1) << 5)); }
__host__ __device__ __forceinline__ void stage_rc(int b, int& R, int& C) { const int st = b / 1024, sb = b % 1024, swz = sb ^ (((sb >> 9) & 1) << 5); R = (st >> 1) * 16 + swz / 64; C = (st & 1) * 32 + (swz % 64) / 2; }
__host__ __device__ __forceinline__ int perm32(int rho) { const int n = rho >> 4, i = rho & 15; return 8 * (i >> 2) + 4 * n + (i & 3); }

struct Unit { int pm, pn; };
struct Gemm { const bf16_t* A; const bf16_t* Bt; int M, N, K; };

struct StaticOrder {
    int nM, nN, nwg, G, c;
    __host__ __device__ void init(int M, int N, int G_, int c_) { nM = M / BM; nN = N / BM; nwg = nM * nN; G = G_; c = c_; }
    __host__ __device__ bool next(int i, Unit& u) const {
        const long L = (long)i * G + c; if (L >= nwg) return false;
        int wgid = (int)L; { const int q = nwg / NXCD, r = nwg % NXCD, xcd = wgid % NXCD, off = wgid / NXCD; wgid = (xcd < r ? xcd * (q + 1) : r * (q + 1) + (xcd - r) * q) + off; }
        const int nig = WGM * nN, gid = wgid / nig, fm = gid * WGM, gsz = (nM - fm) < WGM ? (nM - fm) : WGM;
        u.pm = fm + ((wgid % nig) % gsz); u.pn = (wgid % nig) / gsz; return true;
    }
    __device__ __forceinline__ void a_ready(const Unit&) const {}
    __device__ __forceinline__ void done(const Unit&) const {}
};
__device__ __forceinline__ unsigned cvt_pk_bf16(float lo, float hi) { unsigned r; asm volatile("v_cvt_pk_bf16_f32 %0, %1, %2" : "=v"(r) : "v"(lo), "v"(hi)); return r; }
typedef float f32x2 __attribute__((ext_vector_type(2)));
typedef __bf16 bf16x2_t_ __attribute__((ext_vector_type(2)));
__device__ __forceinline__ unsigned cvtpk_c(float lo, float hi) { f32x2 v = {lo, hi}; bf16x2_t_ b = __builtin_convertvector(v, bf16x2_t_); return __builtin_bit_cast(unsigned, b); }
__device__ __forceinline__ u32x4 pack8(const f32x4 v0, const f32x4 v1) { u32x4 w; w.x = cvt_pk_bf16(v0[0], v0[1]); w.y = cvt_pk_bf16(v0[2], v0[3]); w.z = cvt_pk_bf16(v1[0], v1[1]); w.w = cvt_pk_bf16(v1[2], v1[3]); return w; }
__device__ __forceinline__ float sigm(float x) { return 1.0f / (1.0f + __expf(-x)); }
__device__ __forceinline__ float silu1(float x) { return x / (1.0f + __expf(-x)); }

struct EpiNsaIn {
    static constexpr bool PERM = true, AFTER_DRAIN = false;
    bf16_t *Q, *KV2, *KS, *VS, *KW, *VW; float* GT; float qscale;
    __device__ __forceinline__ void operator()(const f32x4 (&acc)[2][2][4][2], const Unit& u, int wr, int wc, int fr, int fq) const {
        const int pn = u.pn, row0 = u.pm * BM + wr * 64 + fr, c8 = wc * 32 + 8 * fq;
#pragma unroll
        for (int ai = 0; ai < 2; ++ai)
#pragma unroll
            for (int m = 0; m < 4; ++m) { const int row = row0 + ai * HALF + m * 16;
#pragma unroll
                for (int bj = 0; bj < 2; ++bj) { const int col = bj * HALF + c8;
                    f32x4 v0 = acc[ai][bj][m][0], v1 = acc[ai][bj][m][1];
                    if (pn >= 10) { if (col < 48) { float* gp = GT + (size_t)row * 48 + col;
                            *(f32x4*)gp = (f32x4){sigm(v0[0]), sigm(v0[1]), sigm(v0[2]), sigm(v0[3])}; *(f32x4*)(gp + 4) = (f32x4){sigm(v1[0]), sigm(v1[1]), sigm(v1[2]), sigm(v1[3])}; }
                        continue; }
                    bf16_t* dst;
                    if (pn < 4) { v0 = v0 * qscale; v1 = v1 * qscale; dst = Q + (size_t)row * 1024 + pn * 256 + col; }
                    else if (pn < 6) { const int g = col >> 6, d = col & 63; dst = KV2 + (size_t)(pn - 4) * (4096 * 1024) + ((size_t)(((row >> 4) * 4 + g) * 16 + (row & 15))) * 64 + d; }
                    else { bf16_t* base = pn == 6 ? KS : pn == 7 ? VS : pn == 8 ? KW : VW; dst = base + (size_t)row * 256 + col; }
                    *(u32x4*)dst = pack8(v0, v1); } }
    }
};
struct EpiGlaIn {
    static constexpr bool PERM = true, AFTER_DRAIN = false;
    bf16_t* QKVG; float* ALOW; float qscale;
    __device__ __forceinline__ void operator()(const f32x4 (&acc)[2][2][4][2], const Unit& u, int wr, int wc, int fr, int fq) const {
        const int pn = u.pn, row0 = u.pm * BM + wr * 64 + fr, c8 = wc * 32 + 8 * fq;
#pragma unroll
        for (int ai = 0; ai < 2; ++ai)
#pragma unroll
            for (int m = 0; m < 4; ++m) { const int row = row0 + ai * HALF + m * 16;
#pragma unroll
                for (int bj = 0; bj < 2; ++bj) { const int col = bj * HALF + c8;
                    f32x4 v0 = acc[ai][bj][m][0], v1 = acc[ai][bj][m][1];
                    if (pn >= 12) { if (col < 16) { float* gp = ALOW + (size_t)row * 16 + col; *(f32x4*)gp = v0; *(f32x4*)(gp + 4) = v1; } continue; }
                    if (pn < 2) { v0 = v0 * qscale; v1 = v1 * qscale; }
                    *(u32x4*)(QKVG + (size_t)row * 3072 + pn * 256 + col) = pack8(v0, v1); } }
    }
};
struct EpiF32Cmp {
    static constexpr bool PERM = false, AFTER_DRAIN = false;
    float* C;
    __device__ __forceinline__ void operator()(const f32x4 (&acc)[2][2][4][2], const Unit& u, int wr, int wc, int fr, int fq) const {
        const int row0 = u.pm * BM + wr * 64 + fr, col0 = (u.pn & 1) * BM + wc * 32 + 4 * fq;
#pragma unroll
        for (int ai = 0; ai < 2; ++ai)
#pragma unroll
            for (int m = 0; m < 4; ++m) { float* rowp = C + (size_t)(row0 + ai * HALF + m * 16) * 512 + col0;
#pragma unroll
                for (int bj = 0; bj < 2; ++bj)
#pragma unroll
                    for (int n = 0; n < 2; ++n) *(f32x4*)(rowp + bj * HALF + n * 16) = acc[ai][bj][m][n]; }
    }
};
struct EpiResF32 {
    static constexpr bool PERM = false, AFTER_DRAIN = false;
    const float* base; float* out; float alpha;
    __device__ __forceinline__ void operator()(const f32x4 (&acc)[2][2][4][2], const Unit& u, int wr, int wc, int fr, int fq) const {
        const int row0 = u.pm * BM + wr * 64 + fr, col0 = u.pn * BM + wc * 32 + 4 * fq;
#pragma unroll
        for (int ai = 0; ai < 2; ++ai)
#pragma unroll
            for (int m = 0; m < 4; ++m) { const size_t off = (size_t)(row0 + ai * HALF + m * 16) * 1024 + col0;
#pragma unroll
                for (int bj = 0; bj < 2; ++bj)
#pragma unroll
                    for (int n = 0; n < 2; ++n) { const f32x4 bs = *(const f32x4*)(base + off + bj * HALF + n * 16); *(f32x4*)(out + off + bj * HALF + n * 16) = bs * alpha + acc[ai][bj][m][n]; } }
    }
};
struct EpiSwiGLU {
    static constexpr bool PERM = true, AFTER_DRAIN = false;
    bf16_t* H; int ldh, nt;
    __device__ __forceinline__ void operator()(const f32x4 (&acc)[2][2][4][2], const Unit& u, int wr, int wc, int fr, int fq) const {
        const int row0 = u.pm * BM + wr * 64 + fr, col = (u.pn % nt) * HALF + wc * 32 + 8 * fq;
#pragma unroll
        for (int ai = 0; ai < 2; ++ai)
#pragma unroll
            for (int m = 0; m < 4; ++m) { const f32x4 a0 = acc[ai][0][m][0], a1 = acc[ai][0][m][1], b0 = acc[ai][1][m][0], b1 = acc[ai][1][m][1];
                const f32x4 h0 = (f32x4){silu1(a0[0]) * b0[0], silu1(a0[1]) * b0[1], silu1(a0[2]) * b0[2], silu1(a0[3]) * b0[3]};
                const f32x4 h1 = (f32x4){silu1(a1[0]) * b1[0], silu1(a1[1]) * b1[1], silu1(a1[2]) * b1[2], silu1(a1[3]) * b1[3]};
                *(u32x4*)(H + (size_t)(row0 + ai * HALF + m * 16) * ldh + col) = pack8(h0, h1); }
    }
};
struct EpiBf16Y {
    static constexpr bool PERM = true, AFTER_DRAIN = false;
    bf16_t* Y;
    __device__ __forceinline__ void operator()(const f32x4 (&acc)[2][2][4][2], const Unit& u, int wr, int wc, int fr, int fq) const {
        const int row0 = u.pm * BM + wr * 64 + fr, col0 = (u.pn & 3) * BM + wc * 32 + 8 * fq;
#pragma unroll
        for (int ai = 0; ai < 2; ++ai)
#pragma unroll
            for (int m = 0; m < 4; ++m) { bf16_t* rowp = Y + (size_t)(row0 + ai * HALF + m * 16) * 1024 + col0;
#pragma unroll
                for (int bj = 0; bj < 2; ++bj) *(u32x4*)(rowp + bj * HALF) = pack8(acc[ai][bj][m][0], acc[ai][bj][m][1]); }
    }
};
struct CmpOrder {
    int G, c;
    __device__ __forceinline__ bool next(int i, Unit& u) const { const long L = (long)i * G + c; if (L >= 64) return false; const int pm = (int)L >> 1; u.pm = pm; u.pn = (pm >> 4) * 2 + ((int)L & 1); return true; }
    __device__ __forceinline__ void a_ready(const Unit&) const {}
    __device__ __forceinline__ void done(const Unit&) const {}
};
struct GroupedOrder {
    int G, c, NT; const PG8_LAS int* tp;
    __device__ __forceinline__ bool next(int i, Unit& u) const {
        const int nwg = tp[8] * NT; const long L = (long)i * G + c; if (L >= nwg) return false;
        int wgid = (int)L; { const int q = nwg / NXCD, r = nwg % NXCD, xcd = wgid % NXCD, off = wgid / NXCD; wgid = (xcd < r ? xcd * (q + 1) : r * (q + 1) + (xcd - r) * q) + off; }
        int e = 0;
#pragma unroll
        for (int k = 1; k < 8; ++k) if (wgid >= tp[k] * NT) e = k;
        const int t0 = tp[e], nte = tp[e + 1] - t0, l = wgid - t0 * NT, nig = WGM * NT, gid = l / nig, fm = gid * WGM, gsz = (nte - fm) < WGM ? (nte - fm) : WGM;
        u.pm = t0 + fm + ((l % nig) % gsz); u.pn = e * NT + (l % nig) / gsz; return true;
    }
    __device__ __forceinline__ void a_ready(const Unit&) const {}
    __device__ __forceinline__ void done(const Unit&) const {}
};
template <class Epi, class Sched, bool ALIGN_EPI = false, bool SP2 = false>
__device__ __forceinline__ void gemm_phase(PG8_LAS unsigned char* lds, const Gemm g, const Sched& S, const Epi& E) {
    const int tid = threadIdx.x, wid = __builtin_amdgcn_readfirstlane(tid >> 6), lane = tid & 63, wr = wid >> 2, wc = wid & 3, fr = lane & 15, fq = lane >> 4;
    const int K = g.K, nt = K / BK;
    unsigned voffA[2], voffB[2];
#pragma unroll
    for (int i = 0; i < 2; ++i) { int R, C; stage_rc(tid * 16 + i * 8192, R, C); const int Rb = Epi::PERM ? ((R & ~31) + perm32(R & 31)) : R;
        voffA[i] = (unsigned)(R * K + C) * 2u; voffB[i] = (unsigned)(Rb * K + C) * 2u; }
    const size_t kstep = (size_t)(BK * 2);
    const size_t hstep = (size_t)HALF * K * 2;
    const size_t tstep = 2 * hstep;
    const unsigned ldsw = (unsigned)wid * 1024u;
    const int aoff = lds_byte(wr * 64 + fr, fq * 8), boff = lds_byte(wc * 32 + fr, fq * 8);
#define PG8_SA(b, h) (((b) * 2 + (h)) * HTB)
#define PG8_SB(b, h) ((4 + (b) * 2 + (h)) * HTB)
#define PG8_STAGE(bufoff, gbase, voff) do { _Pragma("unroll") for (int _i = 0; _i < 2; ++_i) \
        __builtin_amdgcn_global_load_lds((const unsigned*)((const char*)(gbase) + (voff)[_i]), (PG8_LAS unsigned*)(lds + (bufoff) + ldsw + _i * 8192), 16, 0, 0); } while (0)
#define PG8_LDA(dst, b, h) do { _Pragma("unroll") for (int m = 0; m < 4; ++m) _Pragma("unroll") for (int k = 0; k < 2; ++k) dst[m][k] = *(const PG8_LAS bf16x8*)(lds + PG8_SA(b, h) + aoff + m * 2048 + k * 1024); } while (0)
#define PG8_LDB(dst, b, h) do { _Pragma("unroll") for (int n = 0; n < 2; ++n) _Pragma("unroll") for (int k = 0; k < 2; ++k) dst[n][k] = *(const PG8_LAS bf16x8*)(lds + PG8_SB(b, h) + boff + n * 2048 + k * 1024); } while (0)
#define PG8_MMA(ai, bj, At, Bt) do { __builtin_amdgcn_s_setprio(1); _Pragma("unroll") for (int m = 0; m < 4; ++m) _Pragma("unroll") for (int n = 0; n < 2; ++n) _Pragma("unroll") for (int k = 0; k < 2; ++k) \
        acc[ai][bj][m][n] = __builtin_amdgcn_mfma_f32_16x16x32_bf16(Bt[n][k], At[m][k], acc[ai][bj][m][n], 0, 0, 0); __builtin_amdgcn_s_setprio(0); } while (0)
#define PG8_WAIT_V(n) asm volatile("s_waitcnt vmcnt(" #n ")" ::: "memory")
#define PG8_WAIT_L(n) asm volatile("s_waitcnt lgkmcnt(" #n ")" ::: "memory")
#define PG8_BAR __builtin_amdgcn_s_barrier()
#define PG8_SCHED __builtin_amdgcn_sched_barrier(0)
    Unit cur, nxt; int ui = 0;
    if (!S.next(0, cur)) return;
    f32x4 acc[2][2][4][2];
#pragma unroll
    for (int a = 0; a < 2; ++a)
#pragma unroll
        for (int b = 0; b < 2; ++b)
#pragma unroll
            for (int m = 0; m < 4; ++m)
#pragma unroll
                for (int n = 0; n < 2; ++n) acc[a][b][m][n] = (f32x4){0.f, 0.f, 0.f, 0.f};
    bf16x8 At[4][2], B0[2][2], B1[2][2];
    const char* cA = (const char*)g.A + (size_t)cur.pm * tstep; const char* cB = (const char*)g.Bt + (size_t)cur.pn * tstep;
    S.a_ready(cur);
    if constexpr (SP2) {
        PG8_STAGE(PG8_SB(0, 0), cB, voffB); PG8_STAGE(PG8_SB(0, 1), cB + hstep, voffB); PG8_STAGE(PG8_SA(0, 0), cA, voffA); PG8_STAGE(PG8_SA(0, 1), cA + hstep, voffA);
        if (wr == 1) PG8_BAR;
        PG8_WAIT_V(2); PG8_BAR;
        PG8_STAGE(PG8_SB(1, 0), cB + kstep, voffB); PG8_STAGE(PG8_SA(1, 0), cA + kstep, voffA); PG8_STAGE(PG8_SB(1, 1), cB + hstep + kstep, voffB);
        PG8_WAIT_V(6); PG8_BAR;
    } else {
        PG8_STAGE(PG8_SB(0, 0), cB, voffB); PG8_STAGE(PG8_SA(0, 0), cA, voffA); PG8_STAGE(PG8_SB(0, 1), cB + hstep, voffB); PG8_STAGE(PG8_SA(0, 1), cA + hstep, voffA);
        if (wr == 1) PG8_BAR;
        PG8_WAIT_V(4); PG8_BAR;
        PG8_STAGE(PG8_SB(1, 0), cB + kstep, voffB); PG8_STAGE(PG8_SA(1, 0), cA + kstep, voffA); PG8_STAGE(PG8_SB(1, 1), cB + hstep + kstep, voffB);
        PG8_WAIT_V(6); PG8_BAR;
    }
    for (;;) {
        const bool has_next = S.next(ui + 1, nxt);
        const char* nA = has_next ? (const char*)g.A + (size_t)nxt.pm * tstep : cA; const char* nB = has_next ? (const char*)g.Bt + (size_t)nxt.pn * tstep : cB;
        for (int t = 0; t < nt; t += 2) {
            const bool last = (t == nt - 2);
            const char* a1 = cA + (size_t)(t + 1) * kstep;
            const char* a2 = last ? nA : cA + (size_t)(t + 2) * kstep; const char* b2 = last ? nB : cB + (size_t)(t + 2) * kstep;
            const char* a3 = a2 + kstep; const char* b3 = b2 + kstep;
            if (last && has_next) S.a_ready(nxt);
            if constexpr (SP2) {
            PG8_LDB(B0, 0, 0); PG8_LDB(B1, 0, 1); PG8_SCHED; PG8_LDA(At, 0, 0); PG8_STAGE(PG8_SA(1, 1), a1 + hstep, voffA);
            PG8_WAIT_V(8); PG8_WAIT_L(0); PG8_BAR; PG8_MMA(0, 0, At, B0); PG8_MMA(0, 1, At, B1); PG8_BAR; PG8_SCHED;
            PG8_LDA(At, 0, 1); PG8_STAGE(PG8_SB(0, 0), b2, voffB); PG8_STAGE(PG8_SB(0, 1), b2 + hstep, voffB); PG8_STAGE(PG8_SA(0, 0), a2, voffA);
            PG8_WAIT_V(8); PG8_WAIT_L(0); PG8_BAR; PG8_MMA(1, 0, At, B0); PG8_MMA(1, 1, At, B1); PG8_BAR; PG8_SCHED;
            PG8_LDB(B0, 1, 0); PG8_LDB(B1, 1, 1); PG8_SCHED; PG8_LDA(At, 1, 0); PG8_STAGE(PG8_SA(0, 1), a2 + hstep, voffA);
            PG8_WAIT_V(8); PG8_WAIT_L(0); PG8_BAR; PG8_MMA(0, 0, At, B0); PG8_MMA(0, 1, At, B1); PG8_BAR; PG8_SCHED;
            PG8_LDA(At, 1, 1); PG8_STAGE(PG8_SB(1, 0), b3, voffB); PG8_STAGE(PG8_SB(1, 1), b3 + hstep, voffB); PG8_STAGE(PG8_SA(1, 0), a3, voffA);
            PG8_WAIT_V(8); PG8_WAIT_L(0); PG8_BAR; PG8_MMA(1, 0, At, B0); PG8_MMA(1, 1, At, B1); PG8_BAR; PG8_SCHED;
            } else {
            PG8_LDB(B0, 0, 0); PG8_SCHED; PG8_LDA(At, 0, 0); PG8_STAGE(PG8_SA(1, 1), a1 + hstep, voffA);
            PG8_WAIT_L(8); PG8_BAR; PG8_WAIT_L(0); PG8_MMA(0, 0, At, B0); PG8_BAR; PG8_SCHED;
            PG8_LDB(B1, 0, 1); PG8_STAGE(PG8_SB(0, 0), b2, voffB);
            PG8_BAR; PG8_WAIT_L(0); PG8_MMA(0, 1, At, B1); PG8_BAR;
            PG8_LDA(At, 0, 1); PG8_STAGE(PG8_SA(0, 0), a2, voffA);
            PG8_BAR; PG8_WAIT_L(0); PG8_MMA(1, 0, At, B0); PG8_BAR; PG8_SCHED;
            PG8_STAGE(PG8_SB(0, 1), b2 + hstep, voffB);
            PG8_WAIT_V(6); PG8_BAR; PG8_MMA(1, 1, At, B1); PG8_BAR;
            PG8_LDB(B0, 1, 0); PG8_SCHED; PG8_LDA(At, 1, 0); PG8_STAGE(PG8_SA(0, 1), a2 + hstep, voffA);
            PG8_WAIT_L(8); PG8_BAR; PG8_WAIT_L(0); PG8_MMA(0, 0, At, B0); PG8_BAR; PG8_SCHED;
            PG8_LDB(B1, 1, 1); PG8_STAGE(PG8_SB(1, 0), b3, voffB);
            PG8_BAR; PG8_WAIT_L(0); PG8_MMA(0, 1, At, B1); PG8_BAR;
            PG8_LDA(At, 1, 1); PG8_STAGE(PG8_SA(1, 0), a3, voffA);
            PG8_BAR; PG8_WAIT_L(0); PG8_MMA(1, 0, At, B0); PG8_BAR; PG8_SCHED;
            PG8_STAGE(PG8_SB(1, 1), b3 + hstep, voffB);
            PG8_WAIT_V(6); PG8_BAR; PG8_MMA(1, 1, At, B1); PG8_BAR;
            }
        }
        if constexpr (ALIGN_EPI) { if (wr == 0) PG8_BAR; }
        if constexpr (!Epi::AFTER_DRAIN) { E(acc, cur, wr, wc, fr, fq); S.done(cur); }
        if (!has_next) break;
#pragma unroll
        for (int a = 0; a < 2; ++a)
#pragma unroll
            for (int b = 0; b < 2; ++b)
#pragma unroll
                for (int m = 0; m < 4; ++m)
#pragma unroll
                    for (int n = 0; n < 2; ++n) acc[a][b][m][n] = (f32x4){0.f, 0.f, 0.f, 0.f};
        cur = nxt; cA = nA; cB = nB; ++ui;
        if constexpr (ALIGN_EPI) { if (wr == 1) PG8_BAR; }
    }
    PG8_WAIT_V(0);
    if constexpr (!ALIGN_EPI) { if (wr == 0) PG8_BAR; }
    PG8_BAR;
    if constexpr (Epi::AFTER_DRAIN) { E.fused(acc, cur, wr, wc, fr, fq, lds, wid, lane); S.done(cur); }
#undef PG8_SA
#undef PG8_SB
#undef PG8_STAGE
#undef PG8_LDA
#undef PG8_LDB
#undef PG8_MMA
#undef PG8_WAIT_V
#undef PG8_WAIT_L
#undef PG8_BAR
#undef PG8_SCHED
}
}
#ifndef PG8_SP2
#define PG8_SP2 true
#endif
#ifndef PG8_ALIGN
#define PG8_ALIGN true
#endif
#define GAS __attribute__((address_space(1)))
#define LAS __attribute__((address_space(3)))
typedef unsigned short bf16;
typedef unsigned v4u __attribute__((ext_vector_type(4)));
typedef float f32x4 __attribute__((ext_vector_type(4)));
typedef short bf16x8 __attribute__((ext_vector_type(8)));
typedef GAS unsigned gu32;
typedef GAS unsigned long long gu64;
#define RLX_AGENT __ATOMIC_RELAXED, __HIP_MEMORY_SCOPE_AGENT
#define LDS_WAIT() asm volatile("s_waitcnt lgkmcnt(0)" ::: "memory")
#define VM_WAIT() asm volatile("s_waitcnt vmcnt(0)" ::: "memory")
__device__ __forceinline__ unsigned long long rt() { return __builtin_amdgcn_s_memrealtime(); }
__device__ __forceinline__ unsigned f2bf(float f) { unsigned u = __builtin_bit_cast(unsigned, f); return (u + 0x7fffu + ((u >> 16) & 1u)) >> 16; }
__device__ __forceinline__ unsigned pk2(float lo, float hi) { return f2bf(lo) | (f2bf(hi) << 16); }

#define XB_TMO      128
#define XB_XCNT(j)  (256  + 64 * (j))
#define XB_XSUB(j)  (1280 + 64 * (j))
#define XB_XGEN(j)  (2304 + 64 * (j))
#define XB_TOP      3328
#define XB_TOPGEN   3392
#define XCD_BAR_WORDS 3456
#define XB_SPIN_CAP (1u << 18)

__device__ __forceinline__ unsigned xb_ld(unsigned* p)              { return __hip_atomic_load(p, __ATOMIC_RELAXED, __HIP_MEMORY_SCOPE_AGENT); }
__device__ __forceinline__ unsigned xb_add(unsigned* p, unsigned v) { return __hip_atomic_fetch_add(p, v, __ATOMIC_RELAXED, __HIP_MEMORY_SCOPE_AGENT); }
__device__ __forceinline__ unsigned xb_xcc_id() { return (unsigned)__builtin_amdgcn_s_getreg((3 << 11) | 20) & 0xFu; }
#define XB_SPIN(cond, bar) do { unsigned _sp = 0; while (cond) { __builtin_amdgcn_s_sleep(1); \
    if ((++_sp & 255u) == 0u) { if (xb_ld(&(bar)[XB_TMO])) break; if (_sp > XB_SPIN_CAP) { atomicAdd(&(bar)[XB_TMO], 1u); break; } } } } while (0)

struct XcdBarrier {
    unsigned* bar; unsigned x;
    volatile LAS unsigned* st;
};

__device__ __forceinline__ XcdBarrier xcd_barrier_post(unsigned* bar, volatile LAS unsigned* st) {
    XcdBarrier b; b.bar = bar; b.x = xb_xcc_id(); b.st = st;
    if (threadIdx.x == 0) (void)xb_add(&bar[XB_XCNT(b.x)], 1u);
    return b;
}
__device__ __forceinline__ void xcd_barrier_complete(unsigned* bar, unsigned x, unsigned& nloc, unsigned& nx) {
    const unsigned G = gridDim.x * gridDim.y * gridDim.z;
    unsigned sum, cnt, mine, sp = 0u;
    for (;;) {
        sum = 0u; cnt = 0u; mine = 0u;
#pragma unroll
        for (unsigned j = 0; j < 16; ++j) { const unsigned c = xb_ld(&bar[XB_XCNT(j)]); sum += c; cnt += (c > 0u) ? 1u : 0u; mine = (j == x) ? c : mine; }
        if (sum == G) break;
        __builtin_amdgcn_s_sleep(1);
        if ((++sp & 255u) == 0u) { if (xb_ld(&bar[XB_TMO])) break; if (sp > XB_SPIN_CAP) { atomicAdd(&bar[XB_TMO], 1u); break; } }
    }
    nloc = mine > 0u ? mine : 1u; nx = cnt > 0u ? cnt : 1u;
}

__device__ __forceinline__ void xcd_barrier(const XcdBarrier& b) {
    asm volatile("s_waitcnt vmcnt(0)" ::: "memory");
    __syncthreads();
    if (threadIdx.x == 0) {
        unsigned* bar = b.bar;
        __builtin_amdgcn_s_waitcnt(0);
        unsigned nloc = b.st[0], nx = b.st[1];
        if (nloc == 0u) { xcd_barrier_complete(bar, b.x, nloc, nx); b.st[0] = nloc; b.st[1] = nx; }
        const unsigned old = xb_add(&bar[XB_XSUB(b.x)], 1u);
        const unsigned gen = old / nloc;
        if (old + 1u == (gen + 1u) * nloc) {
            __builtin_amdgcn_fence(__ATOMIC_RELEASE, "agent");
            asm volatile("s_waitcnt vmcnt(0)" ::: "memory");
            const unsigned og = xb_add(&bar[XB_TOP], 1u);
            const unsigned tg = og / nx;
            if (og + 1u == (tg + 1u) * nx) xb_add(&bar[XB_TOPGEN], 1u);
            else XB_SPIN(xb_ld(&bar[XB_TOPGEN]) == tg, bar);
            __builtin_amdgcn_fence(__ATOMIC_ACQUIRE, "agent");
            xb_add(&bar[XB_XGEN(b.x)], 1u);
            asm volatile("s_waitcnt vmcnt(0)" ::: "memory");
        } else {
            XB_SPIN(xb_ld(&bar[XB_XGEN(b.x)]) == gen, bar);
            __builtin_amdgcn_fence(__ATOMIC_ACQUIRE, "agent");
            asm volatile("s_waitcnt vmcnt(0)" ::: "memory");
        }
    }
    __syncthreads();
}
constexpr int NWAVES = 8;
#ifndef MK_PER_PHASE
#define MK_PER_PHASE 0
#endif
constexpr int N_PHASES = 20;

constexpr int BATCH = 2, T = 8192, D = 1024, M = BATCH * T;
constexpr int NSA_IN = 2608, NSA_IN_PAD = 2816, FF0 = 2816, GLA_IN = 3088, GLA_IN_PAD = 3328, FFE = 3584, NE = 8;
constexpr int NCMP = 511, MAXTILES = 136, MAXSLOTS = MAXTILES * 256;
constexpr float ALPHA = 1.41421356237309515f;
constexpr float LN_EPS = 1e-5f, RMS_EPS = 1e-6f, LOG2E = 1.44269504088896341f;

constexpr size_t MiB = 1u << 20;
constexpr size_t WS_CTL = 0, CTL_ZERO_BYTES = 1 * MiB;
constexpr size_t WS_PB = 1 * MiB;
constexpr size_t WS_CNTL = WS_PB + 32768;
constexpr size_t WS_TOKE = WS_CNTL + 16384;
constexpr size_t WS_TOKW = WS_TOKE + (size_t)M * 8;
constexpr size_t WS_TOKP = WS_TOKW + (size_t)M * 8;
constexpr size_t WS_TOKS = WS_TOKP + (size_t)M * 8;
static_assert(WS_TOKS + (size_t)M * 8 <= 2 * MiB, "misc region");
constexpr size_t WS_WIN0 = 2 * MiB, WS_W1C = 8 * MiB, WS_WO0 = 10 * MiB, WS_WGU0 = 12 * MiB, WS_WD0 = 23 * MiB, WS_WIN1 = 29 * MiB, WS_WO1 = 36 * MiB, WS_WGU1 = 38 * MiB, WS_WD1 = 150 * MiB;
constexpr size_t WS_XB = 206 * MiB, WS_XRES = 238 * MiB, WS_T0 = 302 * MiB, WS_SCR = 366 * MiB;
constexpr size_t WS_Q = WS_SCR, WS_KV2 = WS_SCR + 32 * MiB, WS_KS = WS_SCR + 48 * MiB, WS_VS = WS_SCR + 56 * MiB, WS_KW = WS_SCR + 64 * MiB, WS_VW = WS_SCR + 72 * MiB;
constexpr size_t WS_GT = WS_SCR + 80 * MiB, WS_UL = WS_SCR + 83 * MiB, WS_KCMP = WS_SCR + 99 * MiB, WS_VCMP = WS_KCMP + 512 * 1024, WS_O = WS_SCR + 100 * MiB, WS_H0 = WS_SCR + 132 * MiB;
constexpr size_t WS_QKVG = WS_SCR, WS_ALOW = WS_SCR + 96 * MiB, WS_BCUM = WS_SCR + 97 * MiB, WS_ZB = WS_SCR + 129 * MiB, WS_DEC = WS_SCR + 257 * MiB, WS_SST = WS_SCR + 258 * MiB, WS_O1 = WS_SCR + 322 * MiB;
constexpr size_t WS_XG = WS_SCR, WS_YB = WS_SCR + 68 * MiB, WS_H2 = WS_SCR + 136 * MiB, WS_END = WS_H2 + (size_t)MAXSLOTS * FFE * 2;
static_assert(WS_H0 + (size_t)M * FF0 * 2 <= 896 * MiB && WS_O1 + 32 * MiB <= 896 * MiB && WS_END <= 896 * MiB, "d_ws map");
constexpr int CW_TMO = 0, CW_CODE = 1, CW_BAR = 4096;

constexpr int RING_OFF = 0, RING_BYTES = 131072;
constexpr int LDSCTL_OFF = RING_BYTES, MISC_OFF = LDSCTL_OFF + 320;
constexpr int LDS_BYTES = 147456;
typedef float f32x16 __attribute__((ext_vector_type(16)));
typedef short v4i16 __attribute__((ext_vector_type(4)));
typedef unsigned v2u __attribute__((ext_vector_type(2)));
struct Frame {
    LAS unsigned char* lds;
    volatile LAS unsigned* MISC;
    gu32* ctl;
    int tid, lane, wave;
    int vcu, G, wg;
    const float* in[27];
    unsigned char* ws; float* out;
};
__device__ __forceinline__ float wave_sum(float v) {
#pragma unroll
    for (int o = 1; o < 64; o <<= 1) v += __shfl_xor(v, o);
    return v;
}
__device__ __forceinline__ float bf2f(bf16 h) { return __uint_as_float((unsigned)h << 16); }
__device__ __forceinline__ v4i16 vtr(const LAS unsigned char* p) { return __builtin_amdgcn_ds_read_tr16_b64_v4i16((LAS v4i16*)p); }
__device__ __forceinline__ int crow(int r, int hi) { return (r & 3) + 8 * (r >> 2) + 4 * hi; }

__device__ __forceinline__ void tr_item(const float* src, int ldn, int nvalid, int k0, int n0, bf16* dst, int dld, int drow0, LAS float* scr, int lane) {
    const int n_ = n0 + (lane & 31); const bool ok = n_ < nvalid;
#pragma unroll 8
    for (int i = 0; i < 32; ++i) { const int kk = 2 * i + (lane >> 5); scr[kk * 33 + (lane & 31)] = ok ? src[(size_t)(k0 + kk) * ldn + n_] : 0.f; }
    LDS_WAIT(); asm volatile("" ::: "memory");
    const int c = lane & 7;
#pragma unroll
    for (int j = 0; j < 4; ++j) { const int n = (lane >> 3) + 8 * j; const LAS float* s = scr + (8 * c) * 33 + n;
        v4u o; o.x = pk2(s[0 * 33], s[1 * 33]); o.y = pk2(s[2 * 33], s[3 * 33]); o.z = pk2(s[4 * 33], s[5 * 33]); o.w = pk2(s[6 * 33], s[7 * 33]);
        *(GAS v4u*)(dst + (size_t)(drow0 + n) * dld + k0 + 8 * c) = o; }
    LDS_WAIT(); asm volatile("" ::: "memory");
}
__device__ __forceinline__ int swiglu_row(int n0, int F_) { return n0 < F_ ? (n0 / 128) * 256 + (n0 % 128) : ((n0 - F_) / 128) * 256 + 128 + ((n0 - F_) % 128); }
__device__ __forceinline__ void p0_prologue(Frame& F) {
    LAS float* scr = (LAS float*)(F.lds + RING_OFF + F.wave * 16384);
    const int gw = F.vcu * NWAVES + F.wave, NGW = F.G * NWAVES, lane = F.lane;
    unsigned char* ws = F.ws;
    constexpr int I_IN0 = 16 * (NSA_IN_PAD / 32), I_W1 = 4 * 16 * 8, I_WO = 16 * 32, I_GU0 = 16 * (2 * FF0 / 32), I_D0 = (FF0 / 64) * 32, I_IN1 = 16 * (GLA_IN_PAD / 32);
    constexpr int I_GU1E = 16 * (2 * FFE / 32), I_D1E = (FFE / 64) * 32, I_GU1 = NE * I_GU1E, I_D1 = NE * I_D1E;
    constexpr int NITEMS = I_IN0 + I_W1 + I_WO + I_GU0 + I_D0 + I_IN1 + I_WO + I_GU1 + I_D1;
    for (int it = gw; it < NITEMS; it += NGW) {
        int r = it;
        if (r < I_IN0) { constexpr int nnb = NSA_IN_PAD / 32; const int kb = r / nnb, nb = r % nnb; tr_item(F.in[1], NSA_IN, NSA_IN, 64 * kb, 32 * nb, (bf16*)(ws + WS_WIN0), 1024, 32 * nb, scr, lane); continue; } r -= I_IN0;
        if (r < I_W1) { const int blk = r / 128, q = r % 128, kb = q / 8, nb = q % 8;
            const float* src = ((blk >> 1) ? F.in[6] : F.in[4]) + (size_t)(blk & 1) * 1024 * 256; tr_item(src, 256, 256, 64 * kb, 32 * nb, (bf16*)(ws + WS_W1C), 1024, 256 * blk + 32 * nb, scr, lane); continue; } r -= I_W1;
        if (r < I_WO) { const int kb = r / 32, nb = r % 32; tr_item(F.in[8], 1024, 1024, 64 * kb, 32 * nb, (bf16*)(ws + WS_WO0), 1024, 32 * nb, scr, lane); continue; } r -= I_WO;
        if (r < I_GU0) { constexpr int nnb = 2 * FF0 / 32; const int kb = r / nnb, nb = r % nnb; tr_item(F.in[11], 2 * FF0, 2 * FF0, 64 * kb, 32 * nb, (bf16*)(ws + WS_WGU0), 1024, swiglu_row(32 * nb, FF0), scr, lane); continue; } r -= I_GU0;
        if (r < I_D0) { const int kb = r / 32, nb = r % 32; tr_item(F.in[12], 1024, 1024, 64 * kb, 32 * nb, (bf16*)(ws + WS_WD0), FF0, 32 * nb, scr, lane); continue; } r -= I_D0;
        if (r < I_IN1) { constexpr int nnb = GLA_IN_PAD / 32; const int kb = r / nnb, nb = r % nnb; tr_item(F.in[15], GLA_IN, GLA_IN, 64 * kb, 32 * nb, (bf16*)(ws + WS_WIN1), 1024, 32 * nb, scr, lane); continue; } r -= I_IN1;
        if (r < I_WO) { const int kb = r / 32, nb = r % 32; tr_item(F.in[19], 1024, 1024, 64 * kb, 32 * nb, (bf16*)(ws + WS_WO1), 1024, 32 * nb, scr, lane); continue; } r -= I_WO;
        if (r < I_GU1) { constexpr int nnb = 2 * FFE / 32; const int e = r / I_GU1E, q = r % I_GU1E, kb = q / nnb, nb = q % nnb;
            tr_item(F.in[23] + (size_t)e * 1024 * 2 * FFE, 2 * FFE, 2 * FFE, 64 * kb, 32 * nb, (bf16*)(ws + WS_WGU1) + (size_t)e * 2 * FFE * 1024, 1024, swiglu_row(32 * nb, FFE), scr, lane); continue; } r -= I_GU1;
        { const int e = r / I_D1E, q = r % I_D1E, kb = q / 32, nb = q % 32;
            tr_item(F.in[24] + (size_t)e * FFE * 1024, 1024, 1024, 64 * kb, 32 * nb, (bf16*)(ws + WS_WD1) + (size_t)e * 1024 * FFE, FFE, 32 * nb, scr, lane); }
    }
    { const float* x = F.in[0]; bf16* xb = (bf16*)(ws + WS_XB);
      for (int m = gw; m < M; m += NGW) { const GAS f32x4* xr = (const GAS f32x4*)(x + (size_t)m * D) + lane; GAS unsigned long long* o8 = (GAS unsigned long long*)(xb + (size_t)m * D) + lane;
#pragma unroll
          for (int j = 0; j < 4; ++j) { const f32x4 v = xr[64 * j]; o8[64 * j] = (unsigned long long)pk2(v.x, v.y) | ((unsigned long long)pk2(v.z, v.w) << 32); } } }
    { float* pb = (float*)(ws + WS_PB);
      for (int task = gw; task < 64; task += NGW) { const int rp = task & 7, cb = (task >> 3) & 3, kv = task >> 5; const float* pe = kv ? F.in[3] : F.in[2]; const float* w1 = kv ? F.in[6] : F.in[4]; const int c = 64 * cb + lane;
          float a = 0.f;
          for (int r = 256 * rp; r < 256 * rp + 256; ++r) a += pe[r] * w1[(size_t)r * 256 + c];
          pb[rp * 512 + kv * 256 + c] = a; } }
}

__device__ __forceinline__ float gelu_tanh(float x) { const float y = 0.7978845608028654f * (x + 0.044715f * x * x * x); const float e = __expf(2.f * y); const float th = 1.f - 2.f / (e + 1.f); return 0.5f * x * (1.f + th); }
__device__ __forceinline__ void cmp_finish(Frame& F) {
    const int gw = F.vcu * NWAVES + F.wave, NGW = F.G * NWAVES, lane = F.lane;
    LAS float* hb = (LAS float*)(F.lds + RING_OFF + F.wave * 1024);
    const float* ul = (const float*)(F.ws + WS_UL); const float* pb = (const float*)(F.ws + WS_PB);
    for (int task = gw; task < 8192; task += NGW) {
        const int kv = task >> 12, rem = task & 4095, b = rem >> 11, n = (rem >> 2) & 511, g = rem & 3;
        bf16* dst = (bf16*)(F.ws + (kv ? WS_VCMP : WS_KCMP)) + ((size_t)((b * 4 + g) * 512 + n)) * 64;
        if (n == 511) { dst[lane] = 0; continue; }
        const size_t rowU = (size_t)kv * 4096 + (size_t)(b * 512 + n) * 4 + g, rowL = rowU + 4;
        const f32x4 u = *(const f32x4*)(ul + rowU * 512 + lane * 4), lw = *(const f32x4*)(ul + rowL * 512 + 256 + lane * 4);
        f32x4 bs = (f32x4){0.f, 0.f, 0.f, 0.f};
#pragma unroll
        for (int rp = 0; rp < 8; ++rp) bs += *(const f32x4*)(pb + rp * 512 + kv * 256 + lane * 4);
        const f32x4 pre = u + lw + bs;
        *(LAS f32x4*)(hb + lane * 4) = (f32x4){gelu_tanh(pre[0]), gelu_tanh(pre[1]), gelu_tanh(pre[2]), gelu_tanh(pre[3])};
        LDS_WAIT(); asm volatile("" ::: "memory");
        const float* w2 = kv ? F.in[7] : F.in[5]; float a = 0.f;
#pragma unroll 8
        for (int c = 0; c < 256; ++c) a += hb[c] * w2[c * 64 + lane];
        dst[lane] = (bf16)f2bf(a);
        LDS_WAIT(); asm volatile("" ::: "memory");
    }
}

namespace nsa {
constexpr int KT_OFF = 0, VT_OFF = 9216, IMPA_OFF = 18432, IMPB_OFF = 51200, SEL_OFF = 83968, UNI_OFF = 84992;
__device__ __forceinline__ void load_tile(LAS unsigned char* lds, int off, const bf16* src, int pitch, int tid) {
    const int row = tid >> 3, ch = tid & 7;
    const v4u v = *(const GAS v4u*)(src + (size_t)row * pitch + ch * 8);
    *(LAS v4u*)(lds + off + row * 144 + ch * 16) = v;
}
template <int MODE>
__device__ __forceinline__ void tile(LAS unsigned char* lds, const bf16x8 (&qf)[4], f32x16 (&o)[2], float& m, float& l, const int lane, const int t, const float slope2,
                                     const int pos0, const int pstep, const bool selq, const float rl, const int impq, const int jbase) {
    const int hi = lane >> 5, qc = lane & 31;
    f32x16 p[2];
#pragma unroll
    for (int h2 = 0; h2 < 2; ++h2) {
#pragma unroll
        for (int r = 0; r < 16; ++r) p[h2][r] = 0.f;
#pragma unroll
        for (int ks = 0; ks < 4; ++ks) { const bf16x8 a = *(const LAS bf16x8*)(lds + KT_OFF + (32 * h2 + qc) * 144 + 32 * ks + 16 * hi);
            p[h2] = __builtin_amdgcn_mfma_f32_32x32x16_bf16(a, qf[ks], p[h2], 0, 0, 0); }
    }
    unsigned vm = 0u; float mx = -1e30f;
#pragma unroll
    for (int h2 = 0; h2 < 2; ++h2)
#pragma unroll
        for (int r = 0; r < 16; ++r) {
            const int x = 32 * h2 + (r & 3) + 8 * (r >> 2) + 4 * hi;
            const int dist = t - (pos0 + pstep * x);
            bool valid;
            if (MODE <= 1) valid = dist >= 0; else if (MODE == 2) valid = selq && dist >= 0; else valid = dist >= 0 && dist < 512;
            const float s = p[h2][r] - slope2 * (float)dist;
            p[h2][r] = s;
            if (valid) { vm |= 1u << (16 * h2 + r); mx = fmaxf(mx, s); }
        }
    mx = fmaxf(mx, __shfl_xor(mx, 32));
    float mref;
    if (MODE == 1) mref = m;
    else { const float mn = fmaxf(m, mx); const float f = __builtin_amdgcn_exp2f(m - mn); l *= f;
        if (MODE >= 2) {
#pragma unroll
            for (int r = 0; r < 16; ++r) { o[0][r] *= f; o[1][r] *= f; } }
        m = mn; mref = mn; }
    float ls = 0.f;
#pragma unroll
    for (int h2 = 0; h2 < 2; ++h2)
#pragma unroll
        for (int r = 0; r < 16; ++r) { float e = __builtin_amdgcn_exp2f(p[h2][r] - mref); if (MODE == 1) e *= rl; e = ((vm >> (16 * h2 + r)) & 1u) ? e : 0.f; p[h2][r] = e; ls += e; }
    if (MODE != 1) l += ls;
    if (MODE == 0) return;
    if (MODE == 1) {
        LAS float* IA = (LAS float*)(lds + IMPA_OFF) + impq * 128; LAS float* IB = (LAS float*)(lds + IMPB_OFF) + impq * 128;
#pragma unroll
        for (int h2 = 0; h2 < 2; ++h2)
#pragma unroll
            for (int a4 = 0; a4 < 4; ++a4) {
                float qs = (p[h2][4 * a4] + p[h2][4 * a4 + 1]) + (p[h2][4 * a4 + 2] + p[h2][4 * a4 + 3]), last = p[h2][4 * a4 + 3];
                qs += __shfl_xor(qs, 1); qs += __shfl_xor(qs, 2); last += __shfl_xor(last, 1); last += __shfl_xor(last, 2);
                const int j = jbase + 8 * h2 + 2 * a4 + hi;
                if ((qc & 3) == 0) { IA[j] = qs; if (j + 1 < 128) IB[j + 1] = last; }
            }
    }
    bf16x8 pf[2][2];
#pragma unroll
    for (int h2 = 0; h2 < 2; ++h2)
#pragma unroll
        for (int s2 = 0; s2 < 2; ++s2) { v4u wv; wv.x = pg8::cvtpk_c(p[h2][8 * s2 + 0], p[h2][8 * s2 + 1]); wv.y = pg8::cvtpk_c(p[h2][8 * s2 + 2], p[h2][8 * s2 + 3]);
            wv.z = pg8::cvtpk_c(p[h2][8 * s2 + 4], p[h2][8 * s2 + 5]); wv.w = pg8::cvtpk_c(p[h2][8 * s2 + 6], p[h2][8 * s2 + 7]); pf[h2][s2] = __builtin_bit_cast(bf16x8, wv); }
    const int a = (lane >> 4) & 1, q_ = (lane & 15) >> 2, p_ = lane & 3;
#pragma unroll
    for (int d0 = 0; d0 < 2; ++d0)
#pragma unroll
        for (int h2 = 0; h2 < 2; ++h2)
#pragma unroll
            for (int s2 = 0; s2 < 2; ++s2) {
                const LAS unsigned char* ad = lds + VT_OFF + (32 * h2 + 16 * s2 + 4 * hi + q_) * 144 + (32 * d0 + 16 * a + 4 * p_) * 2;
                const v4i16 lo = vtr(ad), hi4 = vtr(ad + 8 * 144);
                const bf16x8 av = (bf16x8){lo[0], lo[1], lo[2], lo[3], hi4[0], hi4[1], hi4[2], hi4[3]};
                o[d0] = __builtin_amdgcn_mfma_f32_32x32x16_bf16(av, pf[h2][s2], o[d0], 0, 0, 0);
            }
}
}
__device__ __forceinline__ void nsa_attn_phase(Frame& F) {
    using namespace nsa;
    LAS unsigned char* lds = F.lds + RING_OFF;
    const int tid = F.tid, lane = F.lane, w = F.wave, hi = lane >> 5, qc = lane & 31;
    unsigned char* ws = F.ws;
    const bf16 *Qp = (const bf16*)(ws + WS_Q), *KS = (const bf16*)(ws + WS_KS), *VS = (const bf16*)(ws + WS_VS), *KW = (const bf16*)(ws + WS_KW), *VW = (const bf16*)(ws + WS_VW);
    const bf16 *KC = (const bf16*)(ws + WS_KCMP), *VC = (const bf16*)(ws + WS_VCMP); const float* GT = (const float*)(ws + WS_GT); bf16* Op = (bf16*)(ws + WS_O);
    LAS unsigned* SEL = (LAS unsigned*)(lds + SEL_OFF); LAS unsigned* UNI = (LAS unsigned*)(lds + UNI_OFF);
    for (int un = F.wg; un < 1024; un += F.G) {
        const int bg = un & 7, cc = un >> 3, c = ((cc >> 5) & 1) ? (cc & ~31) + 31 - (cc & 31) : cc;
        const int b = bg >> 2, g = bg & 3, t0 = c * 64;
        const int tql = 8 * w + (qc >> 2), hh = qc & 3, t = t0 + tql, head = 4 * g + hh;
        const size_t mrow = (size_t)b * T + t;
        const float slope2 = __builtin_amdgcn_exp2f(-0.5f * (float)(head + 1)) * LOG2E;
        bf16x8 qf[4];
#pragma unroll
        for (int ks = 0; ks < 4; ++ks) qf[ks] = *(const GAS bf16x8*)(Qp + mrow * 1024 + head * 64 + 16 * ks + 8 * hi);
        __syncthreads();
        for (int k = tid; k < 4096; k += 512) *(LAS v4u*)(lds + IMPA_OFF + 16 * k) = (v4u){0u, 0u, 0u, 0u};
        if (tid < 4) UNI[tid] = 0u;
        const int nmax = (4 * c + 2) < 510 ? (4 * c + 2) : 510, ncb = nmax / 64 + 1;
        const bf16* kc = KC + (size_t)(b * 4 + g) * 512 * 64; const bf16* vc = VC + (size_t)(b * 4 + g) * 512 * 64;
        float m = -1e30f, l = 0.f; f32x16 o[2];
#pragma unroll
        for (int r = 0; r < 16; ++r) { o[0][r] = 0.f; o[1][r] = 0.f; }
        for (int kb = 0; kb < ncb; ++kb) { __syncthreads(); load_tile(lds, KT_OFF, kc + (size_t)kb * 4096, 64, tid); __syncthreads();
            tile<0>(lds, qf, o, m, l, lane, t, slope2, 1024 * kb + 31, 16, true, 0.f, tql, 16 * kb); }
        const float lt0 = l + __shfl_xor(l, 32); const float rl = 1.0f / fmaxf(lt0, 1e-30f);
        for (int kb = 0; kb < ncb; ++kb) { __syncthreads(); load_tile(lds, KT_OFF, kc + (size_t)kb * 4096, 64, tid); load_tile(lds, VT_OFF, vc + (size_t)kb * 4096, 64, tid); __syncthreads();
            tile<1>(lds, qf, o, m, l, lane, t, slope2, 1024 * kb + 31, 16, true, rl, tql, 16 * kb); }
        const float* gp = GT + mrow * 48 + (g * 4 + hh) * 3; const float g_cmp = gp[0], g_slc = gp[1], g_win = gp[2];
        f32x16 ot[2];
#pragma unroll
        for (int r = 0; r < 16; ++r) { ot[0][r] = g_cmp * o[0][r]; ot[1][r] = g_cmp * o[1][r]; }
        __syncthreads();
        if (c <= 15) { if (lane < 8) { const int q = 8 * w + lane; SEL[q * 4 + 0] = (2u << c) - 1u; SEL[q * 4 + 1] = 0u; SEL[q * 4 + 2] = 0u; SEL[q * 4 + 3] = 0u; } if (tid == 0) UNI[0] = (2u << c) - 1u; }
        else {
            for (int qi = 0; qi < 8; ++qi) { const int q = 8 * w + qi;
                const LAS float* ia = (const LAS float*)(lds + IMPA_OFF) + q * 128; const LAS float* ib = (const LAS float*)(lds + IMPB_OFF) + q * 128;
                const int j0 = lane, j1 = lane + 64;
                const float v0 = ia[j0] + ib[j0], v1 = ia[j1] + ib[j1];
                const unsigned k0 = (j0 >= 1 && j0 <= c - 2) ? __float_as_uint(v0) + 1u : 0u, k1 = (j1 <= c - 2) ? __float_as_uint(v1) + 1u : 0u;
                unsigned th = 0u;
                for (int bit = 31; bit >= 0; --bit) { const unsigned cand = th | (1u << bit); const int cnt = __popcll(__ballot(k0 >= cand)) + __popcll(__ballot(k1 >= cand)); if (cnt >= 13) th = cand; }
                const unsigned long long gt0 = __ballot(k0 > th), gt1 = __ballot(k1 > th), eq0 = __ballot(k0 == th), eq1 = __ballot(k1 == th);
                const int need = 13 - __popcll(gt0) - __popcll(gt1);
                const unsigned long long ltm = (1ull << lane) - 1ull;
                const int r0 = __popcll(eq0 & ltm), r1 = __popcll(eq0) + __popcll(eq1 & ltm);
                const bool s0 = (k0 > th) || (k0 == th && r0 < need), s1 = (k1 > th) || (k1 == th && r1 < need);
                unsigned long long m0 = __ballot(s0), m1 = __ballot(s1);
                m0 |= 1ull;
                if (c - 1 < 64) m0 |= 1ull << (c - 1); else m1 |= 1ull << (c - 1 - 64);
                if (c < 64) m0 |= 1ull << c; else m1 |= 1ull << (c - 64);
                if (lane == 0) { SEL[q * 4 + 0] = (unsigned)m0; SEL[q * 4 + 1] = (unsigned)(m0 >> 32); SEL[q * 4 + 2] = (unsigned)m1; SEL[q * 4 + 3] = (unsigned)(m1 >> 32);
                    __hip_atomic_fetch_or(UNI + 0, (unsigned)m0, __ATOMIC_RELAXED, __HIP_MEMORY_SCOPE_WORKGROUP); __hip_atomic_fetch_or(UNI + 1, (unsigned)(m0 >> 32), __ATOMIC_RELAXED, __HIP_MEMORY_SCOPE_WORKGROUP);
                    __hip_atomic_fetch_or(UNI + 2, (unsigned)m1, __ATOMIC_RELAXED, __HIP_MEMORY_SCOPE_WORKGROUP); __hip_atomic_fetch_or(UNI + 3, (unsigned)(m1 >> 32), __ATOMIC_RELAXED, __HIP_MEMORY_SCOPE_WORKGROUP); }
            }
        }
        __syncthreads();
        unsigned uni[4];
#pragma unroll
        for (int k = 0; k < 4; ++k) uni[k] = (unsigned)__builtin_amdgcn_readfirstlane((int)UNI[k]);
        m = -1e30f; l = 0.f;
#pragma unroll
        for (int r = 0; r < 16; ++r) { o[0][r] = 0.f; o[1][r] = 0.f; }
        for (int j = 0; j <= c; ++j) {
            const int k = j >> 5; const unsigned wsel = k == 0 ? uni[0] : k == 1 ? uni[1] : k == 2 ? uni[2] : uni[3];
            if (!((wsel >> (j & 31)) & 1u)) continue;
            const size_t srow = ((size_t)b * T + 64 * j) * 256 + g * 64;
            __syncthreads(); load_tile(lds, KT_OFF, KS + srow, 256, tid); load_tile(lds, VT_OFF, VS + srow, 256, tid); __syncthreads();
            const bool selq = (SEL[tql * 4 + k] >> (j & 31)) & 1u;
            tile<2>(lds, qf, o, m, l, lane, t, slope2, 64 * j, 1, selq, 0.f, 0, 0); }
        { const float lt = l + __shfl_xor(l, 32); const float sc = g_slc / fmaxf(lt, 1e-30f);
#pragma unroll
          for (int r = 0; r < 16; ++r) { ot[0][r] += sc * o[0][r]; ot[1][r] += sc * o[1][r]; } }
        m = -1e30f; l = 0.f;
#pragma unroll
        for (int r = 0; r < 16; ++r) { o[0][r] = 0.f; o[1][r] = 0.f; }
        for (int j = (c - 8 > 0 ? c - 8 : 0); j <= c; ++j) {
            const size_t srow = ((size_t)b * T + 64 * j) * 256 + g * 64;
            __syncthreads(); load_tile(lds, KT_OFF, KW + srow, 256, tid); load_tile(lds, VT_OFF, VW + srow, 256, tid); __syncthreads();
            tile<3>(lds, qf, o, m, l, lane, t, slope2, 64 * j, 1, true, 0.f, 0, 0); }
        { const float lt = l + __shfl_xor(l, 32); const float sc = g_win / fmaxf(lt, 1e-30f);
#pragma unroll
          for (int r = 0; r < 16; ++r) { ot[0][r] += sc * o[0][r]; ot[1][r] += sc * o[1][r]; } }
        bf16* orow = Op + mrow * 1024 + head * 64;
#pragma unroll
        for (int d0 = 0; d0 < 2; ++d0)
#pragma unroll
            for (int a4 = 0; a4 < 4; ++a4) { v2u wv; wv.x = pg8::cvtpk_c(ot[d0][4 * a4], ot[d0][4 * a4 + 1]); wv.y = pg8::cvtpk_c(ot[d0][4 * a4 + 2], ot[d0][4 * a4 + 3]);
                *(GAS v2u*)(orow + 32 * d0 + 8 * a4 + 4 * hi) = wv; }
    }
}

__device__ __forceinline__ void ln_rows(Frame& F, const float* tin, const float* gain, const float* bias, float* xres, bf16* xb) {
    const int gw = F.vcu * NWAVES + F.wave, NGW = F.G * NWAVES, lane = F.lane;
    f32x4 gv[4], bv[4];
#pragma unroll
    for (int j = 0; j < 4; ++j) { gv[j] = *((const GAS f32x4*)gain + lane + 64 * j); bv[j] = *((const GAS f32x4*)bias + lane + 64 * j); }
    for (int m = gw; m < M; m += NGW) {
        const GAS f32x4* xr = (const GAS f32x4*)(tin + (size_t)m * D) + lane;
        f32x4 v[4]; float s = 0.f;
#pragma unroll
        for (int j = 0; j < 4; ++j) { v[j] = xr[64 * j]; s += (v[j].x + v[j].y) + (v[j].z + v[j].w); }
        const float mean = wave_sum(s) * (1.f / D); float s2 = 0.f;
#pragma unroll
        for (int j = 0; j < 4; ++j) { v[j] = v[j] - mean; s2 += (v[j].x * v[j].x + v[j].y * v[j].y) + (v[j].z * v[j].z + v[j].w * v[j].w); }
        const float rstd = 1.f / sqrtf(wave_sum(s2) * (1.f / D) + LN_EPS);
        GAS f32x4* xo = (GAS f32x4*)(xres + (size_t)m * D) + lane; GAS unsigned long long* o8 = (GAS unsigned long long*)(xb + (size_t)m * D) + lane;
#pragma unroll
        for (int j = 0; j < 4; ++j) { const f32x4 y = v[j] * rstd * gv[j] + bv[j]; xo[64 * j] = y; o8[64 * j] = (unsigned long long)pk2(y.x, y.y) | ((unsigned long long)pk2(y.z, y.w) << 32); }
    }
}
namespace gla {
constexpr int ALS_OFF = 0, SEG_OFF = 4096, BL_OFF = 6144, KH_OFF = 8192, KH_STR = 272, VH1_OFF = KH_OFF + 64 * KH_STR, VH_STR = 528;
constexpr int QS_OFF = 0, QS_STR = 272, AL_OFF = 64 * QS_STR, AL_STR = 144, VH3_OFF = AL_OFF + 64 * AL_STR, SL_OFF = VH3_OFF + 64 * VH_STR, SL_STR = 528, QT_OFF = SL_OFF, KT_OFF = SL_OFF + 64 * QS_STR, SSQ_OFF = SL_OFF + 128 * SL_STR;
static_assert(SSQ_OFF + 1024 <= RING_BYTES && VH1_OFF + 64 * VH_STR <= RING_BYTES && KT_OFF + 64 * QS_STR <= SSQ_OFF, "gla LDS map");
__device__ __forceinline__ bf16x8 trfrag(const LAS unsigned char* p, int rowstep4) { const v4i16 lo = vtr(p), hi4 = vtr(p + rowstep4); return (bf16x8){lo[0], lo[1], lo[2], lo[3], hi4[0], hi4[1], hi4[2], hi4[3]}; }
}
__device__ __forceinline__ void gla_load_v(LAS unsigned char* lds, int off, const bf16* qkvg, size_t m0, int vcol0, int tid) {
#pragma unroll
    for (int k = 0; k < 4; ++k) { const int q = tid + 512 * k, row = q >> 5, ch = q & 31;
        const v4u v = *(const GAS v4u*)(qkvg + (m0 + row) * 3072 + vcol0 + ch * 8); *(LAS v4u*)(lds + off + row * gla::VH_STR + ch * 16) = v; }
}
__device__ __forceinline__ void gla_g1(Frame& F) {
    using namespace gla;
    LAS unsigned char* lds = F.lds + RING_OFF; const int tid = F.tid, lane = F.lane, w = F.wave, hi = lane >> 5;
    unsigned char* ws = F.ws; const bf16* qkvg = (const bf16*)(ws + WS_QKVG); const float* alow = (const float*)(ws + WS_ALOW);
    float* bcum = (float*)(ws + WS_BCUM); float* zb = (float*)(ws + WS_ZB); float* dec = (float*)(ws + WS_DEC);
    const float* wg2 = F.in[16]; const float* bg2 = F.in[17];
    LAS float* ALS = (LAS float*)(lds + ALS_OFF); LAS float* SEG = (LAS float*)(lds + SEG_OFF); LAS float* BL = (LAS float*)(lds + BL_OFF);
    const int d = tid & 127, ig = tid >> 7;
    for (int un = F.wg; un < 1024; un += F.G) {
        const int bh = un >> 7, n = un & 127, b = bh >> 2, h = bh & 3; const size_t m0 = (size_t)b * T + 64 * n;
        __syncthreads();
        if (tid < 256) *(LAS f32x4*)(ALS + tid * 4) = *(const GAS f32x4*)(alow + m0 * 16 + tid * 4);
        gla_load_v(lds, VH1_OFF, qkvg, m0, 1024 + h * 256, tid);
        float wg[16];
#pragma unroll
        for (int r = 0; r < 16; ++r) wg[r] = wg2[r * 512 + h * 128 + d];
        const float bgv = bg2[h * 128 + d];
        __syncthreads();
        float cs[16]; float run = 0.f;
#pragma unroll
        for (int ii = 0; ii < 16; ++ii) { const int i = 16 * ig + ii; float z = bgv;
#pragma unroll
            for (int r = 0; r < 16; ++r) z += ALS[i * 16 + r] * wg[r];
            const float la = (fminf(z, 0.f) - __logf(1.f + __expf(-fabsf(z)))) * (1.f / 16.f);
            run += la; cs[ii] = run; }
        SEG[ig * 128 + d] = run;
        __syncthreads();
        float pre = 0.f, tot = 0.f;
#pragma unroll
        for (int k = 0; k < 4; ++k) { const float sv = SEG[k * 128 + d]; if (k < ig) pre += sv; tot += sv; }
#pragma unroll
        for (int ii = 0; ii < 16; ++ii) { const int i = 16 * ig + ii; const float bb = cs[ii] + pre;
            bcum[(m0 + i) * 512 + h * 128 + d] = bb;
            const float kk = bf2f(qkvg[(m0 + i) * 3072 + 512 + h * 128 + d]);
            *(LAS bf16*)(lds + KH_OFF + i * KH_STR + d * 2) = (bf16)f2bf(kk * __expf(tot - bb)); }
        if (ig == 0) dec[(size_t)(bh * 128 + n) * 128 + d] = __expf(tot);
        __syncthreads();
        f32x16 acc[4];
#pragma unroll
        for (int db = 0; db < 4; ++db)
#pragma unroll
            for (int r = 0; r < 16; ++r) acc[db][r] = 0.f;
        const int a = (lane >> 4) & 1, q_ = (lane & 15) >> 2, p_ = lane & 3;
#pragma unroll
        for (int s = 0; s < 4; ++s) {
            const bf16x8 bfr = trfrag(lds + VH1_OFF + (16 * s + 8 * hi + q_) * VH_STR + (32 * w + 16 * a + 4 * p_) * 2, 4 * VH_STR);
#pragma unroll
            for (int db = 0; db < 4; ++db) { const bf16x8 afr = trfrag(lds + KH_OFF + (16 * s + 8 * hi + q_) * KH_STR + (32 * db + 16 * a + 4 * p_) * 2, 4 * KH_STR);
                acc[db] = __builtin_amdgcn_mfma_f32_32x32x16_bf16(afr, bfr, acc[db], 0, 0, 0); }
        }
        float* zrow = zb + (size_t)(bh * 128 + n) * 128 * 256 + 32 * w + (lane & 31);
#pragma unroll
        for (int db = 0; db < 4; ++db)
#pragma unroll
            for (int r = 0; r < 16; ++r) zrow[(size_t)(32 * db + crow(r, hi)) * 256] = acc[db][r];
    }
}
__device__ __forceinline__ void gla_g2(Frame& F) {
    unsigned char* ws = F.ws; const float* zb = (const float*)(ws + WS_ZB); const float* dec = (const float*)(ws + WS_DEC); bf16* sst = (bf16*)(ws + WS_SST);
    for (int p = F.wg * 512 + F.tid; p < 131072; p += F.G * 512) {
        const int bh = p >> 14, d = (p >> 7) & 127, e2 = p & 127;
        float s0 = 0.f, s1 = 0.f;
        for (int n0 = 0; n0 < 128; n0 += 8) {
            float dv[8]; float z0[8], z1[8];
#pragma unroll
            for (int k = 0; k < 8; ++k) { const size_t cn = (size_t)(bh * 128 + n0 + k); dv[k] = dec[cn * 128 + d]; const float2 zz = *(const float2*)(zb + (cn * 128 + d) * 256 + 2 * e2); z0[k] = zz.x; z1[k] = zz.y; }
#pragma unroll
            for (int k = 0; k < 8; ++k) { const size_t cn = (size_t)(bh * 128 + n0 + k);
                *(unsigned*)(sst + (cn * 128 + d) * 256 + 2 * e2) = pk2(s0, s1);
                s0 = s0 * dv[k] + z0[k]; s1 = s1 * dv[k] + z1[k]; }
        }
    }
}
__device__ __forceinline__ void gla_g3(Frame& F) {
    using namespace gla;
    LAS unsigned char* lds = F.lds + RING_OFF; const int tid = F.tid, lane = F.lane, w = F.wave, hi = lane >> 5, qc = lane & 31;
    unsigned char* ws = F.ws; const bf16* qkvg = (const bf16*)(ws + WS_QKVG); const float* bcum = (const float*)(ws + WS_BCUM); const bf16* sst = (const bf16*)(ws + WS_SST);
    bf16* o1 = (bf16*)(ws + WS_O1); const float* hng = F.in[18];
    LAS float* SSQ = (LAS float*)(lds + SSQ_OFF);
    const int d = tid & 127, ig = tid >> 7;
    const int a = (lane >> 4) & 1, q_ = (lane & 15) >> 2, p_ = lane & 3;
    for (int un = F.wg; un < 1024; un += F.G) {
        const int bh = un >> 7, n = un & 127, b = bh >> 2, h = bh & 3; const size_t m0 = (size_t)b * T + 64 * n;
        __syncthreads();
        gla_load_v(lds, VH3_OFF, qkvg, m0, 1024 + h * 256, tid);
        { const float bref = bcum[(m0 + 32) * 512 + h * 128 + d];
#pragma unroll 4
          for (int ii = 0; ii < 16; ++ii) { const int i = 16 * ig + ii; const float bb = bcum[(m0 + i) * 512 + h * 128 + d];
              const float qv = bf2f(qkvg[(m0 + i) * 3072 + h * 128 + d]), kv = bf2f(qkvg[(m0 + i) * 3072 + 512 + h * 128 + d]);
              *(LAS bf16*)(lds + QT_OFF + i * QS_STR + d * 2) = (bf16)f2bf(qv * __expf(bb - bref));
              *(LAS bf16*)(lds + KT_OFF + i * QS_STR + d * 2) = (bf16)f2bf(kv * __expf(bref - bb));
              *(LAS bf16*)(lds + QS_OFF + i * QS_STR + d * 2) = (bf16)f2bf(qv * __expf(bb)); } }
        __syncthreads();
        if (w < 4) {
            const int jb = w >> 1, ib = w & 1; f32x16 acc;
#pragma unroll
            for (int r = 0; r < 16; ++r) acc[r] = 0.f;
#pragma unroll
            for (int s = 0; s < 8; ++s) { const bf16x8 afr = *(const LAS bf16x8*)(lds + KT_OFF + (32 * jb + qc) * QS_STR + 32 * s + 16 * hi), bfr = *(const LAS bf16x8*)(lds + QT_OFF + (32 * ib + qc) * QS_STR + 32 * s + 16 * hi);
                acc = __builtin_amdgcn_mfma_f32_32x32x16_bf16(afr, bfr, acc, 0, 0, 0); }
            const int i = 32 * ib + qc;
#pragma unroll
            for (int a4 = 0; a4 < 4; ++a4) { float v[4];
#pragma unroll
                for (int k = 0; k < 4; ++k) { const int j = 32 * jb + 8 * a4 + 4 * hi + k; v[k] = (j <= i) ? acc[4 * a4 + k] : 0.f; }
                v2u wv; wv.x = pg8::cvtpk_c(v[0], v[1]); wv.y = pg8::cvtpk_c(v[2], v[3]);
                *(LAS v2u*)(lds + AL_OFF + i * AL_STR + (32 * jb + 8 * a4 + 4 * hi) * 2) = wv; }
        }
        __syncthreads();
        { const bf16* sp = sst + (size_t)(bh * 128 + n) * 128 * 256;
#pragma unroll
          for (int k = 0; k < 8; ++k) { const int q = tid + 512 * k, row = q >> 5, ch = q & 31; const v4u v = *(const GAS v4u*)(sp + row * 256 + ch * 8); *(LAS v4u*)(lds + SL_OFF + row * SL_STR + ch * 16) = v; } }
        __syncthreads();
        const int ib = w & 1, eq = w >> 1; f32x16 acc2[2];
#pragma unroll
        for (int r = 0; r < 16; ++r) { acc2[0][r] = 0.f; acc2[1][r] = 0.f; }
#pragma unroll
        for (int s = 0; s < 4; ++s) { const bf16x8 bfr = *(const LAS bf16x8*)(lds + AL_OFF + (32 * ib + qc) * AL_STR + 32 * s + 16 * hi);
#pragma unroll
            for (int e2 = 0; e2 < 2; ++e2) { const bf16x8 afr = trfrag(lds + VH3_OFF + (16 * s + 8 * hi + q_) * VH_STR + (32 * (2 * eq + e2) + 16 * a + 4 * p_) * 2, 4 * VH_STR);
                acc2[e2] = __builtin_amdgcn_mfma_f32_32x32x16_bf16(afr, bfr, acc2[e2], 0, 0, 0); } }
#pragma unroll
        for (int s = 0; s < 8; ++s) { const bf16x8 bfr = *(const LAS bf16x8*)(lds + QS_OFF + (32 * ib + qc) * QS_STR + 32 * s + 16 * hi);
#pragma unroll
            for (int e2 = 0; e2 < 2; ++e2) { const bf16x8 afr = trfrag(lds + SL_OFF + (16 * s + 8 * hi + q_) * SL_STR + (32 * (2 * eq + e2) + 16 * a + 4 * p_) * 2, 4 * SL_STR);
                acc2[e2] = __builtin_amdgcn_mfma_f32_32x32x16_bf16(afr, bfr, acc2[e2], 0, 0, 0); } }
        float ss = 0.f;
#pragma unroll
        for (int r = 0; r < 16; ++r) ss += acc2[0][r] * acc2[0][r] + acc2[1][r] * acc2[1][r];
        ss += __shfl_xor(ss, 32);
        const int i = 32 * ib + qc;
        if (hi == 0) SSQ[i * 4 + eq] = ss;
        __syncthreads();
        const float tot = (SSQ[i * 4 + 0] + SSQ[i * 4 + 1]) + (SSQ[i * 4 + 2] + SSQ[i * 4 + 3]);
        const float rstd = 1.f / sqrtf(tot * (1.f / 256.f) + RMS_EPS);
#pragma unroll
        for (int e2 = 0; e2 < 2; ++e2)
#pragma unroll
            for (int a4 = 0; a4 < 4; ++a4) { const int e = 32 * (2 * eq + e2) + 8 * a4 + 4 * hi;
                const v2u gg = *(const GAS v2u*)(qkvg + (m0 + i) * 3072 + 2048 + h * 256 + e); const f32x4 ng = *(const GAS f32x4*)(hng + h * 256 + e);
                const float g0 = __uint_as_float(gg.x << 16), g1 = __uint_as_float(gg.x & 0xffff0000u), g2 = __uint_as_float(gg.y << 16), g3 = __uint_as_float(gg.y & 0xffff0000u);
                const float y0 = acc2[e2][4 * a4 + 0] * rstd * ng[0] * pg8::silu1(g0), y1 = acc2[e2][4 * a4 + 1] * rstd * ng[1] * pg8::silu1(g1);
                const float y2 = acc2[e2][4 * a4 + 2] * rstd * ng[2] * pg8::silu1(g2), y3 = acc2[e2][4 * a4 + 3] * rstd * ng[3] * pg8::silu1(g3);
                v2u wv; wv.x = pg8::cvtpk_c(y0, y1); wv.y = pg8::cvtpk_c(y2, y3);
                *(GAS v2u*)(o1 + (m0 + i) * 1024 + h * 256 + e) = wv; }
    }
}

__device__ __forceinline__ void ln_router(Frame& F, const float* tin, const float* gain, const float* bias, float* xres, bf16* xb) {
    LAS unsigned char* lds = F.lds + RING_OFF; const int lane = F.lane, w = F.wave;
    unsigned char* ws = F.ws; const float* wr = F.in[22];
    int* toke = (int*)(ws + WS_TOKE); float* tokw = (float*)(ws + WS_TOKW); int* tokp = (int*)(ws + WS_TOKP); int* cntl = (int*)(ws + WS_CNTL);
    const int RPW = M / F.G, RPV = RPW / NWAVES;
    LAS int* EL = (LAS int*)lds;
    f32x4 gv[4], bv[4];
#pragma unroll
    for (int j = 0; j < 4; ++j) { gv[j] = *((const GAS f32x4*)gain + lane + 64 * j); bv[j] = *((const GAS f32x4*)bias + lane + 64 * j); }
    __syncthreads();
    for (int rr = 0; rr < RPV; ++rr) {
        const int lr = w * RPV + rr, m = F.wg * RPW + lr;
        const GAS f32x4* xr = (const GAS f32x4*)(tin + (size_t)m * D) + lane;
        f32x4 v[4]; float s = 0.f;
#pragma unroll
        for (int j = 0; j < 4; ++j) { v[j] = xr[64 * j]; s += (v[j].x + v[j].y) + (v[j].z + v[j].w); }
        const float mean = wave_sum(s) * (1.f / D); float s2 = 0.f;
#pragma unroll
        for (int j = 0; j < 4; ++j) { v[j] = v[j] - mean; s2 += (v[j].x * v[j].x + v[j].y * v[j].y) + (v[j].z * v[j].z + v[j].w * v[j].w); }
        const float rstd = 1.f / sqrtf(wave_sum(s2) * (1.f / D) + LN_EPS);
        GAS f32x4* xo = (GAS f32x4*)(xres + (size_t)m * D) + lane; GAS unsigned long long* o8 = (GAS unsigned long long*)(xb + (size_t)m * D) + lane;
        float lg[8];
#pragma unroll
        for (int e = 0; e < 8; ++e) lg[e] = 0.f;
#pragma unroll
        for (int j = 0; j < 4; ++j) { const f32x4 y = v[j] * rstd * gv[j] + bv[j]; xo[64 * j] = y; o8[64 * j] = (unsigned long long)pk2(y.x, y.y) | ((unsigned long long)pk2(y.z, y.w) << 32);
            const int c0 = 4 * (lane + 64 * j);
#pragma unroll
            for (int k = 0; k < 4; ++k) { const f32x4 w0 = *(const GAS f32x4*)(wr + (size_t)(c0 + k) * 8), w1 = *(const GAS f32x4*)(wr + (size_t)(c0 + k) * 8 + 4);
                lg[0] += y[k] * w0[0]; lg[1] += y[k] * w0[1]; lg[2] += y[k] * w0[2]; lg[3] += y[k] * w0[3]; lg[4] += y[k] * w1[0]; lg[5] += y[k] * w1[1]; lg[6] += y[k] * w1[2]; lg[7] += y[k] * w1[3]; } }
#pragma unroll
        for (int e = 0; e < 8; ++e) lg[e] = wave_sum(lg[e]);
        int e1 = 0; float v1 = lg[0];
#pragma unroll
        for (int e = 1; e < 8; ++e) if (lg[e] > v1) { v1 = lg[e]; e1 = e; }
        int e2 = -1; float v2 = -3.4e38f;
#pragma unroll
        for (int e = 0; e < 8; ++e) if (e != e1 && lg[e] > v2) { v2 = lg[e]; e2 = e; }
        const float w2 = 1.f / (1.f + __expf(v1 - v2)), w1 = 1.f - w2;
        if (lane == 0) { toke[m * 2] = e1; toke[m * 2 + 1] = e2; tokw[m * 2] = w1; tokw[m * 2 + 1] = w2; EL[lr] = e1; EL[RPW + lr] = e2; }
    }
    __syncthreads();
    if (w == 0) {
        const bool act = lane < RPW; int base[8];
#pragma unroll
        for (int e = 0; e < 8; ++e) base[e] = 0;
        const unsigned long long ltm = (1ull << lane) - 1ull;
#pragma unroll
        for (int k = 0; k < 2; ++k) { const int ek = act ? EL[k * RPW + lane] : -1; int pos = 0;
#pragma unroll
            for (int e = 0; e < 8; ++e) { const unsigned long long mk = __ballot(ek == e); if (ek == e) pos = base[e] + __popcll(mk & ltm); base[e] += __popcll(mk); }
            if (act) tokp[(F.wg * RPW + lane) * 2 + k] = pos; }
        if (lane < 8) { int cv = 0;
#pragma unroll
            for (int e = 0; e < 8; ++e) if (lane == e) cv = base[e];
            cntl[F.wg * 8 + lane] = cv; }
    }
}
__device__ __forceinline__ void moe_tables(Frame& F) {
    LAS int* TP = (LAS int*)(F.lds + LDSCTL_OFF); LAS int* BASE = TP + 16; LAS int* ACC = TP + 32;
    const int* cntl = (const int*)(F.ws + WS_CNTL);
    __syncthreads();
    if (F.tid < 16) ACC[F.tid] = 0;
    __syncthreads();
    int tot = 0, pre = 0; const int e = F.tid & 7;
    for (int wq = F.tid >> 3; wq < F.G; wq += 64) { const int cv = __hip_atomic_load(cntl + wq * 8 + e, __ATOMIC_RELAXED, __HIP_MEMORY_SCOPE_AGENT); tot += cv; if (wq < F.wg) pre += cv; }
    __hip_atomic_fetch_add(ACC + e, tot, __ATOMIC_RELAXED, __HIP_MEMORY_SCOPE_WORKGROUP); __hip_atomic_fetch_add(ACC + 8 + e, pre, __ATOMIC_RELAXED, __HIP_MEMORY_SCOPE_WORKGROUP);
    __syncthreads();
    if (F.tid == 0) { int tp = 0;
        for (int k = 0; k < 8; ++k) { TP[k] = tp; BASE[k] = tp * 256 + ACC[8 + k]; tp += (ACC[k] + 255) >> 8; }
        TP[8] = tp; }
    __syncthreads();
}
__device__ __forceinline__ void moe_gather(Frame& F) {
    moe_tables(F);
    LAS int* BASE = (LAS int*)(F.lds + LDSCTL_OFF) + 16;
    unsigned char* ws = F.ws; const int* toke = (const int*)(ws + WS_TOKE); const int* tokp = (const int*)(ws + WS_TOKP); int* toks = (int*)(ws + WS_TOKS);
    const bf16* xb = (const bf16*)(ws + WS_XB); bf16* xg = (bf16*)(ws + WS_XG);
    const int RPW = M / F.G;
    for (int q = F.wave; q < 2 * RPW; q += NWAVES) { const int m = F.wg * RPW + (q >> 1), k = q & 1;
        const int e = toke[m * 2 + k], slot = BASE[e] + tokp[m * 2 + k];
        if (F.lane == 0) toks[m * 2 + k] = slot;
        const GAS v4u* src = (const GAS v4u*)(xb + (size_t)m * D) + F.lane; GAS v4u* dst = (GAS v4u*)(xg + (size_t)slot * D) + F.lane;
        dst[0] = src[0]; dst[64] = src[64]; }
}
__device__ __forceinline__ void moe_final(Frame& F) {
    const int gw = F.vcu * NWAVES + F.wave, NGW = F.G * NWAVES, lane = F.lane;
    unsigned char* ws = F.ws; const float* xres = (const float*)(ws + WS_XRES); const bf16* yb = (const bf16*)(ws + WS_YB);
    const int* toks = (const int*)(ws + WS_TOKS); const float* tokw = (const float*)(ws + WS_TOKW); const float* gain = F.in[25]; const float* bias = F.in[26];
    f32x4 gv[4], bv[4];
#pragma unroll
    for (int j = 0; j < 4; ++j) { gv[j] = *((const GAS f32x4*)gain + lane + 64 * j); bv[j] = *((const GAS f32x4*)bias + lane + 64 * j); }
    for (int m = gw; m < M; m += NGW) {
        const int s1 = toks[m * 2], s2 = toks[m * 2 + 1]; const float w1 = tokw[m * 2], w2 = tokw[m * 2 + 1];
        const GAS f32x4* xr = (const GAS f32x4*)(xres + (size_t)m * D) + lane;
        const GAS v2u* y1 = (const GAS v2u*)(yb + (size_t)s1 * D) + lane; const GAS v2u* y2 = (const GAS v2u*)(yb + (size_t)s2 * D) + lane;
        f32x4 v[4]; float s = 0.f;
#pragma unroll
        for (int j = 0; j < 4; ++j) { const f32x4 x = xr[64 * j]; const v2u a = y1[64 * j], c = y2[64 * j];
            const f32x4 ya = (f32x4){__uint_as_float(a.x << 16), __uint_as_float(a.x & 0xffff0000u), __uint_as_float(a.y << 16), __uint_as_float(a.y & 0xffff0000u)};
            const f32x4 yc = (f32x4){__uint_as_float(c.x << 16), __uint_as_float(c.x & 0xffff0000u), __uint_as_float(c.y << 16), __uint_as_float(c.y & 0xffff0000u)};
            v[j] = x * ALPHA + (ya * w1 + yc * w2); s += (v[j].x + v[j].y) + (v[j].z + v[j].w); }
        const float mean = wave_sum(s) * (1.f / D); float q2 = 0.f;
#pragma unroll
        for (int j = 0; j < 4; ++j) { v[j] = v[j] - mean; q2 += (v[j].x * v[j].x + v[j].y * v[j].y) + (v[j].z * v[j].z + v[j].w * v[j].w); }
        const float rstd = 1.f / sqrtf(wave_sum(q2) * (1.f / D) + LN_EPS);
        GAS f32x4* xo = (GAS f32x4*)(F.out + (size_t)m * D) + lane;
#pragma unroll
        for (int j = 0; j < 4; ++j) xo[64 * j] = v[j] * rstd * gv[j] + bv[j];
    }
}
struct Args { const float* in[27]; float* out; unsigned char* ws; int ph_lo, ph_hi; };
__global__ void __launch_bounds__(NWAVES * 64, 2) fwd(Args args) {
    extern __shared__ __attribute__((aligned(16))) unsigned char lds[];
    Frame F;
    F.lds = (LAS unsigned char*)lds;
    F.MISC = (volatile LAS unsigned*)(F.lds + MISC_OFF);
    F.tid = threadIdx.x; F.lane = F.tid & 63; F.wave = __builtin_amdgcn_readfirstlane(F.tid >> 6);
    F.G = gridDim.x; F.wg = blockIdx.x; { const int bx = blockIdx.x; F.vcu = (F.G % 8 == 0) ? (bx % 8) * (F.G / 8) + bx / 8 : bx; }
#pragma unroll
    for (int k = 0; k < 27; ++k) F.in[k] = args.in[k];
    F.ws = args.ws; F.out = args.out;
    unsigned char* ws = args.ws;
    F.ctl = (gu32*)(ws + WS_CTL);
    for (int u = F.tid; u < (LDS_BYTES - LDSCTL_OFF) / 4; u += NWAVES * 64) ((LAS unsigned*)(F.lds + LDSCTL_OFF))[u] = 0u;
    __syncthreads();
    XcdBarrier bar; bar.bar = (unsigned*)(F.ctl + CW_BAR); bar.x = 0; bar.st = nullptr;
    if (!MK_PER_PHASE) bar = xcd_barrier_post((unsigned*)(F.ctl + CW_BAR), F.MISC + 8);
#define GRID_BAR() do { if (!MK_PER_PHASE) xcd_barrier(bar); } while (0)
    const int lo = args.ph_lo, hi = args.ph_hi;
#define IN(k) (lo <= (k) && (k) < hi)
#define SEAM(k) do { if (IN((k) + 1)) GRID_BAR(); } while (0)
    bf16* XB = (bf16*)(ws + WS_XB); float* XRES = (float*)(ws + WS_XRES); float* T0 = (float*)(ws + WS_T0);
    const int cwg = (int)blockIdx.x;

    if (IN(0)) { p0_prologue(F); SEAM(0); }
    if (IN(1)) { pg8::Gemm g{XB, (const bf16*)(ws + WS_WIN0), M, NSA_IN_PAD, D}; pg8::StaticOrder S; S.init(M, NSA_IN_PAD, F.G, cwg);
        pg8::EpiNsaIn E{(bf16*)(ws + WS_Q), (bf16*)(ws + WS_KV2), (bf16*)(ws + WS_KS), (bf16*)(ws + WS_VS), (bf16*)(ws + WS_KW), (bf16*)(ws + WS_VW), (float*)(ws + WS_GT), 0.125f * LOG2E};
        pg8::gemm_phase<pg8::EpiNsaIn, pg8::StaticOrder, PG8_ALIGN, PG8_SP2>(F.lds + RING_OFF, g, S, E); SEAM(1); }
    if (IN(2)) { pg8::Gemm g{(const bf16*)(ws + WS_KV2), (const bf16*)(ws + WS_W1C), 8192, 1024, 1024}; pg8::CmpOrder S{F.G, cwg}; pg8::EpiF32Cmp E{(float*)(ws + WS_UL)};
        pg8::gemm_phase<pg8::EpiF32Cmp, pg8::CmpOrder, PG8_ALIGN, PG8_SP2>(F.lds + RING_OFF, g, S, E); SEAM(2); }
    if (IN(3)) { cmp_finish(F); SEAM(3); }
    if (IN(4)) { nsa_attn_phase(F); SEAM(4); }
    if (IN(5)) { pg8::Gemm g{(const bf16*)(ws + WS_O), (const bf16*)(ws + WS_WO0), M, D, D}; pg8::StaticOrder S; S.init(M, D, F.G, cwg); pg8::EpiResF32 E{F.in[0], T0, ALPHA};
        pg8::gemm_phase<pg8::EpiResF32, pg8::StaticOrder, PG8_ALIGN, PG8_SP2>(F.lds + RING_OFF, g, S, E); SEAM(5); }
    if (IN(6)) { ln_rows(F, T0, F.in[9], F.in[10], XRES, XB); SEAM(6); }
    if (IN(7)) { pg8::Gemm g{XB, (const bf16*)(ws + WS_WGU0), M, 2 * FF0, D}; pg8::StaticOrder S; S.init(M, 2 * FF0, F.G, cwg); pg8::EpiSwiGLU E{(bf16*)(ws + WS_H0), FF0, 2 * FF0 / 256};
        pg8::gemm_phase<pg8::EpiSwiGLU, pg8::StaticOrder, PG8_ALIGN, PG8_SP2>(F.lds + RING_OFF, g, S, E); SEAM(7); }
    if (IN(8)) { pg8::Gemm g{(const bf16*)(ws + WS_H0), (const bf16*)(ws + WS_WD0), M, D, FF0}; pg8::StaticOrder S; S.init(M, D, F.G, cwg); pg8::EpiResF32 E{XRES, T0, ALPHA};
        pg8::gemm_phase<pg8::EpiResF32, pg8::StaticOrder, PG8_ALIGN, PG8_SP2>(F.lds + RING_OFF, g, S, E); SEAM(8); }
    if (IN(9)) { ln_rows(F, T0, F.in[13], F.in[14], XRES, XB); SEAM(9); }
    if (IN(10)) { pg8::Gemm g{XB, (const bf16*)(ws + WS_WIN1), M, GLA_IN_PAD, D}; pg8::StaticOrder S; S.init(M, GLA_IN_PAD, F.G, cwg); pg8::EpiGlaIn E{(bf16*)(ws + WS_QKVG), (float*)(ws + WS_ALOW), 0.08838834764831845f};
        pg8::gemm_phase<pg8::EpiGlaIn, pg8::StaticOrder, PG8_ALIGN, PG8_SP2>(F.lds + RING_OFF, g, S, E); SEAM(10); }
    if (IN(11)) { gla_g1(F); SEAM(11); }
    if (IN(12)) { gla_g2(F); SEAM(12); }
    if (IN(13)) { gla_g3(F); SEAM(13); }
    if (IN(14)) { pg8::Gemm g{(const bf16*)(ws + WS_O1), (const bf16*)(ws + WS_WO1), M, D, D}; pg8::StaticOrder S; S.init(M, D, F.G, cwg); pg8::EpiResF32 E{XRES, T0, ALPHA};
        pg8::gemm_phase<pg8::EpiResF32, pg8::StaticOrder, PG8_ALIGN, PG8_SP2>(F.lds + RING_OFF, g, S, E); SEAM(14); }
    if (IN(15)) { ln_router(F, T0, F.in[20], F.in[21], XRES, XB); SEAM(15); }
    if (IN(16)) { moe_gather(F); SEAM(16); }
    if (IN(17)) { moe_tables(F); pg8::Gemm g{(const bf16*)(ws + WS_XG), (const bf16*)(ws + WS_WGU1), MAXSLOTS, NE * 2 * FFE, D};
        pg8::GroupedOrder S{F.G, cwg, 2 * FFE / 256, (const PG8_LAS int*)(F.lds + LDSCTL_OFF)}; pg8::EpiSwiGLU E{(bf16*)(ws + WS_H2), FFE, 2 * FFE / 256};
        pg8::gemm_phase<pg8::EpiSwiGLU, pg8::GroupedOrder, PG8_ALIGN, PG8_SP2>(F.lds + RING_OFF, g, S, E); SEAM(17); }
    if (IN(18)) { moe_tables(F); pg8::Gemm g{(const bf16*)(ws + WS_H2), (const bf16*)(ws + WS_WD1), MAXSLOTS, NE * D, FFE};
        pg8::GroupedOrder S{F.G, cwg, D / 256, (const PG8_LAS int*)(F.lds + LDSCTL_OFF)}; pg8::EpiBf16Y E{(bf16*)(ws + WS_YB)};
        pg8::gemm_phase<pg8::EpiBf16Y, pg8::GroupedOrder, PG8_ALIGN, PG8_SP2>(F.lds + RING_OFF, g, S, E); SEAM(18); }
    if (IN(19)) { moe_final(F); }
#undef IN
#undef SEAM
#undef GRID_BAR
}

extern "C" void kernel_launch(void* const* d_in, const int* in_sizes, int n_in, void* d_out, int out_size, void* d_ws, size_t ws_size, hipStream_t stream) {
    static int grid = 0;
    if (grid == 0) {
        if (n_in != 27 || in_sizes[0] != M * D || out_size != M * D || ws_size < WS_END) { fprintf(stderr, "kernel_launch: unexpected problem shape (n_in %d, in0 %d, out %d, ws %zu); nothing launched\n", n_in, n_in > 0 ? in_sizes[0] : -1, out_size, ws_size); grid = -1; return; }
        if (hipFuncSetAttribute((const void*)fwd, hipFuncAttributeMaxDynamicSharedMemorySize, LDS_BYTES) != hipSuccess) { fprintf(stderr, "kernel_launch: hipFuncSetAttribute failed\n"); grid = -1; return; }
        int dev = 0, cus = 0, per_cu = 0;
        (void)hipGetDevice(&dev); (void)hipDeviceGetAttribute(&cus, hipDeviceAttributeMultiprocessorCount, dev);
        if (hipOccupancyMaxActiveBlocksPerMultiprocessor(&per_cu, (const void*)fwd, NWAVES * 64, LDS_BYTES) != hipSuccess || per_cu < 1) fprintf(stderr, "kernel_launch: note: occupancy query reports %d workgroups per CU\n", per_cu);
        (void)hipGetLastError();
        grid = 256;
        if (cus < 256) fprintf(stderr, "kernel_launch: device has %d CUs; this kernel needs 256 resident workgroups\n", cus);
    }
    if (grid < 0) return;
    if (hipMemsetAsync((char*)d_ws + WS_CTL, 0, CTL_ZERO_BYTES, stream) != hipSuccess) { fprintf(stderr, "kernel_launch: hipMemsetAsync failed\n"); return; }
    Args a{};
    for (int i = 0; i < 27; ++i) a.in[i] = (const float*)d_in[i];
    a.out = (float*)d_out; a.ws = (unsigned char*)d_ws;
#if MK_PER_PHASE
    for (int p = 0; p < N_PHASES; ++p) { a.ph_lo = p; a.ph_hi = p + 1; hipLaunchKernelGGL(fwd, dim3(grid), dim3(NWAVES * 64), LDS_BYTES, stream, a); }
#else
    a.ph_lo = 0; a.ph_hi = N_PHASES;
    hipLaunchKernelGGL(fwd, dim3(grid), dim3(NWAVES * 64), LDS_BYTES, stream, a);
#endif
    const hipError_t le = hipPeekAtLastError();
    if (le != hipSuccess) fprintf(stderr, "kernel_launch: launch failed: %s\n", hipGetErrorName(le));
}
```

```cpp
#include <hip/hip_runtime.h>
#include <cstdio>
#include <cstdint>
namespace pg8 {
#define PG8_LAS __attribute__((address_space(3)))
typedef unsigned short bf16_t;
typedef short bf16x8 __attribute__((ext_vector_type(8)));
typedef float f32x4 __attribute__((ext_vector_type(4)));
typedef unsigned u32x4 __attribute__((ext_vector_type(4)));
constexpr int BM = 256, BK = 64, HALF = 128, HTB = HALF * BK * 2  , STAGE_BYTES = 8 * HTB, NXCD = 8, WGM = 8;

__host__ __device__ __forceinline__ int lds_byte(int r, int c) { const int st = (r >> 4) * 2 + (c >> 5), rr = r & 15, cc = c & 31, ob = rr * 64 + cc * 2; return st * 1024 + (ob ^ (((ob >> 9) & 1) << 5)); }
__host__ __device__ __forceinline__ void stage_rc(int b, int& R, int& C) { const int st = b / 1024, sb = b % 1024, swz = sb ^ (((sb >> 9) & 1) << 5); R = (st >> 1) * 16 + swz / 64; C = (st & 1) * 32 + (swz % 64) / 2; }
__host__ __device__ __forceinline__ int perm32(int rho) { const int n = rho >> 4, i = rho & 15; return 8 * (i >> 2) + 4 * n + (i & 3); }

struct Unit { int pm, pn, ko; };
struct Gemm { const bf16_t* A; const bf16_t* Bt; int M, N, K, ld; };

struct StaticOrder {
    int nM, nN, nwg, G, c;
    __host__ __device__ void init(int M, int N, int G_, int c_) { nM = M / BM; nN = N / BM; nwg = nM * nN; G = G_; c = c_; }
    __host__ __device__ bool next(int i, Unit& u) const {
        const long L = (long)i * G + c; if (L >= nwg) return false;
        int wgid = (int)L; { const int q = nwg / NXCD, r = nwg % NXCD, xcd = wgid % NXCD, off = wgid / NXCD; wgid = (xcd < r ? xcd * (q + 1) : r * (q + 1) + (xcd - r) * q) + off; }
        const int nig = WGM * nN, gid = wgid / nig, fm = gid * WGM, gsz = (nM - fm) < WGM ? (nM - fm) : WGM;
        u.pm = fm + ((wgid % nig) % gsz); u.pn = (wgid % nig) / gsz; u.ko = 0; return true;
    }
    __device__ __forceinline__ void a_ready(const Unit&) const {}
    __device__ __forceinline__ void done(const Unit&) const {}
};
__device__ __forceinline__ unsigned cvt_pk_bf16(float lo, float hi) { unsigned r; asm volatile("v_cvt_pk_bf16_f32 %0, %1, %2" : "=v"(r) : "v"(lo), "v"(hi)); return r; }
typedef float f32x2 __attribute__((ext_vector_type(2)));
typedef __bf16 bf16x2_t_ __attribute__((ext_vector_type(2)));
__device__ __forceinline__ unsigned cvtpk_c(float lo, float hi) { f32x2 v = {lo, hi}; bf16x2_t_ b = __builtin_convertvector(v, bf16x2_t_); return __builtin_bit_cast(unsigned, b); }
__device__ __forceinline__ u32x4 pack8(const f32x4 v0, const f32x4 v1) { u32x4 w; w.x = cvt_pk_bf16(v0[0], v0[1]); w.y = cvt_pk_bf16(v0[2], v0[3]); w.z = cvt_pk_bf16(v1[0], v1[1]); w.w = cvt_pk_bf16(v1[2], v1[3]); return w; }
__device__ __forceinline__ float sigm(float x) { return __builtin_amdgcn_rcpf(1.0f + __builtin_amdgcn_exp2f(-1.44269504088896341f * x)); }
__device__ __forceinline__ float silu1(float x) { return x * __builtin_amdgcn_rcpf(1.0f + __builtin_amdgcn_exp2f(-1.44269504088896341f * x)); }

struct EpiNsaIn {
    static constexpr bool PERM = true, AFTER_DRAIN = false;
    bf16_t *Q, *KV2, *KS, *VS, *KW, *VW; float* GT; float qscale;
    __device__ __forceinline__ void operator()(const f32x4 (&acc)[2][2][4][2], const Unit& u, int wr, int wc, int fr, int fq) const {
        const int pn = u.pn, row0 = u.pm * BM + wr * 64 + fr, c8 = wc * 32 + 8 * fq;
#pragma unroll
        for (int ai = 0; ai < 2; ++ai)
#pragma unroll
            for (int m = 0; m < 4; ++m) { const int row = row0 + ai * HALF + m * 16;
#pragma unroll
                for (int bj = 0; bj < 2; ++bj) { const int col = bj * HALF + c8;
                    f32x4 v0 = acc[ai][bj][m][0], v1 = acc[ai][bj][m][1];
                    if (pn >= 10) { if (col < 48) { float* gp = GT + (size_t)row * 48 + col;
                            *(f32x4*)gp = (f32x4){sigm(v0[0]), sigm(v0[1]), sigm(v0[2]), sigm(v0[3])}; *(f32x4*)(gp + 4) = (f32x4){sigm(v1[0]), sigm(v1[1]), sigm(v1[2]), sigm(v1[3])}; }
                        continue; }
                    bf16_t* dst;
                    if (pn < 4) { v0 = v0 * qscale; v1 = v1 * qscale; dst = Q + (size_t)row * 1024 + pn * 256 + col; }
                    else if (pn < 6) { const int g = col >> 6, d = col & 63; dst = KV2 + (size_t)(pn - 4) * (4096 * 1024) + ((size_t)(((row >> 4) * 4 + g) * 16 + (row & 15))) * 64 + d; }
                    else { bf16_t* base = pn == 6 ? KS : pn == 7 ? VS : pn == 8 ? KW : VW; dst = base + (size_t)row * 256 + col; }
                    *(u32x4*)dst = pack8(v0, v1); } }
    }
};
struct EpiGlaIn {
    static constexpr bool PERM = true, AFTER_DRAIN = false;
    bf16_t* QKVG; float* ALOW; float qscale;
    __device__ __forceinline__ void operator()(const f32x4 (&acc)[2][2][4][2], const Unit& u, int wr, int wc, int fr, int fq) const {
        const int pn = u.pn, row0 = u.pm * BM + wr * 64 + fr, c8 = wc * 32 + 8 * fq;
#pragma unroll
        for (int ai = 0; ai < 2; ++ai)
#pragma unroll
            for (int m = 0; m < 4; ++m) { const int row = row0 + ai * HALF + m * 16;
#pragma unroll
                for (int bj = 0; bj < 2; ++bj) { const int col = bj * HALF + c8;
                    f32x4 v0 = acc[ai][bj][m][0], v1 = acc[ai][bj][m][1];
                    if (pn >= 12) { if (col < 16) { float* gp = ALOW + (size_t)row * 16 + col; *(f32x4*)gp = v0; *(f32x4*)(gp + 4) = v1; } continue; }
                    if (pn < 2) { v0 = v0 * qscale; v1 = v1 * qscale; }
                    *(u32x4*)(QKVG + (size_t)row * 3072 + pn * 256 + col) = pack8(v0, v1); } }
    }
};
struct EpiF32Cmp {
    static constexpr bool PERM = false, AFTER_DRAIN = false;
    float* C;
    __device__ __forceinline__ void operator()(const f32x4 (&acc)[2][2][4][2], const Unit& u, int wr, int wc, int fr, int fq) const {
        const int row0 = u.pm * BM + wr * 64 + fr, col0 = (u.pn & 1) * BM + wc * 32 + 4 * fq;
#pragma unroll
        for (int ai = 0; ai < 2; ++ai)
#pragma unroll
            for (int m = 0; m < 4; ++m) { float* rowp = C + (size_t)(row0 + ai * HALF + m * 16) * 512 + col0;
#pragma unroll
                for (int bj = 0; bj < 2; ++bj)
#pragma unroll
                    for (int n = 0; n < 2; ++n) *(f32x4*)(rowp + bj * HALF + n * 16) = acc[ai][bj][m][n]; }
    }
};
struct EpiResF32 {
    static constexpr bool PERM = false, AFTER_DRAIN = false;
    const float* base; float* out; float alpha;
    __device__ __forceinline__ void operator()(const f32x4 (&acc)[2][2][4][2], const Unit& u, int wr, int wc, int fr, int fq) const {
        const int row0 = u.pm * BM + wr * 64 + fr, col0 = u.pn * BM + wc * 32 + 4 * fq;
#pragma unroll
        for (int ai = 0; ai < 2; ++ai)
#pragma unroll
            for (int m = 0; m < 4; ++m) { const size_t off = (size_t)(row0 + ai * HALF + m * 16) * 1024 + col0;
#pragma unroll
                for (int bj = 0; bj < 2; ++bj)
#pragma unroll
                    for (int n = 0; n < 2; ++n) { const f32x4 bs = *(const f32x4*)(base + off + bj * HALF + n * 16); *(f32x4*)(out + off + bj * HALF + n * 16) = bs * alpha + acc[ai][bj][m][n]; } }
    }
};
template <bool BF> struct EpiResBf16 {
    static constexpr bool PERM = true, AFTER_DRAIN = false;
    const void* base; bf16_t* out; float alpha;
    __device__ __forceinline__ void operator()(const f32x4 (&acc)[2][2][4][2], const Unit& u, int wr, int wc, int fr, int fq) const {
        const int row0 = u.pm * BM + wr * 64 + fr, col0 = u.pn * BM + wc * 32 + 8 * fq;
#pragma unroll
        for (int ai = 0; ai < 2; ++ai)
#pragma unroll
            for (int m = 0; m < 4; ++m) { const size_t off = (size_t)(row0 + ai * HALF + m * 16) * 1024 + col0;
#pragma unroll
                for (int bj = 0; bj < 2; ++bj) { f32x4 b0, b1;
                    if (BF) { const u32x4 r = *(const u32x4*)((const bf16_t*)base + off + bj * HALF);
                        b0 = (f32x4){__uint_as_float(r.x << 16), __uint_as_float(r.x & 0xffff0000u), __uint_as_float(r.y << 16), __uint_as_float(r.y & 0xffff0000u)};
                        b1 = (f32x4){__uint_as_float(r.z << 16), __uint_as_float(r.z & 0xffff0000u), __uint_as_float(r.w << 16), __uint_as_float(r.w & 0xffff0000u)}; }
                    else { b0 = *(const f32x4*)((const float*)base + off + bj * HALF); b1 = *(const f32x4*)((const float*)base + off + bj * HALF + 4); }
                    *(u32x4*)(out + off + bj * HALF) = pack8(b0 * alpha + acc[ai][bj][m][0], b1 * alpha + acc[ai][bj][m][1]); } }
    }
};
__device__ __forceinline__ void store16_sc1(bf16_t* p, const u32x4 v) { asm volatile("global_store_dwordx4 %0, %1, off sc1\n\ts_nop 1" :: "v"(p), "v"(v) : "memory"); }
template <bool SC1> struct EpiSwiGLU {
    static constexpr bool PERM = true, AFTER_DRAIN = false;
    bf16_t* H; int ldh, nt;
    __device__ __forceinline__ void operator()(const f32x4 (&acc)[2][2][4][2], const Unit& u, int wr, int wc, int fr, int fq) const {
        const int row0 = u.pm * BM + wr * 64 + fr, col = (u.pn % nt) * HALF + wc * 32 + 8 * fq;
#pragma unroll
        for (int ai = 0; ai < 2; ++ai)
#pragma unroll
            for (int m = 0; m < 4; ++m) { const f32x4 a0 = acc[ai][0][m][0], a1 = acc[ai][0][m][1], b0 = acc[ai][1][m][0], b1 = acc[ai][1][m][1];
                const f32x4 h0 = (f32x4){silu1(a0[0]) * b0[0], silu1(a0[1]) * b0[1], silu1(a0[2]) * b0[2], silu1(a0[3]) * b0[3]};
                const f32x4 h1 = (f32x4){silu1(a1[0]) * b1[0], silu1(a1[1]) * b1[1], silu1(a1[2]) * b1[2], silu1(a1[3]) * b1[3]};
                bf16_t* dst = H + (size_t)(row0 + ai * HALF + m * 16) * ldh + col;
                if (SC1) store16_sc1(dst, pack8(h0, h1)); else *(u32x4*)dst = pack8(h0, h1); }
    }
};
struct EpiBf16Y {
    static constexpr bool PERM = true, AFTER_DRAIN = false;
    bf16_t* Y; size_t kstride;
    __device__ __forceinline__ void operator()(const f32x4 (&acc)[2][2][4][2], const Unit& u, int wr, int wc, int fr, int fq) const {
        const int row0 = u.pm * BM + wr * 64 + fr, col0 = (u.pn & 3) * BM + wc * 32 + 8 * fq;
#pragma unroll
        for (int ai = 0; ai < 2; ++ai)
#pragma unroll
            for (int m = 0; m < 4; ++m) { bf16_t* rowp = Y + (u.ko ? kstride : (size_t)0) + (size_t)(row0 + ai * HALF + m * 16) * 1024 + col0;
#pragma unroll
                for (int bj = 0; bj < 2; ++bj) *(u32x4*)(rowp + bj * HALF) = pack8(acc[ai][bj][m][0], acc[ai][bj][m][1]); }
    }
};
struct CmpOrder {
    int G, c;
    __device__ __forceinline__ bool next(int i, Unit& u) const { const long L = (long)i * G + c; if (L >= 64) return false; const int pm = (int)L >> 1; u.pm = pm; u.pn = (pm >> 4) * 2 + ((int)L & 1); u.ko = 0; return true; }
    __device__ __forceinline__ void a_ready(const Unit&) const {}
    __device__ __forceinline__ void done(const Unit&) const {}
};
struct GroupedOrder {
    int G, c, NT, KS, KL; const PG8_LAS int* tp;
    __device__ __forceinline__ bool next(int i, Unit& u) const {
        const int nwg = tp[8] * NT * KS; const long L = (long)i * G + c; if (L >= nwg) return false;
        int wgid = (int)L; { const int q = nwg / NXCD, r = nwg % NXCD, xcd = wgid % NXCD, off = wgid / NXCD; wgid = (xcd < r ? xcd * (q + 1) : r * (q + 1) + (xcd - r) * q) + off; }
        const int ks = wgid % KS; wgid /= KS;
        int e = 0;
#pragma unroll
        for (int k = 1; k < 8; ++k) if (wgid >= tp[k] * NT) e = k;
        const int t0 = tp[e], nte = tp[e + 1] - t0, l = wgid - t0 * NT, nig = WGM * NT, gid = l / nig, fm = gid * WGM, gsz = (nte - fm) < WGM ? (nte - fm) : WGM;
        u.pm = t0 + fm + ((l % nig) % gsz); u.pn = e * NT + (l % nig) / gsz; u.ko = ks * KL; return true;
    }
    __device__ __forceinline__ void a_ready(const Unit&) const {}
    __device__ __forceinline__ void done(const Unit&) const {}
};
template <class Base> struct PubOrder : Base {
    unsigned* cnt; mutable int pend;
    __device__ __forceinline__ void publish() const { if (pend >= 0) { if ((threadIdx.x & 63) == 0) __hip_atomic_fetch_add(cnt + 64 * pend, 1u, __ATOMIC_RELAXED, __HIP_MEMORY_SCOPE_AGENT); pend = -1; } }
    __device__ __forceinline__ void a_ready(const Unit&) const { publish(); }
#if defined(PUB_DRAIN) && PUB_DRAIN
    __device__ __forceinline__ void done(const Unit& u) const { asm volatile("s_waitcnt vmcnt(0)" ::: "memory"); pend = u.pm; publish(); }
#else
    __device__ __forceinline__ void done(const Unit& u) const { publish(); pend = u.pm; }
#endif
};
template <class Base> struct WaitOrder : Base {
    const unsigned* ready; unsigned need; unsigned* tmo;
    __device__ __forceinline__ void a_ready(const Unit& u) const {
        if (threadIdx.x < 64) {
            const unsigned long long t0 = __builtin_amdgcn_s_memrealtime(); unsigned polls = 0;
            while ((unsigned)__builtin_amdgcn_readfirstlane(__hip_atomic_load(ready + 64 * u.pm, __ATOMIC_RELAXED, __HIP_MEMORY_SCOPE_AGENT)) < need) {
                if ((++polls & 255u) == 0u && __builtin_amdgcn_readfirstlane(__hip_atomic_load(tmo, __ATOMIC_RELAXED, __HIP_MEMORY_SCOPE_AGENT)) != 0u) break;
                if (__builtin_amdgcn_s_memrealtime() - t0 > 2000000ull) {
                    if (threadIdx.x == 0) { unsigned expect = 0u; __hip_atomic_compare_exchange_strong(tmo + 1, &expect, 0x600u | (unsigned)(u.pm & 0xff), __ATOMIC_RELAXED, __ATOMIC_RELAXED, __HIP_MEMORY_SCOPE_AGENT); __hip_atomic_store(tmo, 1u, __ATOMIC_RELAXED, __HIP_MEMORY_SCOPE_AGENT); }
                    break; }
                __builtin_amdgcn_s_sleep(2); }
            __builtin_amdgcn_fence(__ATOMIC_ACQUIRE, "agent");
            asm volatile("s_waitcnt vmcnt(0)" ::: "memory");
        }
        asm volatile("" ::: "memory"); __builtin_amdgcn_s_barrier(); asm volatile("" ::: "memory");
    }
};
struct MoeDownOrder {
    int G, c, rem; const PG8_LAS int* tp;
    __device__ __forceinline__ int expert_of(int tile) const { int e = 0;
#pragma unroll
        for (int k = 1; k < 8; ++k) if (tile >= tp[k]) e = k;
        return e; }
    __device__ __forceinline__ bool next(int i, Unit& u) const {
        const long L = (long)i * G + c;
        if (!rem) { if (L >= 512) return false;
            int wgid = (int)L; { const int xcd = wgid % NXCD, off = wgid / NXCD; wgid = xcd * 64 + off; }
            const int grp = wgid >> 5, in = wgid & 31; const int tile = grp * 8 + (in & 7), pnl = in >> 3;
            u.pm = tile; u.pn = expert_of(tile) * 4 + pnl; u.ko = 0; return true; }
        const int nrem = tp[8] - 128; if (L >= (long)nrem * 28) return false;
        const int l2 = (int)L, ks = l2 % 7, r = l2 / 7, tile = 128 + (r >> 2);
        u.pm = tile; u.pn = expert_of(tile) * 4 + (r & 3); u.ko = ks * 512; return true;
    }
    __device__ __forceinline__ void a_ready(const Unit&) const {}
    __device__ __forceinline__ void done(const Unit&) const {}
};
struct EpiBf16Y2 {
    static constexpr bool PERM = true, AFTER_DRAIN = false;
    bf16_t* Y; bf16_t* YP; int rem;
    __device__ __forceinline__ void operator()(const f32x4 (&acc)[2][2][4][2], const Unit& u, int wr, int wc, int fr, int fq) const {
        const int row0 = u.pm * BM + wr * 64 + fr, col0 = (u.pn & 3) * BM + wc * 32 + 8 * fq;
        bf16_t* base = rem ? YP + (size_t)(u.ko >> 9) * (2048 * 1024) + (size_t)(row0 - 128 * BM) * 1024 : Y + (size_t)row0 * 1024;
#pragma unroll
        for (int ai = 0; ai < 2; ++ai)
#pragma unroll
            for (int m = 0; m < 4; ++m) { bf16_t* rowp = base + (size_t)(ai * HALF + m * 16) * 1024 + col0;
#pragma unroll
                for (int bj = 0; bj < 2; ++bj) *(u32x4*)(rowp + bj * HALF) = pack8(acc[ai][bj][m][0], acc[ai][bj][m][1]); }
    }
};
template <class Epi, class Sched, bool ALIGN_EPI = false, bool SP2 = false>
__device__ __forceinline__ void gemm_phase(PG8_LAS unsigned char* lds, const Gemm g, const Sched& S, const Epi& E) {
    const int tid = threadIdx.x, wid = __builtin_amdgcn_readfirstlane(tid >> 6), lane = tid & 63, wr = wid >> 2, wc = wid & 3, fr = lane & 15, fq = lane >> 4;
    const int K = g.ld, nt = g.K / BK;
    unsigned voffA[2], voffB[2];
#pragma unroll
    for (int i = 0; i < 2; ++i) { int R, C; stage_rc(tid * 16 + i * 8192, R, C); const int Rb = Epi::PERM ? ((R & ~31) + perm32(R & 31)) : R;
        voffA[i] = (unsigned)(R * K + C) * 2u; voffB[i] = (unsigned)(Rb * K + C) * 2u; }
    const size_t kstep = (size_t)(BK * 2);
    const size_t hstep = (size_t)HALF * K * 2;
    const size_t tstep = 2 * hstep;
    const unsigned ldsw = (unsigned)wid * 1024u;
    const int aoff = lds_byte(wr * 64 + fr, fq * 8), boff = lds_byte(wc * 32 + fr, fq * 8);
#define PG8_SA(b, h) (((b) * 2 + (h)) * HTB)
#define PG8_SB(b, h) ((4 + (b) * 2 + (h)) * HTB)
#define PG8_STAGE(bufoff, gbase, voff) do { _Pragma("unroll") for (int _i = 0; _i < 2; ++_i) \
        __builtin_amdgcn_global_load_lds((const unsigned*)((const char*)(gbase) + (voff)[_i]), (PG8_LAS unsigned*)(lds + (bufoff) + ldsw + _i * 8192), 16, 0, 0); } while (0)
#define PG8_LDA(dst, b, h) do { _Pragma("unroll") for (int m = 0; m < 4; ++m) _Pragma("unroll") for (int k = 0; k < 2; ++k) dst[m][k] = *(const PG8_LAS bf16x8*)(lds + PG8_SA(b, h) + aoff + m * 2048 + k * 1024); } while (0)
#define PG8_LDB(dst, b, h) do { _Pragma("unroll") for (int n = 0; n < 2; ++n) _Pragma("unroll") for (int k = 0; k < 2; ++k) dst[n][k] = *(const PG8_LAS bf16x8*)(lds + PG8_SB(b, h) + boff + n * 2048 + k * 1024); } while (0)
#define PG8_MMA(ai, bj, At, Bt) do { __builtin_amdgcn_s_setprio(1); _Pragma("unroll") for (int m = 0; m < 4; ++m) _Pragma("unroll") for (int n = 0; n < 2; ++n) _Pragma("unroll") for (int k = 0; k < 2; ++k) \
        acc[ai][bj][m][n] = __builtin_amdgcn_mfma_f32_16x16x32_bf16(Bt[n][k], At[m][k], acc[ai][bj][m][n], 0, 0, 0); __builtin_amdgcn_s_setprio(0); } while (0)
#define PG8_WAIT_V(n) asm volatile("s_waitcnt vmcnt(" #n ")" ::: "memory")
#define PG8_WAIT_L(n) asm volatile("s_waitcnt lgkmcnt(" #n ")" ::: "memory")
#define PG8_BAR __builtin_amdgcn_s_barrier()
#define PG8_SCHED __builtin_amdgcn_sched_barrier(0)
    Unit cur, nxt; int ui = 0;
    if (!S.next(0, cur)) return;
    f32x4 acc[2][2][4][2];
#pragma unroll
    for (int a = 0; a < 2; ++a)
#pragma unroll
        for (int b = 0; b < 2; ++b)
#pragma unroll
            for (int m = 0; m < 4; ++m)
#pragma unroll
                for (int n = 0; n < 2; ++n) acc[a][b][m][n] = (f32x4){0.f, 0.f, 0.f, 0.f};
    bf16x8 At[4][2], B0[2][2], B1[2][2];
    const char* cA = (const char*)g.A + (size_t)cur.pm * tstep + (size_t)cur.ko * 2; const char* cB = (const char*)g.Bt + (size_t)cur.pn * tstep + (size_t)cur.ko * 2;
    S.a_ready(cur);
    if constexpr (SP2) {
        PG8_STAGE(PG8_SB(0, 0), cB, voffB); PG8_STAGE(PG8_SB(0, 1), cB + hstep, voffB); PG8_STAGE(PG8_SA(0, 0), cA, voffA); PG8_STAGE(PG8_SA(0, 1), cA + hstep, voffA);
        if (wr == 1) PG8_BAR;
        PG8_WAIT_V(2); PG8_BAR;
        PG8_STAGE(PG8_SB(1, 0), cB + kstep, voffB); PG8_STAGE(PG8_SA(1, 0), cA + kstep, voffA); PG8_STAGE(PG8_SB(1, 1), cB + hstep + kstep, voffB);
        PG8_WAIT_V(6); PG8_BAR;
    } else {
        PG8_STAGE(PG8_SB(0, 0), cB, voffB); PG8_STAGE(PG8_SA(0, 0), cA, voffA); PG8_STAGE(PG8_SB(0, 1), cB + hstep, voffB); PG8_STAGE(PG8_SA(0, 1), cA + hstep, voffA);
        if (wr == 1) PG8_BAR;
        PG8_WAIT_V(4); PG8_BAR;
        PG8_STAGE(PG8_SB(1, 0), cB + kstep, voffB); PG8_STAGE(PG8_SA(1, 0), cA + kstep, voffA); PG8_STAGE(PG8_SB(1, 1), cB + hstep + kstep, voffB);
        PG8_WAIT_V(6); PG8_BAR;
    }
    for (;;) {
        const bool has_next = S.next(ui + 1, nxt);
        const char* nA = has_next ? (const char*)g.A + (size_t)nxt.pm * tstep + (size_t)nxt.ko * 2 : cA; const char* nB = has_next ? (const char*)g.Bt + (size_t)nxt.pn * tstep + (size_t)nxt.ko * 2 : cB;
        for (int t = 0; t < nt; t += 2) {
            const bool last = (t == nt - 2);
            const char* a1 = cA + (size_t)(t + 1) * kstep;
            const char* a2 = last ? nA : cA + (size_t)(t + 2) * kstep; const char* b2 = last ? nB : cB + (size_t)(t + 2) * kstep;
            const char* a3 = a2 + kstep; const char* b3 = b2 + kstep;
            if (last && has_next) S.a_ready(nxt);
            if constexpr (SP2) {
            PG8_LDB(B0, 0, 0); PG8_LDB(B1, 0, 1); PG8_SCHED; PG8_LDA(At, 0, 0); PG8_STAGE(PG8_SA(1, 1), a1 + hstep, voffA);
            PG8_WAIT_V(8); PG8_WAIT_L(0); PG8_BAR; PG8_MMA(0, 0, At, B0); PG8_MMA(0, 1, At, B1); PG8_BAR; PG8_SCHED;
            PG8_LDA(At, 0, 1); PG8_STAGE(PG8_SB(0, 0), b2, voffB); PG8_STAGE(PG8_SB(0, 1), b2 + hstep, voffB); PG8_STAGE(PG8_SA(0, 0), a2, voffA);
            PG8_WAIT_V(8); PG8_WAIT_L(0); PG8_BAR; PG8_MMA(1, 0, At, B0); PG8_MMA(1, 1, At, B1); PG8_BAR; PG8_SCHED;
            PG8_LDB(B0, 1, 0); PG8_LDB(B1, 1, 1); PG8_SCHED; PG8_LDA(At, 1, 0); PG8_STAGE(PG8_SA(0, 1), a2 + hstep, voffA);
            PG8_WAIT_V(8); PG8_WAIT_L(0); PG8_BAR; PG8_MMA(0, 0, At, B0); PG8_MMA(0, 1, At, B1); PG8_BAR; PG8_SCHED;
            PG8_LDA(At, 1, 1); PG8_STAGE(PG8_SB(1, 0), b3, voffB); PG8_STAGE(PG8_SB(1, 1), b3 + hstep, voffB); PG8_STAGE(PG8_SA(1, 0), a3, voffA);
            PG8_WAIT_V(8); PG8_WAIT_L(0); PG8_BAR; PG8_MMA(1, 0, At, B0); PG8_MMA(1, 1, At, B1); PG8_BAR; PG8_SCHED;
            } else {
            PG8_LDB(B0, 0, 0); PG8_SCHED; PG8_LDA(At, 0, 0); PG8_STAGE(PG8_SA(1, 1), a1 + hstep, voffA);
            PG8_WAIT_L(8); PG8_BAR; PG8_WAIT_L(0); PG8_MMA(0, 0, At, B0); PG8_BAR; PG8_SCHED;
            PG8_LDB(B1, 0, 1); PG8_STAGE(PG8_SB(0, 0), b2, voffB);
            PG8_BAR; PG8_WAIT_L(0); PG8_MMA(0, 1, At, B1); PG8_BAR;
            PG8_LDA(At, 0, 1); PG8_STAGE(PG8_SA(0, 0), a2, voffA);
            PG8_BAR; PG8_WAIT_L(0); PG8_MMA(1, 0, At, B0); PG8_BAR; PG8_SCHED;
            PG8_STAGE(PG8_SB(0, 1), b2 + hstep, voffB);
            PG8_WAIT_V(6); PG8_BAR; PG8_MMA(1, 1, At, B1); PG8_BAR;
            PG8_LDB(B0, 1, 0); PG8_SCHED; PG8_LDA(At, 1, 0); PG8_STAGE(PG8_SA(0, 1), a2 + hstep, voffA);
            PG8_WAIT_L(8); PG8_BAR; PG8_WAIT_L(0); PG8_MMA(0, 0, At, B0); PG8_BAR; PG8_SCHED;
            PG8_LDB(B1, 1, 1); PG8_STAGE(PG8_SB(1, 0), b3, voffB);
            PG8_BAR; PG8_WAIT_L(0); PG8_MMA(0, 1, At, B1); PG8_BAR;
            PG8_LDA(At, 1, 1); PG8_STAGE(PG8_SA(1, 0), a3, voffA);
            PG8_BAR; PG8_WAIT_L(0); PG8_MMA(1, 0, At, B0); PG8_BAR; PG8_SCHED;
            PG8_STAGE(PG8_SB(1, 1), b3 + hstep, voffB);
            PG8_WAIT_V(6); PG8_BAR; PG8_MMA(1, 1, At, B1); PG8_BAR;
            }
        }
        if constexpr (ALIGN_EPI) { if (wr == 0) PG8_BAR; }
        if constexpr (!Epi::AFTER_DRAIN) { E(acc, cur, wr, wc, fr, fq); S.done(cur); }
        if (!has_next) break;
#pragma unroll
        for (int a = 0; a < 2; ++a)
#pragma unroll
            for (int b = 0; b < 2; ++b)
#pragma unroll
                for (int m = 0; m < 4; ++m)
#pragma unroll
                    for (int n = 0; n < 2; ++n) acc[a][b][m][n] = (f32x4){0.f, 0.f, 0.f, 0.f};
        cur = nxt; cA = nA; cB = nB; ++ui;
        if constexpr (ALIGN_EPI) { if (wr == 1) PG8_BAR; }
    }
    PG8_WAIT_V(0);
    if constexpr (!ALIGN_EPI) { if (wr == 0) PG8_BAR; }
    PG8_BAR;
    if constexpr (Epi::AFTER_DRAIN) { E.fused(acc, cur, wr, wc, fr, fq, lds, wid, lane); S.done(cur); }
#undef PG8_SA
#undef PG8_SB
#undef PG8_STAGE
#undef PG8_LDA
#undef PG8_LDB
#undef PG8_MMA
#undef PG8_WAIT_V
#undef PG8_WAIT_L
#undef PG8_BAR
#undef PG8_SCHED
}
}
#ifndef PG8_SP2
#define PG8_SP2 true
#endif
#ifndef PG8_ALIGN
#define PG8_ALIGN true
#endif
#define GAS __attribute__((address_space(1)))
#define LAS __attribute__((address_space(3)))
typedef unsigned short bf16;
typedef unsigned v4u __attribute__((ext_vector_type(4)));
typedef float f32x4 __attribute__((ext_vector_type(4)));
typedef short bf16x8 __attribute__((ext_vector_type(8)));
typedef GAS unsigned gu32;
typedef GAS unsigned long long gu64;
#define RLX_AGENT __ATOMIC_RELAXED, __HIP_MEMORY_SCOPE_AGENT
#define LDS_WAIT() asm volatile("s_waitcnt lgkmcnt(0)" ::: "memory")
#define VM_WAIT() asm volatile("s_waitcnt vmcnt(0)" ::: "memory")
__device__ __forceinline__ unsigned long long rt() { return __builtin_amdgcn_s_memrealtime(); }
__device__ __forceinline__ unsigned f2bf(float f) { unsigned u = __builtin_bit_cast(unsigned, f); return (u + 0x7fffu + ((u >> 16) & 1u)) >> 16; }
__device__ __forceinline__ unsigned pk2(float lo, float hi) { return f2bf(lo) | (f2bf(hi) << 16); }

#define XB_TMO      128
#define XB_XCNT(j)  (256  + 64 * (j))
#define XB_XSUB(j)  (1280 + 64 * (j))
#define XB_XGEN(j)  (2304 + 64 * (j))
#define XB_TOP      3328
#define XB_TOPGEN   3392
#define XCD_BAR_WORDS 3456
#define XB_SPIN_CAP (1u << 18)

__device__ __forceinline__ unsigned xb_ld(unsigned* p)              { return __hip_atomic_load(p, __ATOMIC_RELAXED, __HIP_MEMORY_SCOPE_AGENT); }
__device__ __forceinline__ unsigned xb_add(unsigned* p, unsigned v) { return __hip_atomic_fetch_add(p, v, __ATOMIC_RELAXED, __HIP_MEMORY_SCOPE_AGENT); }
__device__ __forceinline__ unsigned xb_xcc_id() { return (unsigned)__builtin_amdgcn_s_getreg((3 << 11) | 20) & 0xFu; }
#define XB_SPIN(cond, bar) do { unsigned _sp = 0; while (cond) { __builtin_amdgcn_s_sleep(1); \
    if ((++_sp & 255u) == 0u) { if (xb_ld(&(bar)[XB_TMO])) break; if (_sp > XB_SPIN_CAP) { atomicAdd(&(bar)[XB_TMO], 1u); break; } } } } while (0)

struct XcdBarrier {
    unsigned* bar; unsigned x;
    volatile LAS unsigned* st;
};

__device__ __forceinline__ XcdBarrier xcd_barrier_post(unsigned* bar, volatile LAS unsigned* st) {
    XcdBarrier b; b.bar = bar; b.x = xb_xcc_id(); b.st = st;
    if (threadIdx.x == 0) (void)xb_add(&bar[XB_XCNT(b.x)], 1u);
    return b;
}
__device__ __forceinline__ void xcd_barrier_complete(unsigned* bar, unsigned x, unsigned& nloc, unsigned& nx) {
    const unsigned G = gridDim.x * gridDim.y * gridDim.z;
    unsigned sum, cnt, mine, sp = 0u;
    for (;;) {
        sum = 0u; cnt = 0u; mine = 0u;
#pragma unroll
        for (unsigned j = 0; j < 16; ++j) { const unsigned c = xb_ld(&bar[XB_XCNT(j)]); sum += c; cnt += (c > 0u) ? 1u : 0u; mine = (j == x) ? c : mine; }
        if (sum == G) break;
        __builtin_amdgcn_s_sleep(1);
        if ((++sp & 255u) == 0u) { if (xb_ld(&bar[XB_TMO])) break; if (sp > XB_SPIN_CAP) { atomicAdd(&bar[XB_TMO], 1u); break; } }
    }
    nloc = mine > 0u ? mine : 1u; nx = cnt > 0u ? cnt : 1u;
}

__device__ __forceinline__ void xcd_barrier(const XcdBarrier& b) {
    asm volatile("s_waitcnt vmcnt(0)" ::: "memory");
    __syncthreads();
    if (threadIdx.x == 0) {
        unsigned* bar = b.bar;
        __builtin_amdgcn_s_waitcnt(0);
        unsigned nloc = b.st[0], nx = b.st[1];
        if (nloc == 0u) { xcd_barrier_complete(bar, b.x, nloc, nx); b.st[0] = nloc; b.st[1] = nx; }
        const unsigned old = xb_add(&bar[XB_XSUB(b.x)], 1u);
        const unsigned gen = old / nloc;
        if (old + 1u == (gen + 1u) * nloc) {
            __builtin_amdgcn_fence(__ATOMIC_RELEASE, "agent");
            asm volatile("s_waitcnt vmcnt(0)" ::: "memory");
            const unsigned og = xb_add(&bar[XB_TOP], 1u);
            const unsigned tg = og / nx;
            if (og + 1u == (tg + 1u) * nx) xb_add(&bar[XB_TOPGEN], 1u);
            else XB_SPIN(xb_ld(&bar[XB_TOPGEN]) == tg, bar);
            __builtin_amdgcn_fence(__ATOMIC_ACQUIRE, "agent");
            xb_add(&bar[XB_XGEN(b.x)], 1u);
            asm volatile("s_waitcnt vmcnt(0)" ::: "memory");
        } else {
            XB_SPIN(xb_ld(&bar[XB_XGEN(b.x)]) == gen, bar);
            __builtin_amdgcn_fence(__ATOMIC_ACQUIRE, "agent");
            asm volatile("s_waitcnt vmcnt(0)" ::: "memory");
        }
    }
    __syncthreads();
}
constexpr int NWAVES = 8;
#ifndef MK_PER_PHASE
#define MK_PER_PHASE 0
#endif
constexpr int N_PHASES = 20;
constexpr int MOE_KS = 1;

constexpr int BATCH = 2, T = 8192, D = 1024, M = BATCH * T;
constexpr int NSA_IN = 2608, NSA_IN_PAD = 2816, FF0 = 2816, GLA_IN = 3088, GLA_IN_PAD = 3328, FFE = 3584, NE = 8;
constexpr int NCMP = 511, MAXTILES = 136, MAXSLOTS = MAXTILES * 256;
constexpr float ALPHA = 1.41421356237309515f;
constexpr float LN_EPS = 1e-5f, RMS_EPS = 1e-6f, LOG2E = 1.44269504088896341f;

constexpr size_t MiB = 1u << 20;
constexpr size_t WS_CTL = 0, CTL_ZERO_BYTES = 1 * MiB;
constexpr size_t WS_PB = 1 * MiB;
constexpr size_t WS_CNTL = WS_PB + 32768;
constexpr size_t WS_TOKE = WS_CNTL + 16384;
constexpr size_t WS_TOKW = WS_TOKE + (size_t)M * 8;
constexpr size_t WS_TOKP = WS_TOKW + (size_t)M * 8;
constexpr size_t WS_TOKS = WS_TOKP + (size_t)M * 8;
static_assert(WS_TOKS + (size_t)M * 8 <= 2 * MiB, "misc region");
constexpr size_t WS_WIN0 = 2 * MiB, WS_W1C = 8 * MiB, WS_WO0 = 10 * MiB, WS_WGU0 = 12 * MiB, WS_WD0 = 23 * MiB, WS_WIN1 = 29 * MiB, WS_WO1 = 36 * MiB, WS_WGU1 = 38 * MiB, WS_WD1 = 150 * MiB;
constexpr size_t WS_XB = 206 * MiB, WS_XRES = 238 * MiB, WS_T0 = 302 * MiB, WS_SCR = 366 * MiB;
constexpr size_t WS_Q = WS_SCR, WS_KV2 = WS_SCR + 32 * MiB, WS_KS = WS_SCR + 48 * MiB, WS_VS = WS_SCR + 56 * MiB, WS_KW = WS_SCR + 64 * MiB, WS_VW = WS_SCR + 72 * MiB;
constexpr size_t WS_GT = WS_SCR + 80 * MiB, WS_UL = WS_SCR + 83 * MiB, WS_KCMP = WS_SCR + 99 * MiB, WS_VCMP = WS_KCMP + 512 * 1024, WS_O = WS_SCR + 100 * MiB, WS_H0 = WS_SCR + 132 * MiB;
constexpr size_t WS_QKVG = WS_SCR, WS_ALOW = WS_SCR + 96 * MiB, WS_BCUM = WS_SCR + 97 * MiB, WS_ZB = WS_SCR + 129 * MiB, WS_DEC = WS_SCR + 257 * MiB, WS_SST = WS_SCR + 258 * MiB, WS_O1 = WS_SCR + 322 * MiB;
constexpr size_t WS_XG = WS_SCR, WS_YB = WS_SCR + 68 * MiB, WS_H2 = WS_SCR + 136 * MiB, WS_YB1 = WS_SCR + 374 * MiB, WS_END = WS_YB1 + 68 * MiB;
static_assert(WS_H2 + (size_t)MAXSLOTS * FFE * 2 <= WS_YB1, "H2 fits");
static_assert(WS_H0 + (size_t)M * FF0 * 2 <= 896 * MiB && WS_O1 + 32 * MiB <= 896 * MiB && WS_END <= 896 * MiB, "d_ws map");
constexpr int CW_TMO = 0, CW_CODE = 1, CW_BAR = 4096;
constexpr int CW_PANEL0 = 16384, CW_PANEL1 = 32768;
static_assert((CW_PANEL1 + 64 * MAXTILES) * 4 <= (int)CTL_ZERO_BYTES, "CTL words inside the memset region");

constexpr int RING_OFF = 0, RING_BYTES = 131072;
constexpr int LDSCTL_OFF = RING_BYTES, MISC_OFF = LDSCTL_OFF + 320;
constexpr int INPTR_OFF = MISC_OFF + 128;
constexpr int LDS_BYTES = 147456;
#ifndef TR_UNROLL
#define TR_UNROLL 8
#endif
typedef float f32x16 __attribute__((ext_vector_type(16)));
typedef short v4i16 __attribute__((ext_vector_type(4)));
typedef unsigned v2u __attribute__((ext_vector_type(2)));
struct Args { const float* in[27]; float* out; unsigned char* ws; int ph_lo, ph_hi; };
struct Frame {
    const Args* A;
    LAS unsigned char* lds;
    volatile LAS unsigned* MISC;
    gu32* ctl;
    int tid, lane, wave;
    int vcu, G, wg;
    unsigned char* ws; float* out;
};
#define inptr(F, k) ((F).A->in[k])
__device__ __forceinline__ float wave_sum(float v) {
#pragma unroll
    for (int o = 1; o < 64; o <<= 1) v += __shfl_xor(v, o);
    return v;
}
__device__ __forceinline__ float bf2f(bf16 h) { return __uint_as_float((unsigned)h << 16); }
__device__ __forceinline__ v4i16 vtr(const LAS unsigned char* p) { return __builtin_amdgcn_ds_read_tr16_b64_v4i16((LAS v4i16*)p); }
__device__ __forceinline__ int crow(int r, int hi) { return (r & 3) + 8 * (r >> 2) + 4 * hi; }

__device__ __forceinline__ void tr_item(const float* src, int ldn, int nvalid, int k0, int n0, bf16* dst, int dld, int drow0, LAS float* scr, int lane) {
    const int n_ = n0 + (lane & 31); const bool ok = n_ < nvalid;
#pragma unroll 8
    for (int i = 0; i < 32; ++i) { const int kk = 2 * i + (lane >> 5); scr[kk * 33 + (lane & 31)] = ok ? src[(size_t)(k0 + kk) * ldn + n_] : 0.f; }
    LDS_WAIT(); asm volatile("" ::: "memory");
    const int c = lane & 7;
#pragma unroll
    for (int j = 0; j < 4; ++j) { const int n = (lane >> 3) + 8 * j; const LAS float* s = scr + (8 * c) * 33 + n;
        v4u o; o.x = pk2(s[0 * 33], s[1 * 33]); o.y = pk2(s[2 * 33], s[3 * 33]); o.z = pk2(s[4 * 33], s[5 * 33]); o.w = pk2(s[6 * 33], s[7 * 33]);
        *(GAS v4u*)(dst + (size_t)(drow0 + n) * dld + k0 + 8 * c) = o; }
    LDS_WAIT(); asm volatile("" ::: "memory");
}
__device__ __forceinline__ int swiglu_row(int n0, int F_) { return n0 < F_ ? (n0 / 128) * 256 + (n0 % 128) : ((n0 - F_) / 128) * 256 + 128 + ((n0 - F_) % 128); }
#define KBNB(idx, nkb, nnb) const int kb = ((idx) % (8 * (nkb))) / 8, nb = ((idx) / (8 * (nkb))) * 8 + (idx) % 8
__device__ __forceinline__ void p0_prologue(Frame& F) {
    LAS float* scr = (LAS float*)(F.lds + RING_OFF + F.wave * 16384);
    const int gw = F.vcu * NWAVES + F.wave, NGW = F.G * NWAVES, lane = F.lane;
    unsigned char* ws = F.ws;
    constexpr int I_IN0 = 16 * (NSA_IN_PAD / 32), I_W1 = 4 * 16 * 8, I_WO = 16 * 32, I_GU0 = 16 * (2 * FF0 / 32), I_D0 = (FF0 / 64) * 32, I_IN1 = 16 * (GLA_IN_PAD / 32);
    constexpr int I_GU1E = 16 * (2 * FFE / 32), I_D1E = (FFE / 64) * 32, I_GU1 = NE * I_GU1E, I_D1 = NE * I_D1E;
    constexpr int NITEMS = I_IN0 + I_W1 + I_WO + I_GU0 + I_D0 + I_IN1 + I_WO + I_GU1 + I_D1;
    for (int it = gw; it < NITEMS; it += NGW) {
        int r = it;
        if (r < I_IN0) { constexpr int nnb = NSA_IN_PAD / 32; KBNB(r, 16, nnb); tr_item(inptr(F, 1), NSA_IN, NSA_IN, 64 * kb, 32 * nb, (bf16*)(ws + WS_WIN0), 1024, 32 * nb, scr, lane); continue; } r -= I_IN0;
        if (r < I_W1) { const int blk = r / 128, q = r % 128; KBNB(q, 16, 8);
            const float* src = ((blk >> 1) ? inptr(F, 6) : inptr(F, 4)) + (size_t)(blk & 1) * 1024 * 256; tr_item(src, 256, 256, 64 * kb, 32 * nb, (bf16*)(ws + WS_W1C), 1024, 256 * blk + 32 * nb, scr, lane); continue; } r -= I_W1;
        if (r < I_WO) { KBNB(r, 16, 32); tr_item(inptr(F, 8), 1024, 1024, 64 * kb, 32 * nb, (bf16*)(ws + WS_WO0), 1024, 32 * nb, scr, lane); continue; } r -= I_WO;
        if (r < I_GU0) { constexpr int nnb = 2 * FF0 / 32; KBNB(r, 16, nnb); tr_item(inptr(F, 11), 2 * FF0, 2 * FF0, 64 * kb, 32 * nb, (bf16*)(ws + WS_WGU0), 1024, swiglu_row(32 * nb, FF0), scr, lane); continue; } r -= I_GU0;
        if (r < I_D0) { KBNB(r, FF0 / 64, 32); tr_item(inptr(F, 12), 1024, 1024, 64 * kb, 32 * nb, (bf16*)(ws + WS_WD0), FF0, 32 * nb, scr, lane); continue; } r -= I_D0;
        if (r < I_IN1) { constexpr int nnb = GLA_IN_PAD / 32; KBNB(r, 16, nnb); tr_item(inptr(F, 15), GLA_IN, GLA_IN, 64 * kb, 32 * nb, (bf16*)(ws + WS_WIN1), 1024, 32 * nb, scr, lane); continue; } r -= I_IN1;
        if (r < I_WO) { KBNB(r, 16, 32); tr_item(inptr(F, 19), 1024, 1024, 64 * kb, 32 * nb, (bf16*)(ws + WS_WO1), 1024, 32 * nb, scr, lane); continue; } r -= I_WO;
        if (r < I_GU1) { constexpr int nnb = 2 * FFE / 32; const int e = r / I_GU1E, q = r % I_GU1E; KBNB(q, 16, nnb);
            tr_item(inptr(F, 23) + (size_t)e * 1024 * 2 * FFE, 2 * FFE, 2 * FFE, 64 * kb, 32 * nb, (bf16*)(ws + WS_WGU1) + (size_t)e * 2 * FFE * 1024, 1024, swiglu_row(32 * nb, FFE), scr, lane); continue; } r -= I_GU1;
        { const int e = r / I_D1E, q = r % I_D1E; KBNB(q, FFE / 64, 32);
            tr_item(inptr(F, 24) + (size_t)e * FFE * 1024, 1024, 1024, 64 * kb, 32 * nb, (bf16*)(ws + WS_WD1) + (size_t)e * 1024 * FFE, FFE, 32 * nb, scr, lane); }
    }
    { const float* x = inptr(F, 0); bf16* xb = (bf16*)(ws + WS_XB);
      for (int m = gw; m < M; m += NGW) { const GAS f32x4* xr = (const GAS f32x4*)(x + (size_t)m * D) + lane; GAS unsigned long long* o8 = (GAS unsigned long long*)(xb + (size_t)m * D) + lane;
#pragma unroll
          for (int j = 0; j < 4; ++j) { const f32x4 v = xr[64 * j]; o8[64 * j] = (unsigned long long)pk2(v.x, v.y) | ((unsigned long long)pk2(v.z, v.w) << 32); } } }
    { float* pb = (float*)(ws + WS_PB);
      for (int task = gw; task < 64; task += NGW) { const int rp = task & 7, cb = (task >> 3) & 3, kv = task >> 5; const float* pe = kv ? inptr(F, 3) : inptr(F, 2); const float* w1 = kv ? inptr(F, 6) : inptr(F, 4); const int c = 64 * cb + lane;
          float a = 0.f;
          for (int r0 = 256 * rp; r0 < 256 * rp + 256; r0 += 32) { float wv[32], pv[32];
#pragma unroll
              for (int u = 0; u < 32; ++u) { wv[u] = *(const GAS float*)(w1 + (size_t)(r0 + u) * 256 + c); pv[u] = *(const GAS float*)(pe + r0 + u); }
#pragma unroll
              for (int u = 0; u < 32; ++u) a += pv[u] * wv[u]; }
          pb[rp * 512 + kv * 256 + c] = a; } }
}

__device__ __forceinline__ float gelu_tanh(float x) { const float y = 0.7978845608028654f * (x + 0.044715f * x * x * x); const float e = __expf(2.f * y); const float th = 1.f - 2.f / (e + 1.f); return 0.5f * x * (1.f + th); }
__device__ __forceinline__ void cmp_finish(Frame& F) {
    const int gw = F.vcu * NWAVES + F.wave, NGW = F.G * NWAVES, lane = F.lane;
    LAS float* hb = (LAS float*)(F.lds + RING_OFF + F.wave * 1024);
    const float* ul = (const float*)(F.ws + WS_UL); const float* pb = (const float*)(F.ws + WS_PB);
    for (int task = gw; task < 8192; task += NGW) {
        const int kv = task >> 12, rem = task & 4095, b = rem >> 11, n = (rem >> 2) & 511, g = rem & 3;
        bf16* dst = (bf16*)(F.ws + (kv ? WS_VCMP : WS_KCMP)) + ((size_t)((b * 4 + g) * 512 + n)) * 64;
        if (n == 511) { dst[lane] = 0; continue; }
        const size_t rowU = (size_t)kv * 4096 + (size_t)(b * 512 + n) * 4 + g, rowL = rowU + 4;
        const f32x4 u = *(const f32x4*)(ul + rowU * 512 + lane * 4), lw = *(const f32x4*)(ul + rowL * 512 + 256 + lane * 4);
        f32x4 bs = (f32x4){0.f, 0.f, 0.f, 0.f};
#pragma unroll
        for (int rp = 0; rp < 8; ++rp) bs += *(const f32x4*)(pb + rp * 512 + kv * 256 + lane * 4);
        const f32x4 pre = u + lw + bs;
        *(LAS f32x4*)(hb + lane * 4) = (f32x4){gelu_tanh(pre[0]), gelu_tanh(pre[1]), gelu_tanh(pre[2]), gelu_tanh(pre[3])};
        LDS_WAIT(); asm volatile("" ::: "memory");
        const float* w2 = kv ? inptr(F, 7) : inptr(F, 5); float a = 0.f;
#pragma unroll 8
        for (int c = 0; c < 256; ++c) a += hb[c] * w2[c * 64 + lane];
        dst[lane] = (bf16)f2bf(a);
        LDS_WAIT(); asm volatile("" ::: "memory");
    }
}

namespace nsa {
constexpr int KB_OFF = 0, VB_OFF = 18432, IMPA_OFF = 36864, IMPB_OFF = 69632, SEL_OFF = 102400, UNI_OFF = 103424, NS_OFF = 103440, SLIST_OFF = 103456, TILE_B = 9216;
static_assert(SLIST_OFF + 512 <= RING_BYTES, "nsa LDS map");
constexpr float THR = 8.f;
__device__ __forceinline__ float dpp_xor1(float v) { return __int_as_float(__builtin_amdgcn_update_dpp(0, __float_as_int(v), 0xB1, 0xF, 0xF, true)); }
__device__ __forceinline__ float dpp_xor2(float v) { return __int_as_float(__builtin_amdgcn_update_dpp(0, __float_as_int(v), 0x4E, 0xF, 0xF, true)); }
__device__ __forceinline__ float max_halves(float v) { const auto rr = __builtin_amdgcn_permlane32_swap(__float_as_uint(v), __float_as_uint(v), false, false); return fmaxf(__uint_as_float(rr[0]), __uint_as_float(rr[1])); }
__device__ __forceinline__ int below(unsigned long long mk) { return (int)__builtin_amdgcn_mbcnt_hi((unsigned)(mk >> 32), __builtin_amdgcn_mbcnt_lo((unsigned)mk, 0u)); }
template <int MODE>
__device__ __forceinline__ void tile(LAS unsigned char* lds, const int kt_off, const int vt_off, const bf16x8 (&qf)[4], const unsigned qaw, f32x16 (&o)[2], float& m, float& l,
                                     const int lane, const float bias, const bool emask, const int d0, const int pstep, const int lim, const float rl, const int impq, const int jbase) {
    const int hi = lane >> 5, qc = lane & 31;
    const v4u qav = (v4u){qaw, 0u, 0u, 0u}; const bf16x8 qaug = __builtin_bit_cast(bf16x8, qav);
    f32x16 p[2];
#pragma unroll
    for (int h2 = 0; h2 < 2; ++h2) {
#pragma unroll
        for (int r = 0; r < 16; ++r) p[h2][r] = 0.f;
#pragma unroll
        for (int ks = 0; ks < 4; ++ks) { const bf16x8 a = *(const LAS bf16x8*)(lds + kt_off + (32 * h2 + qc) * 144 + 32 * ks + 16 * hi);
            p[h2] = __builtin_amdgcn_mfma_f32_32x32x16_bf16(a, qf[ks], p[h2], 0, 0, 0); }
        { const unsigned xb = hi ? 0u : f2bf((float)(32 * h2 + qc)); const v4u kav = (v4u){xb | (xb << 16), 0u, 0u, 0u};
          p[h2] = __builtin_amdgcn_mfma_f32_32x32x16_bf16(__builtin_bit_cast(bf16x8, kav), qaug, p[h2], 0, 0, 0); }
    }
    if (emask) {
#pragma unroll
        for (int h2 = 0; h2 < 2; ++h2)
#pragma unroll
            for (int r = 0; r < 16; ++r) { const int dist = d0 - pstep * (32 * h2 + (r & 3) + 8 * (r >> 2)); p[h2][r] = ((unsigned)dist < (unsigned)lim) ? p[h2][r] : -INFINITY; }
    }
    float mref;
    if (MODE == 1) mref = m - bias;
    else {
        float mx = fmaxf(p[0][0], p[1][0]);
#pragma unroll
        for (int r = 1; r < 16; ++r) mx = fmaxf(fmaxf(mx, p[0][r]), p[1][r]);
        mx = max_halves(mx);
        const float mt = mx + bias;
        const bool up = mt > m + THR;
        if (__any(up)) { const float mn = up ? mt : m; const float f = __builtin_amdgcn_exp2f(m - mn); l *= f; m = mn;
            if (MODE == 2) {
#pragma unroll
                for (int r = 0; r < 16; ++r) { o[0][r] *= f; o[1][r] *= f; } } }
        mref = m - bias;
    }
    float ls0 = 0.f, ls1 = 0.f;
#pragma unroll
    for (int r = 0; r < 16; ++r) { float e0 = __builtin_amdgcn_exp2f(p[0][r] - mref), e1 = __builtin_amdgcn_exp2f(p[1][r] - mref); if (MODE == 1) { e0 *= rl; e1 *= rl; } p[0][r] = e0; p[1][r] = e1; ls0 += e0; ls1 += e1; }
    if (MODE != 1) l += ls0 + ls1;
    if (MODE == 0) return;
    if (MODE == 1) {
        LAS float* IA = (LAS float*)(lds + IMPA_OFF) + impq * 128; LAS float* IB = (LAS float*)(lds + IMPB_OFF) + impq * 128;
#pragma unroll
        for (int h2 = 0; h2 < 2; ++h2)
#pragma unroll
            for (int a4 = 0; a4 < 4; ++a4) {
                float qs = (p[h2][4 * a4] + p[h2][4 * a4 + 1]) + (p[h2][4 * a4 + 2] + p[h2][4 * a4 + 3]), last = p[h2][4 * a4 + 3];
                qs += dpp_xor1(qs); qs += dpp_xor2(qs); last += dpp_xor1(last); last += dpp_xor2(last);
                const int j = jbase + 8 * h2 + 2 * a4 + hi;
                if ((qc & 3) == 0) { IA[j] = qs; if (j + 1 < 128) IB[j + 1] = last; }
            }
    }
    bf16x8 pf[2][2];
#pragma unroll
    for (int h2 = 0; h2 < 2; ++h2)
#pragma unroll
        for (int s2 = 0; s2 < 2; ++s2) { v4u wv; wv.x = pg8::cvtpk_c(p[h2][8 * s2 + 0], p[h2][8 * s2 + 1]); wv.y = pg8::cvtpk_c(p[h2][8 * s2 + 2], p[h2][8 * s2 + 3]);
            wv.z = pg8::cvtpk_c(p[h2][8 * s2 + 4], p[h2][8 * s2 + 5]); wv.w = pg8::cvtpk_c(p[h2][8 * s2 + 6], p[h2][8 * s2 + 7]); pf[h2][s2] = __builtin_bit_cast(bf16x8, wv); }
    const int a = (lane >> 4) & 1, q_ = (lane & 15) >> 2, p_ = lane & 3;
#pragma unroll
    for (int d0_ = 0; d0_ < 2; ++d0_)
#pragma unroll
        for (int h2 = 0; h2 < 2; ++h2)
#pragma unroll
            for (int s2 = 0; s2 < 2; ++s2) {
                const LAS unsigned char* ad = lds + vt_off + (32 * h2 + 16 * s2 + 4 * hi + q_) * 144 + (32 * d0_ + 16 * a + 4 * p_) * 2;
                const v4i16 lo = vtr(ad), hi4 = vtr(ad + 8 * 144);
                const bf16x8 av = (bf16x8){lo[0], lo[1], lo[2], lo[3], hi4[0], hi4[1], hi4[2], hi4[3]};
                o[d0_] = __builtin_amdgcn_mfma_f32_32x32x16_bf16(av, pf[h2][s2], o[d0_], 0, 0, 0);
            }
}
__device__ __forceinline__ void select13(const unsigned (&k0)[4], const unsigned (&k1)[4], const int lane, unsigned long long (&m0)[4], unsigned long long (&m1)[4]) {
    unsigned th[4] = {0u, 0u, 0u, 0u};
    for (int bit = 30; bit >= 0; --bit) {
#pragma unroll
        for (int u = 0; u < 4; ++u) { const unsigned cand = th[u] | (1u << bit); const int cnt = __popcll(__ballot(k0[u] >= cand)) + __popcll(__ballot(k1[u] >= cand)); th[u] = cnt >= 13 ? cand : th[u]; }
    }
#pragma unroll
    for (int u = 0; u < 4; ++u) {
        const unsigned long long gt0 = __ballot(k0[u] > th[u]), gt1 = __ballot(k1[u] > th[u]), eq0 = __ballot(k0[u] == th[u]), eq1 = __ballot(k1[u] == th[u]);
        const int need = 13 - __popcll(gt0) - __popcll(gt1);
        const int r0 = below(eq0), r1 = __popcll(eq0) + below(eq1);
        const bool s0 = (k0[u] > th[u]) || (k0[u] == th[u] && r0 < need), s1 = (k1[u] > th[u]) || (k1[u] == th[u] && r1 < need);
        m0[u] = __ballot(s0); m1[u] = __ballot(s1);
    }
}
}
__device__ __forceinline__ void nsa_attn_phase(Frame& F) {
    using namespace nsa;
    LAS unsigned char* lds = F.lds + RING_OFF;
    const int tid = F.tid, lane = F.lane, w = F.wave, hi = lane >> 5, qc = lane & 31;
    unsigned char* ws = F.ws;
    const bf16* Qp = (const bf16*)(ws + WS_Q); const float* GT = (const float*)(ws + WS_GT); bf16* Op = (bf16*)(ws + WS_O);
    LAS unsigned* SEL = (LAS unsigned*)(lds + SEL_OFF); LAS unsigned* UNI = (LAS unsigned*)(lds + UNI_OFF); LAS int* NSW = (LAS int*)(lds + NS_OFF); LAS int* SLIST = (LAS int*)(lds + SLIST_OFF);
    const int lrow = tid >> 3, lch = tid & 7;
    for (int un = F.wg; un < 1024; un += F.G) {
        const int bg = un & 7, cc = un >> 3, c = ((cc >> 5) & 1) ? (cc & ~31) + 31 - (cc & 31) : cc;
        const int b = bg >> 2, g = bg & 3, t0 = c * 64;
        const int tql = 8 * w + (qc >> 2), hh = qc & 3, t = t0 + tql, head = 4 * g + hh;
        const size_t mrow = (size_t)b * T + t;
        const float slope2 = __builtin_amdgcn_exp2f(-0.5f * (float)(head + 1)) * LOG2E;
        unsigned qaw1, qaw16;
        { const unsigned sh = f2bf(slope2); const float rem = slope2 - __uint_as_float(sh << 16); const unsigned sl = f2bf(rem);
          const unsigned sh16 = f2bf(16.f * __uint_as_float(sh << 16)), sl16 = f2bf(16.f * __uint_as_float(sl << 16));
          qaw1 = hi ? 0u : (sh | (sl << 16)); qaw16 = hi ? 0u : (sh16 | (sl16 << 16)); }
        bf16x8 qf[4];
#pragma unroll
        for (int ks = 0; ks < 4; ++ks) qf[ks] = *(const GAS bf16x8*)(Qp + mrow * 1024 + head * 64 + 16 * ks + 8 * hi);
        const float* gp = GT + mrow * 48 + (g * 4 + hh) * 3; const float g_cmp = gp[0], g_slc = gp[1], g_win = gp[2];
        const int nmax = (4 * c + 2) < 510 ? (4 * c + 2) : 510, ncb = nmax / 64 + 1;
        const int jw0 = c - 8 > 0 ? c - 8 : 0, nw = c - jw0 + 1, S3 = 2 * ncb + nw;
        const unsigned kcb = (unsigned)WS_KCMP + (unsigned)(b * 4 + g) * 65536u, kvb = ((unsigned)b * T * 256u + (unsigned)g * 64u) * 2u;
        const unsigned thr64 = (unsigned)(lrow * 128 + lch * 16), thr256 = (unsigned)(lrow * 512 + lch * 16);
        int ns = 1;
#define NSA_FETCH(s, kr, vr) do { const int s_ = (s); unsigned ko_, vo_ = 0u; \
            if (s_ < ncb) { ko_ = kcb + (unsigned)s_ * 8192u + thr64; } \
            else if (s_ < 2 * ncb) { ko_ = kcb + (unsigned)(s_ - ncb) * 8192u + thr64; vo_ = ko_ + (unsigned)(WS_VCMP - WS_KCMP); } \
            else if (s_ < S3) { ko_ = (unsigned)WS_KW + kvb + (unsigned)(c - (s_ - 2 * ncb)) * 32768u + thr256; vo_ = ko_ + (unsigned)(WS_VW - WS_KW); } \
            else { ko_ = (unsigned)WS_KS + kvb + (unsigned)SLIST[ns - 1 - (s_ - S3)] * 32768u + thr256; vo_ = ko_ + (unsigned)(WS_VS - WS_KS); } \
            kr = *(const GAS v4u*)(ws + ko_); if (s_ >= ncb) vr = *(const GAS v4u*)(ws + vo_); } while (0)
#define NSA_COMMIT(s, kr, vr) do { const int bo_ = ((s) & 1) * TILE_B + lrow * 144 + lch * 16; *(LAS v4u*)(lds + KB_OFF + bo_) = kr; if ((s) >= ncb) *(LAS v4u*)(lds + VB_OFF + bo_) = vr; } while (0)
        __syncthreads();
        if (c <= 15) {
            int ln = lane; asm volatile("" : "+v"(ln));
            if (ln < 8) { const int q = 8 * w + ln; SEL[q * 4 + 0] = (2u << c) - 1u; SEL[q * 4 + 1] = 0u; SEL[q * 4 + 2] = 0u; SEL[q * 4 + 3] = 0u; }
            if (w == 0 && ln <= c) SLIST[ln] = ln;
            ns = c + 1; }
        else if (tid < 4) UNI[tid] = 0u;
        int ST = S3 + ns;
        v4u krA = (v4u){0u, 0u, 0u, 0u}, vrA = krA, krB = krA, vrB = krA;
        NSA_FETCH(0, krA, vrA); NSA_COMMIT(0, krA, vrA); NSA_FETCH(1, krB, vrB);
        __syncthreads();
        float m = -1e30f, l = 0.f, rl = 0.f; f32x16 o[2]; unsigned otp[2][8];
#pragma unroll
        for (int r = 0; r < 16; ++r) { o[0][r] = 0.f; o[1][r] = 0.f; }
#pragma unroll
        for (int r = 0; r < 8; ++r) { otp[0][r] = 0u; otp[1][r] = 0u; }
        for (int s = 0; s < ST; ++s) {
            const bool has_next = s + 1 < ST;
            if (s + 2 < ST) { if (s & 1) NSA_FETCH(s + 2, krB, vrB); else NSA_FETCH(s + 2, krA, vrA); }
            const int kt = KB_OFF + (s & 1) * TILE_B, vt = VB_OFF + (s & 1) * TILE_B;
            if (s < 2 * ncb) { const int kb = s < ncb ? s : s - ncb; const int pos0 = 1024 * kb + 31;
                const float bias = slope2 * (float)(pos0 - t); const bool em = 1024 * kb + 1039 > t0; const int d0 = t - pos0 - 64 * hi;
                if (s < ncb) tile<0>(lds, kt, vt, qf, qaw16, o, m, l, lane, bias, em, d0, 16, 0x7fffffff, 0.f, tql, 0);
#if defined(PROBE_NSA) && PROBE_NSA == 7
                if (s < ncb) { float m2 = m, l2 = l; tile<0>(lds, kt, vt, qf, qaw16, o, m2, l2, lane, bias, em, d0, 16, 0x7fffffff, 0.f, tql, 0); asm volatile("" :: "v"(m2), "v"(l2)); }
#endif
                else tile<1>(lds, kt, vt, qf, qaw16, o, m, l, lane, bias, em, d0, 16, 0x7fffffff, rl, tql, 16 * kb); }
            else { int j; float bias; int lim;
                if (s < S3) { j = c - (s - 2 * ncb); bias = slope2 * (float)(64 * j - t); lim = 512; }
                else { j = SLIST[ns - 1 - (s - S3)]; const bool selq = (SEL[tql * 4 + (j >> 5)] >> (j & 31)) & 1u; bias = selq ? slope2 * (float)(64 * j - t) : -INFINITY; lim = 0x7fffffff; }
                const bool em = (j == c) || (s < S3 && c >= 8 && j == c - 8);
                tile<2>(lds, kt, vt, qf, qaw1, o, m, l, lane, bias, em, t - 64 * j - 4 * hi, 1, lim, 0.f, 0, 0); }
            if (s == ncb - 1) { const float lt0 = l + __shfl_xor(l, 32); rl = 1.0f / fmaxf(lt0, 1e-30f); }
            if (s == 2 * ncb - 1) {
#pragma unroll
                for (int r = 0; r < 8; ++r) { otp[0][r] = pg8::cvtpk_c(g_cmp * o[0][2 * r], g_cmp * o[0][2 * r + 1]); otp[1][r] = pg8::cvtpk_c(g_cmp * o[1][2 * r], g_cmp * o[1][2 * r + 1]); }
#pragma unroll
                for (int r = 0; r < 16; ++r) { o[0][r] = 0.f; o[1][r] = 0.f; }
                m = -1e30f; l = 0.f; }
            if (s == S3 - 1) { const float lt = l + __shfl_xor(l, 32); const float sc = g_win / fmaxf(lt, 1e-30f);
#pragma unroll
                for (int r = 0; r < 8; ++r) { otp[0][r] = pg8::cvtpk_c(__uint_as_float(otp[0][r] << 16) + sc * o[0][2 * r], __uint_as_float(otp[0][r] & 0xffff0000u) + sc * o[0][2 * r + 1]);
                    otp[1][r] = pg8::cvtpk_c(__uint_as_float(otp[1][r] << 16) + sc * o[1][2 * r], __uint_as_float(otp[1][r] & 0xffff0000u) + sc * o[1][2 * r + 1]); }
#pragma unroll
                for (int r = 0; r < 16; ++r) { o[0][r] = 0.f; o[1][r] = 0.f; }
                m = -1e30f; l = 0.f; }
            if (has_next) { if (s & 1) NSA_COMMIT(s + 1, krA, vrA); else NSA_COMMIT(s + 1, krB, vrB); }
            __syncthreads();
            if (s == 2 * ncb - 1 && c >= 16) {
                {
                    unsigned long long uo0 = 0ull, uo1 = 0ull;
#if defined(PROBE_NSA) && PROBE_NSA == 6
                    for (int qq = 0; qq < 16; qq += 4) { const int qi = qq & 7;
#else
                    for (int qi = 0; qi < 8; qi += 4) {
#endif
                        unsigned k0[4], k1[4]; unsigned long long m0[4], m1[4];
#pragma unroll
                        for (int u = 0; u < 4; ++u) { const int q = 8 * w + qi + u;
                            const LAS float* ia = (const LAS float*)(lds + IMPA_OFF) + q * 128; const LAS float* ib = (const LAS float*)(lds + IMPB_OFF) + q * 128;
                            const float v0 = ia[lane] + ib[lane], v1 = ia[lane + 64] + ib[lane + 64];
                            k0[u] = (lane >= 1 && lane <= c - 2) ? __float_as_uint(v0) + 1u : 0u; k1[u] = (lane + 64 <= c - 2) ? __float_as_uint(v1) + 1u : 0u; }
                        select13(k0, k1, lane, m0, m1);
#pragma unroll
                        for (int u = 0; u < 4; ++u) { const int q = 8 * w + qi + u;
                            m0[u] |= 1ull;
                            if (c - 1 < 64) m0[u] |= 1ull << (c - 1); else m1[u] |= 1ull << (c - 1 - 64);
                            if (c < 64) m0[u] |= 1ull << c; else m1[u] |= 1ull << (c - 64);
                            uo0 |= m0[u]; uo1 |= m1[u];
                            if (lane == 0) { SEL[q * 4 + 0] = (unsigned)m0[u]; SEL[q * 4 + 1] = (unsigned)(m0[u] >> 32); SEL[q * 4 + 2] = (unsigned)m1[u]; SEL[q * 4 + 3] = (unsigned)(m1[u] >> 32); } }
                    }
                    if (lane == 0) { __hip_atomic_fetch_or(UNI + 0, (unsigned)uo0, __ATOMIC_RELAXED, __HIP_MEMORY_SCOPE_WORKGROUP); __hip_atomic_fetch_or(UNI + 1, (unsigned)(uo0 >> 32), __ATOMIC_RELAXED, __HIP_MEMORY_SCOPE_WORKGROUP);
                        __hip_atomic_fetch_or(UNI + 2, (unsigned)uo1, __ATOMIC_RELAXED, __HIP_MEMORY_SCOPE_WORKGROUP); __hip_atomic_fetch_or(UNI + 3, (unsigned)(uo1 >> 32), __ATOMIC_RELAXED, __HIP_MEMORY_SCOPE_WORKGROUP); }
                }
                __syncthreads();
                if (w == 0) {
                    const unsigned long long u0 = (unsigned long long)UNI[0] | ((unsigned long long)UNI[1] << 32), u1 = (unsigned long long)UNI[2] | ((unsigned long long)UNI[3] << 32);
                    if ((u0 >> lane) & 1ull) SLIST[below(u0)] = lane;
                    if ((u1 >> lane) & 1ull) SLIST[__popcll(u0) + below(u1)] = 64 + lane;
                    if (lane == 0) NSW[0] = __popcll(u0) + __popcll(u1);
                }
                __syncthreads();
                ns = __builtin_amdgcn_readfirstlane(NSW[0]); ST = S3 + ns;
            }
        }
        { const float lt = l + __shfl_xor(l, 32); const float sc = g_slc / fmaxf(lt, 1e-30f);
          bf16* orow = Op + mrow * 1024 + head * 64;
#pragma unroll
          for (int d0 = 0; d0 < 2; ++d0)
#pragma unroll
              for (int a4 = 0; a4 < 4; ++a4) { const unsigned p0_ = otp[d0][2 * a4], p1_ = otp[d0][2 * a4 + 1]; v2u wv;
                  wv.x = pg8::cvtpk_c(__uint_as_float(p0_ << 16) + sc * o[d0][4 * a4], __uint_as_float(p0_ & 0xffff0000u) + sc * o[d0][4 * a4 + 1]);
                  wv.y = pg8::cvtpk_c(__uint_as_float(p1_ << 16) + sc * o[d0][4 * a4 + 2], __uint_as_float(p1_ & 0xffff0000u) + sc * o[d0][4 * a4 + 3]);
                  *(GAS v2u*)(orow + 32 * d0 + 8 * a4 + 4 * hi) = wv; } }
#undef NSA_FETCH
#undef NSA_COMMIT
    }
}

__device__ __forceinline__ f32x4 bf4(const v2u a) { return (f32x4){__uint_as_float(a.x << 16), __uint_as_float(a.x & 0xffff0000u), __uint_as_float(a.y << 16), __uint_as_float(a.y & 0xffff0000u)}; }
__device__ __forceinline__ void ln_rows(Frame& F, const bf16* tin, const float* gain, const float* bias, bf16* xb) {
    const int gw = F.vcu * NWAVES + F.wave, NGW = F.G * NWAVES, lane = F.lane;
    f32x4 gv[4], bv[4];
#pragma unroll
    for (int j = 0; j < 4; ++j) { gv[j] = *((const GAS f32x4*)gain + lane + 64 * j); bv[j] = *((const GAS f32x4*)bias + lane + 64 * j); }
    for (int m = gw; m < M; m += NGW) {
        const GAS v2u* xr = (const GAS v2u*)(tin + (size_t)m * D) + lane;
        f32x4 v[4]; float s = 0.f;
#pragma unroll
        for (int j = 0; j < 4; ++j) { v[j] = bf4(xr[64 * j]); s += (v[j].x + v[j].y) + (v[j].z + v[j].w); }
        const float mean = wave_sum(s) * (1.f / D); float s2 = 0.f;
#pragma unroll
        for (int j = 0; j < 4; ++j) { v[j] = v[j] - mean; s2 += (v[j].x * v[j].x + v[j].y * v[j].y) + (v[j].z * v[j].z + v[j].w * v[j].w); }
        const float rstd = 1.f / sqrtf(wave_sum(s2) * (1.f / D) + LN_EPS);
        GAS unsigned long long* o8 = (GAS unsigned long long*)(xb + (size_t)m * D) + lane;
#pragma unroll
        for (int j = 0; j < 4; ++j) { const f32x4 y = v[j] * rstd * gv[j] + bv[j]; o8[64 * j] = (unsigned long long)pk2(y.x, y.y) | ((unsigned long long)pk2(y.z, y.w) << 32); }
    }
}
namespace gla {
constexpr int ALS_OFF = 0, SEG_OFF = 4096, KH_OFF = 8192, KH_STR = 272, VH1_OFF = KH_OFF + 64 * KH_STR, VH_STR = 528, ZL_OFF = VH1_OFF + 64 * VH_STR, ZL_STR = 272;
constexpr int QS_OFF = 0, QS_STR = 272, AL_OFF = 64 * QS_STR, AL_STR = 144, VH3_OFF = AL_OFF + 64 * AL_STR, ST_OFF = VH3_OFF + 64 * VH_STR, ST_STR = 272, QT_OFF = ST_OFF, KT_OFF = ST_OFF + 64 * QS_STR, SSQ_OFF = ST_OFF + 256 * ST_STR;
constexpr int OL_OFF = ST_OFF, OL_STR = 1040;
static_assert(SSQ_OFF + 1024 <= RING_BYTES && ZL_OFF + 256 * ZL_STR <= RING_BYTES && KT_OFF + 64 * QS_STR <= SSQ_OFF && OL_OFF + 64 * OL_STR <= SSQ_OFF, "gla LDS map");
__device__ __forceinline__ bf16x8 trfrag(const LAS unsigned char* p, int rowstep4) { const v4i16 lo = vtr(p), hi4 = vtr(p + rowstep4); return (bf16x8){lo[0], lo[1], lo[2], lo[3], hi4[0], hi4[1], hi4[2], hi4[3]}; }
}
__device__ __forceinline__ void gla_load_v(LAS unsigned char* lds, int off, const bf16* qkvg, size_t m0, int vcol0, int tid) {
#pragma unroll
    for (int k = 0; k < 4; ++k) { const int q = tid + 512 * k, row = q >> 5, ch = q & 31;
        const v4u v = *(const GAS v4u*)(qkvg + (m0 + row) * 3072 + vcol0 + ch * 8); *(LAS v4u*)(lds + off + row * gla::VH_STR + ch * 16) = v; }
}
__device__ __forceinline__ void gla_g1(Frame& F) {
    using namespace gla;
    LAS unsigned char* lds = F.lds + RING_OFF; const int tid = F.tid, lane = F.lane, w = F.wave, hi = lane >> 5, qc = lane & 31;
    unsigned char* ws = F.ws; const bf16* qkvg = (const bf16*)(ws + WS_QKVG); const float* alow = (const float*)(ws + WS_ALOW);
    float* bcum = (float*)(ws + WS_BCUM); bf16* zb = (bf16*)(ws + WS_ZB); float* dec = (float*)(ws + WS_DEC);
    const float* wg2 = inptr(F, 16); const float* bg2 = inptr(F, 17);
    LAS float* ALS = (LAS float*)(lds + ALS_OFF); LAS float* SEG = (LAS float*)(lds + SEG_OFF);
    const int d = tid & 127, ig = tid >> 7;
    for (int un = F.wg; un < 1024; un += F.G) {
        const int bh = un >> 7, n = un & 127, b = bh >> 2, h = bh & 3; const size_t m0 = (size_t)b * T + 64 * n;
        __syncthreads();
        if (tid < 256) *(LAS f32x4*)(ALS + tid * 4) = *(const GAS f32x4*)(alow + m0 * 16 + tid * 4);
        gla_load_v(lds, VH1_OFF, qkvg, m0, 1024 + h * 256, tid);
        bf16 kraw[16];
#pragma unroll
        for (int ii = 0; ii < 16; ++ii) kraw[ii] = *(const GAS bf16*)(qkvg + (m0 + 16 * ig + ii) * 3072 + 512 + h * 128 + d);
        float wg[16];
#pragma unroll
        for (int r = 0; r < 16; ++r) wg[r] = wg2[r * 512 + h * 128 + d];
        const float bgv = bg2[h * 128 + d];
        __syncthreads();
        float cs[16]; float run = 0.f;
#pragma unroll
        for (int ii = 0; ii < 16; ++ii) { const int i = 16 * ig + ii; float z = bgv;
#pragma unroll
            for (int r = 0; r < 16; ++r) z += ALS[i * 16 + r] * wg[r];
            const float la = (fminf(z, 0.f) - __logf(1.f + __expf(-fabsf(z)))) * (1.f / 16.f);
            run += la; cs[ii] = run; }
        SEG[ig * 128 + d] = run;
        __syncthreads();
        float pre = 0.f, tot = 0.f;
#pragma unroll
        for (int k = 0; k < 4; ++k) { const float sv = SEG[k * 128 + d]; if (k < ig) pre += sv; tot += sv; }
#pragma unroll
        for (int ii = 0; ii < 16; ++ii) { const int i = 16 * ig + ii; cs[ii] += pre;
            *(LAS bf16*)(lds + KH_OFF + i * KH_STR + d * 2) = (bf16)f2bf(bf2f(kraw[ii]) * __expf(tot - cs[ii])); }
#pragma unroll
        for (int ii = 0; ii < 16; ++ii) *(GAS float*)(bcum + (m0 + 16 * ig + ii) * 512 + h * 128 + d) = cs[ii];
        if (ig == 0) dec[(size_t)(bh * 128 + n) * 128 + d] = __expf(tot);
        __syncthreads();
        f32x16 acc[4];
#pragma unroll
        for (int db = 0; db < 4; ++db)
#pragma unroll
            for (int r = 0; r < 16; ++r) acc[db][r] = 0.f;
        const int a = (lane >> 4) & 1, q_ = (lane & 15) >> 2, p_ = lane & 3;
#pragma unroll
        for (int s = 0; s < 4; ++s) {
            const bf16x8 bfr = trfrag(lds + VH1_OFF + (16 * s + 8 * hi + q_) * VH_STR + (32 * w + 16 * a + 4 * p_) * 2, 4 * VH_STR);
#pragma unroll
            for (int db = 0; db < 4; ++db) { const bf16x8 afr = trfrag(lds + KH_OFF + (16 * s + 8 * hi + q_) * KH_STR + (32 * db + 16 * a + 4 * p_) * 2, 4 * KH_STR);
                acc[db] = __builtin_amdgcn_mfma_f32_32x32x16_bf16(afr, bfr, acc[db], 0, 0, 0); }
        }
#pragma unroll
        for (int db = 0; db < 4; ++db)
#pragma unroll
            for (int a4 = 0; a4 < 4; ++a4) { v2u wv; wv.x = pg8::cvtpk_c(acc[db][4 * a4], acc[db][4 * a4 + 1]); wv.y = pg8::cvtpk_c(acc[db][4 * a4 + 2], acc[db][4 * a4 + 3]);
                *(LAS v2u*)(lds + ZL_OFF + (32 * w + qc) * ZL_STR + (32 * db + 8 * a4 + 4 * hi) * 2) = wv; }
        __syncthreads();
        { bf16* zu = zb + (size_t)(bh * 128 + n) * 256 * 128;
#pragma unroll
          for (int k = 0; k < 8; ++k) { const int q = tid + 512 * k, row = q >> 4, ch = q & 15; *(GAS v4u*)(zu + row * 128 + ch * 8) = *(const LAS v4u*)(lds + ZL_OFF + row * ZL_STR + ch * 16); } }
    }
}
__device__ __forceinline__ void gla_g2(Frame& F) {
    unsigned char* ws = F.ws; const bf16* zb = (const bf16*)(ws + WS_ZB); const float* dec = (const float*)(ws + WS_DEC); bf16* sst = (bf16*)(ws + WS_SST);
    for (int p = F.wg * 512 + F.tid; p < 131072; p += F.G * 512) {
        const int bh = p >> 14, e = (p >> 6) & 255, d2 = p & 63;
        float s0 = 0.f, s1 = 0.f;
        for (int n0 = 0; n0 < 128; n0 += 8) {
            pg8::f32x2 dv[8]; unsigned zz[8];
#pragma unroll
            for (int k = 0; k < 8; ++k) { const size_t cn = (size_t)(bh * 128 + n0 + k); dv[k] = *(const GAS pg8::f32x2*)(dec + cn * 128 + 2 * d2); zz[k] = *(const GAS unsigned*)(zb + (cn * 256 + e) * 128 + 2 * d2); }
#pragma unroll
            for (int k = 0; k < 8; ++k) { const size_t cn = (size_t)(bh * 128 + n0 + k);
                *(GAS unsigned*)(sst + (cn * 256 + e) * 128 + 2 * d2) = pk2(s0, s1);
                s0 = s0 * dv[k].x + __uint_as_float(zz[k] << 16); s1 = s1 * dv[k].y + __uint_as_float(zz[k] & 0xffff0000u); }
        }
    }
}
__device__ __forceinline__ void gla_g3(Frame& F) {
    using namespace gla;
    LAS unsigned char* lds = F.lds + RING_OFF; const int tid = F.tid, lane = F.lane, w = F.wave, hi = lane >> 5, qc = lane & 31;
    unsigned char* ws = F.ws; const bf16* qkvg = (const bf16*)(ws + WS_QKVG); const float* bcum = (const float*)(ws + WS_BCUM); const bf16* sst = (const bf16*)(ws + WS_SST);
    bf16* o1 = (bf16*)(ws + WS_O1); const float* hng = inptr(F, 18);
    LAS float* SSQ = (LAS float*)(lds + SSQ_OFF);
    const int d = tid & 127, ig = tid >> 7;
    const int a = (lane >> 4) & 1, q_ = (lane & 15) >> 2, p_ = lane & 3;
    for (int un = F.wg; un < 1024; un += F.G) {
        const int bh = un >> 7, n = un & 127, b = bh >> 2, h = bh & 3; const size_t m0 = (size_t)b * T + 64 * n;
        __syncthreads();
        gla_load_v(lds, VH3_OFF, qkvg, m0, 1024 + h * 256, tid);
        v4u sreg[8];
        { const bf16* sp = sst + (size_t)(bh * 128 + n) * 256 * 128;
#pragma unroll
          for (int k = 0; k < 8; ++k) { const int q = tid + 512 * k, row = q >> 4, ch = q & 15; sreg[k] = *(const GAS v4u*)(sp + row * 128 + ch * 8); } }
        { const float bref = bcum[(m0 + 32) * 512 + h * 128 + d];
          float bb[16]; bf16 qr[16], kr[16];
#pragma unroll
          for (int ii = 0; ii < 16; ++ii) { const size_t mi = m0 + 16 * ig + ii; bb[ii] = *(const GAS float*)(bcum + mi * 512 + h * 128 + d);
              qr[ii] = *(const GAS bf16*)(qkvg + mi * 3072 + h * 128 + d); kr[ii] = *(const GAS bf16*)(qkvg + mi * 3072 + 512 + h * 128 + d); }
#pragma unroll
          for (int ii = 0; ii < 16; ++ii) { const int i = 16 * ig + ii; const float qv = bf2f(qr[ii]), kv = bf2f(kr[ii]);
              *(LAS bf16*)(lds + QT_OFF + i * QS_STR + d * 2) = (bf16)f2bf(qv * __expf(bb[ii] - bref));
              *(LAS bf16*)(lds + KT_OFF + i * QS_STR + d * 2) = (bf16)f2bf(kv * __expf(bref - bb[ii]));
              *(LAS bf16*)(lds + QS_OFF + i * QS_STR + d * 2) = (bf16)f2bf(qv * __expf(bb[ii])); } }
        __syncthreads();
        if (w < 4) {
            const int jb = w >> 1, ib = w & 1; f32x16 acc;
#pragma unroll
            for (int r = 0; r < 16; ++r) acc[r] = 0.f;
#pragma unroll
            for (int s = 0; s < 8; ++s) { const bf16x8 afr = *(const LAS bf16x8*)(lds + KT_OFF + (32 * jb + qc) * QS_STR + 32 * s + 16 * hi), bfr = *(const LAS bf16x8*)(lds + QT_OFF + (32 * ib + qc) * QS_STR + 32 * s + 16 * hi);
                acc = __builtin_amdgcn_mfma_f32_32x32x16_bf16(afr, bfr, acc, 0, 0, 0); }
            const int i = 32 * ib + qc;
#pragma unroll
            for (int a4 = 0; a4 < 4; ++a4) { float v[4];
#pragma unroll
                for (int k = 0; k < 4; ++k) { const int j = 32 * jb + 8 * a4 + 4 * hi + k; v[k] = (j <= i) ? acc[4 * a4 + k] : 0.f; }
                v2u wv; wv.x = pg8::cvtpk_c(v[0], v[1]); wv.y = pg8::cvtpk_c(v[2], v[3]);
                *(LAS v2u*)(lds + AL_OFF + i * AL_STR + (32 * jb + 8 * a4 + 4 * hi) * 2) = wv; }
        }
        __syncthreads();
#pragma unroll
        for (int k = 0; k < 8; ++k) { const int q = tid + 512 * k, row = q >> 4, ch = q & 15; *(LAS v4u*)(lds + ST_OFF + row * ST_STR + ch * 16) = sreg[k]; }
        v4u ggr[4];
#pragma unroll
        for (int k = 0; k < 4; ++k) { const int q = tid + 512 * k, row = q >> 5, ch = q & 31; ggr[k] = *(const GAS v4u*)(qkvg + (m0 + row) * 3072 + 2048 + h * 256 + ch * 8); }
        __syncthreads();
        const int ib = w & 1, eq = w >> 1; f32x16 acc2[2];
#pragma unroll
        for (int r = 0; r < 16; ++r) { acc2[0][r] = 0.f; acc2[1][r] = 0.f; }
#pragma unroll
        for (int s = 0; s < 4; ++s) { const bf16x8 bfr = *(const LAS bf16x8*)(lds + AL_OFF + (32 * ib + qc) * AL_STR + 32 * s + 16 * hi);
#pragma unroll
            for (int e2 = 0; e2 < 2; ++e2) { const bf16x8 afr = trfrag(lds + VH3_OFF + (16 * s + 8 * hi + q_) * VH_STR + (32 * (2 * eq + e2) + 16 * a + 4 * p_) * 2, 4 * VH_STR);
                acc2[e2] = __builtin_amdgcn_mfma_f32_32x32x16_bf16(afr, bfr, acc2[e2], 0, 0, 0); } }
#pragma unroll
        for (int s = 0; s < 8; ++s) { const bf16x8 bfr = *(const LAS bf16x8*)(lds + QS_OFF + (32 * ib + qc) * QS_STR + 32 * s + 16 * hi);
#pragma unroll
            for (int e2 = 0; e2 < 2; ++e2) { const bf16x8 afr = *(const LAS bf16x8*)(lds + ST_OFF + (32 * (2 * eq + e2) + qc) * ST_STR + 32 * s + 16 * hi);
                acc2[e2] = __builtin_amdgcn_mfma_f32_32x32x16_bf16(afr, bfr, acc2[e2], 0, 0, 0); } }
        float ss = 0.f;
#pragma unroll
        for (int r = 0; r < 16; ++r) ss += acc2[0][r] * acc2[0][r] + acc2[1][r] * acc2[1][r];
        ss += __shfl_xor(ss, 32);
        const int i = 32 * ib + qc;
        if (hi == 0) SSQ[i * 4 + eq] = ss;
        __syncthreads();
#pragma unroll
        for (int e2 = 0; e2 < 2; ++e2)
#pragma unroll
            for (int a4 = 0; a4 < 4; ++a4) *(LAS f32x4*)(lds + OL_OFF + i * OL_STR + (32 * (2 * eq + e2) + 8 * a4 + 4 * hi) * 4) = (f32x4){acc2[e2][4 * a4], acc2[e2][4 * a4 + 1], acc2[e2][4 * a4 + 2], acc2[e2][4 * a4 + 3]};
        __syncthreads();
#pragma unroll
        for (int k = 0; k < 4; ++k) { const int q = tid + 512 * k, row = q >> 5, ch = q & 31;
            const float tot = (SSQ[row * 4 + 0] + SSQ[row * 4 + 1]) + (SSQ[row * 4 + 2] + SSQ[row * 4 + 3]); const float rstd = 1.f / sqrtf(tot * (1.f / 256.f) + RMS_EPS);
            const f32x4 oa = *(const LAS f32x4*)(lds + OL_OFF + row * OL_STR + ch * 32), ob = *(const LAS f32x4*)(lds + OL_OFF + row * OL_STR + ch * 32 + 16);
            const v4u gg = ggr[k];
            const f32x4 na = *(const GAS f32x4*)(hng + h * 256 + ch * 8), nb = *(const GAS f32x4*)(hng + h * 256 + ch * 8 + 4);
            const float g0 = __uint_as_float(gg.x << 16), g1 = __uint_as_float(gg.x & 0xffff0000u), g2 = __uint_as_float(gg.y << 16), g3 = __uint_as_float(gg.y & 0xffff0000u);
            const float g4 = __uint_as_float(gg.z << 16), g5 = __uint_as_float(gg.z & 0xffff0000u), g6 = __uint_as_float(gg.w << 16), g7 = __uint_as_float(gg.w & 0xffff0000u);
            v4u wv; wv.x = pg8::cvtpk_c(oa[0] * rstd * na[0] * pg8::silu1(g0), oa[1] * rstd * na[1] * pg8::silu1(g1)); wv.y = pg8::cvtpk_c(oa[2] * rstd * na[2] * pg8::silu1(g2), oa[3] * rstd * na[3] * pg8::silu1(g3));
            wv.z = pg8::cvtpk_c(ob[0] * rstd * nb[0] * pg8::silu1(g4), ob[1] * rstd * nb[1] * pg8::silu1(g5)); wv.w = pg8::cvtpk_c(ob[2] * rstd * nb[2] * pg8::silu1(g6), ob[3] * rstd * nb[3] * pg8::silu1(g7));
            *(GAS v4u*)(o1 + (m0 + row) * 1024 + h * 256 + ch * 8) = wv; }
    }
}
__device__ __forceinline__ void ln_router(Frame& F, const bf16* tin, const float* gain, const float* bias, bf16* xb) {
    LAS unsigned char* lds = F.lds + RING_OFF; const int lane = F.lane, w = F.wave;
    unsigned char* ws = F.ws; const float* wr = inptr(F, 22);
    int* toke = (int*)(ws + WS_TOKE); float* tokw = (float*)(ws + WS_TOKW); int* tokp = (int*)(ws + WS_TOKP); int* cntl = (int*)(ws + WS_CNTL);
    const int RPW = M / F.G, RPV = RPW / NWAVES;
    LAS int* EL = (LAS int*)lds;
    f32x4 gv[4], bv[4];
#pragma unroll
    for (int j = 0; j < 4; ++j) { gv[j] = *((const GAS f32x4*)gain + lane + 64 * j); bv[j] = *((const GAS f32x4*)bias + lane + 64 * j); }
    __syncthreads();
    for (int rr = 0; rr < RPV; ++rr) {
        const int lr = w * RPV + rr, m = F.wg * RPW + lr;
        const GAS v2u* xr = (const GAS v2u*)(tin + (size_t)m * D) + lane;
        f32x4 v[4]; float s = 0.f;
#pragma unroll
        for (int j = 0; j < 4; ++j) { v[j] = bf4(xr[64 * j]); s += (v[j].x + v[j].y) + (v[j].z + v[j].w); }
        const float mean = wave_sum(s) * (1.f / D); float s2 = 0.f;
#pragma unroll
        for (int j = 0; j < 4; ++j) { v[j] = v[j] - mean; s2 += (v[j].x * v[j].x + v[j].y * v[j].y) + (v[j].z * v[j].z + v[j].w * v[j].w); }
        const float rstd = 1.f / sqrtf(wave_sum(s2) * (1.f / D) + LN_EPS);
        GAS unsigned long long* o8 = (GAS unsigned long long*)(xb + (size_t)m * D) + lane;
        float lg[8];
#pragma unroll
        for (int e = 0; e < 8; ++e) lg[e] = 0.f;
#pragma unroll
        for (int j = 0; j < 4; ++j) { const f32x4 y = v[j] * rstd * gv[j] + bv[j]; o8[64 * j] = (unsigned long long)pk2(y.x, y.y) | ((unsigned long long)pk2(y.z, y.w) << 32);
            const int c0 = 4 * (lane + 64 * j);
#pragma unroll
            for (int k = 0; k < 4; ++k) { const f32x4 w0 = *(const GAS f32x4*)(wr + (size_t)(c0 + k) * 8), w1 = *(const GAS f32x4*)(wr + (size_t)(c0 + k) * 8 + 4);
                lg[0] += y[k] * w0[0]; lg[1] += y[k] * w0[1]; lg[2] += y[k] * w0[2]; lg[3] += y[k] * w0[3]; lg[4] += y[k] * w1[0]; lg[5] += y[k] * w1[1]; lg[6] += y[k] * w1[2]; lg[7] += y[k] * w1[3]; } }
#pragma unroll
        for (int e = 0; e < 8; ++e) lg[e] = wave_sum(lg[e]);
        int e1 = 0; float v1 = lg[0];
#pragma unroll
        for (int e = 1; e < 8; ++e) if (lg[e] > v1) { v1 = lg[e]; e1 = e; }
        int e2 = -1; float v2 = -3.4e38f;
#pragma unroll
        for (int e = 0; e < 8; ++e) if (e != e1 && lg[e] > v2) { v2 = lg[e]; e2 = e; }
        const float w2 = 1.f / (1.f + __expf(v1 - v2)), w1 = 1.f - w2;
        if (lane == 0) { toke[m * 2] = e1; toke[m * 2 + 1] = e2; tokw[m * 2] = w1; tokw[m * 2 + 1] = w2; EL[lr] = e1; EL[RPW + lr] = e2; }
    }
    __syncthreads();
    if (w == 0) {
        const bool act = lane < RPW; int base[8];
#pragma unroll
        for (int e = 0; e < 8; ++e) base[e] = 0;
        const unsigned long long ltm = (1ull << lane) - 1ull;
#pragma unroll
        for (int k = 0; k < 2; ++k) { const int ek = act ? EL[k * RPW + lane] : -1; int pos = 0;
#pragma unroll
            for (int e = 0; e < 8; ++e) { const unsigned long long mk = __ballot(ek == e); if (ek == e) pos = base[e] + __popcll(mk & ltm); base[e] += __popcll(mk); }
            if (act) tokp[(F.wg * RPW + lane) * 2 + k] = pos; }
        if (lane < 8) { int cv = 0;
#pragma unroll
            for (int e = 0; e < 8; ++e) if (lane == e) cv = base[e];
            cntl[F.wg * 8 + lane] = cv; }
    }
}
__device__ __forceinline__ void moe_tables(Frame& F) {
    LAS int* TP = (LAS int*)(F.lds + LDSCTL_OFF); LAS int* BASE = TP + 16; LAS int* ACC = TP + 32;
    const int* cntl = (const int*)(F.ws + WS_CNTL);
    __syncthreads();
    if (F.tid < 16) ACC[F.tid] = 0;
    __syncthreads();
    int tot = 0, pre = 0; const int e = F.tid & 7;
    for (int wq = F.tid >> 3; wq < F.G; wq += 64) { const int cv = __hip_atomic_load(cntl + wq * 8 + e, __ATOMIC_RELAXED, __HIP_MEMORY_SCOPE_AGENT); tot += cv; if (wq < F.wg) pre += cv; }
    __hip_atomic_fetch_add(ACC + e, tot, __ATOMIC_RELAXED, __HIP_MEMORY_SCOPE_WORKGROUP); __hip_atomic_fetch_add(ACC + 8 + e, pre, __ATOMIC_RELAXED, __HIP_MEMORY_SCOPE_WORKGROUP);
    __syncthreads();
    if (F.tid == 0) { int tp = 0;
        for (int k = 0; k < 8; ++k) { TP[k] = tp; BASE[k] = tp * 256 + ACC[8 + k]; tp += (ACC[k] + 255) >> 8; }
        TP[8] = tp; }
    __syncthreads();
}
__device__ __forceinline__ void moe_gather(Frame& F) {
    moe_tables(F);
    LAS int* BASE = (LAS int*)(F.lds + LDSCTL_OFF) + 16;
    unsigned char* ws = F.ws; const int* toke = (const int*)(ws + WS_TOKE); const int* tokp = (const int*)(ws + WS_TOKP); int* toks = (int*)(ws + WS_TOKS);
    const bf16* xb = (const bf16*)(ws + WS_XB); bf16* xg = (bf16*)(ws + WS_XG);
    const int RPW = M / F.G;
    for (int q = F.wave; q < 2 * RPW; q += NWAVES) { const int m = F.wg * RPW + (q >> 1), k = q & 1;
        const int e = toke[m * 2 + k], slot = BASE[e] + tokp[m * 2 + k];
        if (F.lane == 0) toks[m * 2 + k] = slot;
        const GAS v4u* src = (const GAS v4u*)(xb + (size_t)m * D) + F.lane; GAS v4u* dst = (GAS v4u*)(xg + (size_t)slot * D) + F.lane;
        dst[0] = src[0]; dst[64] = src[64]; }
}
__device__ __forceinline__ void moe_final(Frame& F) {
    const int gw = F.vcu * NWAVES + F.wave, NGW = F.G * NWAVES, lane = F.lane;
    unsigned char* ws = F.ws; const bf16* xres = (const bf16*)(ws + WS_XB); const bf16* yb = (const bf16*)(ws + WS_YB); constexpr size_t KSTR = (WS_YB1 - WS_YB) / 2;
    const int* toks = (const int*)(ws + WS_TOKS); const float* tokw = (const float*)(ws + WS_TOKW); const float* gain = inptr(F, 25); const float* bias = inptr(F, 26);
    f32x4 gv[4], bv[4];
#pragma unroll
    for (int j = 0; j < 4; ++j) { gv[j] = *((const GAS f32x4*)gain + lane + 64 * j); bv[j] = *((const GAS f32x4*)bias + lane + 64 * j); }
    for (int m = gw; m < M; m += NGW) {
        const int s1 = toks[m * 2], s2 = toks[m * 2 + 1]; const float w1 = tokw[m * 2], w2 = tokw[m * 2 + 1];
        const GAS v2u* xr = (const GAS v2u*)(xres + (size_t)m * D) + lane;
        f32x4 v[4], ya[4], yc[4];
        if (s1 < 32768) { const GAS v2u* y1 = (const GAS v2u*)(yb + (size_t)s1 * D) + lane;
#pragma unroll
            for (int j = 0; j < 4; ++j) ya[j] = bf4(y1[64 * j]); }
        else {
#pragma unroll
            for (int j = 0; j < 4; ++j) ya[j] = (f32x4){0.f, 0.f, 0.f, 0.f};
            for (int ks = 0; ks < 7; ++ks) { const GAS v2u* y1 = (const GAS v2u*)(yb + KSTR + ((size_t)ks * 2048 + (s1 - 32768)) * D) + lane;
#pragma unroll
                for (int j = 0; j < 4; ++j) ya[j] += bf4(y1[64 * j]); } }
        if (s2 < 32768) { const GAS v2u* y2 = (const GAS v2u*)(yb + (size_t)s2 * D) + lane;
#pragma unroll
            for (int j = 0; j < 4; ++j) yc[j] = bf4(y2[64 * j]); }
        else {
#pragma unroll
            for (int j = 0; j < 4; ++j) yc[j] = (f32x4){0.f, 0.f, 0.f, 0.f};
            for (int ks = 0; ks < 7; ++ks) { const GAS v2u* y2 = (const GAS v2u*)(yb + KSTR + ((size_t)ks * 2048 + (s2 - 32768)) * D) + lane;
#pragma unroll
                for (int j = 0; j < 4; ++j) yc[j] += bf4(y2[64 * j]); } }
        float s = 0.f;
#pragma unroll
        for (int j = 0; j < 4; ++j) { const f32x4 x = bf4(xr[64 * j]); v[j] = x * ALPHA + (ya[j] * w1 + yc[j] * w2); s += (v[j].x + v[j].y) + (v[j].z + v[j].w); }
        const float mean = wave_sum(s) * (1.f / D); float q2 = 0.f;
#pragma unroll
        for (int j = 0; j < 4; ++j) { v[j] = v[j] - mean; q2 += (v[j].x * v[j].x + v[j].y * v[j].y) + (v[j].z * v[j].z + v[j].w * v[j].w); }
        const float rstd = 1.f / sqrtf(wave_sum(q2) * (1.f / D) + LN_EPS);
        GAS f32x4* xo = (GAS f32x4*)(F.out + (size_t)m * D) + lane;
#pragma unroll
        for (int j = 0; j < 4; ++j) xo[64 * j] = v[j] * rstd * gv[j] + bv[j];
    }
}
__global__ void __launch_bounds__(NWAVES * 64, 2) fwd(Args args) {
    extern __shared__ __attribute__((aligned(16))) unsigned char lds[];
    Frame F;
    F.A = &args;
    F.lds = (LAS unsigned char*)lds;
    F.MISC = (volatile LAS unsigned*)(F.lds + MISC_OFF);
    F.tid = threadIdx.x; F.lane = F.tid & 63; F.wave = __builtin_amdgcn_readfirstlane(F.tid >> 6);
    F.G = gridDim.x; F.wg = blockIdx.x; { const int bx = blockIdx.x; F.vcu = (F.G % 8 == 0) ? (bx % 8) * (F.G / 8) + bx / 8 : bx; }
    F.ws = args.ws; F.out = args.out;
    unsigned char* ws = args.ws;
    F.ctl = (gu32*)(ws + WS_CTL);
    for (int u = F.tid; u < (LDS_BYTES - LDSCTL_OFF) / 4; u += NWAVES * 64) ((LAS unsigned*)(F.lds + LDSCTL_OFF))[u] = 0u;
    __syncthreads();
    XcdBarrier bar; bar.bar = (unsigned*)(F.ctl + CW_BAR); bar.x = 0; bar.st = nullptr;
    if (!MK_PER_PHASE) bar = xcd_barrier_post((unsigned*)(F.ctl + CW_BAR), F.MISC + 8);
#define GRID_BAR() do { if (!MK_PER_PHASE) xcd_barrier(bar); } while (0)
    const int lo = args.ph_lo, hi = args.ph_hi;
#define IN(k) (lo <= (k) && (k) < hi)
#define SEAM(k) do { if (IN((k) + 1)) GRID_BAR(); } while (0)
    bf16* XB = (bf16*)(ws + WS_XB); bf16* T0 = (bf16*)(ws + WS_T0);
    const int cwg = (int)blockIdx.x;

#ifndef HANDOFF
#define HANDOFF 0
#endif
#ifndef PROBE_REP
#define PROBE_REP -1
#endif
#define REP(k) (PROBE_REP == (k) ? 2 : 1)
    if (IN(0)) { for (int rep = 0; rep < REP(0); ++rep) { if (rep) GRID_BAR(); p0_prologue(F); } SEAM(0); }
    if (IN(1)) { pg8::Gemm g{XB, (const bf16*)(ws + WS_WIN0), M, NSA_IN_PAD, D, D}; pg8::StaticOrder S; S.init(M, NSA_IN_PAD, F.G, cwg);
        pg8::EpiNsaIn E{(bf16*)(ws + WS_Q), (bf16*)(ws + WS_KV2), (bf16*)(ws + WS_KS), (bf16*)(ws + WS_VS), (bf16*)(ws + WS_KW), (bf16*)(ws + WS_VW), (float*)(ws + WS_GT), 0.125f * LOG2E};
        pg8::gemm_phase<pg8::EpiNsaIn, pg8::StaticOrder, PG8_ALIGN, PG8_SP2>(F.lds + RING_OFF, g, S, E); SEAM(1); }
    if (IN(2)) { pg8::Gemm g{(const bf16*)(ws + WS_KV2), (const bf16*)(ws + WS_W1C), 8192, 1024, 1024, 1024}; pg8::CmpOrder S{F.G, cwg}; pg8::EpiF32Cmp E{(float*)(ws + WS_UL)};
        pg8::gemm_phase<pg8::EpiF32Cmp, pg8::CmpOrder, PG8_ALIGN, PG8_SP2>(F.lds + RING_OFF, g, S, E); SEAM(2); }
    if (IN(3)) { cmp_finish(F); SEAM(3); }
    if (IN(4)) { for (int rep = 0; rep < REP(4); ++rep) { if (rep) GRID_BAR(); nsa_attn_phase(F); } SEAM(4); }
    if (IN(5)) { pg8::Gemm g{(const bf16*)(ws + WS_O), (const bf16*)(ws + WS_WO0), M, D, D, D}; pg8::StaticOrder S; S.init(M, D, F.G, cwg); pg8::EpiResBf16<false> E{inptr(F, 0), T0, ALPHA};
        pg8::gemm_phase<pg8::EpiResBf16<false>, pg8::StaticOrder, PG8_ALIGN, PG8_SP2>(F.lds + RING_OFF, g, S, E); SEAM(5); }
    if (IN(6)) { ln_rows(F, T0, inptr(F, 9), inptr(F, 10), XB); SEAM(6); }
#if HANDOFF
    if (IN(7)) { pg8::Gemm g{XB, (const bf16*)(ws + WS_WGU0), M, 2 * FF0, D, D}; pg8::PubOrder<pg8::StaticOrder> S; S.init(M, 2 * FF0, F.G, cwg); S.cnt = (unsigned*)(F.ctl + CW_PANEL0); S.pend = -1; pg8::EpiSwiGLU<true> E{(bf16*)(ws + WS_H0), FF0, 2 * FF0 / 256};
        pg8::gemm_phase<pg8::EpiSwiGLU<true>, pg8::PubOrder<pg8::StaticOrder>, PG8_ALIGN, PG8_SP2>(F.lds + RING_OFF, g, S, E); S.publish(); }
    if (IN(8)) { pg8::Gemm g{(const bf16*)(ws + WS_H0), (const bf16*)(ws + WS_WD0), M, D, FF0, FF0}; pg8::WaitOrder<pg8::StaticOrder> S; S.init(M, D, F.G, (cwg + F.G - (M / 256 * (2 * FF0 / 256)) % F.G) % F.G); S.ready = (const unsigned*)(F.ctl + CW_PANEL0); S.need = 8u * (2 * FF0 / 256); S.tmo = (unsigned*)(F.ctl + CW_TMO);
        pg8::EpiResBf16<true> E{XB, T0, ALPHA};
        pg8::gemm_phase<pg8::EpiResBf16<true>, pg8::WaitOrder<pg8::StaticOrder>, PG8_ALIGN, PG8_SP2>(F.lds + RING_OFF, g, S, E); SEAM(8); }
#else
    if (IN(7)) { for (int rep = 0; rep < REP(7); ++rep) { if (rep) GRID_BAR(); pg8::Gemm g{XB, (const bf16*)(ws + WS_WGU0), M, 2 * FF0, D, D}; pg8::StaticOrder S; S.init(M, 2 * FF0, F.G, cwg); pg8::EpiSwiGLU<false> E{(bf16*)(ws + WS_H0), FF0, 2 * FF0 / 256};
        pg8::gemm_phase<pg8::EpiSwiGLU<false>, pg8::StaticOrder, PG8_ALIGN, PG8_SP2>(F.lds + RING_OFF, g, S, E); } SEAM(7); }
    if (IN(8)) { for (int rep = 0; rep < REP(8); ++rep) { if (rep) GRID_BAR(); pg8::Gemm g{(const bf16*)(ws + WS_H0), (const bf16*)(ws + WS_WD0), M, D, FF0, FF0}; pg8::StaticOrder S; S.init(M, D, F.G, cwg); pg8::EpiResBf16<true> E{XB, T0, ALPHA};
        pg8::gemm_phase<pg8::EpiResBf16<true>, pg8::StaticOrder, PG8_ALIGN, PG8_SP2>(F.lds + RING_OFF, g, S, E); } SEAM(8); }
#endif
    if (IN(9)) { ln_rows(F, T0, inptr(F, 13), inptr(F, 14), XB); SEAM(9); }
    if (IN(10)) { pg8::Gemm g{XB, (const bf16*)(ws + WS_WIN1), M, GLA_IN_PAD, D, D}; pg8::StaticOrder S; S.init(M, GLA_IN_PAD, F.G, cwg); pg8::EpiGlaIn E{(bf16*)(ws + WS_QKVG), (float*)(ws + WS_ALOW), 0.08838834764831845f};
        pg8::gemm_phase<pg8::EpiGlaIn, pg8::StaticOrder, PG8_ALIGN, PG8_SP2>(F.lds + RING_OFF, g, S, E); SEAM(10); }
    for (int rep = 0; rep < REP(11); ++rep) { if (rep) GRID_BAR();
    if (IN(11)) { gla_g1(F); SEAM(11); }
    if (IN(12)) { gla_g2(F); SEAM(12); }
    if (IN(13)) { gla_g3(F); if (rep + 1 == REP(11)) SEAM(13); }
    }
    if (IN(14)) { pg8::Gemm g{(const bf16*)(ws + WS_O1), (const bf16*)(ws + WS_WO1), M, D, D, D}; pg8::StaticOrder S; S.init(M, D, F.G, cwg); pg8::EpiResBf16<true> E{XB, T0, ALPHA};
        pg8::gemm_phase<pg8::EpiResBf16<true>, pg8::StaticOrder, PG8_ALIGN, PG8_SP2>(F.lds + RING_OFF, g, S, E); SEAM(14); }
    if (IN(15)) { ln_router(F, T0, inptr(F, 20), inptr(F, 21), XB); SEAM(15); }
    if (IN(16)) { moe_gather(F); SEAM(16); }
#if 0
    if (IN(17)) { moe_tables(F); pg8::Gemm g{(const bf16*)(ws + WS_XG), (const bf16*)(ws + WS_WGU1), MAXSLOTS, NE * 2 * FFE, D, D};
        pg8::PubOrder<pg8::GroupedOrder> S; S.G = F.G; S.c = cwg; S.NT = 2 * FFE / 256; S.KS = 1; S.KL = 0; S.tp = (const PG8_LAS int*)(F.lds + LDSCTL_OFF); S.cnt = (unsigned*)(F.ctl + CW_PANEL1); S.pend = -1;
        pg8::EpiSwiGLU<true> E{(bf16*)(ws + WS_H2), FFE, 2 * FFE / 256};
        pg8::gemm_phase<pg8::EpiSwiGLU<true>, pg8::PubOrder<pg8::GroupedOrder>, PG8_ALIGN, PG8_SP2>(F.lds + RING_OFF, g, S, E); S.publish(); }
    if (IN(18)) { moe_tables(F); pg8::Gemm g{(const bf16*)(ws + WS_H2), (const bf16*)(ws + WS_WD1), MAXSLOTS, NE * D, FFE / MOE_KS, FFE};
        pg8::WaitOrder<pg8::GroupedOrder> S; S.G = F.G; S.NT = D / 256; S.KS = MOE_KS; S.KL = FFE / MOE_KS; S.tp = (const PG8_LAS int*)(F.lds + LDSCTL_OFF);
        { const int n17 = S.tp[8] * (2 * FFE / 256); S.c = (cwg + F.G - ((n17 % F.G) & ~7)) % F.G; }
        S.ready = (const unsigned*)(F.ctl + CW_PANEL1); S.need = 8u * (2 * FFE / 256); S.tmo = (unsigned*)(F.ctl + CW_TMO); pg8::EpiBf16Y E{(bf16*)(ws + WS_YB), (size_t)(WS_YB1 - WS_YB) / 2};
        pg8::gemm_phase<pg8::EpiBf16Y, pg8::WaitOrder<pg8::GroupedOrder>, PG8_ALIGN, PG8_SP2>(F.lds + RING_OFF, g, S, E); SEAM(18); }
#else
#ifndef STAGGER_US
#define STAGGER_US 0
#endif
    if (IN(17)) { for (int rep = 0; rep < REP(17); ++rep) { if (rep) GRID_BAR(); moe_tables(F);
        if (STAGGER_US) { const unsigned long long t0 = __builtin_amdgcn_s_memrealtime(), dl = (unsigned long long)((cwg >> 3) & 3) * (STAGGER_US * 100ull); while (__builtin_amdgcn_s_memrealtime() - t0 < dl) __builtin_amdgcn_s_sleep(8); }
        pg8::Gemm g{(const bf16*)(ws + WS_XG), (const bf16*)(ws + WS_WGU1), MAXSLOTS, NE * 2 * FFE, D, D};
        pg8::GroupedOrder S{F.G, cwg, 2 * FFE / 256, 1, 0, (const PG8_LAS int*)(F.lds + LDSCTL_OFF)}; pg8::EpiSwiGLU<false> E{(bf16*)(ws + WS_H2), FFE, 2 * FFE / 256};
        pg8::gemm_phase<pg8::EpiSwiGLU<false>, pg8::GroupedOrder, PG8_ALIGN, PG8_SP2>(F.lds + RING_OFF, g, S, E); } SEAM(17); }
    if (IN(18)) { for (int rep = 0; rep < REP(18); ++rep) { if (rep) GRID_BAR(); moe_tables(F);
        { pg8::Gemm g{(const bf16*)(ws + WS_H2), (const bf16*)(ws + WS_WD1), MAXSLOTS, NE * D, FFE, FFE}; pg8::MoeDownOrder S{F.G, cwg, 0, (const PG8_LAS int*)(F.lds + LDSCTL_OFF)};
          pg8::EpiBf16Y2 E{(bf16*)(ws + WS_YB), (bf16*)(ws + WS_YB1), 0}; pg8::gemm_phase<pg8::EpiBf16Y2, pg8::MoeDownOrder, PG8_ALIGN, PG8_SP2>(F.lds + RING_OFF, g, S, E); }
        { pg8::Gemm g{(const bf16*)(ws + WS_H2), (const bf16*)(ws + WS_WD1), MAXSLOTS, NE * D, 512, FFE}; pg8::MoeDownOrder S{F.G, cwg, 1, (const PG8_LAS int*)(F.lds + LDSCTL_OFF)};
          pg8::EpiBf16Y2 E{(bf16*)(ws + WS_YB), (bf16*)(ws + WS_YB1), 1}; pg8::gemm_phase<pg8::EpiBf16Y2, pg8::MoeDownOrder, PG8_ALIGN, PG8_SP2>(F.lds + RING_OFF, g, S, E); } } SEAM(18); }
#endif
    if (IN(19)) { moe_final(F); }
#undef IN
#undef SEAM
#undef GRID_BAR
}

extern "C" void kernel_launch(void* const* d_in, const int* in_sizes, int n_in, void* d_out, int out_size, void* d_ws, size_t ws_size, hipStream_t stream) {
    static int grid = 0;
    if (grid == 0) {
        if (n_in != 27 || in_sizes[0] != M * D || out_size != M * D || ws_size < WS_END) { fprintf(stderr, "kernel_launch: unexpected problem shape (n_in %d, in0 %d, out %d, ws %zu); nothing launched\n", n_in, n_in > 0 ? in_sizes[0] : -1, out_size, ws_size); grid = -1; return; }
        if (hipFuncSetAttribute((const void*)fwd, hipFuncAttributeMaxDynamicSharedMemorySize, LDS_BYTES) != hipSuccess) { fprintf(stderr, "kernel_launch: hipFuncSetAttribute failed\n"); grid = -1; return; }
        int dev = 0, cus = 0, per_cu = 0;
        (void)hipGetDevice(&dev); (void)hipDeviceGetAttribute(&cus, hipDeviceAttributeMultiprocessorCount, dev);
        if (hipOccupancyMaxActiveBlocksPerMultiprocessor(&per_cu, (const void*)fwd, NWAVES * 64, LDS_BYTES) != hipSuccess || per_cu < 1) fprintf(stderr, "kernel_launch: note: occupancy query reports %d workgroups per CU\n", per_cu);
        (void)hipGetLastError();
        grid = 256;
        if (cus < 256) fprintf(stderr, "kernel_launch: device has %d CUs; this kernel needs 256 resident workgroups\n", cus);
    }
    if (grid < 0) return;
    if (hipMemsetAsync((char*)d_ws + WS_CTL, 0, CTL_ZERO_BYTES, stream) != hipSuccess) { fprintf(stderr, "kernel_launch: hipMemsetAsync failed\n"); return; }
    Args a{};
    for (int i = 0; i < 27; ++i) a.in[i] = (const float*)d_in[i];
    a.out = (float*)d_out; a.ws = (unsigned char*)d_ws;
#if MK_PER_PHASE
    for (int p = 0; p < N_PHASES; ++p) { a.ph_lo = p; a.ph_hi = p + 1; hipLaunchKernelGGL(fwd, dim3(grid), dim3(NWAVES * 64), LDS_BYTES, stream, a); }
#else
    a.ph_lo = 0; a.ph_hi = N_PHASES;
    hipLaunchKernelGGL(fwd, dim3(grid), dim3(NWAVES * 64), LDS_BYTES, stream, a);
#endif
    const hipError_t le = hipPeekAtLastError();
    if (le != hipSuccess) fprintf(stderr, "kernel_launch: launch failed: %s\n", hipGetErrorName(le));
}
```

```cpp
#include <hip/hip_runtime.h>
#include <cstdio>
#include <cstdint>
namespace pg8 {
#define PG8_LAS __attribute__((address_space(3)))
typedef unsigned short bf16_t;
typedef short bf16x8 __attribute__((ext_vector_type(8)));
typedef float f32x4 __attribute__((ext_vector_type(4)));
typedef unsigned u32x4 __attribute__((ext_vector_type(4)));
constexpr int BM = 256, BK = 64, HALF = 128, HTB = HALF * BK * 2  , STAGE_BYTES = 8 * HTB, NXCD = 8, WGM = 8;

__host__ __device__ __forceinline__ int lds_byte(int r, int c) { const int st = (r >> 4) * 2 + (c >> 5), rr = r & 15, cc = c & 31, ob = rr * 64 + cc * 2; return st * 1024 + (ob ^ (((ob >> 9) & 1) << 5)); }
__host__ __device__ __forceinline__ void stage_rc(int b, int& R, int& C) { const int st = b / 1024, sb = b % 1024, swz = sb ^ (((sb >> 9) & 1) << 5); R = (st >> 1) * 16 + swz / 64; C = (st & 1) * 32 + (swz % 64) / 2; }
__host__ __device__ __forceinline__ int perm32(int rho) { const int n = rho >> 4, i = rho & 15; return 8 * (i >> 2) + 4 * n + (i & 3); }

struct Unit { int pm, pn, ko; };
struct Gemm { const bf16_t* A; const bf16_t* Bt; int M, N, K, ld; };

struct StaticOrder {
    int nM, nN, nwg, G, c;
    __host__ __device__ void init(int M, int N, int G_, int c_) { nM = M / BM; nN = N / BM; nwg = nM * nN; G = G_; c = c_; }
    __host__ __device__ bool next(int i, Unit& u) const {
        const long L = (long)i * G + c; if (L >= nwg) return false;
        int wgid = (int)L; { const int q = nwg / NXCD, r = nwg % NXCD, xcd = wgid % NXCD, off = wgid / NXCD; wgid = (xcd < r ? xcd * (q + 1) : r * (q + 1) + (xcd - r) * q) + off; }
        const int nig = WGM * nN, gid = wgid / nig, fm = gid * WGM, gsz = (nM - fm) < WGM ? (nM - fm) : WGM;
        u.pm = fm + ((wgid % nig) % gsz); u.pn = (wgid % nig) / gsz; u.ko = 0; return true;
    }
    __device__ __forceinline__ void a_ready(const Unit&) const {}
    __device__ __forceinline__ void done(const Unit&) const {}
};
__device__ __forceinline__ unsigned cvt_pk_bf16(float lo, float hi) { unsigned r; asm volatile("v_cvt_pk_bf16_f32 %0, %1, %2" : "=v"(r) : "v"(lo), "v"(hi)); return r; }
typedef float f32x2 __attribute__((ext_vector_type(2)));
typedef __bf16 bf16x2_t_ __attribute__((ext_vector_type(2)));
__device__ __forceinline__ unsigned cvtpk_c(float lo, float hi) { f32x2 v = {lo, hi}; bf16x2_t_ b = __builtin_convertvector(v, bf16x2_t_); return __builtin_bit_cast(unsigned, b); }
__device__ __forceinline__ u32x4 pack8(const f32x4 v0, const f32x4 v1) { u32x4 w; w.x = cvt_pk_bf16(v0[0], v0[1]); w.y = cvt_pk_bf16(v0[2], v0[3]); w.z = cvt_pk_bf16(v1[0], v1[1]); w.w = cvt_pk_bf16(v1[2], v1[3]); return w; }
__device__ __forceinline__ float sigm(float x) { return __builtin_amdgcn_rcpf(1.0f + __builtin_amdgcn_exp2f(-1.44269504088896341f * x)); }
__device__ __forceinline__ float silu1(float x) { return x * __builtin_amdgcn_rcpf(1.0f + __builtin_amdgcn_exp2f(-1.44269504088896341f * x)); }

struct EpiNsaIn {
    static constexpr bool PERM = true, AFTER_DRAIN = false;
    bf16_t *Q, *KV2, *KS, *VS, *KW, *VW; float* GT; float qscale;
    __device__ __forceinline__ void operator()(const f32x4 (&acc)[2][2][4][2], const Unit& u, int wr, int wc, int fr, int fq) const {
        const int pn = u.pn, row0 = u.pm * BM + wr * 64 + fr, c8 = wc * 32 + 8 * fq;
#pragma unroll
        for (int ai = 0; ai < 2; ++ai)
#pragma unroll
            for (int m = 0; m < 4; ++m) { const int row = row0 + ai * HALF + m * 16;
#pragma unroll
                for (int bj = 0; bj < 2; ++bj) { const int col = bj * HALF + c8;
                    f32x4 v0 = acc[ai][bj][m][0], v1 = acc[ai][bj][m][1];
                    if (pn >= 10) { if (col < 48) { float* gp = GT + (size_t)row * 48 + col;
                            *(f32x4*)gp = (f32x4){sigm(v0[0]), sigm(v0[1]), sigm(v0[2]), sigm(v0[3])}; *(f32x4*)(gp + 4) = (f32x4){sigm(v1[0]), sigm(v1[1]), sigm(v1[2]), sigm(v1[3])}; }
                        continue; }
                    bf16_t* dst;
                    if (pn < 4) { v0 = v0 * qscale; v1 = v1 * qscale; dst = Q + (size_t)row * 1024 + pn * 256 + col; }
                    else if (pn < 6) { const int g = col >> 6, d = col & 63; dst = KV2 + (size_t)(pn - 4) * (4096 * 1024) + ((size_t)(((row >> 4) * 4 + g) * 16 + (row & 15))) * 64 + d; }
                    else { bf16_t* base = pn == 6 ? KS : pn == 7 ? VS : pn == 8 ? KW : VW; dst = base + (size_t)row * 256 + col; }
                    *(u32x4*)dst = pack8(v0, v1); } }
    }
};
struct EpiGlaIn {
    static constexpr bool PERM = true, AFTER_DRAIN = false;
    bf16_t* QKVG; float* ALOW; float qscale;
    __device__ __forceinline__ void operator()(const f32x4 (&acc)[2][2][4][2], const Unit& u, int wr, int wc, int fr, int fq) const {
        const int pn = u.pn, row0 = u.pm * BM + wr * 64 + fr, c8 = wc * 32 + 8 * fq;
#pragma unroll
        for (int ai = 0; ai < 2; ++ai)
#pragma unroll
            for (int m = 0; m < 4; ++m) { const int row = row0 + ai * HALF + m * 16;
#pragma unroll
                for (int bj = 0; bj < 2; ++bj) { const int col = bj * HALF + c8;
                    f32x4 v0 = acc[ai][bj][m][0], v1 = acc[ai][bj][m][1];
                    if (pn >= 12) { if (col < 16) { float* gp = ALOW + (size_t)row * 16 + col; *(f32x4*)gp = v0; *(f32x4*)(gp + 4) = v1; } continue; }
                    if (pn < 2) { v0 = v0 * qscale; v1 = v1 * qscale; }
                    *(u32x4*)(QKVG + (size_t)row * 3072 + pn * 256 + col) = pack8(v0, v1); } }
    }
};
struct EpiF32Cmp {
    static constexpr bool PERM = false, AFTER_DRAIN = false;
    float* C;
    __device__ __forceinline__ void operator()(const f32x4 (&acc)[2][2][4][2], const Unit& u, int wr, int wc, int fr, int fq) const {
        const int row0 = u.pm * BM + wr * 64 + fr, col0 = (u.pn & 1) * BM + wc * 32 + 4 * fq;
#pragma unroll
        for (int ai = 0; ai < 2; ++ai)
#pragma unroll
            for (int m = 0; m < 4; ++m) { float* rowp = C + (size_t)(row0 + ai * HALF + m * 16) * 512 + col0;
#pragma unroll
                for (int bj = 0; bj < 2; ++bj)
#pragma unroll
                    for (int n = 0; n < 2; ++n) *(f32x4*)(rowp + bj * HALF + n * 16) = acc[ai][bj][m][n]; }
    }
};
struct EpiResF32 {
    static constexpr bool PERM = false, AFTER_DRAIN = false;
    const float* base; float* out; float alpha;
    __device__ __forceinline__ void operator()(const f32x4 (&acc)[2][2][4][2], const Unit& u, int wr, int wc, int fr, int fq) const {
        const int row0 = u.pm * BM + wr * 64 + fr, col0 = u.pn * BM + wc * 32 + 4 * fq;
#pragma unroll
        for (int ai = 0; ai < 2; ++ai)
#pragma unroll
            for (int m = 0; m < 4; ++m) { const size_t off = (size_t)(row0 + ai * HALF + m * 16) * 1024 + col0;
#pragma unroll
                for (int bj = 0; bj < 2; ++bj)
#pragma unroll
                    for (int n = 0; n < 2; ++n) { const f32x4 bs = *(const f32x4*)(base + off + bj * HALF + n * 16); *(f32x4*)(out + off + bj * HALF + n * 16) = bs * alpha + acc[ai][bj][m][n]; } }
    }
};
template <bool BF> struct EpiResBf16 {
    static constexpr bool PERM = true, AFTER_DRAIN = false;
    const void* base; bf16_t* out; float alpha;
    __device__ __forceinline__ void operator()(const f32x4 (&acc)[2][2][4][2], const Unit& u, int wr, int wc, int fr, int fq) const {
        const int row0 = u.pm * BM + wr * 64 + fr, col0 = u.pn * BM + wc * 32 + 8 * fq;
#pragma unroll
        for (int ai = 0; ai < 2; ++ai)
#pragma unroll
            for (int m = 0; m < 4; ++m) { const size_t off = (size_t)(row0 + ai * HALF + m * 16) * 1024 + col0;
#pragma unroll
                for (int bj = 0; bj < 2; ++bj) { f32x4 b0, b1;
                    if (BF) { const u32x4 r = *(const u32x4*)((const bf16_t*)base + off + bj * HALF);
                        b0 = (f32x4){__uint_as_float(r.x << 16), __uint_as_float(r.x & 0xffff0000u), __uint_as_float(r.y << 16), __uint_as_float(r.y & 0xffff0000u)};
                        b1 = (f32x4){__uint_as_float(r.z << 16), __uint_as_float(r.z & 0xffff0000u), __uint_as_float(r.w << 16), __uint_as_float(r.w & 0xffff0000u)}; }
                    else { b0 = *(const f32x4*)((const float*)base + off + bj * HALF); b1 = *(const f32x4*)((const float*)base + off + bj * HALF + 4); }
                    *(u32x4*)(out + off + bj * HALF) = pack8(b0 * alpha + acc[ai][bj][m][0], b1 * alpha + acc[ai][bj][m][1]); } }
    }
};
__device__ __forceinline__ void store16_sc1(bf16_t* p, const u32x4 v) { asm volatile("global_store_dwordx4 %0, %1, off sc1\n\ts_nop 1" :: "v"(p), "v"(v) : "memory"); }
template <bool SC1> struct EpiSwiGLU {
    static constexpr bool PERM = true, AFTER_DRAIN = false;
    bf16_t* H; int ldh, nt;
    __device__ __forceinline__ void operator()(const f32x4 (&acc)[2][2][4][2], const Unit& u, int wr, int wc, int fr, int fq) const {
        const int row0 = u.pm * BM + wr * 64 + fr, col = (u.pn % nt) * HALF + wc * 32 + 8 * fq;
#pragma unroll
        for (int ai = 0; ai < 2; ++ai)
#pragma unroll
            for (int m = 0; m < 4; ++m) { const f32x4 a0 = acc[ai][0][m][0], a1 = acc[ai][0][m][1], b0 = acc[ai][1][m][0], b1 = acc[ai][1][m][1];
                const f32x4 h0 = (f32x4){silu1(a0[0]) * b0[0], silu1(a0[1]) * b0[1], silu1(a0[2]) * b0[2], silu1(a0[3]) * b0[3]};
                const f32x4 h1 = (f32x4){silu1(a1[0]) * b1[0], silu1(a1[1]) * b1[1], silu1(a1[2]) * b1[2], silu1(a1[3]) * b1[3]};
                bf16_t* dst = H + (size_t)(row0 + ai * HALF + m * 16) * ldh + col;
                if (SC1) store16_sc1(dst, pack8(h0, h1)); else *(u32x4*)dst = pack8(h0, h1); }
    }
};
struct EpiBf16Y {
    static constexpr bool PERM = true, AFTER_DRAIN = false;
    bf16_t* Y; size_t kstride;
    __device__ __forceinline__ void operator()(const f32x4 (&acc)[2][2][4][2], const Unit& u, int wr, int wc, int fr, int fq) const {
        const int row0 = u.pm * BM + wr * 64 + fr, col0 = (u.pn & 3) * BM + wc * 32 + 8 * fq;
#pragma unroll
        for (int ai = 0; ai < 2; ++ai)
#pragma unroll
            for (int m = 0; m < 4; ++m) { bf16_t* rowp = Y + (u.ko ? kstride : (size_t)0) + (size_t)(row0 + ai * HALF + m * 16) * 1024 + col0;
#pragma unroll
                for (int bj = 0; bj < 2; ++bj) *(u32x4*)(rowp + bj * HALF) = pack8(acc[ai][bj][m][0], acc[ai][bj][m][1]); }
    }
};
struct CmpOrder {
    int G, c;
    __device__ __forceinline__ bool next(int i, Unit& u) const { const long L = (long)i * G + c; if (L >= 64) return false; const int pm = (int)L >> 1; u.pm = pm; u.pn = (pm >> 4) * 2 + ((int)L & 1); u.ko = 0; return true; }
    __device__ __forceinline__ void a_ready(const Unit&) const {}
    __device__ __forceinline__ void done(const Unit&) const {}
};
struct GroupedOrder {
    int G, c, NT, KS, KL; const PG8_LAS int* tp;
    __device__ __forceinline__ bool next(int i, Unit& u) const {
        const int nwg = tp[8] * NT * KS; const long L = (long)i * G + c; if (L >= nwg) return false;
        int wgid = (int)L; { const int q = nwg / NXCD, r = nwg % NXCD, xcd = wgid % NXCD, off = wgid / NXCD; wgid = (xcd < r ? xcd * (q + 1) : r * (q + 1) + (xcd - r) * q) + off; }
        const int ks = wgid % KS; wgid /= KS;
        int e = 0;
#pragma unroll
        for (int k = 1; k < 8; ++k) if (wgid >= tp[k] * NT) e = k;
        const int t0 = tp[e], nte = tp[e + 1] - t0, l = wgid - t0 * NT, nig = WGM * NT, gid = l / nig, fm = gid * WGM, gsz = (nte - fm) < WGM ? (nte - fm) : WGM;
        u.pm = t0 + fm + ((l % nig) % gsz); u.pn = e * NT + (l % nig) / gsz; u.ko = ks * KL; return true;
    }
    __device__ __forceinline__ void a_ready(const Unit&) const {}
    __device__ __forceinline__ void done(const Unit&) const {}
};
template <class Base> struct PubOrder : Base {
    unsigned* cnt; mutable int pend;
    __device__ __forceinline__ void publish() const { if (pend >= 0) { if ((threadIdx.x & 63) == 0) __hip_atomic_fetch_add(cnt + 64 * pend, 1u, __ATOMIC_RELAXED, __HIP_MEMORY_SCOPE_AGENT); pend = -1; } }
    __device__ __forceinline__ void a_ready(const Unit&) const { publish(); }
#if defined(PUB_DRAIN) && PUB_DRAIN
    __device__ __forceinline__ void done(const Unit& u) const { asm volatile("s_waitcnt vmcnt(0)" ::: "memory"); pend = u.pm; publish(); }
#else
    __device__ __forceinline__ void done(const Unit& u) const { publish(); pend = u.pm; }
#endif
};
template <class Base> struct WaitOrder : Base {
    const unsigned* ready; unsigned need; unsigned* tmo;
    __device__ __forceinline__ void a_ready(const Unit& u) const {
        if (threadIdx.x < 64) {
            const unsigned long long t0 = __builtin_amdgcn_s_memrealtime(); unsigned polls = 0;
            while ((unsigned)__builtin_amdgcn_readfirstlane(__hip_atomic_load(ready + 64 * u.pm, __ATOMIC_RELAXED, __HIP_MEMORY_SCOPE_AGENT)) < need) {
                if ((++polls & 255u) == 0u && __builtin_amdgcn_readfirstlane(__hip_atomic_load(tmo, __ATOMIC_RELAXED, __HIP_MEMORY_SCOPE_AGENT)) != 0u) break;
                if (__builtin_amdgcn_s_memrealtime() - t0 > 2000000ull) {
                    if (threadIdx.x == 0) { unsigned expect = 0u; __hip_atomic_compare_exchange_strong(tmo + 1, &expect, 0x600u | (unsigned)(u.pm & 0xff), __ATOMIC_RELAXED, __ATOMIC_RELAXED, __HIP_MEMORY_SCOPE_AGENT); __hip_atomic_store(tmo, 1u, __ATOMIC_RELAXED, __HIP_MEMORY_SCOPE_AGENT); }
                    break; }
                __builtin_amdgcn_s_sleep(2); }
            __builtin_amdgcn_fence(__ATOMIC_ACQUIRE, "agent");
            asm volatile("s_waitcnt vmcnt(0)" ::: "memory");
        }
        asm volatile("" ::: "memory"); __builtin_amdgcn_s_barrier(); asm volatile("" ::: "memory");
    }
};
struct MoeDownOrder {
    int G, c, rem; const PG8_LAS int* tp;
    __device__ __forceinline__ int expert_of(int tile) const { int e = 0;
#pragma unroll
        for (int k = 1; k < 8; ++k) if (tile >= tp[k]) e = k;
        return e; }
    __device__ __forceinline__ bool next(int i, Unit& u) const {
        const long L = (long)i * G + c;
        if (!rem) { if (L >= 512) return false;
            int wgid = (int)L; { const int xcd = wgid % NXCD, off = wgid / NXCD; wgid = xcd * 64 + off; }
            const int grp = wgid >> 5, in = wgid & 31; const int tile = grp * 8 + (in & 7), pnl = in >> 3;
            u.pm = tile; u.pn = expert_of(tile) * 4 + pnl; u.ko = 0; return true; }
        const int nrem = tp[8] - 128; if (L >= (long)nrem * 28) return false;
        const int l2 = (int)L, ks = l2 % 7, r = l2 / 7, tile = 128 + (r >> 2);
        u.pm = tile; u.pn = expert_of(tile) * 4 + (r & 3); u.ko = ks * 512; return true;
    }
    __device__ __forceinline__ void a_ready(const Unit&) const {}
    __device__ __forceinline__ void done(const Unit&) const {}
};
struct EpiBf16Y2 {
    static constexpr bool PERM = true, AFTER_DRAIN = false;
    bf16_t* Y; bf16_t* YP; int rem;
    __device__ __forceinline__ void operator()(const f32x4 (&acc)[2][2][4][2], const Unit& u, int wr, int wc, int fr, int fq) const {
        const int row0 = u.pm * BM + wr * 64 + fr, col0 = (u.pn & 3) * BM + wc * 32 + 8 * fq;
        bf16_t* base = rem ? YP + (size_t)(u.ko >> 9) * (2048 * 1024) + (size_t)(row0 - 128 * BM) * 1024 : Y + (size_t)row0 * 1024;
#pragma unroll
        for (int ai = 0; ai < 2; ++ai)
#pragma unroll
            for (int m = 0; m < 4; ++m) { bf16_t* rowp = base + (size_t)(ai * HALF + m * 16) * 1024 + col0;
#pragma unroll
                for (int bj = 0; bj < 2; ++bj) *(u32x4*)(rowp + bj * HALF) = pack8(acc[ai][bj][m][0], acc[ai][bj][m][1]); }
    }
};
template <class Epi, class Sched, bool ALIGN_EPI = false, bool SP2 = false>
__device__ __forceinline__ void gemm_phase(PG8_LAS unsigned char* lds, const Gemm g, const Sched& S, const Epi& E) {
    const int tid = threadIdx.x, wid = __builtin_amdgcn_readfirstlane(tid >> 6), lane = tid & 63, wr = wid >> 2, wc = wid & 3, fr = lane & 15, fq = lane >> 4;
    const int K = g.ld, nt = g.K / BK;
    unsigned voffA[2], voffB[2];
#pragma unroll
    for (int i = 0; i < 2; ++i) { int R, C; stage_rc(tid * 16 + i * 8192, R, C); const int Rb = Epi::PERM ? ((R & ~31) + perm32(R & 31)) : R;
        voffA[i] = (unsigned)(R * K + C) * 2u; voffB[i] = (unsigned)(Rb * K + C) * 2u; }
    const size_t kstep = (size_t)(BK * 2);
    const size_t hstep = (size_t)HALF * K * 2;
    const size_t tstep = 2 * hstep;
    const unsigned ldsw = (unsigned)wid * 1024u;
    const int aoff = lds_byte(wr * 64 + fr, fq * 8), boff = lds_byte(wc * 32 + fr, fq * 8);
#define PG8_SA(b, h) (((b) * 2 + (h)) * HTB)
#define PG8_SB(b, h) ((4 + (b) * 2 + (h)) * HTB)
#define PG8_STAGE(bufoff, gbase, voff) do { _Pragma("unroll") for (int _i = 0; _i < 2; ++_i) \
        __builtin_amdgcn_global_load_lds((const unsigned*)((const char*)(gbase) + (voff)[_i]), (PG8_LAS unsigned*)(lds + (bufoff) + ldsw + _i * 8192), 16, 0, 0); } while (0)
#define PG8_LDA(dst, b, h) do { _Pragma("unroll") for (int m = 0; m < 4; ++m) _Pragma("unroll") for (int k = 0; k < 2; ++k) dst[m][k] = *(const PG8_LAS bf16x8*)(lds + PG8_SA(b, h) + aoff + m * 2048 + k * 1024); } while (0)
#define PG8_LDB(dst, b, h) do { _Pragma("unroll") for (int n = 0; n < 2; ++n) _Pragma("unroll") for (int k = 0; k < 2; ++k) dst[n][k] = *(const PG8_LAS bf16x8*)(lds + PG8_SB(b, h) + boff + n * 2048 + k * 1024); } while (0)
#define PG8_MMA(ai, bj, At, Bt) do { __builtin_amdgcn_s_setprio(1); _Pragma("unroll") for (int m = 0; m < 4; ++m) _Pragma("unroll") for (int n = 0; n < 2; ++n) _Pragma("unroll") for (int k = 0; k < 2; ++k) \
        acc[ai][bj][m][n] = __builtin_amdgcn_mfma_f32_16x16x32_bf16(Bt[n][k], At[m][k], acc[ai][bj][m][n], 0, 0, 0); __builtin_amdgcn_s_setprio(0); } while (0)
#define PG8_WAIT_V(n) asm volatile("s_waitcnt vmcnt(" #n ")" ::: "memory")
#define PG8_WAIT_L(n) asm volatile("s_waitcnt lgkmcnt(" #n ")" ::: "memory")
#define PG8_BAR __builtin_amdgcn_s_barrier()
#define PG8_SCHED __builtin_amdgcn_sched_barrier(0)
    Unit cur, nxt; int ui = 0;
    if (!S.next(0, cur)) return;
    f32x4 acc[2][2][4][2];
#pragma unroll
    for (int a = 0; a < 2; ++a)
#pragma unroll
        for (int b = 0; b < 2; ++b)
#pragma unroll
            for (int m = 0; m < 4; ++m)
#pragma unroll
                for (int n = 0; n < 2; ++n) acc[a][b][m][n] = (f32x4){0.f, 0.f, 0.f, 0.f};
    bf16x8 At[4][2], B0[2][2], B1[2][2];
    const char* cA = (const char*)g.A + (size_t)cur.pm * tstep + (size_t)cur.ko * 2; const char* cB = (const char*)g.Bt + (size_t)cur.pn * tstep + (size_t)cur.ko * 2;
    S.a_ready(cur);
    if constexpr (SP2) {
        PG8_STAGE(PG8_SB(0, 0), cB, voffB); PG8_STAGE(PG8_SB(0, 1), cB + hstep, voffB); PG8_STAGE(PG8_SA(0, 0), cA, voffA); PG8_STAGE(PG8_SA(0, 1), cA + hstep, voffA);
        if (wr == 1) PG8_BAR;
        PG8_WAIT_V(2); PG8_BAR;
        PG8_STAGE(PG8_SB(1, 0), cB + kstep, voffB); PG8_STAGE(PG8_SA(1, 0), cA + kstep, voffA); PG8_STAGE(PG8_SB(1, 1), cB + hstep + kstep, voffB);
        PG8_WAIT_V(6); PG8_BAR;
    } else {
        PG8_STAGE(PG8_SB(0, 0), cB, voffB); PG8_STAGE(PG8_SA(0, 0), cA, voffA); PG8_STAGE(PG8_SB(0, 1), cB + hstep, voffB); PG8_STAGE(PG8_SA(0, 1), cA + hstep, voffA);
        if (wr == 1) PG8_BAR;
        PG8_WAIT_V(4); PG8_BAR;
        PG8_STAGE(PG8_SB(1, 0), cB + kstep, voffB); PG8_STAGE(PG8_SA(1, 0), cA + kstep, voffA); PG8_STAGE(PG8_SB(1, 1), cB + hstep + kstep, voffB);
        PG8_WAIT_V(6); PG8_BAR;
    }
    for (;;) {
        const bool has_next = S.next(ui + 1, nxt);
        const char* nA = has_next ? (const char*)g.A + (size_t)nxt.pm * tstep + (size_t)nxt.ko * 2 : cA; const char* nB = has_next ? (const char*)g.Bt + (size_t)nxt.pn * tstep + (size_t)nxt.ko * 2 : cB;
        for (int t = 0; t < nt; t += 2) {
            const bool last = (t == nt - 2);
            const char* a1 = cA + (size_t)(t + 1) * kstep;
            const char* a2 = last ? nA : cA + (size_t)(t + 2) * kstep; const char* b2 = last ? nB : cB + (size_t)(t + 2) * kstep;
            const char* a3 = a2 + kstep; const char* b3 = b2 + kstep;
            if (last && has_next) S.a_ready(nxt);
            if constexpr (SP2) {
            PG8_LDB(B0, 0, 0); PG8_LDB(B1, 0, 1); PG8_SCHED; PG8_LDA(At, 0, 0); PG8_STAGE(PG8_SA(1, 1), a1 + hstep, voffA);
            PG8_WAIT_V(8); PG8_WAIT_L(0); PG8_BAR; PG8_MMA(0, 0, At, B0); PG8_MMA(0, 1, At, B1); PG8_BAR; PG8_SCHED;
            PG8_LDA(At, 0, 1); PG8_STAGE(PG8_SB(0, 0), b2, voffB); PG8_STAGE(PG8_SB(0, 1), b2 + hstep, voffB); PG8_STAGE(PG8_SA(0, 0), a2, voffA);
            PG8_WAIT_V(8); PG8_WAIT_L(0); PG8_BAR; PG8_MMA(1, 0, At, B0); PG8_MMA(1, 1, At, B1); PG8_BAR; PG8_SCHED;
            PG8_LDB(B0, 1, 0); PG8_LDB(B1, 1, 1); PG8_SCHED; PG8_LDA(At, 1, 0); PG8_STAGE(PG8_SA(0, 1), a2 + hstep, voffA);
            PG8_WAIT_V(8); PG8_WAIT_L(0); PG8_BAR; PG8_MMA(0, 0, At, B0); PG8_MMA(0, 1, At, B1); PG8_BAR; PG8_SCHED;
            PG8_LDA(At, 1, 1); PG8_STAGE(PG8_SB(1, 0), b3, voffB); PG8_STAGE(PG8_SB(1, 1), b3 + hstep, voffB); PG8_STAGE(PG8_SA(1, 0), a3, voffA);
            PG8_WAIT_V(8); PG8_WAIT_L(0); PG8_BAR; PG8_MMA(1, 0, At, B0); PG8_MMA(1, 1, At, B1); PG8_BAR; PG8_SCHED;
            } else {
            PG8_LDB(B0, 0, 0); PG8_SCHED; PG8_LDA(At, 0, 0); PG8_STAGE(PG8_SA(1, 1), a1 + hstep, voffA);
            PG8_WAIT_L(8); PG8_BAR; PG8_WAIT_L(0); PG8_MMA(0, 0, At, B0); PG8_BAR; PG8_SCHED;
            PG8_LDB(B1, 0, 1); PG8_STAGE(PG8_SB(0, 0), b2, voffB);
            PG8_BAR; PG8_WAIT_L(0); PG8_MMA(0, 1, At, B1); PG8_BAR;
            PG8_LDA(At, 0, 1); PG8_STAGE(PG8_SA(0, 0), a2, voffA);
            PG8_BAR; PG8_WAIT_L(0); PG8_MMA(1, 0, At, B0); PG8_BAR; PG8_SCHED;
            PG8_STAGE(PG8_SB(0, 1), b2 + hstep, voffB);
            PG8_WAIT_V(6); PG8_BAR; PG8_MMA(1, 1, At, B1); PG8_BAR;
            PG8_LDB(B0, 1, 0); PG8_SCHED; PG8_LDA(At, 1, 0); PG8_STAGE(PG8_SA(0, 1), a2 + hstep, voffA);
            PG8_WAIT_L(8); PG8_BAR; PG8_WAIT_L(0); PG8_MMA(0, 0, At, B0); PG8_BAR; PG8_SCHED;
            PG8_LDB(B1, 1, 1); PG8_STAGE(PG8_SB(1, 0), b3, voffB);
            PG8_BAR; PG8_WAIT_L(0); PG8_MMA(0, 1, At, B1); PG8_BAR;
            PG8_LDA(At, 1, 1); PG8_STAGE(PG8_SA(1, 0), a3, voffA);
            PG8_BAR; PG8_WAIT_L(0); PG8_MMA(1, 0, At, B0); PG8_BAR; PG8_SCHED;
            PG8_STAGE(PG8_SB(1, 1), b3 + hstep, voffB);
            PG8_WAIT_V(6); PG8_BAR; PG8_MMA(1, 1, At, B1); PG8_BAR;
            }
        }
        if constexpr (ALIGN_EPI) { if (wr == 0) PG8_BAR; }
        if constexpr (!Epi::AFTER_DRAIN) { E(acc, cur, wr, wc, fr, fq); S.done(cur); }
        if (!has_next) break;
#pragma unroll
        for (int a = 0; a < 2; ++a)
#pragma unroll
            for (int b = 0; b < 2; ++b)
#pragma unroll
                for (int m = 0; m < 4; ++m)
#pragma unroll
                    for (int n = 0; n < 2; ++n) acc[a][b][m][n] = (f32x4){0.f, 0.f, 0.f, 0.f};
        cur = nxt; cA = nA; cB = nB; ++ui;
        if constexpr (ALIGN_EPI) { if (wr == 1) PG8_BAR; }
    }
    PG8_WAIT_V(0);
    if constexpr (!ALIGN_EPI) { if (wr == 0) PG8_BAR; }
    PG8_BAR;
    if constexpr (Epi::AFTER_DRAIN) { E.fused(acc, cur, wr, wc, fr, fq, lds, wid, lane); S.done(cur); }
#undef PG8_SA
#undef PG8_SB
#undef PG8_STAGE
#undef PG8_LDA
#undef PG8_LDB
#undef PG8_MMA
#undef PG8_WAIT_V
#undef PG8_WAIT_L
#undef PG8_BAR
#undef PG8_SCHED
}
}
#ifndef PG8_SP2
#define PG8_SP2 true
#endif
#ifndef PG8_ALIGN
#define PG8_ALIGN true
#endif
#define GAS __attribute__((address_space(1)))
#define LAS __attribute__((address_space(3)))
typedef unsigned short bf16;
typedef unsigned v4u __attribute__((ext_vector_type(4)));
typedef float f32x4 __attribute__((ext_vector_type(4)));
typedef short bf16x8 __attribute__((ext_vector_type(8)));
typedef GAS unsigned gu32;
typedef GAS unsigned long long gu64;
#define RLX_AGENT __ATOMIC_RELAXED, __HIP_MEMORY_SCOPE_AGENT
#define LDS_WAIT() asm volatile("s_waitcnt lgkmcnt(0)" ::: "memory")
#define VM_WAIT() asm volatile("s_waitcnt vmcnt(0)" ::: "memory")
__device__ __forceinline__ unsigned long long rt() { return __builtin_amdgcn_s_memrealtime(); }
__device__ __forceinline__ unsigned f2bf(float f) { unsigned u = __builtin_bit_cast(unsigned, f); return (u + 0x7fffu + ((u >> 16) & 1u)) >> 16; }
__device__ __forceinline__ unsigned pk2(float lo, float hi) { return f2bf(lo) | (f2bf(hi) << 16); }

#define XB_TMO      128
#define XB_XCNT(j)  (256  + 64 * (j))
#define XB_XSUB(j)  (1280 + 64 * (j))
#define XB_XGEN(j)  (2304 + 64 * (j))
#define XB_TOP      3328
#define XB_TOPGEN   3392
#define XCD_BAR_WORDS 3456
#define XB_SPIN_CAP (1u << 18)

__device__ __forceinline__ unsigned xb_ld(unsigned* p)              { return __hip_atomic_load(p, __ATOMIC_RELAXED, __HIP_MEMORY_SCOPE_AGENT); }
__device__ __forceinline__ unsigned xb_add(unsigned* p, unsigned v) { return __hip_atomic_fetch_add(p, v, __ATOMIC_RELAXED, __HIP_MEMORY_SCOPE_AGENT); }
__device__ __forceinline__ unsigned xb_xcc_id() { return (unsigned)__builtin_amdgcn_s_getreg((3 << 11) | 20) & 0xFu; }
#define XB_SPIN(cond, bar) do { unsigned _sp = 0; while (cond) { __builtin_amdgcn_s_sleep(1); \
    if ((++_sp & 255u) == 0u) { if (xb_ld(&(bar)[XB_TMO])) break; if (_sp > XB_SPIN_CAP) { atomicAdd(&(bar)[XB_TMO], 1u); break; } } } } while (0)

struct XcdBarrier {
    unsigned* bar; unsigned x;
    volatile LAS unsigned* st;
};

__device__ __forceinline__ XcdBarrier xcd_barrier_post(unsigned* bar, volatile LAS unsigned* st) {
    XcdBarrier b; b.bar = bar; b.x = xb_xcc_id(); b.st = st;
    if (threadIdx.x == 0) (void)xb_add(&bar[XB_XCNT(b.x)], 1u);
    return b;
}
__device__ __forceinline__ void xcd_barrier_complete(unsigned* bar, unsigned x, unsigned& nloc, unsigned& nx) {
    const unsigned G = gridDim.x * gridDim.y * gridDim.z;
    unsigned sum, cnt, mine, sp = 0u;
    for (;;) {
        sum = 0u; cnt = 0u; mine = 0u;
#pragma unroll
        for (unsigned j = 0; j < 16; ++j) { const unsigned c = xb_ld(&bar[XB_XCNT(j)]); sum += c; cnt += (c > 0u) ? 1u : 0u; mine = (j == x) ? c : mine; }
        if (sum == G) break;
        __builtin_amdgcn_s_sleep(1);
        if ((++sp & 255u) == 0u) { if (xb_ld(&bar[XB_TMO])) break; if (sp > XB_SPIN_CAP) { atomicAdd(&bar[XB_TMO], 1u); break; } }
    }
    nloc = mine > 0u ? mine : 1u; nx = cnt > 0u ? cnt : 1u;
}

__device__ __forceinline__ void xcd_barrier(const XcdBarrier& b) {
    asm volatile("s_waitcnt vmcnt(0)" ::: "memory");
    __syncthreads();
    if (threadIdx.x == 0) {
        unsigned* bar = b.bar;
        __builtin_amdgcn_s_waitcnt(0);
        unsigned nloc = b.st[0], nx = b.st[1];
        if (nloc == 0u) { xcd_barrier_complete(bar, b.x, nloc, nx); b.st[0] = nloc; b.st[1] = nx; }
        const unsigned old = xb_add(&bar[XB_XSUB(b.x)], 1u);
        const unsigned gen = old / nloc;
        if (old + 1u == (gen + 1u) * nloc) {
            __builtin_amdgcn_fence(__ATOMIC_RELEASE, "agent");
            asm volatile("s_waitcnt vmcnt(0)" ::: "memory");
            const unsigned og = xb_add(&bar[XB_TOP], 1u);
            const unsigned tg = og / nx;
            if (og + 1u == (tg + 1u) * nx) xb_add(&bar[XB_TOPGEN], 1u);
            else XB_SPIN(xb_ld(&bar[XB_TOPGEN]) == tg, bar);
            __builtin_amdgcn_fence(__ATOMIC_ACQUIRE, "agent");
            xb_add(&bar[XB_XGEN(b.x)], 1u);
            asm volatile("s_waitcnt vmcnt(0)" ::: "memory");
        } else {
            XB_SPIN(xb_ld(&bar[XB_XGEN(b.x)]) == gen, bar);
            __builtin_amdgcn_fence(__ATOMIC_ACQUIRE, "agent");
            asm volatile("s_waitcnt vmcnt(0)" ::: "memory");
        }
    }
    __syncthreads();
}
constexpr int NWAVES = 8;
#ifndef MK_PER_PHASE
#define MK_PER_PHASE 0
#endif
constexpr int N_PHASES = 20;
constexpr int MOE_KS = 1;

constexpr int BATCH = 2, T = 8192, D = 1024, M = BATCH * T;
constexpr int NSA_IN = 2608, NSA_IN_PAD = 2816, FF0 = 2816, GLA_IN = 3088, GLA_IN_PAD = 3328, FFE = 3584, NE = 8;
constexpr int NCMP = 511, MAXTILES = 136, MAXSLOTS = MAXTILES * 256;
constexpr float ALPHA = 1.41421356237309515f;
constexpr float LN_EPS = 1e-5f, RMS_EPS = 1e-6f, LOG2E = 1.44269504088896341f;

constexpr size_t MiB = 1u << 20;
constexpr size_t WS_CTL = 0, CTL_ZERO_BYTES = 1 * MiB;
constexpr size_t WS_PB = 1 * MiB;
constexpr size_t WS_CNTL = WS_PB + 32768;
constexpr size_t WS_TOKE = WS_CNTL + 16384;
constexpr size_t WS_TOKW = WS_TOKE + (size_t)M * 8;
constexpr size_t WS_TOKP = WS_TOKW + (size_t)M * 8;
constexpr size_t WS_TOKS = WS_TOKP + (size_t)M * 8;
static_assert(WS_TOKS + (size_t)M * 8 <= 2 * MiB, "misc region");
constexpr size_t WS_WIN0 = 2 * MiB, WS_W1C = 8 * MiB, WS_WO0 = 10 * MiB, WS_WGU0 = 12 * MiB, WS_WD0 = 23 * MiB, WS_WIN1 = 29 * MiB, WS_WO1 = 36 * MiB, WS_WGU1 = 38 * MiB, WS_WD1 = 150 * MiB;
constexpr size_t WS_XB = 206 * MiB, WS_XRES = 238 * MiB, WS_T0 = 302 * MiB, WS_SCR = 366 * MiB;
constexpr size_t WS_Q = WS_SCR, WS_KV2 = WS_SCR + 32 * MiB, WS_KS = WS_SCR + 48 * MiB, WS_VS = WS_SCR + 56 * MiB, WS_KW = WS_SCR + 64 * MiB, WS_VW = WS_SCR + 72 * MiB;
constexpr size_t WS_GT = WS_SCR + 80 * MiB, WS_UL = WS_SCR + 83 * MiB, WS_KCMP = WS_SCR + 99 * MiB, WS_VCMP = WS_KCMP + 512 * 1024, WS_O = WS_SCR + 100 * MiB, WS_H0 = WS_SCR + 132 * MiB;
constexpr size_t WS_QKVG = WS_SCR, WS_ALOW = WS_SCR + 96 * MiB, WS_BCUM = WS_SCR + 97 * MiB, WS_ZB = WS_SCR + 129 * MiB, WS_DEC = WS_SCR + 257 * MiB, WS_SST = WS_SCR + 258 * MiB, WS_O1 = WS_SCR + 322 * MiB;
constexpr size_t WS_XG = WS_SCR, WS_YB = WS_SCR + 68 * MiB, WS_H2 = WS_SCR + 136 * MiB, WS_YB1 = WS_SCR + 374 * MiB, WS_END = WS_YB1 + 68 * MiB;
static_assert(WS_H2 + (size_t)MAXSLOTS * FFE * 2 <= WS_YB1, "H2 fits");
static_assert(WS_H0 + (size_t)M * FF0 * 2 <= 896 * MiB && WS_O1 + 32 * MiB <= 896 * MiB && WS_END <= 896 * MiB, "d_ws map");
constexpr int CW_TMO = 0, CW_CODE = 1, CW_BAR = 4096;
constexpr int CW_PANEL0 = 16384, CW_PANEL1 = 32768;
static_assert((CW_PANEL1 + 64 * MAXTILES) * 4 <= (int)CTL_ZERO_BYTES, "CTL words inside the memset region");

constexpr int RING_OFF = 0, RING_BYTES = 131072;
constexpr int LDSCTL_OFF = RING_BYTES, MISC_OFF = LDSCTL_OFF + 320;
constexpr int INPTR_OFF = MISC_OFF + 128;
constexpr int LDS_BYTES = 147456;
#ifndef TR_UNROLL
#define TR_UNROLL 8
#endif
typedef float f32x16 __attribute__((ext_vector_type(16)));
typedef short v4i16 __attribute__((ext_vector_type(4)));
typedef unsigned v2u __attribute__((ext_vector_type(2)));
struct Args { const float* in[27]; float* out; unsigned char* ws; int ph_lo, ph_hi; };
struct Frame {
    const Args* A;
    LAS unsigned char* lds;
    volatile LAS unsigned* MISC;
    gu32* ctl;
    int tid, lane, wave;
    int vcu, G, wg;
    unsigned char* ws; float* out;
};
#define inptr(F, k) ((F).A->in[k])
__device__ __forceinline__ float wave_sum(float v) {
#pragma unroll
    for (int o = 1; o < 64; o <<= 1) v += __shfl_xor(v, o);
    return v;
}
__device__ __forceinline__ float bf2f(bf16 h) { return __uint_as_float((unsigned)h << 16); }
__device__ __forceinline__ v4i16 vtr(const LAS unsigned char* p) { return __builtin_amdgcn_ds_read_tr16_b64_v4i16((LAS v4i16*)p); }
__device__ __forceinline__ int crow(int r, int hi) { return (r & 3) + 8 * (r >> 2) + 4 * hi; }

__device__ __forceinline__ void tr_item(const float* src, int ldn, int nvalid, int k0, int n0, bf16* dst, int dld, int drow0, LAS float* scr, int lane) {
    const int n_ = n0 + (lane & 31); const bool ok = n_ < nvalid;
    float tv[32];
#pragma unroll
    for (int i = 0; i < 32; ++i) { const int kk = 2 * i + (lane >> 5); tv[i] = ok ? *(const GAS float*)(src + (size_t)(k0 + kk) * ldn + n_) : 0.f; }
#pragma unroll
    for (int i = 0; i < 32; ++i) { const int kk = 2 * i + (lane >> 5); scr[kk * 33 + (lane & 31)] = tv[i]; }
    LDS_WAIT(); asm volatile("" ::: "memory");
    const int c = lane & 7;
#pragma unroll
    for (int j = 0; j < 4; ++j) { const int n = (lane >> 3) + 8 * j; const LAS float* s = scr + (8 * c) * 33 + n;
        v4u o; o.x = pk2(s[0 * 33], s[1 * 33]); o.y = pk2(s[2 * 33], s[3 * 33]); o.z = pk2(s[4 * 33], s[5 * 33]); o.w = pk2(s[6 * 33], s[7 * 33]);
        *(GAS v4u*)(dst + (size_t)(drow0 + n) * dld + k0 + 8 * c) = o; }
    LDS_WAIT(); asm volatile("" ::: "memory");
}
__device__ __forceinline__ int swiglu_row(int n0, int F_) { return n0 < F_ ? (n0 / 128) * 256 + (n0 % 128) : ((n0 - F_) / 128) * 256 + 128 + ((n0 - F_) % 128); }
#define KBNB(idx, nkb, nnb) const int kb = ((idx) % (8 * (nkb))) / 8, nb = ((idx) / (8 * (nkb))) * 8 + (idx) % 8
__device__ __forceinline__ void p0_items(Frame& F, const int first, const int last, const int gw, const int NGW) {
    LAS float* scr = (LAS float*)(F.lds + RING_OFF + F.wave * 16384);
    const int lane = F.lane;
    unsigned char* ws = F.ws;
    constexpr int I_IN0 = 16 * (NSA_IN_PAD / 32), I_W1 = 4 * 16 * 8, I_WO = 16 * 32, I_GU0 = 16 * (2 * FF0 / 32), I_D0 = (FF0 / 64) * 32, I_IN1 = 16 * (GLA_IN_PAD / 32);
    constexpr int I_GU1E = 16 * (2 * FFE / 32), I_D1E = (FFE / 64) * 32, I_GU1 = NE * I_GU1E, I_D1 = NE * I_D1E;
    constexpr int NITEMS = I_IN0 + I_W1 + I_WO + I_GU0 + I_D0 + I_IN1 + I_WO + I_GU1 + I_D1;
    for (int it = first + gw; it < last; it += NGW) {
        int r = it;
        if (r < I_IN0) { constexpr int nnb = NSA_IN_PAD / 32; KBNB(r, 16, nnb); tr_item(inptr(F, 1), NSA_IN, NSA_IN, 64 * kb, 32 * nb, (bf16*)(ws + WS_WIN0), 1024, 32 * nb, scr, lane); continue; } r -= I_IN0;
        if (r < I_W1) { const int blk = r / 128, q = r % 128; KBNB(q, 16, 8);
            const float* src = ((blk >> 1) ? inptr(F, 6) : inptr(F, 4)) + (size_t)(blk & 1) * 1024 * 256; tr_item(src, 256, 256, 64 * kb, 32 * nb, (bf16*)(ws + WS_W1C), 1024, 256 * blk + 32 * nb, scr, lane); continue; } r -= I_W1;
        if (r < I_WO) { KBNB(r, 16, 32); tr_item(inptr(F, 8), 1024, 1024, 64 * kb, 32 * nb, (bf16*)(ws + WS_WO0), 1024, 32 * nb, scr, lane); continue; } r -= I_WO;
        if (r < I_GU0) { constexpr int nnb = 2 * FF0 / 32; KBNB(r, 16, nnb); tr_item(inptr(F, 11), 2 * FF0, 2 * FF0, 64 * kb, 32 * nb, (bf16*)(ws + WS_WGU0), 1024, swiglu_row(32 * nb, FF0), scr, lane); continue; } r -= I_GU0;
        if (r < I_D0) { KBNB(r, FF0 / 64, 32); tr_item(inptr(F, 12), 1024, 1024, 64 * kb, 32 * nb, (bf16*)(ws + WS_WD0), FF0, 32 * nb, scr, lane); continue; } r -= I_D0;
        if (r < I_IN1) { constexpr int nnb = GLA_IN_PAD / 32; KBNB(r, 16, nnb); tr_item(inptr(F, 15), GLA_IN, GLA_IN, 64 * kb, 32 * nb, (bf16*)(ws + WS_WIN1), 1024, 32 * nb, scr, lane); continue; } r -= I_IN1;
        if (r < I_WO) { KBNB(r, 16, 32); tr_item(inptr(F, 19), 1024, 1024, 64 * kb, 32 * nb, (bf16*)(ws + WS_WO1), 1024, 32 * nb, scr, lane); continue; } r -= I_WO;
        if (r < I_GU1) { constexpr int nnb = 2 * FFE / 32; const int e = r / I_GU1E, q = r % I_GU1E; KBNB(q, 16, nnb);
            tr_item(inptr(F, 23) + (size_t)e * 1024 * 2 * FFE, 2 * FFE, 2 * FFE, 64 * kb, 32 * nb, (bf16*)(ws + WS_WGU1) + (size_t)e * 2 * FFE * 1024, 1024, swiglu_row(32 * nb, FFE), scr, lane); continue; } r -= I_GU1;
        { const int e = r / I_D1E, q = r % I_D1E; KBNB(q, FFE / 64, 32);
            tr_item(inptr(F, 24) + (size_t)e * FFE * 1024, 1024, 1024, 64 * kb, 32 * nb, (bf16*)(ws + WS_WD1) + (size_t)e * 1024 * FFE, FFE, 32 * nb, scr, lane); }
    }
}
namespace p0n { constexpr int I_D1 = NE * (FFE / 64) * 32, I_ALL = 16 * (NSA_IN_PAD / 32) + 4 * 16 * 8 + 16 * 32 + 16 * (2 * FF0 / 32) + (FF0 / 64) * 32 + 16 * (GLA_IN_PAD / 32) + 16 * 32 + NE * 16 * (2 * FFE / 32) + I_D1; }
constexpr int CMP_WGS = 64;
__device__ __forceinline__ void p0_prologue(Frame& F) {
    const int gw = F.vcu * NWAVES + F.wave, NGW = F.G * NWAVES, lane = F.lane;
    unsigned char* ws = F.ws;
    p0_items(F, 0, p0n::I_ALL, gw, NGW);
    { const float* x = inptr(F, 0); bf16* xb = (bf16*)(ws + WS_XB);
      for (int m = gw; m < M; m += NGW) { const GAS f32x4* xr = (const GAS f32x4*)(x + (size_t)m * D) + lane; GAS unsigned long long* o8 = (GAS unsigned long long*)(xb + (size_t)m * D) + lane;
#pragma unroll
          for (int j = 0; j < 4; ++j) { const f32x4 v = xr[64 * j]; o8[64 * j] = (unsigned long long)pk2(v.x, v.y) | ((unsigned long long)pk2(v.z, v.w) << 32); } } }
    { float* pb = (float*)(ws + WS_PB);
      for (int task = gw; task < 64; task += NGW) { const int rp = task & 7, cb = (task >> 3) & 3, kv = task >> 5; const float* pe = kv ? inptr(F, 3) : inptr(F, 2); const float* w1 = kv ? inptr(F, 6) : inptr(F, 4); const int c = 64 * cb + lane;
          float a = 0.f;
          for (int r0 = 256 * rp; r0 < 256 * rp + 256; r0 += 32) { float wv[32], pv[32];
#pragma unroll
              for (int u = 0; u < 32; ++u) { wv[u] = *(const GAS float*)(w1 + (size_t)(r0 + u) * 256 + c); pv[u] = *(const GAS float*)(pe + r0 + u); }
#pragma unroll
              for (int u = 0; u < 32; ++u) a += pv[u] * wv[u]; }
          pb[rp * 512 + kv * 256 + c] = a; } }
}

__device__ __forceinline__ float gelu_tanh(float x) { const float y = 0.7978845608028654f * (x + 0.044715f * x * x * x); const float e = __expf(2.f * y); const float th = 1.f - 2.f / (e + 1.f); return 0.5f * x * (1.f + th); }
__device__ __forceinline__ void cmp_finish(Frame& F) {
    const int gw = F.vcu * NWAVES + F.wave, NGW = F.G * NWAVES, lane = F.lane;
    LAS float* hb = (LAS float*)(F.lds + RING_OFF + F.wave * 1024);
    LAS float* W2L = (LAS float*)(F.lds + RING_OFF + 16384);
    const float* ul = (const float*)(F.ws + WS_UL); const float* pb = (const float*)(F.ws + WS_PB);
    int staged = -1;
    for (int task = gw; task < 8192; task += NGW) {
        const int kv = task >> 12, rem = task & 4095, b = rem >> 11, n = (rem >> 2) & 511, g = rem & 3;
        if (kv != staged) { const float* w2 = kv ? inptr(F, 7) : inptr(F, 5);
            __syncthreads();
            for (int q = F.tid; q < 4096; q += NWAVES * 64) *(LAS f32x4*)(W2L + q * 4) = *(const GAS f32x4*)(w2 + q * 4);
            __syncthreads(); staged = kv; }
        bf16* dst = (bf16*)(F.ws + (kv ? WS_VCMP : WS_KCMP)) + ((size_t)((b * 4 + g) * 512 + n)) * 64;
        if (n == 511) { dst[lane] = 0; continue; }
        const size_t rowU = (size_t)kv * 4096 + (size_t)(b * 512 + n) * 4 + g, rowL = rowU + 4;
        const f32x4 u = *(const f32x4*)(ul + rowU * 512 + lane * 4), lw = *(const f32x4*)(ul + rowL * 512 + 256 + lane * 4);
        f32x4 bs = (f32x4){0.f, 0.f, 0.f, 0.f};
#pragma unroll
        for (int rp = 0; rp < 8; ++rp) bs += *(const f32x4*)(pb + rp * 512 + kv * 256 + lane * 4);
        const f32x4 pre = u + lw + bs;
        *(LAS f32x4*)(hb + lane * 4) = (f32x4){gelu_tanh(pre[0]), gelu_tanh(pre[1]), gelu_tanh(pre[2]), gelu_tanh(pre[3])};
        LDS_WAIT(); asm volatile("" ::: "memory");
        float a0 = 0.f, a1 = 0.f, a2 = 0.f, a3 = 0.f;
#pragma unroll 8
        for (int c = 0; c < 256; c += 4) { const f32x4 h4 = *(const LAS f32x4*)(hb + c);
            a0 += h4[0] * W2L[(c + 0) * 64 + lane]; a1 += h4[1] * W2L[(c + 1) * 64 + lane]; a2 += h4[2] * W2L[(c + 2) * 64 + lane]; a3 += h4[3] * W2L[(c + 3) * 64 + lane]; }
        dst[lane] = (bf16)f2bf((a0 + a1) + (a2 + a3));
        LDS_WAIT(); asm volatile("" ::: "memory");
    }
}

namespace nsa {
constexpr int KB_OFF = 0, VB_OFF = 18432, IMPA_OFF = 36864, IMPB_OFF = 69632, SEL_OFF = 102400, UNI_OFF = 103424, NS_OFF = 103440, SLIST_OFF = 103456, TILE_B = 9216;
static_assert(SLIST_OFF + 512 <= RING_BYTES, "nsa LDS map");
constexpr float THR = 8.f;
__device__ __forceinline__ float dpp_xor1(float v) { return __int_as_float(__builtin_amdgcn_update_dpp(0, __float_as_int(v), 0xB1, 0xF, 0xF, true)); }
__device__ __forceinline__ float dpp_xor2(float v) { return __int_as_float(__builtin_amdgcn_update_dpp(0, __float_as_int(v), 0x4E, 0xF, 0xF, true)); }
__device__ __forceinline__ float max_halves(float v) { const auto rr = __builtin_amdgcn_permlane32_swap(__float_as_uint(v), __float_as_uint(v), false, false); return fmaxf(__uint_as_float(rr[0]), __uint_as_float(rr[1])); }
__device__ __forceinline__ int below(unsigned long long mk) { return (int)__builtin_amdgcn_mbcnt_hi((unsigned)(mk >> 32), __builtin_amdgcn_mbcnt_lo((unsigned)mk, 0u)); }
template <int MODE>
__device__ __forceinline__ void tile(LAS unsigned char* lds, const int kt_off, const int vt_off, const bf16x8 (&qf)[4], const unsigned qaw, f32x16 (&o)[2], float& m, float& l,
                                     const int lane, const float bias, const bool emask, const int d0, const int pstep, const int lim, const float rl, const int impq, const int jbase) {
    const int hi = lane >> 5, qc = lane & 31;
    const v4u qav = (v4u){qaw, 0u, 0u, 0u}; const bf16x8 qaug = __builtin_bit_cast(bf16x8, qav);
    f32x16 p[2];
#pragma unroll
    for (int h2 = 0; h2 < 2; ++h2) {
#pragma unroll
        for (int r = 0; r < 16; ++r) p[h2][r] = 0.f;
#pragma unroll
        for (int ks = 0; ks < 4; ++ks) { const bf16x8 a = *(const LAS bf16x8*)(lds + kt_off + (32 * h2 + qc) * 144 + 32 * ks + 16 * hi);
            p[h2] = __builtin_amdgcn_mfma_f32_32x32x16_bf16(a, qf[ks], p[h2], 0, 0, 0); }
        { const unsigned xb = hi ? 0u : f2bf((float)(32 * h2 + qc)); const v4u kav = (v4u){xb | (xb << 16), 0u, 0u, 0u};
          p[h2] = __builtin_amdgcn_mfma_f32_32x32x16_bf16(__builtin_bit_cast(bf16x8, kav), qaug, p[h2], 0, 0, 0); }
    }
    if (emask) {
#pragma unroll
        for (int h2 = 0; h2 < 2; ++h2)
#pragma unroll
            for (int r = 0; r < 16; ++r) { const int dist = d0 - pstep * (32 * h2 + (r & 3) + 8 * (r >> 2)); p[h2][r] = ((unsigned)dist < (unsigned)lim) ? p[h2][r] : -INFINITY; }
    }
    float mref;
    if (MODE == 1) mref = m - bias;
    else {
        float mx = fmaxf(p[0][0], p[1][0]);
#pragma unroll
        for (int r = 1; r < 16; ++r) mx = fmaxf(fmaxf(mx, p[0][r]), p[1][r]);
        mx = max_halves(mx);
        const float mt = mx + bias;
        const bool up = mt > m + THR;
        if (__any(up)) { const float mn = up ? mt : m; const float f = __builtin_amdgcn_exp2f(m - mn); l *= f; m = mn;
            if (MODE == 2) {
#pragma unroll
                for (int r = 0; r < 16; ++r) { o[0][r] *= f; o[1][r] *= f; } } }
        mref = m - bias;
    }
    float ls0 = 0.f, ls1 = 0.f;
#pragma unroll
    for (int r = 0; r < 16; ++r) { float e0 = __builtin_amdgcn_exp2f(p[0][r] - mref), e1 = __builtin_amdgcn_exp2f(p[1][r] - mref); if (MODE == 1) { e0 *= rl; e1 *= rl; } p[0][r] = e0; p[1][r] = e1; ls0 += e0; ls1 += e1; }
    if (MODE != 1) l += ls0 + ls1;
    if (MODE == 0) return;
    if (MODE == 1) {
        LAS float* IA = (LAS float*)(lds + IMPA_OFF) + impq * 128; LAS float* IB = (LAS float*)(lds + IMPB_OFF) + impq * 128;
#pragma unroll
        for (int h2 = 0; h2 < 2; ++h2)
#pragma unroll
            for (int a4 = 0; a4 < 4; ++a4) {
                float qs = (p[h2][4 * a4] + p[h2][4 * a4 + 1]) + (p[h2][4 * a4 + 2] + p[h2][4 * a4 + 3]), last = p[h2][4 * a4 + 3];
                qs += dpp_xor1(qs); qs += dpp_xor2(qs); last += dpp_xor1(last); last += dpp_xor2(last);
                const int j = jbase + 8 * h2 + 2 * a4 + hi;
                if ((qc & 3) == 0) { IA[j] = qs; if (j + 1 < 128) IB[j + 1] = last; }
            }
    }
    bf16x8 pf[2][2];
#pragma unroll
    for (int h2 = 0; h2 < 2; ++h2)
#pragma unroll
        for (int s2 = 0; s2 < 2; ++s2) { v4u wv; wv.x = pg8::cvtpk_c(p[h2][8 * s2 + 0], p[h2][8 * s2 + 1]); wv.y = pg8::cvtpk_c(p[h2][8 * s2 + 2], p[h2][8 * s2 + 3]);
            wv.z = pg8::cvtpk_c(p[h2][8 * s2 + 4], p[h2][8 * s2 + 5]); wv.w = pg8::cvtpk_c(p[h2][8 * s2 + 6], p[h2][8 * s2 + 7]); pf[h2][s2] = __builtin_bit_cast(bf16x8, wv); }
    const int a = (lane >> 4) & 1, q_ = (lane & 15) >> 2, p_ = lane & 3;
#pragma unroll
    for (int d0_ = 0; d0_ < 2; ++d0_)
#pragma unroll
        for (int h2 = 0; h2 < 2; ++h2)
#pragma unroll
            for (int s2 = 0; s2 < 2; ++s2) {
                const LAS unsigned char* ad = lds + vt_off + (32 * h2 + 16 * s2 + 4 * hi + q_) * 144 + (32 * d0_ + 16 * a + 4 * p_) * 2;
                const v4i16 lo = vtr(ad), hi4 = vtr(ad + 8 * 144);
                const bf16x8 av = (bf16x8){lo[0], lo[1], lo[2], lo[3], hi4[0], hi4[1], hi4[2], hi4[3]};
                o[d0_] = __builtin_amdgcn_mfma_f32_32x32x16_bf16(av, pf[h2][s2], o[d0_], 0, 0, 0);
            }
}
__device__ __forceinline__ void select13(const unsigned (&k0)[4], const unsigned (&k1)[4], const int lane, unsigned long long (&m0)[4], unsigned long long (&m1)[4]) {
    unsigned th[4] = {0u, 0u, 0u, 0u};
    for (int bit = 30; bit >= 0; --bit) {
#pragma unroll
        for (int u = 0; u < 4; ++u) { const unsigned cand = th[u] | (1u << bit); const int cnt = __popcll(__ballot(k0[u] >= cand)) + __popcll(__ballot(k1[u] >= cand)); th[u] = cnt >= 13 ? cand : th[u]; }
    }
#pragma unroll
    for (int u = 0; u < 4; ++u) {
        const unsigned long long gt0 = __ballot(k0[u] > th[u]), gt1 = __ballot(k1[u] > th[u]), eq0 = __ballot(k0[u] == th[u]), eq1 = __ballot(k1[u] == th[u]);
        const int need = 13 - __popcll(gt0) - __popcll(gt1);
        const int r0 = below(eq0), r1 = __popcll(eq0) + below(eq1);
        const bool s0 = (k0[u] > th[u]) || (k0[u] == th[u] && r0 < need), s1 = (k1[u] > th[u]) || (k1[u] == th[u] && r1 < need);
        m0[u] = __ballot(s0); m1[u] = __ballot(s1);
    }
}
}
__device__ __forceinline__ void nsa_attn_phase(Frame& F) {
    using namespace nsa;
    LAS unsigned char* lds = F.lds + RING_OFF;
    const int tid = F.tid, lane = F.lane, w = F.wave, hi = lane >> 5, qc = lane & 31;
    unsigned char* ws = F.ws;
    const bf16* Qp = (const bf16*)(ws + WS_Q); const float* GT = (const float*)(ws + WS_GT); bf16* Op = (bf16*)(ws + WS_O);
    LAS unsigned* SEL = (LAS unsigned*)(lds + SEL_OFF); LAS unsigned* UNI = (LAS unsigned*)(lds + UNI_OFF); LAS int* NSW = (LAS int*)(lds + NS_OFF); LAS int* SLIST = (LAS int*)(lds + SLIST_OFF);
    const int lrow = tid >> 3, lch = tid & 7;
    for (int un = F.wg; un < 1024; un += F.G) {
        const int bg = un & 7, cc = un >> 3, c = ((cc >> 5) & 1) ? (cc & ~31) + 31 - (cc & 31) : cc;
        const int b = bg >> 2, g = bg & 3, t0 = c * 64;
        const int tql = 8 * w + (qc >> 2), hh = qc & 3, t = t0 + tql, head = 4 * g + hh;
        const size_t mrow = (size_t)b * T + t;
        const float slope2 = __builtin_amdgcn_exp2f(-0.5f * (float)(head + 1)) * LOG2E;
        unsigned qaw1, qaw16;
        { const unsigned sh = f2bf(slope2); const float rem = slope2 - __uint_as_float(sh << 16); const unsigned sl = f2bf(rem);
          const unsigned sh16 = f2bf(16.f * __uint_as_float(sh << 16)), sl16 = f2bf(16.f * __uint_as_float(sl << 16));
          qaw1 = hi ? 0u : (sh | (sl << 16)); qaw16 = hi ? 0u : (sh16 | (sl16 << 16)); }
        bf16x8 qf[4];
#pragma unroll
        for (int ks = 0; ks < 4; ++ks) qf[ks] = *(const GAS bf16x8*)(Qp + mrow * 1024 + head * 64 + 16 * ks + 8 * hi);
        const float* gp = GT + mrow * 48 + (g * 4 + hh) * 3; const float g_cmp = gp[0], g_slc = gp[1], g_win = gp[2];
        const int nmax = (4 * c + 2) < 510 ? (4 * c + 2) : 510, ncb = nmax / 64 + 1;
        const int jw0 = c - 8 > 0 ? c - 8 : 0, nw = c - jw0 + 1, S3 = 2 * ncb + nw;
        const unsigned kcb = (unsigned)WS_KCMP + (unsigned)(b * 4 + g) * 65536u, kvb = ((unsigned)b * T * 256u + (unsigned)g * 64u) * 2u;
        const unsigned thr64 = (unsigned)(lrow * 128 + lch * 16), thr256 = (unsigned)(lrow * 512 + lch * 16);
        int ns = 1;
#define NSA_FETCH(s, kr, vr) do { const int s_ = (s); unsigned ko_, vo_ = 0u; \
            if (s_ < ncb) { ko_ = kcb + (unsigned)s_ * 8192u + thr64; } \
            else if (s_ < 2 * ncb) { ko_ = kcb + (unsigned)(s_ - ncb) * 8192u + thr64; vo_ = ko_ + (unsigned)(WS_VCMP - WS_KCMP); } \
            else if (s_ < S3) { ko_ = (unsigned)WS_KW + kvb + (unsigned)(c - (s_ - 2 * ncb)) * 32768u + thr256; vo_ = ko_ + (unsigned)(WS_VW - WS_KW); } \
            else { ko_ = (unsigned)WS_KS + kvb + (unsigned)SLIST[ns - 1 - (s_ - S3)] * 32768u + thr256; vo_ = ko_ + (unsigned)(WS_VS - WS_KS); } \
            kr = *(const GAS v4u*)(ws + ko_); if (s_ >= ncb) vr = *(const GAS v4u*)(ws + vo_); } while (0)
#define NSA_COMMIT(s, kr, vr) do { const int bo_ = ((s) & 1) * TILE_B + lrow * 144 + lch * 16; *(LAS v4u*)(lds + KB_OFF + bo_) = kr; if ((s) >= ncb) *(LAS v4u*)(lds + VB_OFF + bo_) = vr; } while (0)
        __syncthreads();
        if (c <= 15) {
            int ln = lane; asm volatile("" : "+v"(ln));
            if (ln < 8) { const int q = 8 * w + ln; SEL[q * 4 + 0] = (2u << c) - 1u; SEL[q * 4 + 1] = 0u; SEL[q * 4 + 2] = 0u; SEL[q * 4 + 3] = 0u; }
            if (w == 0 && ln <= c) SLIST[ln] = ln;
            ns = c + 1; }
        else if (tid < 4) UNI[tid] = 0u;
        int ST = S3 + ns;
        v4u krA = (v4u){0u, 0u, 0u, 0u}, vrA = krA, krB = krA, vrB = krA;
        NSA_FETCH(0, krA, vrA); NSA_COMMIT(0, krA, vrA); NSA_FETCH(1, krB, vrB);
        __syncthreads();
        float m = -1e30f, l = 0.f, rl = 0.f; f32x16 o[2]; unsigned otp[2][8];
#pragma unroll
        for (int r = 0; r < 16; ++r) { o[0][r] = 0.f; o[1][r] = 0.f; }
#pragma unroll
        for (int r = 0; r < 8; ++r) { otp[0][r] = 0u; otp[1][r] = 0u; }
        for (int s = 0; s < ST; ++s) {
            const bool has_next = s + 1 < ST;
            if (s + 2 < ST) { if (s & 1) NSA_FETCH(s + 2, krB, vrB); else NSA_FETCH(s + 2, krA, vrA); }
            const int kt = KB_OFF + (s & 1) * TILE_B, vt = VB_OFF + (s & 1) * TILE_B;
            if (s < 2 * ncb) { const int kb = s < ncb ? s : s - ncb; const int pos0 = 1024 * kb + 31;
                const float bias = slope2 * (float)(pos0 - t); const bool em = 1024 * kb + 1039 > t0; const int d0 = t - pos0 - 64 * hi;
                if (s < ncb) tile<0>(lds, kt, vt, qf, qaw16, o, m, l, lane, bias, em, d0, 16, 0x7fffffff, 0.f, tql, 0);
#if defined(PROBE_NSA) && PROBE_NSA == 7
                if (s < ncb) { float m2 = m, l2 = l; tile<0>(lds, kt, vt, qf, qaw16, o, m2, l2, lane, bias, em, d0, 16, 0x7fffffff, 0.f, tql, 0); asm volatile("" :: "v"(m2), "v"(l2)); }
#endif
                else tile<1>(lds, kt, vt, qf, qaw16, o, m, l, lane, bias, em, d0, 16, 0x7fffffff, rl, tql, 16 * kb); }
            else { int j; float bias; int lim;
                if (s < S3) { j = c - (s - 2 * ncb); bias = slope2 * (float)(64 * j - t); lim = 512; }
                else { j = SLIST[ns - 1 - (s - S3)]; const bool selq = (SEL[tql * 4 + (j >> 5)] >> (j & 31)) & 1u; bias = selq ? slope2 * (float)(64 * j - t) : -INFINITY; lim = 0x7fffffff; }
                const bool em = (j == c) || (s < S3 && c >= 8 && j == c - 8);
                tile<2>(lds, kt, vt, qf, qaw1, o, m, l, lane, bias, em, t - 64 * j - 4 * hi, 1, lim, 0.f, 0, 0); }
            if (s == ncb - 1) { const float lt0 = l + __shfl_xor(l, 32); rl = 1.0f / fmaxf(lt0, 1e-30f); }
            if (s == 2 * ncb - 1) {
#pragma unroll
                for (int r = 0; r < 8; ++r) { otp[0][r] = pg8::cvtpk_c(g_cmp * o[0][2 * r], g_cmp * o[0][2 * r + 1]); otp[1][r] = pg8::cvtpk_c(g_cmp * o[1][2 * r], g_cmp * o[1][2 * r + 1]); }
#pragma unroll
                for (int r = 0; r < 16; ++r) { o[0][r] = 0.f; o[1][r] = 0.f; }
                m = -1e30f; l = 0.f; }
            if (s == S3 - 1) { const float lt = l + __shfl_xor(l, 32); const float sc = g_win / fmaxf(lt, 1e-30f);
#pragma unroll
                for (int r = 0; r < 8; ++r) { otp[0][r] = pg8::cvtpk_c(__uint_as_float(otp[0][r] << 16) + sc * o[0][2 * r], __uint_as_float(otp[0][r] & 0xffff0000u) + sc * o[0][2 * r + 1]);
                    otp[1][r] = pg8::cvtpk_c(__uint_as_float(otp[1][r] << 16) + sc * o[1][2 * r], __uint_as_float(otp[1][r] & 0xffff0000u) + sc * o[1][2 * r + 1]); }
#pragma unroll
                for (int r = 0; r < 16; ++r) { o[0][r] = 0.f; o[1][r] = 0.f; }
                m = -1e30f; l = 0.f; }
            if (has_next) { if (s & 1) NSA_COMMIT(s + 1, krA, vrA); else NSA_COMMIT(s + 1, krB, vrB); }
            __syncthreads();
            if (s == 2 * ncb - 1 && c >= 16) {
                {
                    unsigned long long uo0 = 0ull, uo1 = 0ull;
#if defined(PROBE_NSA) && PROBE_NSA == 6
                    for (int qq = 0; qq < 16; qq += 4) { const int qi = qq & 7;
#else
                    for (int qi = 0; qi < 8; qi += 4) {
#endif
                        unsigned k0[4], k1[4]; unsigned long long m0[4], m1[4];
#pragma unroll
                        for (int u = 0; u < 4; ++u) { const int q = 8 * w + qi + u;
                            const LAS float* ia = (const LAS float*)(lds + IMPA_OFF) + q * 128; const LAS float* ib = (const LAS float*)(lds + IMPB_OFF) + q * 128;
                            const float v0 = ia[lane] + ib[lane], v1 = ia[lane + 64] + ib[lane + 64];
                            k0[u] = (lane >= 1 && lane <= c - 2) ? __float_as_uint(v0) + 1u : 0u; k1[u] = (lane + 64 <= c - 2) ? __float_as_uint(v1) + 1u : 0u; }
                        select13(k0, k1, lane, m0, m1);
#pragma unroll
                        for (int u = 0; u < 4; ++u) { const int q = 8 * w + qi + u;
                            m0[u] |= 1ull;
                            if (c - 1 < 64) m0[u] |= 1ull << (c - 1); else m1[u] |= 1ull << (c - 1 - 64);
                            if (c < 64) m0[u] |= 1ull << c; else m1[u] |= 1ull << (c - 64);
                            uo0 |= m0[u]; uo1 |= m1[u];
                            if (lane == 0) { SEL[q * 4 + 0] = (unsigned)m0[u]; SEL[q * 4 + 1] = (unsigned)(m0[u] >> 32); SEL[q * 4 + 2] = (unsigned)m1[u]; SEL[q * 4 + 3] = (unsigned)(m1[u] >> 32); } }
                    }
                    if (lane == 0) { __hip_atomic_fetch_or(UNI + 0, (unsigned)uo0, __ATOMIC_RELAXED, __HIP_MEMORY_SCOPE_WORKGROUP); __hip_atomic_fetch_or(UNI + 1, (unsigned)(uo0 >> 32), __ATOMIC_RELAXED, __HIP_MEMORY_SCOPE_WORKGROUP);
                        __hip_atomic_fetch_or(UNI + 2, (unsigned)uo1, __ATOMIC_RELAXED, __HIP_MEMORY_SCOPE_WORKGROUP); __hip_atomic_fetch_or(UNI + 3, (unsigned)(uo1 >> 32), __ATOMIC_RELAXED, __HIP_MEMORY_SCOPE_WORKGROUP); }
                }
                __syncthreads();
                if (w == 0) {
                    const unsigned long long u0 = (unsigned long long)UNI[0] | ((unsigned long long)UNI[1] << 32), u1 = (unsigned long long)UNI[2] | ((unsigned long long)UNI[3] << 32);
                    if ((u0 >> lane) & 1ull) SLIST[below(u0)] = lane;
                    if ((u1 >> lane) & 1ull) SLIST[__popcll(u0) + below(u1)] = 64 + lane;
                    if (lane == 0) NSW[0] = __popcll(u0) + __popcll(u1);
                }
                __syncthreads();
                ns = __builtin_amdgcn_readfirstlane(NSW[0]); ST = S3 + ns;
            }
        }
        { const float lt = l + __shfl_xor(l, 32); const float sc = g_slc / fmaxf(lt, 1e-30f);
          bf16* orow = Op + mrow * 1024 + head * 64;
#pragma unroll
          for (int d0 = 0; d0 < 2; ++d0)
#pragma unroll
              for (int a4 = 0; a4 < 4; ++a4) { const unsigned p0_ = otp[d0][2 * a4], p1_ = otp[d0][2 * a4 + 1]; v2u wv;
                  wv.x = pg8::cvtpk_c(__uint_as_float(p0_ << 16) + sc * o[d0][4 * a4], __uint_as_float(p0_ & 0xffff0000u) + sc * o[d0][4 * a4 + 1]);
                  wv.y = pg8::cvtpk_c(__uint_as_float(p1_ << 16) + sc * o[d0][4 * a4 + 2], __uint_as_float(p1_ & 0xffff0000u) + sc * o[d0][4 * a4 + 3]);
                  *(GAS v2u*)(orow + 32 * d0 + 8 * a4 + 4 * hi) = wv; } }
#undef NSA_FETCH
#undef NSA_COMMIT
    }
}

__device__ __forceinline__ f32x4 bf4(const v2u a) { return (f32x4){__uint_as_float(a.x << 16), __uint_as_float(a.x & 0xffff0000u), __uint_as_float(a.y << 16), __uint_as_float(a.y & 0xffff0000u)}; }
__device__ __forceinline__ void ln_rows(Frame& F, const bf16* tin, const float* gain, const float* bias, bf16* xb) {
    const int gw = F.vcu * NWAVES + F.wave, NGW = F.G * NWAVES, lane = F.lane;
    f32x4 gv[4], bv[4];
#pragma unroll
    for (int j = 0; j < 4; ++j) { gv[j] = *((const GAS f32x4*)gain + lane + 64 * j); bv[j] = *((const GAS f32x4*)bias + lane + 64 * j); }
    for (int m0 = gw; m0 < M; m0 += 8 * NGW) {
        v2u raw[8][4];
#pragma unroll
        for (int k = 0; k < 8; ++k) { const int m = m0 + k * NGW; if (m < M) { const GAS v2u* xr = (const GAS v2u*)(tin + (size_t)m * D) + lane;
#pragma unroll
            for (int j = 0; j < 4; ++j) raw[k][j] = xr[64 * j]; } }
#pragma unroll
        for (int k = 0; k < 8; ++k) { const int m = m0 + k * NGW; if (m >= M) break;
            f32x4 v[4]; float s = 0.f;
#pragma unroll
            for (int j = 0; j < 4; ++j) { v[j] = bf4(raw[k][j]); s += (v[j].x + v[j].y) + (v[j].z + v[j].w); }
            const float mean = wave_sum(s) * (1.f / D); float s2 = 0.f;
#pragma unroll
            for (int j = 0; j < 4; ++j) { v[j] = v[j] - mean; s2 += (v[j].x * v[j].x + v[j].y * v[j].y) + (v[j].z * v[j].z + v[j].w * v[j].w); }
            const float rstd = 1.f / sqrtf(wave_sum(s2) * (1.f / D) + LN_EPS);
            GAS unsigned long long* o8 = (GAS unsigned long long*)(xb + (size_t)m * D) + lane;
#pragma unroll
            for (int j = 0; j < 4; ++j) { const f32x4 y = v[j] * rstd * gv[j] + bv[j]; o8[64 * j] = (unsigned long long)pk2(y.x, y.y) | ((unsigned long long)pk2(y.z, y.w) << 32); }
        }
    }
}
namespace gla {
constexpr int ALS_OFF = 0, SEG_OFF = 4096, KH_OFF = 8192, KH_STR = 272, VH1_OFF = KH_OFF + 64 * KH_STR, VH_STR = 528, ZL_OFF = VH1_OFF + 64 * VH_STR, ZL_STR = 272;
constexpr int QS_OFF = 0, QS_STR = 272, AL_OFF = 64 * QS_STR, AL_STR = 144, VH3_OFF = AL_OFF + 64 * AL_STR, ST_OFF = VH3_OFF + 64 * VH_STR, ST_STR = 272, QT_OFF = ST_OFF, KT_OFF = ST_OFF + 64 * QS_STR, SSQ_OFF = ST_OFF + 256 * ST_STR;
constexpr int OL_OFF = ST_OFF, OL_STR = 1040;
static_assert(SSQ_OFF + 1024 <= RING_BYTES && ZL_OFF + 256 * ZL_STR <= RING_BYTES && KT_OFF + 64 * QS_STR <= SSQ_OFF && OL_OFF + 64 * OL_STR <= SSQ_OFF, "gla LDS map");
__device__ __forceinline__ bf16x8 trfrag(const LAS unsigned char* p, int rowstep4) { const v4i16 lo = vtr(p), hi4 = vtr(p + rowstep4); return (bf16x8){lo[0], lo[1], lo[2], lo[3], hi4[0], hi4[1], hi4[2], hi4[3]}; }
}
__device__ __forceinline__ void gla_load_v(LAS unsigned char* lds, int off, const bf16* qkvg, size_t m0, int vcol0, int tid) {
#pragma unroll
    for (int k = 0; k < 4; ++k) { const int q = tid + 512 * k, row = q >> 5, ch = q & 31;
        const v4u v = *(const GAS v4u*)(qkvg + (m0 + row) * 3072 + vcol0 + ch * 8); *(LAS v4u*)(lds + off + row * gla::VH_STR + ch * 16) = v; }
}
__device__ __forceinline__ void gla_g1(Frame& F) {
    using namespace gla;
    LAS unsigned char* lds = F.lds + RING_OFF; const int tid = F.tid, lane = F.lane, w = F.wave, hi = lane >> 5, qc = lane & 31;
    unsigned char* ws = F.ws; const bf16* qkvg = (const bf16*)(ws + WS_QKVG); const float* alow = (const float*)(ws + WS_ALOW);
    float* bcum = (float*)(ws + WS_BCUM); bf16* zb = (bf16*)(ws + WS_ZB); float* dec = (float*)(ws + WS_DEC);
    const float* wg2 = inptr(F, 16); const float* bg2 = inptr(F, 17);
    LAS float* ALS = (LAS float*)(lds + ALS_OFF); LAS float* SEG = (LAS float*)(lds + SEG_OFF);
    const int d = tid & 127, ig = tid >> 7;
    for (int un = F.wg; un < 1024; un += F.G) {
        const int bh = un >> 7, n = un & 127, b = bh >> 2, h = bh & 3; const size_t m0 = (size_t)b * T + 64 * n;
        __syncthreads();
        if (tid < 256) *(LAS f32x4*)(ALS + tid * 4) = *(const GAS f32x4*)(alow + m0 * 16 + tid * 4);
        gla_load_v(lds, VH1_OFF, qkvg, m0, 1024 + h * 256, tid);
        bf16 kraw[16];
#pragma unroll
        for (int ii = 0; ii < 16; ++ii) kraw[ii] = *(const GAS bf16*)(qkvg + (m0 + 16 * ig + ii) * 3072 + 512 + h * 128 + d);
        float wg[16];
#pragma unroll
        for (int r = 0; r < 16; ++r) wg[r] = wg2[r * 512 + h * 128 + d];
        const float bgv = bg2[h * 128 + d];
        __syncthreads();
        float cs[16]; float run = 0.f;
#pragma unroll
        for (int ii = 0; ii < 16; ++ii) { const int i = 16 * ig + ii; float z = bgv;
#pragma unroll
            for (int r = 0; r < 16; ++r) z += ALS[i * 16 + r] * wg[r];
            const float la = (fminf(z, 0.f) - __logf(1.f + __expf(-fabsf(z)))) * (1.f / 16.f);
            run += la; cs[ii] = run; }
        SEG[ig * 128 + d] = run;
        __syncthreads();
        float pre = 0.f, tot = 0.f;
#pragma unroll
        for (int k = 0; k < 4; ++k) { const float sv = SEG[k * 128 + d]; if (k < ig) pre += sv; tot += sv; }
#pragma unroll
        for (int ii = 0; ii < 16; ++ii) { const int i = 16 * ig + ii; cs[ii] += pre;
            *(LAS bf16*)(lds + KH_OFF + i * KH_STR + d * 2) = (bf16)f2bf(bf2f(kraw[ii]) * __expf(tot - cs[ii])); }
#pragma unroll
        for (int ii = 0; ii < 16; ++ii) *(GAS float*)(bcum + (m0 + 16 * ig + ii) * 512 + h * 128 + d) = cs[ii];
        if (ig == 0) dec[(size_t)(bh * 128 + n) * 128 + d] = __expf(tot);
        __syncthreads();
        f32x16 acc[4];
#pragma unroll
        for (int db = 0; db < 4; ++db)
#pragma unroll
            for (int r = 0; r < 16; ++r) acc[db][r] = 0.f;
        const int a = (lane >> 4) & 1, q_ = (lane & 15) >> 2, p_ = lane & 3;
#pragma unroll
        for (int s = 0; s < 4; ++s) {
            const bf16x8 bfr = trfrag(lds + VH1_OFF + (16 * s + 8 * hi + q_) * VH_STR + (32 * w + 16 * a + 4 * p_) * 2, 4 * VH_STR);
#pragma unroll
            for (int db = 0; db < 4; ++db) { const bf16x8 afr = trfrag(lds + KH_OFF + (16 * s + 8 * hi + q_) * KH_STR + (32 * db + 16 * a + 4 * p_) * 2, 4 * KH_STR);
                acc[db] = __builtin_amdgcn_mfma_f32_32x32x16_bf16(afr, bfr, acc[db], 0, 0, 0); }
        }
#pragma unroll
        for (int db = 0; db < 4; ++db)
#pragma unroll
            for (int a4 = 0; a4 < 4; ++a4) { v2u wv; wv.x = pg8::cvtpk_c(acc[db][4 * a4], acc[db][4 * a4 + 1]); wv.y = pg8::cvtpk_c(acc[db][4 * a4 + 2], acc[db][4 * a4 + 3]);
                *(LAS v2u*)(lds + ZL_OFF + (32 * w + qc) * ZL_STR + (32 * db + 8 * a4 + 4 * hi) * 2) = wv; }
        __syncthreads();
        { bf16* zu = zb + (size_t)(bh * 128 + n) * 256 * 128;
#pragma unroll
          for (int k = 0; k < 8; ++k) { const int q = tid + 512 * k, row = q >> 4, ch = q & 15; *(GAS v4u*)(zu + row * 128 + ch * 8) = *(const LAS v4u*)(lds + ZL_OFF + row * ZL_STR + ch * 16); } }
    }
}
__device__ __forceinline__ void gla_g2(Frame& F) {
    unsigned char* ws = F.ws; const bf16* zb = (const bf16*)(ws + WS_ZB); const float* dec = (const float*)(ws + WS_DEC); bf16* sst = (bf16*)(ws + WS_SST);
    for (int p = F.wg * 512 + F.tid; p < 131072; p += F.G * 512) {
        const int bh = p >> 14, e = (p >> 6) & 255, d2 = p & 63;
        float s0 = 0.f, s1 = 0.f;
        for (int n0 = 0; n0 < 128; n0 += 8) {
            pg8::f32x2 dv[8]; unsigned zz[8];
#pragma unroll
            for (int k = 0; k < 8; ++k) { const size_t cn = (size_t)(bh * 128 + n0 + k); dv[k] = *(const GAS pg8::f32x2*)(dec + cn * 128 + 2 * d2); zz[k] = *(const GAS unsigned*)(zb + (cn * 256 + e) * 128 + 2 * d2); }
#pragma unroll
            for (int k = 0; k < 8; ++k) { const size_t cn = (size_t)(bh * 128 + n0 + k);
                *(GAS unsigned*)(sst + (cn * 256 + e) * 128 + 2 * d2) = pk2(s0, s1);
                s0 = s0 * dv[k].x + __uint_as_float(zz[k] << 16); s1 = s1 * dv[k].y + __uint_as_float(zz[k] & 0xffff0000u); }
        }
    }
}
__device__ __forceinline__ void gla_g3(Frame& F) {
    using namespace gla;
    LAS unsigned char* lds = F.lds + RING_OFF; const int tid = F.tid, lane = F.lane, w = F.wave, hi = lane >> 5, qc = lane & 31;
    unsigned char* ws = F.ws; const bf16* qkvg = (const bf16*)(ws + WS_QKVG); const float* bcum = (const float*)(ws + WS_BCUM); const bf16* sst = (const bf16*)(ws + WS_SST);
    bf16* o1 = (bf16*)(ws + WS_O1); const float* hng = inptr(F, 18);
    LAS float* SSQ = (LAS float*)(lds + SSQ_OFF);
    const int d = tid & 127, ig = tid >> 7;
    const int a = (lane >> 4) & 1, q_ = (lane & 15) >> 2, p_ = lane & 3;
    for (int un = F.wg; un < 1024; un += F.G) {
        const int bh = un >> 7, n = un & 127, b = bh >> 2, h = bh & 3; const size_t m0 = (size_t)b * T + 64 * n;
        __syncthreads();
        gla_load_v(lds, VH3_OFF, qkvg, m0, 1024 + h * 256, tid);
        v4u sreg[8];
        { const bf16* sp = sst + (size_t)(bh * 128 + n) * 256 * 128;
#pragma unroll
          for (int k = 0; k < 8; ++k) { const int q = tid + 512 * k, row = q >> 4, ch = q & 15; sreg[k] = *(const GAS v4u*)(sp + row * 128 + ch * 8); } }
        { const float bref = bcum[(m0 + 32) * 512 + h * 128 + d];
          float bb[16]; bf16 qr[16], kr[16];
#pragma unroll
          for (int ii = 0; ii < 16; ++ii) { const size_t mi = m0 + 16 * ig + ii; bb[ii] = *(const GAS float*)(bcum + mi * 512 + h * 128 + d);
              qr[ii] = *(const GAS bf16*)(qkvg + mi * 3072 + h * 128 + d); kr[ii] = *(const GAS bf16*)(qkvg + mi * 3072 + 512 + h * 128 + d); }
#pragma unroll
          for (int ii = 0; ii < 16; ++ii) { const int i = 16 * ig + ii; const float qv = bf2f(qr[ii]), kv = bf2f(kr[ii]);
              *(LAS bf16*)(lds + QT_OFF + i * QS_STR + d * 2) = (bf16)f2bf(qv * __expf(bb[ii] - bref));
              *(LAS bf16*)(lds + KT_OFF + i * QS_STR + d * 2) = (bf16)f2bf(kv * __expf(bref - bb[ii]));
              *(LAS bf16*)(lds + QS_OFF + i * QS_STR + d * 2) = (bf16)f2bf(qv * __expf(bb[ii])); } }
        __syncthreads();
        if (w < 4) {
            const int jb = w >> 1, ib = w & 1; f32x16 acc;
#pragma unroll
            for (int r = 0; r < 16; ++r) acc[r] = 0.f;
#pragma unroll
            for (int s = 0; s < 8; ++s) { const bf16x8 afr = *(const LAS bf16x8*)(lds + KT_OFF + (32 * jb + qc) * QS_STR + 32 * s + 16 * hi), bfr = *(const LAS bf16x8*)(lds + QT_OFF + (32 * ib + qc) * QS_STR + 32 * s + 16 * hi);
                acc = __builtin_amdgcn_mfma_f32_32x32x16_bf16(afr, bfr, acc, 0, 0, 0); }
            const int i = 32 * ib + qc;
#pragma unroll
            for (int a4 = 0; a4 < 4; ++a4) { float v[4];
#pragma unroll
                for (int k = 0; k < 4; ++k) { const int j = 32 * jb + 8 * a4 + 4 * hi + k; v[k] = (j <= i) ? acc[4 * a4 + k] : 0.f; }
                v2u wv; wv.x = pg8::cvtpk_c(v[0], v[1]); wv.y = pg8::cvtpk_c(v[2], v[3]);
                *(LAS v2u*)(lds + AL_OFF + i * AL_STR + (32 * jb + 8 * a4 + 4 * hi) * 2) = wv; }
        }
        __syncthreads();
#pragma unroll
        for (int k = 0; k < 8; ++k) { const int q = tid + 512 * k, row = q >> 4, ch = q & 15; *(LAS v4u*)(lds + ST_OFF + row * ST_STR + ch * 16) = sreg[k]; }
        v4u ggr[4];
#pragma unroll
        for (int k = 0; k < 4; ++k) { const int q = tid + 512 * k, row = q >> 5, ch = q & 31; ggr[k] = *(const GAS v4u*)(qkvg + (m0 + row) * 3072 + 2048 + h * 256 + ch * 8); }
        __syncthreads();
        const int ib = w & 1, eq = w >> 1; f32x16 acc2[2];
#pragma unroll
        for (int r = 0; r < 16; ++r) { acc2[0][r] = 0.f; acc2[1][r] = 0.f; }
#pragma unroll
        for (int s = 0; s < 4; ++s) { const bf16x8 bfr = *(const LAS bf16x8*)(lds + AL_OFF + (32 * ib + qc) * AL_STR + 32 * s + 16 * hi);
#pragma unroll
            for (int e2 = 0; e2 < 2; ++e2) { const bf16x8 afr = trfrag(lds + VH3_OFF + (16 * s + 8 * hi + q_) * VH_STR + (32 * (2 * eq + e2) + 16 * a + 4 * p_) * 2, 4 * VH_STR);
                acc2[e2] = __builtin_amdgcn_mfma_f32_32x32x16_bf16(afr, bfr, acc2[e2], 0, 0, 0); } }
#pragma unroll
        for (int s = 0; s < 8; ++s) { const bf16x8 bfr = *(const LAS bf16x8*)(lds + QS_OFF + (32 * ib + qc) * QS_STR + 32 * s + 16 * hi);
#pragma unroll
            for (int e2 = 0; e2 < 2; ++e2) { const bf16x8 afr = *(const LAS bf16x8*)(lds + ST_OFF + (32 * (2 * eq + e2) + qc) * ST_STR + 32 * s + 16 * hi);
                acc2[e2] = __builtin_amdgcn_mfma_f32_32x32x16_bf16(afr, bfr, acc2[e2], 0, 0, 0); } }
        float ss = 0.f;
#pragma unroll
        for (int r = 0; r < 16; ++r) ss += acc2[0][r] * acc2[0][r] + acc2[1][r] * acc2[1][r];
        ss += __shfl_xor(ss, 32);
        const int i = 32 * ib + qc;
        if (hi == 0) SSQ[i * 4 + eq] = ss;
        __syncthreads();
#pragma unroll
        for (int e2 = 0; e2 < 2; ++e2)
#pragma unroll
            for (int a4 = 0; a4 < 4; ++a4) *(LAS f32x4*)(lds + OL_OFF + i * OL_STR + (32 * (2 * eq + e2) + 8 * a4 + 4 * hi) * 4) = (f32x4){acc2[e2][4 * a4], acc2[e2][4 * a4 + 1], acc2[e2][4 * a4 + 2], acc2[e2][4 * a4 + 3]};
        __syncthreads();
#pragma unroll
        for (int k = 0; k < 4; ++k) { const int q = tid + 512 * k, row = q >> 5, ch = q & 31;
            const float tot = (SSQ[row * 4 + 0] + SSQ[row * 4 + 1]) + (SSQ[row * 4 + 2] + SSQ[row * 4 + 3]); const float rstd = 1.f / sqrtf(tot * (1.f / 256.f) + RMS_EPS);
            const f32x4 oa = *(const LAS f32x4*)(lds + OL_OFF + row * OL_STR + ch * 32), ob = *(const LAS f32x4*)(lds + OL_OFF + row * OL_STR + ch * 32 + 16);
            const v4u gg = ggr[k];
            const f32x4 na = *(const GAS f32x4*)(hng + h * 256 + ch * 8), nb = *(const GAS f32x4*)(hng + h * 256 + ch * 8 + 4);
            const float g0 = __uint_as_float(gg.x << 16), g1 = __uint_as_float(gg.x & 0xffff0000u), g2 = __uint_as_float(gg.y << 16), g3 = __uint_as_float(gg.y & 0xffff0000u);
            const float g4 = __uint_as_float(gg.z << 16), g5 = __uint_as_float(gg.z & 0xffff0000u), g6 = __uint_as_float(gg.w << 16), g7 = __uint_as_float(gg.w & 0xffff0000u);
            v4u wv; wv.x = pg8::cvtpk_c(oa[0] * rstd * na[0] * pg8::silu1(g0), oa[1] * rstd * na[1] * pg8::silu1(g1)); wv.y = pg8::cvtpk_c(oa[2] * rstd * na[2] * pg8::silu1(g2), oa[3] * rstd * na[3] * pg8::silu1(g3));
            wv.z = pg8::cvtpk_c(ob[0] * rstd * nb[0] * pg8::silu1(g4), ob[1] * rstd * nb[1] * pg8::silu1(g5)); wv.w = pg8::cvtpk_c(ob[2] * rstd * nb[2] * pg8::silu1(g6), ob[3] * rstd * nb[3] * pg8::silu1(g7));
            *(GAS v4u*)(o1 + (m0 + row) * 1024 + h * 256 + ch * 8) = wv; }
    }
}
__device__ __forceinline__ void ln_router(Frame& F, const bf16* tin, const float* gain, const float* bias, bf16* xb) {
    LAS unsigned char* lds = F.lds + RING_OFF; const int lane = F.lane, w = F.wave;
    unsigned char* ws = F.ws; const float* wr = inptr(F, 22);
    int* toke = (int*)(ws + WS_TOKE); float* tokw = (float*)(ws + WS_TOKW); int* tokp = (int*)(ws + WS_TOKP); int* cntl = (int*)(ws + WS_CNTL);
    const int RPW = M / F.G, RPV = RPW / NWAVES;
    LAS int* EL = (LAS int*)lds;
    f32x4 gv[4], bv[4];
#pragma unroll
    for (int j = 0; j < 4; ++j) { gv[j] = *((const GAS f32x4*)gain + lane + 64 * j); bv[j] = *((const GAS f32x4*)bias + lane + 64 * j); }
    LAS float* WL = (LAS float*)(lds + 1024);
    __syncthreads();
    for (int c = F.tid; c < D; c += NWAVES * 64) { const f32x4 w0 = *(const GAS f32x4*)(wr + (size_t)c * 8), w1 = *(const GAS f32x4*)(wr + (size_t)c * 8 + 4);
        const int rec = (4 * (c >> 8) + (c & 3)) * 64 + ((c & 255) >> 2); *(LAS f32x4*)(WL + rec * 8) = w0; *(LAS f32x4*)(WL + rec * 8 + 4) = w1; }
    v2u raw[8][4];
#pragma unroll
    for (int rr = 0; rr < 8; ++rr) if (rr < RPV) { const GAS v2u* xr = (const GAS v2u*)(tin + (size_t)(F.wg * RPW + w * RPV + rr) * D) + lane;
#pragma unroll
        for (int j = 0; j < 4; ++j) raw[rr][j] = xr[64 * j]; }
    __syncthreads();
#pragma unroll
    for (int rr = 0; rr < 8; ++rr) { if (rr >= RPV) break;
        const int lr = w * RPV + rr, m = F.wg * RPW + lr;
        f32x4 v[4]; float s = 0.f;
#pragma unroll
        for (int j = 0; j < 4; ++j) { v[j] = bf4(raw[rr][j]); s += (v[j].x + v[j].y) + (v[j].z + v[j].w); }
        const float mean = wave_sum(s) * (1.f / D); float s2 = 0.f;
#pragma unroll
        for (int j = 0; j < 4; ++j) { v[j] = v[j] - mean; s2 += (v[j].x * v[j].x + v[j].y * v[j].y) + (v[j].z * v[j].z + v[j].w * v[j].w); }
        const float rstd = 1.f / sqrtf(wave_sum(s2) * (1.f / D) + LN_EPS);
        GAS unsigned long long* o8 = (GAS unsigned long long*)(xb + (size_t)m * D) + lane;
        float lg[8];
#pragma unroll
        for (int e = 0; e < 8; ++e) lg[e] = 0.f;
#pragma unroll
        for (int j = 0; j < 4; ++j) { const f32x4 y = v[j] * rstd * gv[j] + bv[j]; o8[64 * j] = (unsigned long long)pk2(y.x, y.y) | ((unsigned long long)pk2(y.z, y.w) << 32);
#pragma unroll
            for (int k = 0; k < 4; ++k) { const LAS float* rp = WL + ((4 * j + k) * 64 + lane) * 8; const f32x4 w0 = *(const LAS f32x4*)rp, w1 = *(const LAS f32x4*)(rp + 4);
                lg[0] += y[k] * w0[0]; lg[1] += y[k] * w0[1]; lg[2] += y[k] * w0[2]; lg[3] += y[k] * w0[3]; lg[4] += y[k] * w1[0]; lg[5] += y[k] * w1[1]; lg[6] += y[k] * w1[2]; lg[7] += y[k] * w1[3]; } }
#pragma unroll
        for (int e = 0; e < 8; ++e) lg[e] = wave_sum(lg[e]);
        int e1 = 0; float v1 = lg[0];
#pragma unroll
        for (int e = 1; e < 8; ++e) if (lg[e] > v1) { v1 = lg[e]; e1 = e; }
        int e2 = -1; float v2 = -3.4e38f;
#pragma unroll
        for (int e = 0; e < 8; ++e) if (e != e1 && lg[e] > v2) { v2 = lg[e]; e2 = e; }
        const float w2 = 1.f / (1.f + __expf(v1 - v2)), w1 = 1.f - w2;
        if (lane == 0) { toke[m * 2] = e1; toke[m * 2 + 1] = e2; tokw[m * 2] = w1; tokw[m * 2 + 1] = w2; EL[lr] = e1; EL[RPW + lr] = e2; }
    }
    __syncthreads();
    if (w == 0) {
        const bool act = lane < RPW; int base[8];
#pragma unroll
        for (int e = 0; e < 8; ++e) base[e] = 0;
        const unsigned long long ltm = (1ull << lane) - 1ull;
#pragma unroll
        for (int k = 0; k < 2; ++k) { const int ek = act ? EL[k * RPW + lane] : -1; int pos = 0;
#pragma unroll
            for (int e = 0; e < 8; ++e) { const unsigned long long mk = __ballot(ek == e); if (ek == e) pos = base[e] + __popcll(mk & ltm); base[e] += __popcll(mk); }
            if (act) tokp[(F.wg * RPW + lane) * 2 + k] = pos; }
        if (lane < 8) { int cv = 0;
#pragma unroll
            for (int e = 0; e < 8; ++e) if (lane == e) cv = base[e];
            cntl[F.wg * 8 + lane] = cv; }
    }
}
__device__ __forceinline__ void moe_tables(Frame& F) {
    LAS int* TP = (LAS int*)(F.lds + LDSCTL_OFF); LAS int* BASE = TP + 16; LAS int* ACC = TP + 32;
    const int* cntl = (const int*)(F.ws + WS_CNTL);
    __syncthreads();
    if (F.tid < 16) ACC[F.tid] = 0;
    __syncthreads();
    int tot = 0, pre = 0; const int e = F.tid & 7;
    for (int wq = F.tid >> 3; wq < F.G; wq += 64) { const int cv = __hip_atomic_load(cntl + wq * 8 + e, __ATOMIC_RELAXED, __HIP_MEMORY_SCOPE_AGENT); tot += cv; if (wq < F.wg) pre += cv; }
    __hip_atomic_fetch_add(ACC + e, tot, __ATOMIC_RELAXED, __HIP_MEMORY_SCOPE_WORKGROUP); __hip_atomic_fetch_add(ACC + 8 + e, pre, __ATOMIC_RELAXED, __HIP_MEMORY_SCOPE_WORKGROUP);
    __syncthreads();
    if (F.tid == 0) { int tp = 0;
        for (int k = 0; k < 8; ++k) { TP[k] = tp; BASE[k] = tp * 256 + ACC[8 + k]; tp += (ACC[k] + 255) >> 8; }
        TP[8] = tp; }
    __syncthreads();
}
__device__ __forceinline__ void moe_gather(Frame& F) {
    moe_tables(F);
    LAS int* BASE = (LAS int*)(F.lds + LDSCTL_OFF) + 16;
    unsigned char* ws = F.ws; const int* toke = (const int*)(ws + WS_TOKE); const int* tokp = (const int*)(ws + WS_TOKP); int* toks = (int*)(ws + WS_TOKS);
    const bf16* xb = (const bf16*)(ws + WS_XB); bf16* xg = (bf16*)(ws + WS_XG);
    const int RPW = M / F.G;
    for (int q0 = F.wave; q0 < 2 * RPW; q0 += 4 * NWAVES) {
        int mm[4], sl[4]; v4u ra[4], rb[4];
#pragma unroll
        for (int u = 0; u < 4; ++u) { const int q = q0 + u * NWAVES; const bool ok = q < 2 * RPW; const int m = F.wg * RPW + (q >> 1), k = q & 1; mm[u] = ok ? m * 2 + k : -1;
            const int e = ok ? toke[m * 2 + k] : 0; sl[u] = BASE[e] + (ok ? tokp[m * 2 + k] : 0); }
#pragma unroll
        for (int u = 0; u < 4; ++u) if (mm[u] >= 0) { const GAS v4u* src = (const GAS v4u*)(xb + (size_t)(mm[u] >> 1) * D) + F.lane; ra[u] = src[0]; rb[u] = src[64]; }
#pragma unroll
        for (int u = 0; u < 4; ++u) if (mm[u] >= 0) { if (F.lane == 0) toks[mm[u]] = sl[u]; GAS v4u* dst = (GAS v4u*)(xg + (size_t)sl[u] * D) + F.lane; dst[0] = ra[u]; dst[64] = rb[u]; }
    }
}
__device__ __forceinline__ void moe_final(Frame& F) {
    const int gw = F.vcu * NWAVES + F.wave, NGW = F.G * NWAVES, lane = F.lane;
    unsigned char* ws = F.ws; const bf16* xres = (const bf16*)(ws + WS_XB); const bf16* yb = (const bf16*)(ws + WS_YB); constexpr size_t KSTR = (WS_YB1 - WS_YB) / 2;
    const int* toks = (const int*)(ws + WS_TOKS); const float* tokw = (const float*)(ws + WS_TOKW); const float* gain = inptr(F, 25); const float* bias = inptr(F, 26);
    f32x4 gv[4], bv[4];
#pragma unroll
    for (int j = 0; j < 4; ++j) { gv[j] = *((const GAS f32x4*)gain + lane + 64 * j); bv[j] = *((const GAS f32x4*)bias + lane + 64 * j); }
    for (int m0 = gw; m0 < M; m0 += 4 * NGW) {
        int s1[4], s2[4]; float w1[4], w2[4];
#pragma unroll
        for (int k = 0; k < 4; ++k) { const int m = m0 + k * NGW; const bool ok = m < M; s1[k] = ok ? toks[m * 2] : 0; s2[k] = ok ? toks[m * 2 + 1] : 0; w1[k] = ok ? tokw[m * 2] : 0.f; w2[k] = ok ? tokw[m * 2 + 1] : 0.f; }
        v2u xr_[4][4], ya_[4][4], yc_[4][4];
#pragma unroll
        for (int k = 0; k < 4; ++k) { const int m = m0 + k * NGW; if (m < M) {
            const GAS v2u* xr = (const GAS v2u*)(xres + (size_t)m * D) + lane;
            const GAS v2u* y1 = (const GAS v2u*)(s1[k] < 32768 ? yb + (size_t)s1[k] * D : yb + KSTR + (size_t)(s1[k] - 32768) * D) + lane;
            const GAS v2u* y2 = (const GAS v2u*)(s2[k] < 32768 ? yb + (size_t)s2[k] * D : yb + KSTR + (size_t)(s2[k] - 32768) * D) + lane;
#pragma unroll
            for (int j = 0; j < 4; ++j) { xr_[k][j] = xr[64 * j]; ya_[k][j] = y1[64 * j]; yc_[k][j] = y2[64 * j]; } } }
#pragma unroll
        for (int k = 0; k < 4; ++k) { const int m = m0 + k * NGW; if (m >= M) break;
            f32x4 v[4], ya[4], yc[4];
#pragma unroll
            for (int j = 0; j < 4; ++j) { ya[j] = bf4(ya_[k][j]); yc[j] = bf4(yc_[k][j]); }
            if (s1[k] >= 32768) { for (int ks = 1; ks < 7; ++ks) { const GAS v2u* y1 = (const GAS v2u*)(yb + KSTR + ((size_t)ks * 2048 + (s1[k] - 32768)) * D) + lane;
#pragma unroll
                for (int j = 0; j < 4; ++j) ya[j] += bf4(y1[64 * j]); } }
            if (s2[k] >= 32768) { for (int ks = 1; ks < 7; ++ks) { const GAS v2u* y2 = (const GAS v2u*)(yb + KSTR + ((size_t)ks * 2048 + (s2[k] - 32768)) * D) + lane;
#pragma unroll
                for (int j = 0; j < 4; ++j) yc[j] += bf4(y2[64 * j]); } }
            float s = 0.f;
#pragma unroll
            for (int j = 0; j < 4; ++j) { const f32x4 x = bf4(xr_[k][j]); v[j] = x * ALPHA + (ya[j] * w1[k] + yc[j] * w2[k]); s += (v[j].x + v[j].y) + (v[j].z + v[j].w); }
            const float mean = wave_sum(s) * (1.f / D); float q2 = 0.f;
#pragma unroll
            for (int j = 0; j < 4; ++j) { v[j] = v[j] - mean; q2 += (v[j].x * v[j].x + v[j].y * v[j].y) + (v[j].z * v[j].z + v[j].w * v[j].w); }
            const float rstd = 1.f / sqrtf(wave_sum(q2) * (1.f / D) + LN_EPS);
            GAS f32x4* xo = (GAS f32x4*)(F.out + (size_t)m * D) + lane;
#pragma unroll
            for (int j = 0; j < 4; ++j) xo[64 * j] = v[j] * rstd * gv[j] + bv[j];
        }
    }
}
__global__ void __launch_bounds__(NWAVES * 64, 2) fwd(Args args) {
    extern __shared__ __attribute__((aligned(16))) unsigned char lds[];
    Frame F;
    F.A = &args;
    F.lds = (LAS unsigned char*)lds;
    F.MISC = (volatile LAS unsigned*)(F.lds + MISC_OFF);
    F.tid = threadIdx.x; F.lane = F.tid & 63; F.wave = __builtin_amdgcn_readfirstlane(F.tid >> 6);
    F.G = gridDim.x; F.wg = blockIdx.x; { const int bx = blockIdx.x; F.vcu = (F.G % 8 == 0) ? (bx % 8) * (F.G / 8) + bx / 8 : bx; }
    F.ws = args.ws; F.out = args.out;
    unsigned char* ws = args.ws;
    F.ctl = (gu32*)(ws + WS_CTL);
    for (int u = F.tid; u < (LDS_BYTES - LDSCTL_OFF) / 4; u += NWAVES * 64) ((LAS unsigned*)(F.lds + LDSCTL_OFF))[u] = 0u;
    __syncthreads();
    XcdBarrier bar; bar.bar = (unsigned*)(F.ctl + CW_BAR); bar.x = 0; bar.st = nullptr;
    if (!MK_PER_PHASE) bar = xcd_barrier_post((unsigned*)(F.ctl + CW_BAR), F.MISC + 8);
#define GRID_BAR() do { if (!MK_PER_PHASE) xcd_barrier(bar); } while (0)
    const int lo = args.ph_lo, hi = args.ph_hi;
#define IN(k) (lo <= (k) && (k) < hi)
#define SEAM(k) do { if (IN((k) + 1)) GRID_BAR(); } while (0)
    bf16* XB = (bf16*)(ws + WS_XB); bf16* T0 = (bf16*)(ws + WS_T0);
    const int cwg = (int)blockIdx.x;

#ifndef HANDOFF
#define HANDOFF 0
#endif
#ifndef PROBE_REP
#define PROBE_REP -1
#endif
#define REP(k) (PROBE_REP == (k) ? 2 : 1)
    if (IN(0)) { for (int rep = 0; rep < REP(0); ++rep) { if (rep) GRID_BAR(); p0_prologue(F); } SEAM(0); }
    if (IN(1)) { pg8::Gemm g{XB, (const bf16*)(ws + WS_WIN0), M, NSA_IN_PAD, D, D}; pg8::StaticOrder S; S.init(M, NSA_IN_PAD, F.G, cwg);
        pg8::EpiNsaIn E{(bf16*)(ws + WS_Q), (bf16*)(ws + WS_KV2), (bf16*)(ws + WS_KS), (bf16*)(ws + WS_VS), (bf16*)(ws + WS_KW), (bf16*)(ws + WS_VW), (float*)(ws + WS_GT), 0.125f * LOG2E};
        pg8::gemm_phase<pg8::EpiNsaIn, pg8::StaticOrder, PG8_ALIGN, PG8_SP2>(F.lds + RING_OFF, g, S, E); SEAM(1); }
    if (IN(2)) { pg8::Gemm g{(const bf16*)(ws + WS_KV2), (const bf16*)(ws + WS_W1C), 8192, 1024, 1024, 1024}; pg8::CmpOrder S{F.G, cwg}; pg8::EpiF32Cmp E{(float*)(ws + WS_UL)};
        pg8::gemm_phase<pg8::EpiF32Cmp, pg8::CmpOrder, PG8_ALIGN, PG8_SP2>(F.lds + RING_OFF, g, S, E);
        SEAM(2); }
    if (IN(3)) { cmp_finish(F); SEAM(3); }
    if (IN(4)) { for (int rep = 0; rep < REP(4); ++rep) { if (rep) GRID_BAR(); nsa_attn_phase(F); } SEAM(4); }
    if (IN(5)) { pg8::Gemm g{(const bf16*)(ws + WS_O), (const bf16*)(ws + WS_WO0), M, D, D, D}; pg8::StaticOrder S; S.init(M, D, F.G, cwg); pg8::EpiResBf16<false> E{inptr(F, 0), T0, ALPHA};
        pg8::gemm_phase<pg8::EpiResBf16<false>, pg8::StaticOrder, PG8_ALIGN, PG8_SP2>(F.lds + RING_OFF, g, S, E); SEAM(5); }
    if (IN(6)) { ln_rows(F, T0, inptr(F, 9), inptr(F, 10), XB); SEAM(6); }
#if HANDOFF
    if (IN(7)) { pg8::Gemm g{XB, (const bf16*)(ws + WS_WGU0), M, 2 * FF0, D, D}; pg8::PubOrder<pg8::StaticOrder> S; S.init(M, 2 * FF0, F.G, cwg); S.cnt = (unsigned*)(F.ctl + CW_PANEL0); S.pend = -1; pg8::EpiSwiGLU<true> E{(bf16*)(ws + WS_H0), FF0, 2 * FF0 / 256};
        pg8::gemm_phase<pg8::EpiSwiGLU<true>, pg8::PubOrder<pg8::StaticOrder>, PG8_ALIGN, PG8_SP2>(F.lds + RING_OFF, g, S, E); S.publish(); }
    if (IN(8)) { pg8::Gemm g{(const bf16*)(ws + WS_H0), (const bf16*)(ws + WS_WD0), M, D, FF0, FF0}; pg8::WaitOrder<pg8::StaticOrder> S; S.init(M, D, F.G, (cwg + F.G - (M / 256 * (2 * FF0 / 256)) % F.G) % F.G); S.ready = (const unsigned*)(F.ctl + CW_PANEL0); S.need = 8u * (2 * FF0 / 256); S.tmo = (unsigned*)(F.ctl + CW_TMO);
        pg8::EpiResBf16<true> E{XB, T0, ALPHA};
        pg8::gemm_phase<pg8::EpiResBf16<true>, pg8::WaitOrder<pg8::StaticOrder>, PG8_ALIGN, PG8_SP2>(F.lds + RING_OFF, g, S, E); SEAM(8); }
#else
    if (IN(7)) { for (int rep = 0; rep < REP(7); ++rep) { if (rep) GRID_BAR(); pg8::Gemm g{XB, (const bf16*)(ws + WS_WGU0), M, 2 * FF0, D, D}; pg8::StaticOrder S; S.init(M, 2 * FF0, F.G, cwg); pg8::EpiSwiGLU<false> E{(bf16*)(ws + WS_H0), FF0, 2 * FF0 / 256};
        pg8::gemm_phase<pg8::EpiSwiGLU<false>, pg8::StaticOrder, PG8_ALIGN, PG8_SP2>(F.lds + RING_OFF, g, S, E); } SEAM(7); }
    if (IN(8)) { for (int rep = 0; rep < REP(8); ++rep) { if (rep) GRID_BAR(); pg8::Gemm g{(const bf16*)(ws + WS_H0), (const bf16*)(ws + WS_WD0), M, D, FF0, FF0}; pg8::StaticOrder S; S.init(M, D, F.G, cwg); pg8::EpiResBf16<true> E{XB, T0, ALPHA};
        pg8::gemm_phase<pg8::EpiResBf16<true>, pg8::StaticOrder, PG8_ALIGN, PG8_SP2>(F.lds + RING_OFF, g, S, E); } SEAM(8); }
#endif
    if (IN(9)) { ln_rows(F, T0, inptr(F, 13), inptr(F, 14), XB); SEAM(9); }
    if (IN(10)) { pg8::Gemm g{XB, (const bf16*)(ws + WS_WIN1), M, GLA_IN_PAD, D, D}; pg8::StaticOrder S; S.init(M, GLA_IN_PAD, F.G, cwg); pg8::EpiGlaIn E{(bf16*)(ws + WS_QKVG), (float*)(ws + WS_ALOW), 0.08838834764831845f};
        pg8::gemm_phase<pg8::EpiGlaIn, pg8::StaticOrder, PG8_ALIGN, PG8_SP2>(F.lds + RING_OFF, g, S, E); SEAM(10); }
    for (int rep = 0; rep < REP(11); ++rep) { if (rep) GRID_BAR();
    if (IN(11)) { gla_g1(F); SEAM(11); }
    if (IN(12)) { gla_g2(F); SEAM(12); }
    if (IN(13)) { gla_g3(F); if (rep + 1 == REP(11)) SEAM(13); }
    }
    if (IN(14)) { pg8::Gemm g{(const bf16*)(ws + WS_O1), (const bf16*)(ws + WS_WO1), M, D, D, D}; pg8::StaticOrder S; S.init(M, D, F.G, cwg); pg8::EpiResBf16<true> E{XB, T0, ALPHA};
        pg8::gemm_phase<pg8::EpiResBf16<true>, pg8::StaticOrder, PG8_ALIGN, PG8_SP2>(F.lds + RING_OFF, g, S, E); SEAM(14); }
    if (IN(15)) { ln_router(F, T0, inptr(F, 20), inptr(F, 21), XB); SEAM(15); }
    if (IN(16)) { moe_gather(F); SEAM(16); }
#if 0
    if (IN(17)) { moe_tables(F); pg8::Gemm g{(const bf16*)(ws + WS_XG), (const bf16*)(ws + WS_WGU1), MAXSLOTS, NE * 2 * FFE, D, D};
        pg8::PubOrder<pg8::GroupedOrder> S; S.G = F.G; S.c = cwg; S.NT = 2 * FFE / 256; S.KS = 1; S.KL = 0; S.tp = (const PG8_LAS int*)(F.lds + LDSCTL_OFF); S.cnt = (unsigned*)(F.ctl + CW_PANEL1); S.pend = -1;
        pg8::EpiSwiGLU<true> E{(bf16*)(ws + WS_H2), FFE, 2 * FFE / 256};
        pg8::gemm_phase<pg8::EpiSwiGLU<true>, pg8::PubOrder<pg8::GroupedOrder>, PG8_ALIGN, PG8_SP2>(F.lds + RING_OFF, g, S, E); S.publish(); }
    if (IN(18)) { moe_tables(F); pg8::Gemm g{(const bf16*)(ws + WS_H2), (const bf16*)(ws + WS_WD1), MAXSLOTS, NE * D, FFE / MOE_KS, FFE};
        pg8::WaitOrder<pg8::GroupedOrder> S; S.G = F.G; S.NT = D / 256; S.KS = MOE_KS; S.KL = FFE / MOE_KS; S.tp = (const PG8_LAS int*)(F.lds + LDSCTL_OFF);
        { const int n17 = S.tp[8] * (2 * FFE / 256); S.c = (cwg + F.G - ((n17 % F.G) & ~7)) % F.G; }
        S.ready = (const unsigned*)(F.ctl + CW_PANEL1); S.need = 8u * (2 * FFE / 256); S.tmo = (unsigned*)(F.ctl + CW_TMO); pg8::EpiBf16Y E{(bf16*)(ws + WS_YB), (size_t)(WS_YB1 - WS_YB) / 2};
        pg8::gemm_phase<pg8::EpiBf16Y, pg8::WaitOrder<pg8::GroupedOrder>, PG8_ALIGN, PG8_SP2>(F.lds + RING_OFF, g, S, E); SEAM(18); }
#else
#ifndef STAGGER_US
#define STAGGER_US 0
#endif
    if (IN(17)) { for (int rep = 0; rep < REP(17); ++rep) { if (rep) GRID_BAR(); moe_tables(F);
        if (STAGGER_US) { const unsigned long long t0 = __builtin_amdgcn_s_memrealtime(), dl = (unsigned long long)((cwg >> 3) & 3) * (STAGGER_US * 100ull); while (__builtin_amdgcn_s_memrealtime() - t0 < dl) __builtin_amdgcn_s_sleep(8); }
        pg8::Gemm g{(const bf16*)(ws + WS_XG), (const bf16*)(ws + WS_WGU1), MAXSLOTS, NE * 2 * FFE, D, D};
        pg8::GroupedOrder S{F.G, cwg, 2 * FFE / 256, 1, 0, (const PG8_LAS int*)(F.lds + LDSCTL_OFF)}; pg8::EpiSwiGLU<false> E{(bf16*)(ws + WS_H2), FFE, 2 * FFE / 256};
        pg8::gemm_phase<pg8::EpiSwiGLU<false>, pg8::GroupedOrder, PG8_ALIGN, PG8_SP2>(F.lds + RING_OFF, g, S, E); } SEAM(17); }
    if (IN(18)) { for (int rep = 0; rep < REP(18); ++rep) { if (rep) GRID_BAR(); moe_tables(F);
        { pg8::Gemm g{(const bf16*)(ws + WS_H2), (const bf16*)(ws + WS_WD1), MAXSLOTS, NE * D, FFE, FFE}; pg8::MoeDownOrder S{F.G, cwg, 0, (const PG8_LAS int*)(F.lds + LDSCTL_OFF)};
          pg8::EpiBf16Y2 E{(bf16*)(ws + WS_YB), (bf16*)(ws + WS_YB1), 0}; pg8::gemm_phase<pg8::EpiBf16Y2, pg8::MoeDownOrder, PG8_ALIGN, PG8_SP2>(F.lds + RING_OFF, g, S, E); }
        { pg8::Gemm g{(const bf16*)(ws + WS_H2), (const bf16*)(ws + WS_WD1), MAXSLOTS, NE * D, 512, FFE}; pg8::MoeDownOrder S{F.G, cwg, 1, (const PG8_LAS int*)(F.lds + LDSCTL_OFF)};
          pg8::EpiBf16Y2 E{(bf16*)(ws + WS_YB), (bf16*)(ws + WS_YB1), 1}; pg8::gemm_phase<pg8::EpiBf16Y2, pg8::MoeDownOrder, PG8_ALIGN, PG8_SP2>(F.lds + RING_OFF, g, S, E); } } SEAM(18); }
#endif
    if (IN(19)) { moe_final(F); }
#undef IN
#undef SEAM
#undef GRID_BAR
}

extern "C" void kernel_launch(void* const* d_in, const int* in_sizes, int n_in, void* d_out, int out_size, void* d_ws, size_t ws_size, hipStream_t stream) {
    static int grid = 0;
    if (grid == 0) {
        if (n_in != 27 || in_sizes[0] != M * D || out_size != M * D || ws_size < WS_END) { fprintf(stderr, "kernel_launch: unexpected problem shape (n_in %d, in0 %d, out %d, ws %zu); nothing launched\n", n_in, n_in > 0 ? in_sizes[0] : -1, out_size, ws_size); grid = -1; return; }
        if (hipFuncSetAttribute((const void*)fwd, hipFuncAttributeMaxDynamicSharedMemorySize, LDS_BYTES) != hipSuccess) { fprintf(stderr, "kernel_launch: hipFuncSetAttribute failed\n"); grid = -1; return; }
        int dev = 0, cus = 0, per_cu = 0;
        (void)hipGetDevice(&dev); (void)hipDeviceGetAttribute(&cus, hipDeviceAttributeMultiprocessorCount, dev);
        if (hipOccupancyMaxActiveBlocksPerMultiprocessor(&per_cu, (const void*)fwd, NWAVES * 64, LDS_BYTES) != hipSuccess || per_cu < 1) fprintf(stderr, "kernel_launch: note: occupancy query reports %d workgroups per CU\n", per_cu);
        (void)hipGetLastError();
        grid = 256;
        if (cus < 256) fprintf(stderr, "kernel_launch: device has %d CUs; this kernel needs 256 resident workgroups\n", cus);
    }
    if (grid < 0) return;
    if (hipMemsetAsync((char*)d_ws + WS_CTL, 0, CTL_ZERO_BYTES, stream) != hipSuccess) { fprintf(stderr, "kernel_launch: hipMemsetAsync failed\n"); return; }
    Args a{};
    for (int i = 0; i < 27; ++i) a.in[i] = (const float*)d_in[i];
    a.out = (float*)d_out; a.ws = (unsigned char*)d_ws;
#if MK_PER_PHASE
    for (int p = 0; p < N_PHASES; ++p) { a.ph_lo = p; a.ph_hi = p + 1; hipLaunchKernelGGL(fwd, dim3(grid), dim3(NWAVES * 64), LDS_BYTES, stream, a); }
#else
    a.ph_lo = 0; a.ph_hi = N_PHASES;
    hipLaunchKernelGGL(fwd, dim3(grid), dim3(NWAVES * 64), LDS_BYTES, stream, a);
#endif
    const hipError_t le = hipPeekAtLastError();
    if (le != hipSuccess) fprintf(stderr, "kernel_launch: launch failed: %s\n", hipGetErrorName(le));
}
```

```cpp
#include <hip/hip_runtime.h>
#include <cstdio>
#include <cstdint>
namespace pg8 {
#define PG8_LAS __attribute__((address_space(3)))
typedef unsigned short bf16_t;
typedef short bf16x8 __attribute__((ext_vector_type(8)));
typedef float f32x4 __attribute__((ext_vector_type(4)));
typedef unsigned u32x4 __attribute__((ext_vector_type(4)));
constexpr int BM = 256, BK = 64, HALF = 128, HTB = HALF * BK * 2  , STAGE_BYTES = 8 * HTB, NXCD = 8, WGM = 8;

__host__ __device__ __forceinline__ int lds_byte(int r, int c) { const int st = (r >> 4) * 2 + (c >> 5), rr = r & 15, cc = c & 31, ob = rr * 64 + cc * 2; return st * 1024 + (ob ^ (((ob >> 9) & 1) << 5)); }
__host__ __device__ __forceinline__ void stage_rc(int b, int& R, int& C) { const int st = b / 1024, sb = b % 1024, swz = sb ^ (((sb >> 9) & 1) << 5); R = (st >> 1) * 16 + swz / 64; C = (st & 1) * 32 + (swz % 64) / 2; }
__host__ __device__ __forceinline__ int perm32(int rho) { const int n = rho >> 4, i = rho & 15; return 8 * (i >> 2) + 4 * n + (i & 3); }

struct Unit { int pm, pn, ko; };
struct Gemm { const bf16_t* A; const bf16_t* Bt; int M, N, K, ld; };

struct StaticOrder {
    int nM, nN, nwg, G, c;
    __host__ __device__ void init(int M, int N, int G_, int c_) { nM = M / BM; nN = N / BM; nwg = nM * nN; G = G_; c = c_; }
    __host__ __device__ bool next(int i, Unit& u) const {
        const long L = (long)i * G + c; if (L >= nwg) return false;
        int wgid = (int)L; { const int q = nwg / NXCD, r = nwg % NXCD, xcd = wgid % NXCD, off = wgid / NXCD; wgid = (xcd < r ? xcd * (q + 1) : r * (q + 1) + (xcd - r) * q) + off; }
        const int nig = WGM * nN, gid = wgid / nig, fm = gid * WGM, gsz = (nM - fm) < WGM ? (nM - fm) : WGM;
        u.pm = fm + ((wgid % nig) % gsz); u.pn = (wgid % nig) / gsz; u.ko = 0; return true;
    }
    __device__ __forceinline__ void a_ready(const Unit&) const {}
    __device__ __forceinline__ void done(const Unit&) const {}
};
__device__ __forceinline__ unsigned cvt_pk_bf16(float lo, float hi) { unsigned r; asm volatile("v_cvt_pk_bf16_f32 %0, %1, %2" : "=v"(r) : "v"(lo), "v"(hi)); return r; }
typedef float f32x2 __attribute__((ext_vector_type(2)));
typedef __bf16 bf16x2_t_ __attribute__((ext_vector_type(2)));
__device__ __forceinline__ unsigned cvtpk_c(float lo, float hi) { f32x2 v = {lo, hi}; bf16x2_t_ b = __builtin_convertvector(v, bf16x2_t_); return __builtin_bit_cast(unsigned, b); }
__device__ __forceinline__ u32x4 pack8(const f32x4 v0, const f32x4 v1) { u32x4 w; w.x = cvt_pk_bf16(v0[0], v0[1]); w.y = cvt_pk_bf16(v0[2], v0[3]); w.z = cvt_pk_bf16(v1[0], v1[1]); w.w = cvt_pk_bf16(v1[2], v1[3]); return w; }
__device__ __forceinline__ float sigm(float x) { return __builtin_amdgcn_rcpf(1.0f + __builtin_amdgcn_exp2f(-1.44269504088896341f * x)); }
__device__ __forceinline__ float silu1(float x) { return x * __builtin_amdgcn_rcpf(1.0f + __builtin_amdgcn_exp2f(-1.44269504088896341f * x)); }

struct EpiNsaIn {
    static constexpr bool PERM = true, AFTER_DRAIN = false;
    bf16_t *Q, *KV2, *KS, *VS, *KW, *VW; float* GT; float qscale;
    __device__ __forceinline__ void operator()(const f32x4 (&acc)[2][2][4][2], const Unit& u, int wr, int wc, int fr, int fq) const {
        const int pn = u.pn, row0 = u.pm * BM + wr * 64 + fr, c8 = wc * 32 + 8 * fq;
#pragma unroll
        for (int ai = 0; ai < 2; ++ai)
#pragma unroll
            for (int m = 0; m < 4; ++m) { const int row = row0 + ai * HALF + m * 16;
#pragma unroll
                for (int bj = 0; bj < 2; ++bj) { const int col = bj * HALF + c8;
                    f32x4 v0 = acc[ai][bj][m][0], v1 = acc[ai][bj][m][1];
                    if (pn >= 10) { if (col < 48) { float* gp = GT + (size_t)row * 48 + col;
                            *(f32x4*)gp = (f32x4){sigm(v0[0]), sigm(v0[1]), sigm(v0[2]), sigm(v0[3])}; *(f32x4*)(gp + 4) = (f32x4){sigm(v1[0]), sigm(v1[1]), sigm(v1[2]), sigm(v1[3])}; }
                        continue; }
                    bf16_t* dst;
                    if (pn < 4) { v0 = v0 * qscale; v1 = v1 * qscale; dst = Q + (size_t)row * 1024 + pn * 256 + col; }
                    else if (pn < 6) { const int g = col >> 6, d = col & 63; dst = KV2 + (size_t)(pn - 4) * (4096 * 1024) + ((size_t)(((row >> 4) * 4 + g) * 16 + (row & 15))) * 64 + d; }
                    else { bf16_t* base = pn == 6 ? KS : pn == 7 ? VS : pn == 8 ? KW : VW; dst = base + (size_t)row * 256 + col; }
                    *(u32x4*)dst = pack8(v0, v1); } }
    }
};
struct EpiGlaIn {
    static constexpr bool PERM = true, AFTER_DRAIN = false;
    bf16_t* QKVG; float* ALOW; float qscale;
    __device__ __forceinline__ void operator()(const f32x4 (&acc)[2][2][4][2], const Unit& u, int wr, int wc, int fr, int fq) const {
        const int pn = u.pn, row0 = u.pm * BM + wr * 64 + fr, c8 = wc * 32 + 8 * fq;
#pragma unroll
        for (int ai = 0; ai < 2; ++ai)
#pragma unroll
            for (int m = 0; m < 4; ++m) { const int row = row0 + ai * HALF + m * 16;
#pragma unroll
                for (int bj = 0; bj < 2; ++bj) { const int col = bj * HALF + c8;
                    f32x4 v0 = acc[ai][bj][m][0], v1 = acc[ai][bj][m][1];
                    if (pn >= 12) { if (col < 16) { float* gp = ALOW + (size_t)row * 16 + col; *(f32x4*)gp = v0; *(f32x4*)(gp + 4) = v1; } continue; }
                    if (pn < 2) { v0 = v0 * qscale; v1 = v1 * qscale; }
                    *(u32x4*)(QKVG + (size_t)row * 3072 + pn * 256 + col) = pack8(v0, v1); } }
    }
};
struct EpiF32Cmp {
    static constexpr bool PERM = false, AFTER_DRAIN = false;
    float* C;
    __device__ __forceinline__ void operator()(const f32x4 (&acc)[2][2][4][2], const Unit& u, int wr, int wc, int fr, int fq) const {
        const int row0 = u.pm * BM + wr * 64 + fr, col0 = (u.pn & 1) * BM + wc * 32 + 4 * fq;
#pragma unroll
        for (int ai = 0; ai < 2; ++ai)
#pragma unroll
            for (int m = 0; m < 4; ++m) { float* rowp = C + (size_t)(row0 + ai * HALF + m * 16) * 512 + col0;
#pragma unroll
                for (int bj = 0; bj < 2; ++bj)
#pragma unroll
                    for (int n = 0; n < 2; ++n) *(f32x4*)(rowp + bj * HALF + n * 16) = acc[ai][bj][m][n]; }
    }
};
struct EpiResF32 {
    static constexpr bool PERM = false, AFTER_DRAIN = false;
    const float* base; float* out; float alpha;
    __device__ __forceinline__ void operator()(const f32x4 (&acc)[2][2][4][2], const Unit& u, int wr, int wc, int fr, int fq) const {
        const int row0 = u.pm * BM + wr * 64 + fr, col0 = u.pn * BM + wc * 32 + 4 * fq;
#pragma unroll
        for (int ai = 0; ai < 2; ++ai)
#pragma unroll
            for (int m = 0; m < 4; ++m) { const size_t off = (size_t)(row0 + ai * HALF + m * 16) * 1024 + col0;
#pragma unroll
                for (int bj = 0; bj < 2; ++bj)
#pragma unroll
                    for (int n = 0; n < 2; ++n) { const f32x4 bs = *(const f32x4*)(base + off + bj * HALF + n * 16); *(f32x4*)(out + off + bj * HALF + n * 16) = bs * alpha + acc[ai][bj][m][n]; } }
    }
};
template <bool BF> struct EpiResBf16 {
    static constexpr bool PERM = true, AFTER_DRAIN = false;
    const void* base; bf16_t* out; float alpha;
    __device__ __forceinline__ void operator()(const f32x4 (&acc)[2][2][4][2], const Unit& u, int wr, int wc, int fr, int fq) const {
        const int row0 = u.pm * BM + wr * 64 + fr, col0 = u.pn * BM + wc * 32 + 8 * fq;
#pragma unroll
        for (int ai = 0; ai < 2; ++ai)
#pragma unroll
            for (int m = 0; m < 4; ++m) { const size_t off = (size_t)(row0 + ai * HALF + m * 16) * 1024 + col0;
#pragma unroll
                for (int bj = 0; bj < 2; ++bj) { f32x4 b0, b1;
                    if (BF) { const u32x4 r = *(const u32x4*)((const bf16_t*)base + off + bj * HALF);
                        b0 = (f32x4){__uint_as_float(r.x << 16), __uint_as_float(r.x & 0xffff0000u), __uint_as_float(r.y << 16), __uint_as_float(r.y & 0xffff0000u)};
                        b1 = (f32x4){__uint_as_float(r.z << 16), __uint_as_float(r.z & 0xffff0000u), __uint_as_float(r.w << 16), __uint_as_float(r.w & 0xffff0000u)}; }
                    else { b0 = *(const f32x4*)((const float*)base + off + bj * HALF); b1 = *(const f32x4*)((const float*)base + off + bj * HALF + 4); }
                    *(u32x4*)(out + off + bj * HALF) = pack8(b0 * alpha + acc[ai][bj][m][0], b1 * alpha + acc[ai][bj][m][1]); } }
    }
};
__device__ __forceinline__ void store16_sc1(bf16_t* p, const u32x4 v) { asm volatile("global_store_dwordx4 %0, %1, off sc1\n\ts_nop 1" :: "v"(p), "v"(v) : "memory"); }
template <bool SC1> struct EpiSwiGLU {
    static constexpr bool PERM = true, AFTER_DRAIN = false;
    bf16_t* H; int ldh, nt;
    __device__ __forceinline__ void operator()(const f32x4 (&acc)[2][2][4][2], const Unit& u, int wr, int wc, int fr, int fq) const {
        const int row0 = u.pm * BM + wr * 64 + fr, col = (u.pn % nt) * HALF + wc * 32 + 8 * fq;
#pragma unroll
        for (int ai = 0; ai < 2; ++ai)
#pragma unroll
            for (int m = 0; m < 4; ++m) { const f32x4 a0 = acc[ai][0][m][0], a1 = acc[ai][0][m][1], b0 = acc[ai][1][m][0], b1 = acc[ai][1][m][1];
                const f32x4 h0 = (f32x4){silu1(a0[0]) * b0[0], silu1(a0[1]) * b0[1], silu1(a0[2]) * b0[2], silu1(a0[3]) * b0[3]};
                const f32x4 h1 = (f32x4){silu1(a1[0]) * b1[0], silu1(a1[1]) * b1[1], silu1(a1[2]) * b1[2], silu1(a1[3]) * b1[3]};
                bf16_t* dst = H + (size_t)(row0 + ai * HALF + m * 16) * ldh + col;
                if (SC1) store16_sc1(dst, pack8(h0, h1)); else *(u32x4*)dst = pack8(h0, h1); }
    }
};
struct EpiBf16Y {
    static constexpr bool PERM = true, AFTER_DRAIN = false;
    bf16_t* Y; size_t kstride;
    __device__ __forceinline__ void operator()(const f32x4 (&acc)[2][2][4][2], const Unit& u, int wr, int wc, int fr, int fq) const {
        const int row0 = u.pm * BM + wr * 64 + fr, col0 = (u.pn & 3) * BM + wc * 32 + 8 * fq;
#pragma unroll
        for (int ai = 0; ai < 2; ++ai)
#pragma unroll
            for (int m = 0; m < 4; ++m) { bf16_t* rowp = Y + (u.ko ? kstride : (size_t)0) + (size_t)(row0 + ai * HALF + m * 16) * 1024 + col0;
#pragma unroll
                for (int bj = 0; bj < 2; ++bj) *(u32x4*)(rowp + bj * HALF) = pack8(acc[ai][bj][m][0], acc[ai][bj][m][1]); }
    }
};
struct CmpOrder {
    int G, c;
    __device__ __forceinline__ bool next(int i, Unit& u) const { const long L = (long)i * G + c; if (L >= 64) return false; const int pm = (int)L >> 1; u.pm = pm; u.pn = (pm >> 4) * 2 + ((int)L & 1); u.ko = 0; return true; }
    __device__ __forceinline__ void a_ready(const Unit&) const {}
    __device__ __forceinline__ void done(const Unit&) const {}
};
struct GroupedOrder {
    int G, c, NT, KS, KL; const PG8_LAS int* tp;
    __device__ __forceinline__ bool next(int i, Unit& u) const {
        const int nwg = tp[8] * NT * KS; const long L = (long)i * G + c; if (L >= nwg) return false;
        int wgid = (int)L; { const int q = nwg / NXCD, r = nwg % NXCD, xcd = wgid % NXCD, off = wgid / NXCD; wgid = (xcd < r ? xcd * (q + 1) : r * (q + 1) + (xcd - r) * q) + off; }
        const int ks = wgid % KS; wgid /= KS;
        int e = 0;
#pragma unroll
        for (int k = 1; k < 8; ++k) if (wgid >= tp[k] * NT) e = k;
        const int t0 = tp[e], nte = tp[e + 1] - t0, l = wgid - t0 * NT, nig = WGM * NT, gid = l / nig, fm = gid * WGM, gsz = (nte - fm) < WGM ? (nte - fm) : WGM;
        u.pm = t0 + fm + ((l % nig) % gsz); u.pn = e * NT + (l % nig) / gsz; u.ko = ks * KL; return true;
    }
    __device__ __forceinline__ void a_ready(const Unit&) const {}
    __device__ __forceinline__ void done(const Unit&) const {}
};
template <class Base> struct PubOrder : Base {
    unsigned* cnt; mutable int pend;
    __device__ __forceinline__ void publish() const { if (pend >= 0) { if ((threadIdx.x & 63) == 0) __hip_atomic_fetch_add(cnt + 64 * pend, 1u, __ATOMIC_RELAXED, __HIP_MEMORY_SCOPE_AGENT); pend = -1; } }
    __device__ __forceinline__ void a_ready(const Unit&) const { publish(); }
#if defined(PUB_DRAIN) && PUB_DRAIN
    __device__ __forceinline__ void done(const Unit& u) const { asm volatile("s_waitcnt vmcnt(0)" ::: "memory"); pend = u.pm; publish(); }
#else
    __device__ __forceinline__ void done(const Unit& u) const { publish(); pend = u.pm; }
#endif
};
template <class Base> struct WaitOrder : Base {
    const unsigned* ready; unsigned need; unsigned* tmo;
    __device__ __forceinline__ void a_ready(const Unit& u) const {
        if (threadIdx.x < 64) {
            const unsigned long long t0 = __builtin_amdgcn_s_memrealtime(); unsigned polls = 0;
            while ((unsigned)__builtin_amdgcn_readfirstlane(__hip_atomic_load(ready + 64 * u.pm, __ATOMIC_RELAXED, __HIP_MEMORY_SCOPE_AGENT)) < need) {
                if ((++polls & 255u) == 0u && __builtin_amdgcn_readfirstlane(__hip_atomic_load(tmo, __ATOMIC_RELAXED, __HIP_MEMORY_SCOPE_AGENT)) != 0u) break;
                if (__builtin_amdgcn_s_memrealtime() - t0 > 2000000ull) {
                    if (threadIdx.x == 0) { unsigned expect = 0u; __hip_atomic_compare_exchange_strong(tmo + 1, &expect, 0x600u | (unsigned)(u.pm & 0xff), __ATOMIC_RELAXED, __ATOMIC_RELAXED, __HIP_MEMORY_SCOPE_AGENT); __hip_atomic_store(tmo, 1u, __ATOMIC_RELAXED, __HIP_MEMORY_SCOPE_AGENT); }
                    break; }
                __builtin_amdgcn_s_sleep(2); }
            __builtin_amdgcn_fence(__ATOMIC_ACQUIRE, "agent");
            asm volatile("s_waitcnt vmcnt(0)" ::: "memory");
        }
        asm volatile("" ::: "memory"); __builtin_amdgcn_s_barrier(); asm volatile("" ::: "memory");
    }
};
struct MoeDownOrder {
    int G, c, rem; const PG8_LAS int* tp;
    __device__ __forceinline__ int expert_of(int tile) const { int e = 0;
#pragma unroll
        for (int k = 1; k < 8; ++k) if (tile >= tp[k]) e = k;
        return e; }
    __device__ __forceinline__ bool next(int i, Unit& u) const {
        const long L = (long)i * G + c;
        if (!rem) { if (L >= 512) return false;
            int wgid = (int)L; { const int xcd = wgid % NXCD, off = wgid / NXCD; wgid = xcd * 64 + off; }
            const int grp = wgid >> 5, in = wgid & 31; const int tile = grp * 8 + (in & 7), pnl = in >> 3;
            u.pm = tile; u.pn = expert_of(tile) * 4 + pnl; u.ko = 0; return true; }
        const int nrem = tp[8] - 128; if (L >= (long)nrem * 28) return false;
        const int l2 = (int)L, ks = l2 % 7, r = l2 / 7, tile = 128 + (r >> 2);
        u.pm = tile; u.pn = expert_of(tile) * 4 + (r & 3); u.ko = ks * 512; return true;
    }
    __device__ __forceinline__ void a_ready(const Unit&) const {}
    __device__ __forceinline__ void done(const Unit&) const {}
};
struct EpiBf16Y2 {
    static constexpr bool PERM = true, AFTER_DRAIN = false;
    bf16_t* Y; bf16_t* YP; int rem;
    __device__ __forceinline__ void operator()(const f32x4 (&acc)[2][2][4][2], const Unit& u, int wr, int wc, int fr, int fq) const {
        const int row0 = u.pm * BM + wr * 64 + fr, col0 = (u.pn & 3) * BM + wc * 32 + 8 * fq;
        bf16_t* base = rem ? YP + (size_t)(u.ko >> 9) * (2048 * 1024) + (size_t)(row0 - 128 * BM) * 1024 : Y + (size_t)row0 * 1024;
#pragma unroll
        for (int ai = 0; ai < 2; ++ai)
#pragma unroll
            for (int m = 0; m < 4; ++m) { bf16_t* rowp = base + (size_t)(ai * HALF + m * 16) * 1024 + col0;
#pragma unroll
                for (int bj = 0; bj < 2; ++bj) *(u32x4*)(rowp + bj * HALF) = pack8(acc[ai][bj][m][0], acc[ai][bj][m][1]); }
    }
};
template <class Epi, class Sched, bool ALIGN_EPI = false, bool SP2 = false>
__device__ __forceinline__ void gemm_phase(PG8_LAS unsigned char* lds, const Gemm g, const Sched& S, const Epi& E) {
    const int tid = threadIdx.x, wid = __builtin_amdgcn_readfirstlane(tid >> 6), lane = tid & 63, wr = wid >> 2, wc = wid & 3, fr = lane & 15, fq = lane >> 4;
    const int K = g.ld, nt = g.K / BK;
    unsigned voffA[2], voffB[2];
#pragma unroll
    for (int i = 0; i < 2; ++i) { int R, C; stage_rc(tid * 16 + i * 8192, R, C); const int Rb = Epi::PERM ? ((R & ~31) + perm32(R & 31)) : R;
        voffA[i] = (unsigned)(R * K + C) * 2u; voffB[i] = (unsigned)(Rb * K + C) * 2u; }
    const size_t kstep = (size_t)(BK * 2);
    const size_t hstep = (size_t)HALF * K * 2;
    const size_t tstep = 2 * hstep;
    const unsigned ldsw = (unsigned)wid * 1024u;
    const int aoff = lds_byte(wr * 64 + fr, fq * 8), boff = lds_byte(wc * 32 + fr, fq * 8);
#define PG8_SA(b, h) (((b) * 2 + (h)) * HTB)
#define PG8_SB(b, h) ((4 + (b) * 2 + (h)) * HTB)
#define PG8_STAGE(bufoff, gbase, voff) do { _Pragma("unroll") for (int _i = 0; _i < 2; ++_i) \
        __builtin_amdgcn_global_load_lds((const unsigned*)((const char*)(gbase) + (voff)[_i]), (PG8_LAS unsigned*)(lds + (bufoff) + ldsw + _i * 8192), 16, 0, 0); } while (0)
#define PG8_LDA(dst, b, h) do { _Pragma("unroll") for (int m = 0; m < 4; ++m) _Pragma("unroll") for (int k = 0; k < 2; ++k) dst[m][k] = *(const PG8_LAS bf16x8*)(lds + PG8_SA(b, h) + aoff + m * 2048 + k * 1024); } while (0)
#define PG8_LDB(dst, b, h) do { _Pragma("unroll") for (int n = 0; n < 2; ++n) _Pragma("unroll") for (int k = 0; k < 2; ++k) dst[n][k] = *(const PG8_LAS bf16x8*)(lds + PG8_SB(b, h) + boff + n * 2048 + k * 1024); } while (0)
#define PG8_MMA(ai, bj, At, Bt) do { __builtin_amdgcn_s_setprio(1); _Pragma("unroll") for (int m = 0; m < 4; ++m) _Pragma("unroll") for (int n = 0; n < 2; ++n) _Pragma("unroll") for (int k = 0; k < 2; ++k) \
        acc[ai][bj][m][n] = __builtin_amdgcn_mfma_f32_16x16x32_bf16(Bt[n][k], At[m][k], acc[ai][bj][m][n], 0, 0, 0); __builtin_amdgcn_s_setprio(0); } while (0)
#define PG8_WAIT_V(n) asm volatile("s_waitcnt vmcnt(" #n ")" ::: "memory")
#define PG8_WAIT_L(n) asm volatile("s_waitcnt lgkmcnt(" #n ")" ::: "memory")
#define PG8_BAR __builtin_amdgcn_s_barrier()
#define PG8_SCHED __builtin_amdgcn_sched_barrier(0)
    Unit cur, nxt; int ui = 0;
    if (!S.next(0, cur)) return;
    f32x4 acc[2][2][4][2];
#pragma unroll
    for (int a = 0; a < 2; ++a)
#pragma unroll
        for (int b = 0; b < 2; ++b)
#pragma unroll
            for (int m = 0; m < 4; ++m)
#pragma unroll
                for (int n = 0; n < 2; ++n) acc[a][b][m][n] = (f32x4){0.f, 0.f, 0.f, 0.f};
    bf16x8 At[4][2], B0[2][2], B1[2][2];
    const char* cA = (const char*)g.A + (size_t)cur.pm * tstep + (size_t)cur.ko * 2; const char* cB = (const char*)g.Bt + (size_t)cur.pn * tstep + (size_t)cur.ko * 2;
    S.a_ready(cur);
    if constexpr (SP2) {
        PG8_STAGE(PG8_SB(0, 0), cB, voffB); PG8_STAGE(PG8_SB(0, 1), cB + hstep, voffB); PG8_STAGE(PG8_SA(0, 0), cA, voffA); PG8_STAGE(PG8_SA(0, 1), cA + hstep, voffA);
        if (wr == 1) PG8_BAR;
        PG8_WAIT_V(2); PG8_BAR;
        PG8_STAGE(PG8_SB(1, 0), cB + kstep, voffB); PG8_STAGE(PG8_SA(1, 0), cA + kstep, voffA); PG8_STAGE(PG8_SB(1, 1), cB + hstep + kstep, voffB);
        PG8_WAIT_V(6); PG8_BAR;
    } else {
        PG8_STAGE(PG8_SB(0, 0), cB, voffB); PG8_STAGE(PG8_SA(0, 0), cA, voffA); PG8_STAGE(PG8_SB(0, 1), cB + hstep, voffB); PG8_STAGE(PG8_SA(0, 1), cA + hstep, voffA);
        if (wr == 1) PG8_BAR;
        PG8_WAIT_V(4); PG8_BAR;
        PG8_STAGE(PG8_SB(1, 0), cB + kstep, voffB); PG8_STAGE(PG8_SA(1, 0), cA + kstep, voffA); PG8_STAGE(PG8_SB(1, 1), cB + hstep + kstep, voffB);
        PG8_WAIT_V(6); PG8_BAR;
    }
    for (;;) {
        const bool has_next = S.next(ui + 1, nxt);
        const char* nA = has_next ? (const char*)g.A + (size_t)nxt.pm * tstep + (size_t)nxt.ko * 2 : cA; const char* nB = has_next ? (const char*)g.Bt + (size_t)nxt.pn * tstep + (size_t)nxt.ko * 2 : cB;
        for (int t = 0; t < nt; t += 2) {
            const bool last = (t == nt - 2);
            const char* a1 = cA + (size_t)(t + 1) * kstep;
            const char* a2 = last ? nA : cA + (size_t)(t + 2) * kstep; const char* b2 = last ? nB : cB + (size_t)(t + 2) * kstep;
            const char* a3 = a2 + kstep; const char* b3 = b2 + kstep;
            if (last && has_next) S.a_ready(nxt);
            if constexpr (SP2) {
            PG8_LDB(B0, 0, 0); PG8_LDB(B1, 0, 1); PG8_SCHED; PG8_LDA(At, 0, 0); PG8_STAGE(PG8_SA(1, 1), a1 + hstep, voffA);
            PG8_WAIT_V(8); PG8_WAIT_L(0); PG8_BAR; PG8_MMA(0, 0, At, B0); PG8_MMA(0, 1, At, B1); PG8_BAR; PG8_SCHED;
            PG8_LDA(At, 0, 1); PG8_STAGE(PG8_SB(0, 0), b2, voffB); PG8_STAGE(PG8_SB(0, 1), b2 + hstep, voffB); PG8_STAGE(PG8_SA(0, 0), a2, voffA);
            PG8_WAIT_V(8); PG8_WAIT_L(0); PG8_BAR; PG8_MMA(1, 0, At, B0); PG8_MMA(1, 1, At, B1); PG8_BAR; PG8_SCHED;
            PG8_LDB(B0, 1, 0); PG8_LDB(B1, 1, 1); PG8_SCHED; PG8_LDA(At, 1, 0); PG8_STAGE(PG8_SA(0, 1), a2 + hstep, voffA);
            PG8_WAIT_V(8); PG8_WAIT_L(0); PG8_BAR; PG8_MMA(0, 0, At, B0); PG8_MMA(0, 1, At, B1); PG8_BAR; PG8_SCHED;
            PG8_LDA(At, 1, 1); PG8_STAGE(PG8_SB(1, 0), b3, voffB); PG8_STAGE(PG8_SB(1, 1), b3 + hstep, voffB); PG8_STAGE(PG8_SA(1, 0), a3, voffA);
            PG8_WAIT_V(8); PG8_WAIT_L(0); PG8_BAR; PG8_MMA(1, 0, At, B0); PG8_MMA(1, 1, At, B1); PG8_BAR; PG8_SCHED;
            } else {
            PG8_LDB(B0, 0, 0); PG8_SCHED; PG8_LDA(At, 0, 0); PG8_STAGE(PG8_SA(1, 1), a1 + hstep, voffA);
            PG8_WAIT_L(8); PG8_BAR; PG8_WAIT_L(0); PG8_MMA(0, 0, At, B0); PG8_BAR; PG8_SCHED;
            PG8_LDB(B1, 0, 1); PG8_STAGE(PG8_SB(0, 0), b2, voffB);
            PG8_BAR; PG8_WAIT_L(0); PG8_MMA(0, 1, At, B1); PG8_BAR;
            PG8_LDA(At, 0, 1); PG8_STAGE(PG8_SA(0, 0), a2, voffA);
            PG8_BAR; PG8_WAIT_L(0); PG8_MMA(1, 0, At, B0); PG8_BAR; PG8_SCHED;
            PG8_STAGE(PG8_SB(0, 1), b2 + hstep, voffB);
            PG8_WAIT_V(6); PG8_BAR; PG8_MMA(1, 1, At, B1); PG8_BAR;
            PG8_LDB(B0, 1, 0); PG8_SCHED; PG8_LDA(At, 1, 0); PG8_STAGE(PG8_SA(0, 1), a2 + hstep, voffA);
            PG8_WAIT_L(8); PG8_BAR; PG8_WAIT_L(0); PG8_MMA(0, 0, At, B0); PG8_BAR; PG8_SCHED;
            PG8_LDB(B1, 1, 1); PG8_STAGE(PG8_SB(1, 0), b3, voffB);
            PG8_BAR; PG8_WAIT_L(0); PG8_MMA(0, 1, At, B1); PG8_BAR;
            PG8_LDA(At, 1, 1); PG8_STAGE(PG8_SA(1, 0), a3, voffA);
            PG8_BAR; PG8_WAIT_L(0); PG8_MMA(1, 0, At, B0); PG8_BAR; PG8_SCHED;
            PG8_STAGE(PG8_SB(1, 1), b3 + hstep, voffB);
            PG8_WAIT_V(6); PG8_BAR; PG8_MMA(1, 1, At, B1); PG8_BAR;
            }
        }
        if constexpr (ALIGN_EPI) { if (wr == 0) PG8_BAR; }
        if constexpr (!Epi::AFTER_DRAIN) { E(acc, cur, wr, wc, fr, fq); S.done(cur); }
        if (!has_next) break;
#pragma unroll
        for (int a = 0; a < 2; ++a)
#pragma unroll
            for (int b = 0; b < 2; ++b)
#pragma unroll
                for (int m = 0; m < 4; ++m)
#pragma unroll
                    for (int n = 0; n < 2; ++n) acc[a][b][m][n] = (f32x4){0.f, 0.f, 0.f, 0.f};
        cur = nxt; cA = nA; cB = nB; ++ui;
        if constexpr (ALIGN_EPI) { if (wr == 1) PG8_BAR; }
    }
    PG8_WAIT_V(0);
    if constexpr (!ALIGN_EPI) { if (wr == 0) PG8_BAR; }
    PG8_BAR;
    if constexpr (Epi::AFTER_DRAIN) { E.fused(acc, cur, wr, wc, fr, fq, lds, wid, lane); S.done(cur); }
#undef PG8_SA
#undef PG8_SB
#undef PG8_STAGE
#undef PG8_LDA
#undef PG8_LDB
#undef PG8_MMA
#undef PG8_WAIT_V
#undef PG8_WAIT_L
#undef PG8_BAR
#undef PG8_SCHED
}
}
#ifndef PG8_SP2
#define PG8_SP2 true
#endif
#ifndef PG8_ALIGN
#define PG8_ALIGN true
#endif
#define GAS __attribute__((address_space(1)))
#define LAS __attribute__((address_space(3)))
typedef unsigned short bf16;
typedef unsigned v4u __attribute__((ext_vector_type(4)));
typedef float f32x4 __attribute__((ext_vector_type(4)));
typedef short bf16x8 __attribute__((ext_vector_type(8)));
typedef GAS unsigned gu32;
typedef GAS unsigned long long gu64;
#define RLX_AGENT __ATOMIC_RELAXED, __HIP_MEMORY_SCOPE_AGENT
#define LDS_WAIT() asm volatile("s_waitcnt lgkmcnt(0)" ::: "memory")
#define VM_WAIT() asm volatile("s_waitcnt vmcnt(0)" ::: "memory")
__device__ __forceinline__ unsigned long long rt() { return __builtin_amdgcn_s_memrealtime(); }
__device__ __forceinline__ unsigned f2bf(float f) { unsigned u = __builtin_bit_cast(unsigned, f); return (u + 0x7fffu + ((u >> 16) & 1u)) >> 16; }
__device__ __forceinline__ unsigned pk2(float lo, float hi) { return f2bf(lo) | (f2bf(hi) << 16); }

#define XB_TMO      128
#define XB_XCNT(j)  (256  + 64 * (j))
#define XB_XSUB(j)  (1280 + 64 * (j))
#define XB_XGEN(j)  (2304 + 64 * (j))
#define XB_TOP      3328
#define XB_TOPGEN   3392
#define XCD_BAR_WORDS 3456
#define XB_SPIN_CAP (1u << 18)

__device__ __forceinline__ unsigned xb_ld(unsigned* p)              { return __hip_atomic_load(p, __ATOMIC_RELAXED, __HIP_MEMORY_SCOPE_AGENT); }
__device__ __forceinline__ unsigned xb_add(unsigned* p, unsigned v) { return __hip_atomic_fetch_add(p, v, __ATOMIC_RELAXED, __HIP_MEMORY_SCOPE_AGENT); }
__device__ __forceinline__ unsigned xb_xcc_id() { return (unsigned)__builtin_amdgcn_s_getreg((3 << 11) | 20) & 0xFu; }
#define XB_SPIN(cond, bar) do { unsigned _sp = 0; while (cond) { __builtin_amdgcn_s_sleep(1); \
    if ((++_sp & 255u) == 0u) { if (xb_ld(&(bar)[XB_TMO])) break; if (_sp > XB_SPIN_CAP) { atomicAdd(&(bar)[XB_TMO], 1u); break; } } } } while (0)

struct XcdBarrier {
    unsigned* bar; unsigned x;
    volatile LAS unsigned* st;
};

__device__ __forceinline__ XcdBarrier xcd_barrier_post(unsigned* bar, volatile LAS unsigned* st) {
    XcdBarrier b; b.bar = bar; b.x = xb_xcc_id(); b.st = st;
    if (threadIdx.x == 0) (void)xb_add(&bar[XB_XCNT(b.x)], 1u);
    return b;
}
__device__ __forceinline__ void xcd_barrier_complete(unsigned* bar, unsigned x, unsigned& nloc, unsigned& nx) {
    const unsigned G = gridDim.x * gridDim.y * gridDim.z;
    unsigned sum, cnt, mine, sp = 0u;
    for (;;) {
        sum = 0u; cnt = 0u; mine = 0u;
#pragma unroll
        for (unsigned j = 0; j < 16; ++j) { const unsigned c = xb_ld(&bar[XB_XCNT(j)]); sum += c; cnt += (c > 0u) ? 1u : 0u; mine = (j == x) ? c : mine; }
        if (sum == G) break;
        __builtin_amdgcn_s_sleep(1);
        if ((++sp & 255u) == 0u) { if (xb_ld(&bar[XB_TMO])) break; if (sp > XB_SPIN_CAP) { atomicAdd(&bar[XB_TMO], 1u); break; } }
    }
    nloc = mine > 0u ? mine : 1u; nx = cnt > 0u ? cnt : 1u;
}

__device__ __forceinline__ void xcd_barrier(const XcdBarrier& b) {
    asm volatile("s_waitcnt vmcnt(0)" ::: "memory");
    __syncthreads();
    if (threadIdx.x == 0) {
        unsigned* bar = b.bar;
        __builtin_amdgcn_s_waitcnt(0);
        unsigned nloc = b.st[0], nx = b.st[1];
        if (nloc == 0u) { xcd_barrier_complete(bar, b.x, nloc, nx); b.st[0] = nloc; b.st[1] = nx; }
        const unsigned old = xb_add(&bar[XB_XSUB(b.x)], 1u);
        const unsigned gen = old / nloc;
        if (old + 1u == (gen + 1u) * nloc) {
            __builtin_amdgcn_fence(__ATOMIC_RELEASE, "agent");
            asm volatile("s_waitcnt vmcnt(0)" ::: "memory");
            const unsigned og = xb_add(&bar[XB_TOP], 1u);
            const unsigned tg = og / nx;
            if (og + 1u == (tg + 1u) * nx) xb_add(&bar[XB_TOPGEN], 1u);
            else XB_SPIN(xb_ld(&bar[XB_TOPGEN]) == tg, bar);
            __builtin_amdgcn_fence(__ATOMIC_ACQUIRE, "agent");
            xb_add(&bar[XB_XGEN(b.x)], 1u);
            asm volatile("s_waitcnt vmcnt(0)" ::: "memory");
        } else {
            XB_SPIN(xb_ld(&bar[XB_XGEN(b.x)]) == gen, bar);
            __builtin_amdgcn_fence(__ATOMIC_ACQUIRE, "agent");
            asm volatile("s_waitcnt vmcnt(0)" ::: "memory");
        }
    }
    __syncthreads();
}
constexpr int NWAVES = 8;
#ifndef MK_PER_PHASE
#define MK_PER_PHASE 0
#endif
constexpr int N_PHASES = 20;
constexpr int MOE_KS = 1;

constexpr int BATCH = 2, T = 8192, D = 1024, M = BATCH * T;
constexpr int NSA_IN = 2608, NSA_IN_PAD = 2816, FF0 = 2816, GLA_IN = 3088, GLA_IN_PAD = 3328, FFE = 3584, NE = 8;
constexpr int NCMP = 511, MAXTILES = 136, MAXSLOTS = MAXTILES * 256;
constexpr float ALPHA = 1.41421356237309515f;
constexpr float LN_EPS = 1e-5f, RMS_EPS = 1e-6f, LOG2E = 1.44269504088896341f;

constexpr size_t MiB = 1u << 20;
constexpr size_t WS_CTL = 0, CTL_ZERO_BYTES = 1 * MiB;
constexpr size_t WS_PB = 1 * MiB;
constexpr size_t WS_CNTL = WS_PB + 32768;
constexpr size_t WS_TOKE = WS_CNTL + 16384;
constexpr size_t WS_TOKW = WS_TOKE + (size_t)M * 8;
constexpr size_t WS_TOKP = WS_TOKW + (size_t)M * 8;
constexpr size_t WS_TOKS = WS_TOKP + (size_t)M * 8;
static_assert(WS_TOKS + (size_t)M * 8 <= 2 * MiB, "misc region");
constexpr size_t WS_WIN0 = 2 * MiB, WS_W1C = 8 * MiB, WS_WO0 = 10 * MiB, WS_WGU0 = 12 * MiB, WS_WD0 = 23 * MiB, WS_WIN1 = 29 * MiB, WS_WO1 = 36 * MiB, WS_WGU1 = 38 * MiB, WS_WD1 = 150 * MiB;
constexpr size_t WS_XB = 206 * MiB, WS_XRES = 238 * MiB, WS_T0 = 302 * MiB, WS_SCR = 366 * MiB;
constexpr size_t WS_Q = WS_SCR, WS_KV2 = WS_SCR + 32 * MiB, WS_KS = WS_SCR + 48 * MiB, WS_VS = WS_SCR + 56 * MiB, WS_KW = WS_SCR + 64 * MiB, WS_VW = WS_SCR + 72 * MiB;
constexpr size_t WS_GT = WS_SCR + 80 * MiB, WS_UL = WS_SCR + 83 * MiB, WS_KCMP = WS_SCR + 99 * MiB, WS_VCMP = WS_KCMP + 512 * 1024, WS_O = WS_SCR + 100 * MiB, WS_H0 = WS_SCR + 132 * MiB;
constexpr size_t WS_QKVG = WS_SCR, WS_ALOW = WS_SCR + 96 * MiB, WS_BCUM = WS_SCR + 97 * MiB, WS_ZB = WS_SCR + 129 * MiB, WS_DEC = WS_SCR + 257 * MiB, WS_SST = WS_SCR + 258 * MiB, WS_O1 = WS_SCR + 322 * MiB;
constexpr size_t WS_XG = WS_SCR, WS_YB = WS_SCR + 68 * MiB, WS_H2 = WS_SCR + 136 * MiB, WS_YB1 = WS_SCR + 374 * MiB, WS_END = WS_YB1 + 68 * MiB;
static_assert(WS_H2 + (size_t)MAXSLOTS * FFE * 2 <= WS_YB1, "H2 fits");
static_assert(WS_H0 + (size_t)M * FF0 * 2 <= 896 * MiB && WS_O1 + 32 * MiB <= 896 * MiB && WS_END <= 896 * MiB, "d_ws map");
constexpr int CW_TMO = 0, CW_CODE = 1, CW_BAR = 4096;
constexpr int CW_PANEL0 = 16384, CW_PANEL1 = 32768;
static_assert((CW_PANEL1 + 64 * MAXTILES) * 4 <= (int)CTL_ZERO_BYTES, "CTL words inside the memset region");

constexpr int RING_OFF = 0, RING_BYTES = 131072;
constexpr int LDSCTL_OFF = RING_BYTES, MISC_OFF = LDSCTL_OFF + 320;
constexpr int INPTR_OFF = MISC_OFF + 128;
constexpr int LDS_BYTES = 147456;
#ifndef TR_UNROLL
#define TR_UNROLL 8
#endif
typedef float f32x16 __attribute__((ext_vector_type(16)));
typedef short v4i16 __attribute__((ext_vector_type(4)));
typedef unsigned v2u __attribute__((ext_vector_type(2)));
struct Args { const float* in[27]; float* out; unsigned char* ws; int ph_lo, ph_hi; };
struct Frame {
    const Args* A;
    LAS unsigned char* lds;
    volatile LAS unsigned* MISC;
    gu32* ctl;
    int tid, lane, wave;
    int vcu, G, wg;
    unsigned char* ws; float* out;
};
#define inptr(F, k) ((F).A->in[k])
__device__ __forceinline__ float wave_sum(float v) {
#pragma unroll
    for (int o = 1; o < 64; o <<= 1) v += __shfl_xor(v, o);
    return v;
}
__device__ __forceinline__ float bf2f(bf16 h) { return __uint_as_float((unsigned)h << 16); }
__device__ __forceinline__ v4i16 vtr(const LAS unsigned char* p) { return __builtin_amdgcn_ds_read_tr16_b64_v4i16((LAS v4i16*)p); }
__device__ __forceinline__ int crow(int r, int hi) { return (r & 3) + 8 * (r >> 2) + 4 * hi; }

__device__ __forceinline__ void tr_item(const float* src, int ldn, int nvalid, int k0, int n0, bf16* dst, int dld, int drow0, LAS float* scr, int lane) {
    const int n_ = n0 + (lane & 31); const bool ok = n_ < nvalid;
    float tv[32];
#pragma unroll
    for (int i = 0; i < 32; ++i) { const int kk = 2 * i + (lane >> 5); tv[i] = ok ? *(const GAS float*)(src + (size_t)(k0 + kk) * ldn + n_) : 0.f; }
#pragma unroll
    for (int i = 0; i < 32; ++i) { const int kk = 2 * i + (lane >> 5); scr[kk * 33 + (lane & 31)] = tv[i]; }
    LDS_WAIT(); asm volatile("" ::: "memory");
    const int c = lane & 7;
#pragma unroll
    for (int j = 0; j < 4; ++j) { const int n = (lane >> 3) + 8 * j; const LAS float* s = scr + (8 * c) * 33 + n;
        v4u o; o.x = pk2(s[0 * 33], s[1 * 33]); o.y = pk2(s[2 * 33], s[3 * 33]); o.z = pk2(s[4 * 33], s[5 * 33]); o.w = pk2(s[6 * 33], s[7 * 33]);
        *(GAS v4u*)(dst + (size_t)(drow0 + n) * dld + k0 + 8 * c) = o; }
    LDS_WAIT(); asm volatile("" ::: "memory");
}
__device__ __forceinline__ int swiglu_row(int n0, int F_) { return n0 < F_ ? (n0 / 128) * 256 + (n0 % 128) : ((n0 - F_) / 128) * 256 + 128 + ((n0 - F_) % 128); }
#define KBNB(idx, nkb, nnb) const int kb = ((idx) % (8 * (nkb))) / 8, nb = ((idx) / (8 * (nkb))) * 8 + (idx) % 8
__device__ __forceinline__ void p0_items(Frame& F, const int first, const int last, const int gw, const int NGW) {
    LAS float* scr = (LAS float*)(F.lds + RING_OFF + F.wave * 16384);
    const int lane = F.lane;
    unsigned char* ws = F.ws;
    constexpr int I_IN0 = 16 * (NSA_IN_PAD / 32), I_W1 = 4 * 16 * 8, I_WO = 16 * 32, I_GU0 = 16 * (2 * FF0 / 32), I_D0 = (FF0 / 64) * 32, I_IN1 = 16 * (GLA_IN_PAD / 32);
    constexpr int I_GU1E = 16 * (2 * FFE / 32), I_D1E = (FFE / 64) * 32, I_GU1 = NE * I_GU1E, I_D1 = NE * I_D1E;
    constexpr int NITEMS = I_IN0 + I_W1 + I_WO + I_GU0 + I_D0 + I_IN1 + I_WO + I_GU1 + I_D1;
    for (int it = first + gw; it < last; it += NGW) {
        int r = it;
        if (r < I_IN0) { constexpr int nnb = NSA_IN_PAD / 32; KBNB(r, 16, nnb); tr_item(inptr(F, 1), NSA_IN, NSA_IN, 64 * kb, 32 * nb, (bf16*)(ws + WS_WIN0), 1024, 32 * nb, scr, lane); continue; } r -= I_IN0;
        if (r < I_W1) { const int blk = r / 128, q = r % 128; KBNB(q, 16, 8);
            const float* src = ((blk >> 1) ? inptr(F, 6) : inptr(F, 4)) + (size_t)(blk & 1) * 1024 * 256; tr_item(src, 256, 256, 64 * kb, 32 * nb, (bf16*)(ws + WS_W1C), 1024, 256 * blk + 32 * nb, scr, lane); continue; } r -= I_W1;
        if (r < I_WO) { KBNB(r, 16, 32); tr_item(inptr(F, 8), 1024, 1024, 64 * kb, 32 * nb, (bf16*)(ws + WS_WO0), 1024, 32 * nb, scr, lane); continue; } r -= I_WO;
        if (r < I_GU0) { constexpr int nnb = 2 * FF0 / 32; KBNB(r, 16, nnb); tr_item(inptr(F, 11), 2 * FF0, 2 * FF0, 64 * kb, 32 * nb, (bf16*)(ws + WS_WGU0), 1024, swiglu_row(32 * nb, FF0), scr, lane); continue; } r -= I_GU0;
        if (r < I_D0) { KBNB(r, FF0 / 64, 32); tr_item(inptr(F, 12), 1024, 1024, 64 * kb, 32 * nb, (bf16*)(ws + WS_WD0), FF0, 32 * nb, scr, lane); continue; } r -= I_D0;
        if (r < I_IN1) { constexpr int nnb = GLA_IN_PAD / 32; KBNB(r, 16, nnb); tr_item(inptr(F, 15), GLA_IN, GLA_IN, 64 * kb, 32 * nb, (bf16*)(ws + WS_WIN1), 1024, 32 * nb, scr, lane); continue; } r -= I_IN1;
        if (r < I_WO) { KBNB(r, 16, 32); tr_item(inptr(F, 19), 1024, 1024, 64 * kb, 32 * nb, (bf16*)(ws + WS_WO1), 1024, 32 * nb, scr, lane); continue; } r -= I_WO;
        if (r < I_GU1) { constexpr int nnb = 2 * FFE / 32; const int e = r / I_GU1E, q = r % I_GU1E; KBNB(q, 16, nnb);
            tr_item(inptr(F, 23) + (size_t)e * 1024 * 2 * FFE, 2 * FFE, 2 * FFE, 64 * kb, 32 * nb, (bf16*)(ws + WS_WGU1) + (size_t)e * 2 * FFE * 1024, 1024, swiglu_row(32 * nb, FFE), scr, lane); continue; } r -= I_GU1;
        { const int e = r / I_D1E, q = r % I_D1E; KBNB(q, FFE / 64, 32);
            tr_item(inptr(F, 24) + (size_t)e * FFE * 1024, 1024, 1024, 64 * kb, 32 * nb, (bf16*)(ws + WS_WD1) + (size_t)e * 1024 * FFE, FFE, 32 * nb, scr, lane); }
    }
}
namespace p0n { constexpr int I_D1 = NE * (FFE / 64) * 32, I_ALL = 16 * (NSA_IN_PAD / 32) + 4 * 16 * 8 + 16 * 32 + 16 * (2 * FF0 / 32) + (FF0 / 64) * 32 + 16 * (GLA_IN_PAD / 32) + 16 * 32 + NE * 16 * (2 * FFE / 32) + I_D1; }
constexpr int CMP_WGS = 64;
__device__ __forceinline__ void p0_prologue(Frame& F) {
    const int gw = F.vcu * NWAVES + F.wave, NGW = F.G * NWAVES, lane = F.lane;
    unsigned char* ws = F.ws;
    p0_items(F, 0, p0n::I_ALL, gw, NGW);
    { const float* x = inptr(F, 0); bf16* xb = (bf16*)(ws + WS_XB);
      for (int m = gw; m < M; m += NGW) { const GAS f32x4* xr = (const GAS f32x4*)(x + (size_t)m * D) + lane; GAS unsigned long long* o8 = (GAS unsigned long long*)(xb + (size_t)m * D) + lane;
#pragma unroll
          for (int j = 0; j < 4; ++j) { const f32x4 v = xr[64 * j]; o8[64 * j] = (unsigned long long)pk2(v.x, v.y) | ((unsigned long long)pk2(v.z, v.w) << 32); } } }
    { float* pb = (float*)(ws + WS_PB);
      for (int task = gw; task < 64; task += NGW) { const int rp = task & 7, cb = (task >> 3) & 3, kv = task >> 5; const float* pe = kv ? inptr(F, 3) : inptr(F, 2); const float* w1 = kv ? inptr(F, 6) : inptr(F, 4); const int c = 64 * cb + lane;
          float a = 0.f;
          for (int r0 = 256 * rp; r0 < 256 * rp + 256; r0 += 32) { float wv[32], pv[32];
#pragma unroll
              for (int u = 0; u < 32; ++u) { wv[u] = *(const GAS float*)(w1 + (size_t)(r0 + u) * 256 + c); pv[u] = *(const GAS float*)(pe + r0 + u); }
#pragma unroll
              for (int u = 0; u < 32; ++u) a += pv[u] * wv[u]; }
          pb[rp * 512 + kv * 256 + c] = a; } }
}

__device__ __forceinline__ float gelu_tanh(float x) { const float y = 0.7978845608028654f * (x + 0.044715f * x * x * x); const float e = __expf(2.f * y); const float th = 1.f - 2.f / (e + 1.f); return 0.5f * x * (1.f + th); }
__device__ __forceinline__ void cmp_finish(Frame& F) {
    const int gw = F.vcu * NWAVES + F.wave, NGW = F.G * NWAVES, lane = F.lane;
    LAS float* hb = (LAS float*)(F.lds + RING_OFF + F.wave * 1024);
    LAS float* W2L = (LAS float*)(F.lds + RING_OFF + 16384);
    const float* ul = (const float*)(F.ws + WS_UL); const float* pb = (const float*)(F.ws + WS_PB);
    int staged = -1;
    for (int task = gw; task < 8192; task += NGW) {
        const int kv = task >> 12, rem = task & 4095, b = rem >> 11, n = (rem >> 2) & 511, g = rem & 3;
        if (kv != staged) { const float* w2 = kv ? inptr(F, 7) : inptr(F, 5);
            __syncthreads();
            for (int q = F.tid; q < 4096; q += NWAVES * 64) *(LAS f32x4*)(W2L + q * 4) = *(const GAS f32x4*)(w2 + q * 4);
            __syncthreads(); staged = kv; }
        bf16* dst = (bf16*)(F.ws + (kv ? WS_VCMP : WS_KCMP)) + ((size_t)((b * 4 + g) * 512 + n)) * 64;
        if (n == 511) { dst[lane] = 0; continue; }
        const size_t rowU = (size_t)kv * 4096 + (size_t)(b * 512 + n) * 4 + g, rowL = rowU + 4;
        const f32x4 u = *(const f32x4*)(ul + rowU * 512 + lane * 4), lw = *(const f32x4*)(ul + rowL * 512 + 256 + lane * 4);
        f32x4 bs = (f32x4){0.f, 0.f, 0.f, 0.f};
#pragma unroll
        for (int rp = 0; rp < 8; ++rp) bs += *(const f32x4*)(pb + rp * 512 + kv * 256 + lane * 4);
        const f32x4 pre = u + lw + bs;
        *(LAS f32x4*)(hb + lane * 4) = (f32x4){gelu_tanh(pre[0]), gelu_tanh(pre[1]), gelu_tanh(pre[2]), gelu_tanh(pre[3])};
        LDS_WAIT(); asm volatile("" ::: "memory");
        float a0 = 0.f, a1 = 0.f, a2 = 0.f, a3 = 0.f;
#pragma unroll 8
        for (int c = 0; c < 256; c += 4) { const f32x4 h4 = *(const LAS f32x4*)(hb + c);
            a0 += h4[0] * W2L[(c + 0) * 64 + lane]; a1 += h4[1] * W2L[(c + 1) * 64 + lane]; a2 += h4[2] * W2L[(c + 2) * 64 + lane]; a3 += h4[3] * W2L[(c + 3) * 64 + lane]; }
        dst[lane] = (bf16)f2bf((a0 + a1) + (a2 + a3));
        LDS_WAIT(); asm volatile("" ::: "memory");
    }
}

namespace nsa {
constexpr int KB_OFF = 0, VB_OFF = 18432, IMPA_OFF = 36864, IMPB_OFF = 69632, SEL_OFF = 102400, UNI_OFF = 103424, NS_OFF = 103440, SLIST_OFF = 103456, TILE_B = 9216;
static_assert(SLIST_OFF + 512 <= RING_BYTES, "nsa LDS map");
constexpr float THR = 8.f;
__device__ __forceinline__ float dpp_xor1(float v) { return __int_as_float(__builtin_amdgcn_update_dpp(0, __float_as_int(v), 0xB1, 0xF, 0xF, true)); }
__device__ __forceinline__ float dpp_xor2(float v) { return __int_as_float(__builtin_amdgcn_update_dpp(0, __float_as_int(v), 0x4E, 0xF, 0xF, true)); }
__device__ __forceinline__ float max_halves(float v) { const auto rr = __builtin_amdgcn_permlane32_swap(__float_as_uint(v), __float_as_uint(v), false, false); return fmaxf(__uint_as_float(rr[0]), __uint_as_float(rr[1])); }
__device__ __forceinline__ int below(unsigned long long mk) { return (int)__builtin_amdgcn_mbcnt_hi((unsigned)(mk >> 32), __builtin_amdgcn_mbcnt_lo((unsigned)mk, 0u)); }
template <int MODE>
__device__ __forceinline__ void tile(LAS unsigned char* lds, const int kt_off, const int vt_off, const bf16x8 (&qf)[4], const unsigned qaw, f32x16 (&o)[2], float& m, float& l,
                                     const int lane, const float bias, const bool emask, const int d0, const int pstep, const int lim, const float rl, const int impq, const int jbase) {
    const int hi = lane >> 5, qc = lane & 31;
    const v4u qav = (v4u){qaw, 0u, 0u, 0u}; const bf16x8 qaug = __builtin_bit_cast(bf16x8, qav);
    f32x16 p[2];
#pragma unroll
    for (int h2 = 0; h2 < 2; ++h2) {
#pragma unroll
        for (int r = 0; r < 16; ++r) p[h2][r] = 0.f;
#pragma unroll
        for (int ks = 0; ks < 4; ++ks) { const bf16x8 a = *(const LAS bf16x8*)(lds + kt_off + (32 * h2 + qc) * 144 + 32 * ks + 16 * hi);
            p[h2] = __builtin_amdgcn_mfma_f32_32x32x16_bf16(a, qf[ks], p[h2], 0, 0, 0); }
        { const unsigned xb = hi ? 0u : f2bf((float)(32 * h2 + qc)); const v4u kav = (v4u){xb | (xb << 16), 0u, 0u, 0u};
          p[h2] = __builtin_amdgcn_mfma_f32_32x32x16_bf16(__builtin_bit_cast(bf16x8, kav), qaug, p[h2], 0, 0, 0); }
    }
    if (emask) {
#pragma unroll
        for (int h2 = 0; h2 < 2; ++h2)
#pragma unroll
            for (int r = 0; r < 16; ++r) { const int dist = d0 - pstep * (32 * h2 + (r & 3) + 8 * (r >> 2)); p[h2][r] = ((unsigned)dist < (unsigned)lim) ? p[h2][r] : -INFINITY; }
    }
    float mref;
    if (MODE == 1) mref = m - bias;
    else {
        float mx = fmaxf(p[0][0], p[1][0]);
#pragma unroll
        for (int r = 1; r < 16; ++r) mx = fmaxf(fmaxf(mx, p[0][r]), p[1][r]);
        mx = max_halves(mx);
        const float mt = mx + bias;
        const bool up = mt > m + THR;
        if (__any(up)) { const float mn = up ? mt : m; const float f = __builtin_amdgcn_exp2f(m - mn); l *= f; m = mn;
            if (MODE == 2) {
#pragma unroll
                for (int r = 0; r < 16; ++r) { o[0][r] *= f; o[1][r] *= f; } } }
        mref = m - bias;
    }
    float ls0 = 0.f, ls1 = 0.f;
#pragma unroll
    for (int r = 0; r < 16; ++r) { float e0 = __builtin_amdgcn_exp2f(p[0][r] - mref), e1 = __builtin_amdgcn_exp2f(p[1][r] - mref); if (MODE == 1) { e0 *= rl; e1 *= rl; } p[0][r] = e0; p[1][r] = e1; ls0 += e0; ls1 += e1; }
    if (MODE != 1) l += ls0 + ls1;
    if (MODE == 0) return;
    if (MODE == 1) {
        LAS float* IA = (LAS float*)(lds + IMPA_OFF) + impq * 128; LAS float* IB = (LAS float*)(lds + IMPB_OFF) + impq * 128;
#pragma unroll
        for (int h2 = 0; h2 < 2; ++h2)
#pragma unroll
            for (int a4 = 0; a4 < 4; ++a4) {
                float qs = (p[h2][4 * a4] + p[h2][4 * a4 + 1]) + (p[h2][4 * a4 + 2] + p[h2][4 * a4 + 3]), last = p[h2][4 * a4 + 3];
                qs += dpp_xor1(qs); qs += dpp_xor2(qs); last += dpp_xor1(last); last += dpp_xor2(last);
                const int j = jbase + 8 * h2 + 2 * a4 + hi;
                if ((qc & 3) == 0) { IA[j] = qs; if (j + 1 < 128) IB[j + 1] = last; }
            }
    }
    bf16x8 pf[2][2];
#pragma unroll
    for (int h2 = 0; h2 < 2; ++h2)
#pragma unroll
        for (int s2 = 0; s2 < 2; ++s2) { v4u wv; wv.x = pg8::cvtpk_c(p[h2][8 * s2 + 0], p[h2][8 * s2 + 1]); wv.y = pg8::cvtpk_c(p[h2][8 * s2 + 2], p[h2][8 * s2 + 3]);
            wv.z = pg8::cvtpk_c(p[h2][8 * s2 + 4], p[h2][8 * s2 + 5]); wv.w = pg8::cvtpk_c(p[h2][8 * s2 + 6], p[h2][8 * s2 + 7]); pf[h2][s2] = __builtin_bit_cast(bf16x8, wv); }
    const int a = (lane >> 4) & 1, q_ = (lane & 15) >> 2, p_ = lane & 3;
#pragma unroll
    for (int d0_ = 0; d0_ < 2; ++d0_)
#pragma unroll
        for (int h2 = 0; h2 < 2; ++h2)
#pragma unroll
            for (int s2 = 0; s2 < 2; ++s2) {
                const LAS unsigned char* ad = lds + vt_off + (32 * h2 + 16 * s2 + 4 * hi + q_) * 144 + (32 * d0_ + 16 * a + 4 * p_) * 2;
                const v4i16 lo = vtr(ad), hi4 = vtr(ad + 8 * 144);
                const bf16x8 av = (bf16x8){lo[0], lo[1], lo[2], lo[3], hi4[0], hi4[1], hi4[2], hi4[3]};
                o[d0_] = __builtin_amdgcn_mfma_f32_32x32x16_bf16(av, pf[h2][s2], o[d0_], 0, 0, 0);
            }
}
__device__ __forceinline__ void select13(const unsigned (&k0)[4], const unsigned (&k1)[4], const int lane, unsigned long long (&m0)[4], unsigned long long (&m1)[4]) {
    unsigned th[4] = {0u, 0u, 0u, 0u};
    for (int bit = 30; bit >= 0; --bit) {
#pragma unroll
        for (int u = 0; u < 4; ++u) { const unsigned cand = th[u] | (1u << bit); const int cnt = __popcll(__ballot(k0[u] >= cand)) + __popcll(__ballot(k1[u] >= cand)); th[u] = cnt >= 13 ? cand : th[u]; }
    }
#pragma unroll
    for (int u = 0; u < 4; ++u) {
        const unsigned long long gt0 = __ballot(k0[u] > th[u]), gt1 = __ballot(k1[u] > th[u]), eq0 = __ballot(k0[u] == th[u]), eq1 = __ballot(k1[u] == th[u]);
        const int need = 13 - __popcll(gt0) - __popcll(gt1);
        const int r0 = below(eq0), r1 = __popcll(eq0) + below(eq1);
        const bool s0 = (k0[u] > th[u]) || (k0[u] == th[u] && r0 < need), s1 = (k1[u] > th[u]) || (k1[u] == th[u] && r1 < need);
        m0[u] = __ballot(s0); m1[u] = __ballot(s1);
    }
}
}
__device__ __forceinline__ void nsa_attn_phase(Frame& F) {
    using namespace nsa;
    LAS unsigned char* lds = F.lds + RING_OFF;
    const int tid = F.tid, lane = F.lane, w = F.wave, hi = lane >> 5, qc = lane & 31;
    unsigned char* ws = F.ws;
    const bf16* Qp = (const bf16*)(ws + WS_Q); const float* GT = (const float*)(ws + WS_GT); bf16* Op = (bf16*)(ws + WS_O);
    LAS unsigned* SEL = (LAS unsigned*)(lds + SEL_OFF); LAS unsigned* UNI = (LAS unsigned*)(lds + UNI_OFF); LAS int* NSW = (LAS int*)(lds + NS_OFF); LAS int* SLIST = (LAS int*)(lds + SLIST_OFF);
    const int lrow = tid >> 3, lch = tid & 7;
    for (int un = F.wg; un < 1024; un += F.G) {
        const int bg = un & 7, cc = un >> 3, c = ((cc >> 5) & 1) ? (cc & ~31) + 31 - (cc & 31) : cc;
        const int b = bg >> 2, g = bg & 3, t0 = c * 64;
        const int tql = 8 * w + (qc >> 2), hh = qc & 3, t = t0 + tql, head = 4 * g + hh;
        const size_t mrow = (size_t)b * T + t;
        const float slope2 = __builtin_amdgcn_exp2f(-0.5f * (float)(head + 1)) * LOG2E;
        unsigned qaw1, qaw16;
        { const unsigned sh = f2bf(slope2); const float rem = slope2 - __uint_as_float(sh << 16); const unsigned sl = f2bf(rem);
          const unsigned sh16 = f2bf(16.f * __uint_as_float(sh << 16)), sl16 = f2bf(16.f * __uint_as_float(sl << 16));
          qaw1 = hi ? 0u : (sh | (sl << 16)); qaw16 = hi ? 0u : (sh16 | (sl16 << 16)); }
        bf16x8 qf[4];
#pragma unroll
        for (int ks = 0; ks < 4; ++ks) qf[ks] = *(const GAS bf16x8*)(Qp + mrow * 1024 + head * 64 + 16 * ks + 8 * hi);
        const float* gp = GT + mrow * 48 + (g * 4 + hh) * 3; const float g_cmp = gp[0], g_slc = gp[1], g_win = gp[2];
        const int nmax = (4 * c + 2) < 510 ? (4 * c + 2) : 510, ncb = nmax / 64 + 1;
        const int jw0 = c - 8 > 0 ? c - 8 : 0, nw = c - jw0 + 1, S3 = 2 * ncb + nw;
        const unsigned kcb = (unsigned)WS_KCMP + (unsigned)(b * 4 + g) * 65536u, kvb = ((unsigned)b * T * 256u + (unsigned)g * 64u) * 2u;
        const unsigned thr64 = (unsigned)(lrow * 128 + lch * 16), thr256 = (unsigned)(lrow * 512 + lch * 16);
        int ns = 1;
#define NSA_FETCH(s, kr, vr) do { const int s_ = (s); unsigned ko_, vo_ = 0u; \
            if (s_ < ncb) { ko_ = kcb + (unsigned)s_ * 8192u + thr64; } \
            else if (s_ < 2 * ncb) { ko_ = kcb + (unsigned)(s_ - ncb) * 8192u + thr64; vo_ = ko_ + (unsigned)(WS_VCMP - WS_KCMP); } \
            else if (s_ < S3) { ko_ = (unsigned)WS_KW + kvb + (unsigned)(c - (s_ - 2 * ncb)) * 32768u + thr256; vo_ = ko_ + (unsigned)(WS_VW - WS_KW); } \
            else { ko_ = (unsigned)WS_KS + kvb + (unsigned)SLIST[ns - 1 - (s_ - S3)] * 32768u + thr256; vo_ = ko_ + (unsigned)(WS_VS - WS_KS); } \
            kr = *(const GAS v4u*)(ws + ko_); if (s_ >= ncb) vr = *(const GAS v4u*)(ws + vo_); } while (0)
#define NSA_COMMIT(s, kr, vr) do { const int bo_ = ((s) & 1) * TILE_B + lrow * 144 + lch * 16; *(LAS v4u*)(lds + KB_OFF + bo_) = kr; if ((s) >= ncb) *(LAS v4u*)(lds + VB_OFF + bo_) = vr; } while (0)
        __syncthreads();
        if (c <= 15) {
            int ln = lane; asm volatile("" : "+v"(ln));
            if (ln < 8) { const int q = 8 * w + ln; SEL[q * 4 + 0] = (2u << c) - 1u; SEL[q * 4 + 1] = 0u; SEL[q * 4 + 2] = 0u; SEL[q * 4 + 3] = 0u; }
            if (w == 0 && ln <= c) SLIST[ln] = ln;
            ns = c + 1; }
        else if (tid < 4) UNI[tid] = 0u;
        int ST = S3 + ns;
        v4u krA = (v4u){0u, 0u, 0u, 0u}, vrA = krA, krB = krA, vrB = krA;
        NSA_FETCH(0, krA, vrA); NSA_COMMIT(0, krA, vrA); NSA_FETCH(1, krB, vrB);
        __syncthreads();
        float m = -1e30f, l = 0.f, rl = 0.f; f32x16 o[2]; unsigned otp[2][8];
#pragma unroll
        for (int r = 0; r < 16; ++r) { o[0][r] = 0.f; o[1][r] = 0.f; }
#pragma unroll
        for (int r = 0; r < 8; ++r) { otp[0][r] = 0u; otp[1][r] = 0u; }
        for (int s = 0; s < ST; ++s) {
            const bool has_next = s + 1 < ST;
            if (s + 2 < ST) { if (s & 1) NSA_FETCH(s + 2, krB, vrB); else NSA_FETCH(s + 2, krA, vrA); }
            const int kt = KB_OFF + (s & 1) * TILE_B, vt = VB_OFF + (s & 1) * TILE_B;
            if (s < 2 * ncb) { const int kb = s < ncb ? s : s - ncb; const int pos0 = 1024 * kb + 31;
                const float bias = slope2 * (float)(pos0 - t); const bool em = 1024 * kb + 1039 > t0; const int d0 = t - pos0 - 64 * hi;
                if (s < ncb) tile<0>(lds, kt, vt, qf, qaw16, o, m, l, lane, bias, em, d0, 16, 0x7fffffff, 0.f, tql, 0);
#if defined(PROBE_NSA) && PROBE_NSA == 7
                if (s < ncb) { float m2 = m, l2 = l; tile<0>(lds, kt, vt, qf, qaw16, o, m2, l2, lane, bias, em, d0, 16, 0x7fffffff, 0.f, tql, 0); asm volatile("" :: "v"(m2), "v"(l2)); }
#endif
                else tile<1>(lds, kt, vt, qf, qaw16, o, m, l, lane, bias, em, d0, 16, 0x7fffffff, rl, tql, 16 * kb); }
            else { int j; float bias; int lim;
                if (s < S3) { j = c - (s - 2 * ncb); bias = slope2 * (float)(64 * j - t); lim = 512; }
                else { j = SLIST[ns - 1 - (s - S3)]; const bool selq = (SEL[tql * 4 + (j >> 5)] >> (j & 31)) & 1u; bias = selq ? slope2 * (float)(64 * j - t) : -INFINITY; lim = 0x7fffffff; }
                const bool em = (j == c) || (s < S3 && c >= 8 && j == c - 8);
                tile<2>(lds, kt, vt, qf, qaw1, o, m, l, lane, bias, em, t - 64 * j - 4 * hi, 1, lim, 0.f, 0, 0); }
            if (s == ncb - 1) { const float lt0 = l + __shfl_xor(l, 32); rl = 1.0f / fmaxf(lt0, 1e-30f); }
            if (s == 2 * ncb - 1) {
#pragma unroll
                for (int r = 0; r < 8; ++r) { otp[0][r] = pg8::cvtpk_c(g_cmp * o[0][2 * r], g_cmp * o[0][2 * r + 1]); otp[1][r] = pg8::cvtpk_c(g_cmp * o[1][2 * r], g_cmp * o[1][2 * r + 1]); }
#pragma unroll
                for (int r = 0; r < 16; ++r) { o[0][r] = 0.f; o[1][r] = 0.f; }
                m = -1e30f; l = 0.f; }
            if (s == S3 - 1) { const float lt = l + __shfl_xor(l, 32); const float sc = g_win / fmaxf(lt, 1e-30f);
#pragma unroll
                for (int r = 0; r < 8; ++r) { otp[0][r] = pg8::cvtpk_c(__uint_as_float(otp[0][r] << 16) + sc * o[0][2 * r], __uint_as_float(otp[0][r] & 0xffff0000u) + sc * o[0][2 * r + 1]);
                    otp[1][r] = pg8::cvtpk_c(__uint_as_float(otp[1][r] << 16) + sc * o[1][2 * r], __uint_as_float(otp[1][r] & 0xffff0000u) + sc * o[1][2 * r + 1]); }
#pragma unroll
                for (int r = 0; r < 16; ++r) { o[0][r] = 0.f; o[1][r] = 0.f; }
                m = -1e30f; l = 0.f; }
            if (has_next) { if (s & 1) NSA_COMMIT(s + 1, krA, vrA); else NSA_COMMIT(s + 1, krB, vrB); }
            __syncthreads();
            if (s == 2 * ncb - 1 && c >= 16) {
                {
                    unsigned long long uo0 = 0ull, uo1 = 0ull;
#if defined(PROBE_NSA) && PROBE_NSA == 6
                    for (int qq = 0; qq < 16; qq += 4) { const int qi = qq & 7;
#else
                    for (int qi = 0; qi < 8; qi += 4) {
#endif
                        unsigned k0[4], k1[4]; unsigned long long m0[4], m1[4];
#pragma unroll
                        for (int u = 0; u < 4; ++u) { const int q = 8 * w + qi + u;
                            const LAS float* ia = (const LAS float*)(lds + IMPA_OFF) + q * 128; const LAS float* ib = (const LAS float*)(lds + IMPB_OFF) + q * 128;
                            const float v0 = ia[lane] + ib[lane], v1 = ia[lane + 64] + ib[lane + 64];
                            k0[u] = (lane >= 1 && lane <= c - 2) ? __float_as_uint(v0) + 1u : 0u; k1[u] = (lane + 64 <= c - 2) ? __float_as_uint(v1) + 1u : 0u; }
                        select13(k0, k1, lane, m0, m1);
#pragma unroll
                        for (int u = 0; u < 4; ++u) { const int q = 8 * w + qi + u;
                            m0[u] |= 1ull;
                            if (c - 1 < 64) m0[u] |= 1ull << (c - 1); else m1[u] |= 1ull << (c - 1 - 64);
                            if (c < 64) m0[u] |= 1ull << c; else m1[u] |= 1ull << (c - 64);
                            uo0 |= m0[u]; uo1 |= m1[u];
                            if (lane == 0) { SEL[q * 4 + 0] = (unsigned)m0[u]; SEL[q * 4 + 1] = (unsigned)(m0[u] >> 32); SEL[q * 4 + 2] = (unsigned)m1[u]; SEL[q * 4 + 3] = (unsigned)(m1[u] >> 32); } }
                    }
                    if (lane == 0) { __hip_atomic_fetch_or(UNI + 0, (unsigned)uo0, __ATOMIC_RELAXED, __HIP_MEMORY_SCOPE_WORKGROUP); __hip_atomic_fetch_or(UNI + 1, (unsigned)(uo0 >> 32), __ATOMIC_RELAXED, __HIP_MEMORY_SCOPE_WORKGROUP);
                        __hip_atomic_fetch_or(UNI + 2, (unsigned)uo1, __ATOMIC_RELAXED, __HIP_MEMORY_SCOPE_WORKGROUP); __hip_atomic_fetch_or(UNI + 3, (unsigned)(uo1 >> 32), __ATOMIC_RELAXED, __HIP_MEMORY_SCOPE_WORKGROUP); }
                }
                __syncthreads();
                if (w == 0) {
                    const unsigned long long u0 = (unsigned long long)UNI[0] | ((unsigned long long)UNI[1] << 32), u1 = (unsigned long long)UNI[2] | ((unsigned long long)UNI[3] << 32);
                    if ((u0 >> lane) & 1ull) SLIST[below(u0)] = lane;
                    if ((u1 >> lane) & 1ull) SLIST[__popcll(u0) + below(u1)] = 64 + lane;
                    if (lane == 0) NSW[0] = __popcll(u0) + __popcll(u1);
                }
                __syncthreads();
                ns = __builtin_amdgcn_readfirstlane(NSW[0]); ST = S3 + ns;
            }
        }
        { const float lt = l + __shfl_xor(l, 32); const float sc = g_slc / fmaxf(lt, 1e-30f);
          bf16* orow = Op + mrow * 1024 + head * 64;
#pragma unroll
          for (int d0 = 0; d0 < 2; ++d0)
#pragma unroll
              for (int a4 = 0; a4 < 4; ++a4) { const unsigned p0_ = otp[d0][2 * a4], p1_ = otp[d0][2 * a4 + 1]; v2u wv;
                  wv.x = pg8::cvtpk_c(__uint_as_float(p0_ << 16) + sc * o[d0][4 * a4], __uint_as_float(p0_ & 0xffff0000u) + sc * o[d0][4 * a4 + 1]);
                  wv.y = pg8::cvtpk_c(__uint_as_float(p1_ << 16) + sc * o[d0][4 * a4 + 2], __uint_as_float(p1_ & 0xffff0000u) + sc * o[d0][4 * a4 + 3]);
                  *(GAS v2u*)(orow + 32 * d0 + 8 * a4 + 4 * hi) = wv; } }
#undef NSA_FETCH
#undef NSA_COMMIT
    }
}

__device__ __forceinline__ f32x4 bf4(const v2u a) { return (f32x4){__uint_as_float(a.x << 16), __uint_as_float(a.x & 0xffff0000u), __uint_as_float(a.y << 16), __uint_as_float(a.y & 0xffff0000u)}; }
__device__ __forceinline__ void ln_rows(Frame& F, const bf16* tin, const float* gain, const float* bias, bf16* xb) {
    const int gw = F.vcu * NWAVES + F.wave, NGW = F.G * NWAVES, lane = F.lane;
    f32x4 gv[4], bv[4];
#pragma unroll
    for (int j = 0; j < 4; ++j) { gv[j] = *((const GAS f32x4*)gain + lane + 64 * j); bv[j] = *((const GAS f32x4*)bias + lane + 64 * j); }
    for (int m0 = gw; m0 < M; m0 += 8 * NGW) {
        v2u raw[8][4];
#pragma unroll
        for (int k = 0; k < 8; ++k) { const int m = m0 + k * NGW; if (m < M) { const GAS v2u* xr = (const GAS v2u*)(tin + (size_t)m * D) + lane;
#pragma unroll
            for (int j = 0; j < 4; ++j) raw[k][j] = xr[64 * j]; } }
#pragma unroll
        for (int k = 0; k < 8; ++k) { const int m = m0 + k * NGW; if (m >= M) break;
            f32x4 v[4]; float s = 0.f;
#pragma unroll
            for (int j = 0; j < 4; ++j) { v[j] = bf4(raw[k][j]); s += (v[j].x + v[j].y) + (v[j].z + v[j].w); }
            const float mean = wave_sum(s) * (1.f / D); float s2 = 0.f;
#pragma unroll
            for (int j = 0; j < 4; ++j) { v[j] = v[j] - mean; s2 += (v[j].x * v[j].x + v[j].y * v[j].y) + (v[j].z * v[j].z + v[j].w * v[j].w); }
            const float rstd = 1.f / sqrtf(wave_sum(s2) * (1.f / D) + LN_EPS);
            GAS unsigned long long* o8 = (GAS unsigned long long*)(xb + (size_t)m * D) + lane;
#pragma unroll
            for (int j = 0; j < 4; ++j) { const f32x4 y = v[j] * rstd * gv[j] + bv[j]; o8[64 * j] = (unsigned long long)pk2(y.x, y.y) | ((unsigned long long)pk2(y.z, y.w) << 32); }
        }
    }
}
namespace gla {
constexpr int ALS_OFF = 0, SEG_OFF = 4096, KH_OFF = 8192, KH_STR = 272, VH1_OFF = KH_OFF + 64 * KH_STR, VH_STR = 528, ZL_OFF = VH1_OFF + 64 * VH_STR, ZL_STR = 272;
constexpr int QS_OFF = 0, QS_STR = 272, AL_OFF = 64 * QS_STR, AL_STR = 144, VH3_OFF = AL_OFF + 64 * AL_STR, ST_OFF = VH3_OFF + 64 * VH_STR, ST_STR = 272, QT_OFF = ST_OFF, KT_OFF = ST_OFF + 64 * QS_STR, SSQ_OFF = ST_OFF + 256 * ST_STR;
constexpr int OL_OFF = ST_OFF, OL_STR = 1040;
static_assert(SSQ_OFF + 1024 <= RING_BYTES && ZL_OFF + 256 * ZL_STR <= RING_BYTES && KT_OFF + 64 * QS_STR <= SSQ_OFF && OL_OFF + 64 * OL_STR <= SSQ_OFF, "gla LDS map");
__device__ __forceinline__ bf16x8 trfrag(const LAS unsigned char* p, int rowstep4) { const v4i16 lo = vtr(p), hi4 = vtr(p + rowstep4); return (bf16x8){lo[0], lo[1], lo[2], lo[3], hi4[0], hi4[1], hi4[2], hi4[3]}; }
}
__device__ __forceinline__ void gla_load_v(LAS unsigned char* lds, int off, const bf16* qkvg, size_t m0, int vcol0, int tid) {
#pragma unroll
    for (int k = 0; k < 4; ++k) { const int q = tid + 512 * k, row = q >> 5, ch = q & 31;
        const v4u v = *(const GAS v4u*)(qkvg + (m0 + row) * 3072 + vcol0 + ch * 8); *(LAS v4u*)(lds + off + row * gla::VH_STR + ch * 16) = v; }
}
__device__ __forceinline__ void gla_g1(Frame& F) {
    using namespace gla;
    LAS unsigned char* lds = F.lds + RING_OFF; const int tid = F.tid, lane = F.lane, w = F.wave, hi = lane >> 5, qc = lane & 31;
    unsigned char* ws = F.ws; const bf16* qkvg = (const bf16*)(ws + WS_QKVG); const bf16* xbrows = (const bf16*)(ws + WS_XB); const bf16* wat = (const bf16*)(ws + WS_WIN1) + (size_t)3072 * 1024;
    float* bcum = (float*)(ws + WS_BCUM); bf16* zb = (bf16*)(ws + WS_ZB); float* dec = (float*)(ws + WS_DEC);
    const float* wg2 = inptr(F, 16); const float* bg2 = inptr(F, 17);
    LAS float* ALS = (LAS float*)(lds + ALS_OFF); LAS float* SEG = (LAS float*)(lds + SEG_OFF);
    const int d = tid & 127, ig = tid >> 7;
    for (int un = F.wg; un < 1024; un += F.G) {
        const int bh = un >> 7, n = un & 127, b = bh >> 2, h = bh & 3; const size_t m0 = (size_t)b * T + 64 * n;
        __syncthreads();
        { typedef float f32x4_ __attribute__((ext_vector_type(4)));
          const bf16* xbp = xbrows + (m0 + (lane & 15)) * 1024 + 128 * w + 8 * (lane >> 4); const bf16* wbp = wat + (size_t)(lane & 15) * 1024 + 128 * w + 8 * (lane >> 4);
          bf16x8 bq[4], aq[4][4];
#pragma unroll
          for (int ks = 0; ks < 4; ++ks) bq[ks] = *(const GAS bf16x8*)(wbp + 32 * ks);
#pragma unroll
          for (int rb = 0; rb < 4; ++rb)
#pragma unroll
              for (int ks = 0; ks < 4; ++ks) aq[rb][ks] = *(const GAS bf16x8*)(xbp + (size_t)rb * 16 * 1024 + 32 * ks);
          LAS float* PART = (LAS float*)(lds + ZL_OFF) + w * 1024;
#pragma unroll
          for (int rb = 0; rb < 4; ++rb) { f32x4_ pa = (f32x4_){0.f, 0.f, 0.f, 0.f};
#pragma unroll
              for (int ks = 0; ks < 4; ++ks) pa = __builtin_amdgcn_mfma_f32_16x16x32_bf16(aq[rb][ks], bq[ks], pa, 0, 0, 0);
#pragma unroll
              for (int j = 0; j < 4; ++j) PART[(16 * rb + 4 * (lane >> 4) + j) * 16 + (lane & 15)] = pa[j]; } }
        gla_load_v(lds, VH1_OFF, qkvg, m0, 1024 + h * 256, tid);
        bf16 kraw[16];
#pragma unroll
        for (int ii = 0; ii < 16; ++ii) kraw[ii] = *(const GAS bf16*)(qkvg + (m0 + 16 * ig + ii) * 3072 + 512 + h * 128 + d);
        float wg[16];
#pragma unroll
        for (int r = 0; r < 16; ++r) wg[r] = wg2[r * 512 + h * 128 + d];
        const float bgv = bg2[h * 128 + d];
        __syncthreads();
        { const LAS float* P0 = (const LAS float*)(lds + ZL_OFF) + 2 * tid; float s0 = 0.f, s1 = 0.f;
#pragma unroll
          for (int k = 0; k < 8; ++k) { s0 += P0[k * 1024]; s1 += P0[k * 1024 + 1]; }
          ALS[2 * tid] = s0; ALS[2 * tid + 1] = s1; }
        __syncthreads();
        float cs[16]; float run = 0.f;
#pragma unroll
        for (int ii = 0; ii < 16; ++ii) { const int i = 16 * ig + ii; float z = bgv;
#pragma unroll
            for (int r = 0; r < 16; ++r) z += ALS[i * 16 + r] * wg[r];
            const float la = (fminf(z, 0.f) - __logf(1.f + __expf(-fabsf(z)))) * (1.f / 16.f);
            run += la; cs[ii] = run; }
        SEG[ig * 128 + d] = run;
        __syncthreads();
        float pre = 0.f, tot = 0.f;
#pragma unroll
        for (int k = 0; k < 4; ++k) { const float sv = SEG[k * 128 + d]; if (k < ig) pre += sv; tot += sv; }
#pragma unroll
        for (int ii = 0; ii < 16; ++ii) { const int i = 16 * ig + ii; cs[ii] += pre;
            *(LAS bf16*)(lds + KH_OFF + i * KH_STR + d * 2) = (bf16)f2bf(bf2f(kraw[ii]) * __expf(tot - cs[ii])); }
#pragma unroll
        for (int ii = 0; ii < 16; ++ii) *(GAS float*)(bcum + (m0 + 16 * ig + ii) * 512 + h * 128 + d) = cs[ii];
        if (ig == 0) dec[(size_t)(bh * 128 + n) * 128 + d] = __expf(tot);
        __syncthreads();
        f32x16 acc[4];
#pragma unroll
        for (int db = 0; db < 4; ++db)
#pragma unroll
            for (int r = 0; r < 16; ++r) acc[db][r] = 0.f;
        const int a = (lane >> 4) & 1, q_ = (lane & 15) >> 2, p_ = lane & 3;
#pragma unroll
        for (int s = 0; s < 4; ++s) {
            const bf16x8 bfr = trfrag(lds + VH1_OFF + (16 * s + 8 * hi + q_) * VH_STR + (32 * w + 16 * a + 4 * p_) * 2, 4 * VH_STR);
#pragma unroll
            for (int db = 0; db < 4; ++db) { const bf16x8 afr = trfrag(lds + KH_OFF + (16 * s + 8 * hi + q_) * KH_STR + (32 * db + 16 * a + 4 * p_) * 2, 4 * KH_STR);
                acc[db] = __builtin_amdgcn_mfma_f32_32x32x16_bf16(afr, bfr, acc[db], 0, 0, 0); }
        }
#pragma unroll
        for (int db = 0; db < 4; ++db)
#pragma unroll
            for (int a4 = 0; a4 < 4; ++a4) { v2u wv; wv.x = pg8::cvtpk_c(acc[db][4 * a4], acc[db][4 * a4 + 1]); wv.y = pg8::cvtpk_c(acc[db][4 * a4 + 2], acc[db][4 * a4 + 3]);
                *(LAS v2u*)(lds + ZL_OFF + (32 * w + qc) * ZL_STR + (32 * db + 8 * a4 + 4 * hi) * 2) = wv; }
        __syncthreads();
        { bf16* zu = zb + (size_t)(bh * 128 + n) * 256 * 128;
#pragma unroll
          for (int k = 0; k < 8; ++k) { const int q = tid + 512 * k, row = q >> 4, ch = q & 15; *(GAS v4u*)(zu + row * 128 + ch * 8) = *(const LAS v4u*)(lds + ZL_OFF + row * ZL_STR + ch * 16); } }
    }
}
__device__ __forceinline__ void gla_g2(Frame& F) {
    unsigned char* ws = F.ws; const bf16* zb = (const bf16*)(ws + WS_ZB); const float* dec = (const float*)(ws + WS_DEC); bf16* sst = (bf16*)(ws + WS_SST);
    for (int p = F.wg * 512 + F.tid; p < 131072; p += F.G * 512) {
        const int bh = p >> 14, e = (p >> 6) & 255, d2 = p & 63;
        float s0 = 0.f, s1 = 0.f;
        for (int n0 = 0; n0 < 128; n0 += 8) {
            pg8::f32x2 dv[8]; unsigned zz[8];
#pragma unroll
            for (int k = 0; k < 8; ++k) { const size_t cn = (size_t)(bh * 128 + n0 + k); dv[k] = *(const GAS pg8::f32x2*)(dec + cn * 128 + 2 * d2); zz[k] = *(const GAS unsigned*)(zb + (cn * 256 + e) * 128 + 2 * d2); }
#pragma unroll
            for (int k = 0; k < 8; ++k) { const size_t cn = (size_t)(bh * 128 + n0 + k);
                *(GAS unsigned*)(sst + (cn * 256 + e) * 128 + 2 * d2) = pk2(s0, s1);
                s0 = s0 * dv[k].x + __uint_as_float(zz[k] << 16); s1 = s1 * dv[k].y + __uint_as_float(zz[k] & 0xffff0000u); }
        }
    }
}
__device__ __forceinline__ void gla_g3(Frame& F) {
    using namespace gla;
    LAS unsigned char* lds = F.lds + RING_OFF; const int tid = F.tid, lane = F.lane, w = F.wave, hi = lane >> 5, qc = lane & 31;
    unsigned char* ws = F.ws; const bf16* qkvg = (const bf16*)(ws + WS_QKVG); const float* bcum = (const float*)(ws + WS_BCUM); const bf16* sst = (const bf16*)(ws + WS_SST);
    bf16* o1 = (bf16*)(ws + WS_O1); const float* hng = inptr(F, 18);
    LAS float* SSQ = (LAS float*)(lds + SSQ_OFF);
    const int d = tid & 127, ig = tid >> 7;
    const int a = (lane >> 4) & 1, q_ = (lane & 15) >> 2, p_ = lane & 3;
    for (int un = F.wg; un < 1024; un += F.G) {
        const int bh = un >> 7, n = un & 127, b = bh >> 2, h = bh & 3; const size_t m0 = (size_t)b * T + 64 * n;
        __syncthreads();
        gla_load_v(lds, VH3_OFF, qkvg, m0, 1024 + h * 256, tid);
        v4u sreg[8];
        { const bf16* sp = sst + (size_t)(bh * 128 + n) * 256 * 128;
#pragma unroll
          for (int k = 0; k < 8; ++k) { const int q = tid + 512 * k, row = q >> 4, ch = q & 15; sreg[k] = *(const GAS v4u*)(sp + row * 128 + ch * 8); } }
        { const float bref = bcum[(m0 + 32) * 512 + h * 128 + d];
          float bb[16]; bf16 qr[16], kr[16];
#pragma unroll
          for (int ii = 0; ii < 16; ++ii) { const size_t mi = m0 + 16 * ig + ii; bb[ii] = *(const GAS float*)(bcum + mi * 512 + h * 128 + d);
              qr[ii] = *(const GAS bf16*)(qkvg + mi * 3072 + h * 128 + d); kr[ii] = *(const GAS bf16*)(qkvg + mi * 3072 + 512 + h * 128 + d); }
#pragma unroll
          for (int ii = 0; ii < 16; ++ii) { const int i = 16 * ig + ii; const float qv = bf2f(qr[ii]), kv = bf2f(kr[ii]);
              *(LAS bf16*)(lds + QT_OFF + i * QS_STR + d * 2) = (bf16)f2bf(qv * __expf(bb[ii] - bref));
              *(LAS bf16*)(lds + KT_OFF + i * QS_STR + d * 2) = (bf16)f2bf(kv * __expf(bref - bb[ii]));
              *(LAS bf16*)(lds + QS_OFF + i * QS_STR + d * 2) = (bf16)f2bf(qv * __expf(bb[ii])); } }
        __syncthreads();
        if (w < 4) {
            const int jb = w >> 1, ib = w & 1; f32x16 acc;
#pragma unroll
            for (int r = 0; r < 16; ++r) acc[r] = 0.f;
#pragma unroll
            for (int s = 0; s < 8; ++s) { const bf16x8 afr = *(const LAS bf16x8*)(lds + KT_OFF + (32 * jb + qc) * QS_STR + 32 * s + 16 * hi), bfr = *(const LAS bf16x8*)(lds + QT_OFF + (32 * ib + qc) * QS_STR + 32 * s + 16 * hi);
                acc = __builtin_amdgcn_mfma_f32_32x32x16_bf16(afr, bfr, acc, 0, 0, 0); }
            const int i = 32 * ib + qc;
#pragma unroll
            for (int a4 = 0; a4 < 4; ++a4) { float v[4];
#pragma unroll
                for (int k = 0; k < 4; ++k) { const int j = 32 * jb + 8 * a4 + 4 * hi + k; v[k] = (j <= i) ? acc[4 * a4 + k] : 0.f; }
                v2u wv; wv.x = pg8::cvtpk_c(v[0], v[1]); wv.y = pg8::cvtpk_c(v[2], v[3]);
                *(LAS v2u*)(lds + AL_OFF + i * AL_STR + (32 * jb + 8 * a4 + 4 * hi) * 2) = wv; }
        }
        __syncthreads();
#pragma unroll
        for (int k = 0; k < 8; ++k) { const int q = tid + 512 * k, row = q >> 4, ch = q & 15; *(LAS v4u*)(lds + ST_OFF + row * ST_STR + ch * 16) = sreg[k]; }
        v4u ggr[4];
#pragma unroll
        for (int k = 0; k < 4; ++k) { const int q = tid + 512 * k, row = q >> 5, ch = q & 31; ggr[k] = *(const GAS v4u*)(qkvg + (m0 + row) * 3072 + 2048 + h * 256 + ch * 8); }
        __syncthreads();
        const int ib = w & 1, eq = w >> 1; f32x16 acc2[2];
#pragma unroll
        for (int r = 0; r < 16; ++r) { acc2[0][r] = 0.f; acc2[1][r] = 0.f; }
#pragma unroll
        for (int s = 0; s < 4; ++s) { const bf16x8 bfr = *(const LAS bf16x8*)(lds + AL_OFF + (32 * ib + qc) * AL_STR + 32 * s + 16 * hi);
#pragma unroll
            for (int e2 = 0; e2 < 2; ++e2) { const bf16x8 afr = trfrag(lds + VH3_OFF + (16 * s + 8 * hi + q_) * VH_STR + (32 * (2 * eq + e2) + 16 * a + 4 * p_) * 2, 4 * VH_STR);
                acc2[e2] = __builtin_amdgcn_mfma_f32_32x32x16_bf16(afr, bfr, acc2[e2], 0, 0, 0); } }
#pragma unroll
        for (int s = 0; s < 8; ++s) { const bf16x8 bfr = *(const LAS bf16x8*)(lds + QS_OFF + (32 * ib + qc) * QS_STR + 32 * s + 16 * hi);
#pragma unroll
            for (int e2 = 0; e2 < 2; ++e2) { const bf16x8 afr = *(const LAS bf16x8*)(lds + ST_OFF + (32 * (2 * eq + e2) + qc) * ST_STR + 32 * s + 16 * hi);
                acc2[e2] = __builtin_amdgcn_mfma_f32_32x32x16_bf16(afr, bfr, acc2[e2], 0, 0, 0); } }
        float ss = 0.f;
#pragma unroll
        for (int r = 0; r < 16; ++r) ss += acc2[0][r] * acc2[0][r] + acc2[1][r] * acc2[1][r];
        ss += __shfl_xor(ss, 32);
        const int i = 32 * ib + qc;
        if (hi == 0) SSQ[i * 4 + eq] = ss;
        __syncthreads();
#pragma unroll
        for (int e2 = 0; e2 < 2; ++e2)
#pragma unroll
            for (int a4 = 0; a4 < 4; ++a4) *(LAS f32x4*)(lds + OL_OFF + i * OL_STR + (32 * (2 * eq + e2) + 8 * a4 + 4 * hi) * 4) = (f32x4){acc2[e2][4 * a4], acc2[e2][4 * a4 + 1], acc2[e2][4 * a4 + 2], acc2[e2][4 * a4 + 3]};
        __syncthreads();
#pragma unroll
        for (int k = 0; k < 4; ++k) { const int q = tid + 512 * k, row = q >> 5, ch = q & 31;
            const float tot = (SSQ[row * 4 + 0] + SSQ[row * 4 + 1]) + (SSQ[row * 4 + 2] + SSQ[row * 4 + 3]); const float rstd = 1.f / sqrtf(tot * (1.f / 256.f) + RMS_EPS);
            const f32x4 oa = *(const LAS f32x4*)(lds + OL_OFF + row * OL_STR + ch * 32), ob = *(const LAS f32x4*)(lds + OL_OFF + row * OL_STR + ch * 32 + 16);
            const v4u gg = ggr[k];
            const f32x4 na = *(const GAS f32x4*)(hng + h * 256 + ch * 8), nb = *(const GAS f32x4*)(hng + h * 256 + ch * 8 + 4);
            const float g0 = __uint_as_float(gg.x << 16), g1 = __uint_as_float(gg.x & 0xffff0000u), g2 = __uint_as_float(gg.y << 16), g3 = __uint_as_float(gg.y & 0xffff0000u);
            const float g4 = __uint_as_float(gg.z << 16), g5 = __uint_as_float(gg.z & 0xffff0000u), g6 = __uint_as_float(gg.w << 16), g7 = __uint_as_float(gg.w & 0xffff0000u);
            v4u wv; wv.x = pg8::cvtpk_c(oa[0] * rstd * na[0] * pg8::silu1(g0), oa[1] * rstd * na[1] * pg8::silu1(g1)); wv.y = pg8::cvtpk_c(oa[2] * rstd * na[2] * pg8::silu1(g2), oa[3] * rstd * na[3] * pg8::silu1(g3));
            wv.z = pg8::cvtpk_c(ob[0] * rstd * nb[0] * pg8::silu1(g4), ob[1] * rstd * nb[1] * pg8::silu1(g5)); wv.w = pg8::cvtpk_c(ob[2] * rstd * nb[2] * pg8::silu1(g6), ob[3] * rstd * nb[3] * pg8::silu1(g7));
            *(GAS v4u*)(o1 + (m0 + row) * 1024 + h * 256 + ch * 8) = wv; }
    }
}
__device__ __forceinline__ void ln_router(Frame& F, const bf16* tin, const float* gain, const float* bias, bf16* xb) {
    LAS unsigned char* lds = F.lds + RING_OFF; const int lane = F.lane, w = F.wave;
    unsigned char* ws = F.ws; const float* wr = inptr(F, 22);
    int* toke = (int*)(ws + WS_TOKE); float* tokw = (float*)(ws + WS_TOKW); int* tokp = (int*)(ws + WS_TOKP); int* cntl = (int*)(ws + WS_CNTL);
    const int RPW = M / F.G, RPV = RPW / NWAVES;
    LAS int* EL = (LAS int*)lds;
    f32x4 gv[4], bv[4];
#pragma unroll
    for (int j = 0; j < 4; ++j) { gv[j] = *((const GAS f32x4*)gain + lane + 64 * j); bv[j] = *((const GAS f32x4*)bias + lane + 64 * j); }
    LAS float* WL = (LAS float*)(lds + 1024);
    __syncthreads();
    for (int c = F.tid; c < D; c += NWAVES * 64) { const f32x4 w0 = *(const GAS f32x4*)(wr + (size_t)c * 8), w1 = *(const GAS f32x4*)(wr + (size_t)c * 8 + 4);
        const int rec = (4 * (c >> 8) + (c & 3)) * 64 + ((c & 255) >> 2); *(LAS f32x4*)(WL + rec * 8) = w0; *(LAS f32x4*)(WL + rec * 8 + 4) = w1; }
    v2u raw[8][4];
#pragma unroll
    for (int rr = 0; rr < 8; ++rr) if (rr < RPV) { const GAS v2u* xr = (const GAS v2u*)(tin + (size_t)(F.wg * RPW + w * RPV + rr) * D) + lane;
#pragma unroll
        for (int j = 0; j < 4; ++j) raw[rr][j] = xr[64 * j]; }
    __syncthreads();
#pragma unroll
    for (int rr = 0; rr < 8; ++rr) { if (rr >= RPV) break;
        const int lr = w * RPV + rr, m = F.wg * RPW + lr;
        f32x4 v[4]; float s = 0.f;
#pragma unroll
        for (int j = 0; j < 4; ++j) { v[j] = bf4(raw[rr][j]); s += (v[j].x + v[j].y) + (v[j].z + v[j].w); }
        const float mean = wave_sum(s) * (1.f / D); float s2 = 0.f;
#pragma unroll
        for (int j = 0; j < 4; ++j) { v[j] = v[j] - mean; s2 += (v[j].x * v[j].x + v[j].y * v[j].y) + (v[j].z * v[j].z + v[j].w * v[j].w); }
        const float rstd = 1.f / sqrtf(wave_sum(s2) * (1.f / D) + LN_EPS);
        GAS unsigned long long* o8 = (GAS unsigned long long*)(xb + (size_t)m * D) + lane;
        float lg[8];
#pragma unroll
        for (int e = 0; e < 8; ++e) lg[e] = 0.f;
#pragma unroll
        for (int j = 0; j < 4; ++j) { const f32x4 y = v[j] * rstd * gv[j] + bv[j]; o8[64 * j] = (unsigned long long)pk2(y.x, y.y) | ((unsigned long long)pk2(y.z, y.w) << 32);
#pragma unroll
            for (int k = 0; k < 4; ++k) { const LAS float* rp = WL + ((4 * j + k) * 64 + lane) * 8; const f32x4 w0 = *(const LAS f32x4*)rp, w1 = *(const LAS f32x4*)(rp + 4);
                lg[0] += y[k] * w0[0]; lg[1] += y[k] * w0[1]; lg[2] += y[k] * w0[2]; lg[3] += y[k] * w0[3]; lg[4] += y[k] * w1[0]; lg[5] += y[k] * w1[1]; lg[6] += y[k] * w1[2]; lg[7] += y[k] * w1[3]; } }
#pragma unroll
        for (int e = 0; e < 8; ++e) lg[e] = wave_sum(lg[e]);
        int e1 = 0; float v1 = lg[0];
#pragma unroll
        for (int e = 1; e < 8; ++e) if (lg[e] > v1) { v1 = lg[e]; e1 = e; }
        int e2 = -1; float v2 = -3.4e38f;
#pragma unroll
        for (int e = 0; e < 8; ++e) if (e != e1 && lg[e] > v2) { v2 = lg[e]; e2 = e; }
        const float w2 = 1.f / (1.f + __expf(v1 - v2)), w1 = 1.f - w2;
        if (lane == 0) { toke[m * 2] = e1; toke[m * 2 + 1] = e2; tokw[m * 2] = w1; tokw[m * 2 + 1] = w2; EL[lr] = e1; EL[RPW + lr] = e2; }
    }
    __syncthreads();
    if (w == 0) {
        const bool act = lane < RPW; int base[8];
#pragma unroll
        for (int e = 0; e < 8; ++e) base[e] = 0;
        const unsigned long long ltm = (1ull << lane) - 1ull;
#pragma unroll
        for (int k = 0; k < 2; ++k) { const int ek = act ? EL[k * RPW + lane] : -1; int pos = 0;
#pragma unroll
            for (int e = 0; e < 8; ++e) { const unsigned long long mk = __ballot(ek == e); if (ek == e) pos = base[e] + __popcll(mk & ltm); base[e] += __popcll(mk); }
            if (act) tokp[(F.wg * RPW + lane) * 2 + k] = pos; }
        if (lane < 8) { int cv = 0;
#pragma unroll
            for (int e = 0; e < 8; ++e) if (lane == e) cv = base[e];
            cntl[F.wg * 8 + lane] = cv; }
    }
}
__device__ __forceinline__ void moe_tables(Frame& F) {
    LAS int* TP = (LAS int*)(F.lds + LDSCTL_OFF); LAS int* BASE = TP + 16; LAS int* ACC = TP + 32;
    const int* cntl = (const int*)(F.ws + WS_CNTL);
    __syncthreads();
    if (F.tid < 16) ACC[F.tid] = 0;
    __syncthreads();
    int tot = 0, pre = 0; const int e = F.tid & 7;
    for (int wq = F.tid >> 3; wq < F.G; wq += 64) { const int cv = __hip_atomic_load(cntl + wq * 8 + e, __ATOMIC_RELAXED, __HIP_MEMORY_SCOPE_AGENT); tot += cv; if (wq < F.wg) pre += cv; }
    __hip_atomic_fetch_add(ACC + e, tot, __ATOMIC_RELAXED, __HIP_MEMORY_SCOPE_WORKGROUP); __hip_atomic_fetch_add(ACC + 8 + e, pre, __ATOMIC_RELAXED, __HIP_MEMORY_SCOPE_WORKGROUP);
    __syncthreads();
    if (F.tid == 0) { int tp = 0;
        for (int k = 0; k < 8; ++k) { TP[k] = tp; BASE[k] = tp * 256 + ACC[8 + k]; tp += (ACC[k] + 255) >> 8; }
        TP[8] = tp; }
    __syncthreads();
}
__device__ __forceinline__ void moe_gather(Frame& F) {
    moe_tables(F);
    LAS int* BASE = (LAS int*)(F.lds + LDSCTL_OFF) + 16;
    unsigned char* ws = F.ws; const int* toke = (const int*)(ws + WS_TOKE); const int* tokp = (const int*)(ws + WS_TOKP); int* toks = (int*)(ws + WS_TOKS);
    const bf16* xb = (const bf16*)(ws + WS_XB); bf16* xg = (bf16*)(ws + WS_XG);
    const int RPW = M / F.G;
    for (int q0 = F.wave; q0 < 2 * RPW; q0 += 4 * NWAVES) {
        int mm[4], sl[4]; v4u ra[4], rb[4];
#pragma unroll
        for (int u = 0; u < 4; ++u) { const int q = q0 + u * NWAVES; const bool ok = q < 2 * RPW; const int m = F.wg * RPW + (q >> 1), k = q & 1; mm[u] = ok ? m * 2 + k : -1;
            const int e = ok ? toke[m * 2 + k] : 0; sl[u] = BASE[e] + (ok ? tokp[m * 2 + k] : 0); }
#pragma unroll
        for (int u = 0; u < 4; ++u) if (mm[u] >= 0) { const GAS v4u* src = (const GAS v4u*)(xb + (size_t)(mm[u] >> 1) * D) + F.lane; ra[u] = src[0]; rb[u] = src[64]; }
#pragma unroll
        for (int u = 0; u < 4; ++u) if (mm[u] >= 0) { if (F.lane == 0) toks[mm[u]] = sl[u]; GAS v4u* dst = (GAS v4u*)(xg + (size_t)sl[u] * D) + F.lane; dst[0] = ra[u]; dst[64] = rb[u]; }
    }
}
__device__ __forceinline__ void moe_final(Frame& F) {
    const int gw = F.vcu * NWAVES + F.wave, NGW = F.G * NWAVES, lane = F.lane;
    unsigned char* ws = F.ws; const bf16* xres = (const bf16*)(ws + WS_XB); const bf16* yb = (const bf16*)(ws + WS_YB); constexpr size_t KSTR = (WS_YB1 - WS_YB) / 2;
    const int* toks = (const int*)(ws + WS_TOKS); const float* tokw = (const float*)(ws + WS_TOKW); const float* gain = inptr(F, 25); const float* bias = inptr(F, 26);
    f32x4 gv[4], bv[4];
#pragma unroll
    for (int j = 0; j < 4; ++j) { gv[j] = *((const GAS f32x4*)gain + lane + 64 * j); bv[j] = *((const GAS f32x4*)bias + lane + 64 * j); }
    for (int m0 = gw; m0 < M; m0 += 4 * NGW) {
        int s1[4], s2[4]; float w1[4], w2[4];
#pragma unroll
        for (int k = 0; k < 4; ++k) { const int m = m0 + k * NGW; const bool ok = m < M; s1[k] = ok ? toks[m * 2] : 0; s2[k] = ok ? toks[m * 2 + 1] : 0; w1[k] = ok ? tokw[m * 2] : 0.f; w2[k] = ok ? tokw[m * 2 + 1] : 0.f; }
        v2u xr_[4][4], ya_[4][4], yc_[4][4];
#pragma unroll
        for (int k = 0; k < 4; ++k) { const int m = m0 + k * NGW; if (m < M) {
            const GAS v2u* xr = (const GAS v2u*)(xres + (size_t)m * D) + lane;
            const GAS v2u* y1 = (const GAS v2u*)(s1[k] < 32768 ? yb + (size_t)s1[k] * D : yb + KSTR + (size_t)(s1[k] - 32768) * D) + lane;
            const GAS v2u* y2 = (const GAS v2u*)(s2[k] < 32768 ? yb + (size_t)s2[k] * D : yb + KSTR + (size_t)(s2[k] - 32768) * D) + lane;
#pragma unroll
            for (int j = 0; j < 4; ++j) { xr_[k][j] = xr[64 * j]; ya_[k][j] = y1[64 * j]; yc_[k][j] = y2[64 * j]; } } }
#pragma unroll
        for (int k = 0; k < 4; ++k) { const int m = m0 + k * NGW; if (m >= M) break;
            f32x4 v[4], ya[4], yc[4];
#pragma unroll
            for (int j = 0; j < 4; ++j) { ya[j] = bf4(ya_[k][j]); yc[j] = bf4(yc_[k][j]); }
            if (s1[k] >= 32768) { for (int ks = 1; ks < 7; ++ks) { const GAS v2u* y1 = (const GAS v2u*)(yb + KSTR + ((size_t)ks * 2048 + (s1[k] - 32768)) * D) + lane;
#pragma unroll
                for (int j = 0; j < 4; ++j) ya[j] += bf4(y1[64 * j]); } }
            if (s2[k] >= 32768) { for (int ks = 1; ks < 7; ++ks) { const GAS v2u* y2 = (const GAS v2u*)(yb + KSTR + ((size_t)ks * 2048 + (s2[k] - 32768)) * D) + lane;
#pragma unroll
                for (int j = 0; j < 4; ++j) yc[j] += bf4(y2[64 * j]); } }
            float s = 0.f;
#pragma unroll
            for (int j = 0; j < 4; ++j) { const f32x4 x = bf4(xr_[k][j]); v[j] = x * ALPHA + (ya[j] * w1[k] + yc[j] * w2[k]); s += (v[j].x + v[j].y) + (v[j].z + v[j].w); }
            const float mean = wave_sum(s) * (1.f / D); float q2 = 0.f;
#pragma unroll
            for (int j = 0; j < 4; ++j) { v[j] = v[j] - mean; q2 += (v[j].x * v[j].x + v[j].y * v[j].y) + (v[j].z * v[j].z + v[j].w * v[j].w); }
            const float rstd = 1.f / sqrtf(wave_sum(q2) * (1.f / D) + LN_EPS);
            GAS f32x4* xo = (GAS f32x4*)(F.out + (size_t)m * D) + lane;
#pragma unroll
            for (int j = 0; j < 4; ++j) xo[64 * j] = v[j] * rstd * gv[j] + bv[j];
        }
    }
}
__global__ void __launch_bounds__(NWAVES * 64, 2) fwd(Args args) {
    extern __shared__ __attribute__((aligned(16))) unsigned char lds[];
    Frame F;
    F.A = &args;
    F.lds = (LAS unsigned char*)lds;
    F.MISC = (volatile LAS unsigned*)(F.lds + MISC_OFF);
    F.tid = threadIdx.x; F.lane = F.tid & 63; F.wave = __builtin_amdgcn_readfirstlane(F.tid >> 6);
    F.G = gridDim.x; F.wg = blockIdx.x; { const int bx = blockIdx.x; F.vcu = (F.G % 8 == 0) ? (bx % 8) * (F.G / 8) + bx / 8 : bx; }
    F.ws = args.ws; F.out = args.out;
    unsigned char* ws = args.ws;
    F.ctl = (gu32*)(ws + WS_CTL);
    for (int u = F.tid; u < (LDS_BYTES - LDSCTL_OFF) / 4; u += NWAVES * 64) ((LAS unsigned*)(F.lds + LDSCTL_OFF))[u] = 0u;
    __syncthreads();
    XcdBarrier bar; bar.bar = (unsigned*)(F.ctl + CW_BAR); bar.x = 0; bar.st = nullptr;
    if (!MK_PER_PHASE) bar = xcd_barrier_post((unsigned*)(F.ctl + CW_BAR), F.MISC + 8);
#define GRID_BAR() do { if (!MK_PER_PHASE) xcd_barrier(bar); } while (0)
    const int lo = args.ph_lo, hi = args.ph_hi;
#define IN(k) (lo <= (k) && (k) < hi)
#define SEAM(k) do { if (IN((k) + 1)) GRID_BAR(); } while (0)
    bf16* XB = (bf16*)(ws + WS_XB); bf16* T0 = (bf16*)(ws + WS_T0);
    const int cwg = (int)blockIdx.x;

#ifndef HANDOFF
#define HANDOFF 0
#endif
#ifndef PROBE_REP
#define PROBE_REP -1
#endif
#define REP(k) (PROBE_REP == (k) ? 2 : 1)
    if (IN(0)) { for (int rep = 0; rep < REP(0); ++rep) { if (rep) GRID_BAR(); p0_prologue(F); } SEAM(0); }
    if (IN(1)) { pg8::Gemm g{XB, (const bf16*)(ws + WS_WIN0), M, NSA_IN_PAD, D, D}; pg8::StaticOrder S; S.init(M, NSA_IN_PAD, F.G, cwg);
        pg8::EpiNsaIn E{(bf16*)(ws + WS_Q), (bf16*)(ws + WS_KV2), (bf16*)(ws + WS_KS), (bf16*)(ws + WS_VS), (bf16*)(ws + WS_KW), (bf16*)(ws + WS_VW), (float*)(ws + WS_GT), 0.125f * LOG2E};
        pg8::gemm_phase<pg8::EpiNsaIn, pg8::StaticOrder, PG8_ALIGN, PG8_SP2>(F.lds + RING_OFF, g, S, E); SEAM(1); }
    if (IN(2)) { pg8::Gemm g{(const bf16*)(ws + WS_KV2), (const bf16*)(ws + WS_W1C), 8192, 1024, 1024, 1024}; pg8::CmpOrder S{F.G, cwg}; pg8::EpiF32Cmp E{(float*)(ws + WS_UL)};
        pg8::gemm_phase<pg8::EpiF32Cmp, pg8::CmpOrder, PG8_ALIGN, PG8_SP2>(F.lds + RING_OFF, g, S, E);
        SEAM(2); }
    if (IN(3)) { cmp_finish(F); SEAM(3); }
    if (IN(4)) { for (int rep = 0; rep < REP(4); ++rep) { if (rep) GRID_BAR(); nsa_attn_phase(F); } SEAM(4); }
    if (IN(5)) { pg8::Gemm g{(const bf16*)(ws + WS_O), (const bf16*)(ws + WS_WO0), M, D, D, D}; pg8::StaticOrder S; S.init(M, D, F.G, cwg); pg8::EpiResBf16<false> E{inptr(F, 0), T0, ALPHA};
        pg8::gemm_phase<pg8::EpiResBf16<false>, pg8::StaticOrder, PG8_ALIGN, PG8_SP2>(F.lds + RING_OFF, g, S, E); SEAM(5); }
    if (IN(6)) { ln_rows(F, T0, inptr(F, 9), inptr(F, 10), XB); SEAM(6); }
#if HANDOFF
    if (IN(7)) { pg8::Gemm g{XB, (const bf16*)(ws + WS_WGU0), M, 2 * FF0, D, D}; pg8::PubOrder<pg8::StaticOrder> S; S.init(M, 2 * FF0, F.G, cwg); S.cnt = (unsigned*)(F.ctl + CW_PANEL0); S.pend = -1; pg8::EpiSwiGLU<true> E{(bf16*)(ws + WS_H0), FF0, 2 * FF0 / 256};
        pg8::gemm_phase<pg8::EpiSwiGLU<true>, pg8::PubOrder<pg8::StaticOrder>, PG8_ALIGN, PG8_SP2>(F.lds + RING_OFF, g, S, E); S.publish(); }
    if (IN(8)) { pg8::Gemm g{(const bf16*)(ws + WS_H0), (const bf16*)(ws + WS_WD0), M, D, FF0, FF0}; pg8::WaitOrder<pg8::StaticOrder> S; S.init(M, D, F.G, (cwg + F.G - (M / 256 * (2 * FF0 / 256)) % F.G) % F.G); S.ready = (const unsigned*)(F.ctl + CW_PANEL0); S.need = 8u * (2 * FF0 / 256); S.tmo = (unsigned*)(F.ctl + CW_TMO);
        pg8::EpiResBf16<true> E{XB, T0, ALPHA};
        pg8::gemm_phase<pg8::EpiResBf16<true>, pg8::WaitOrder<pg8::StaticOrder>, PG8_ALIGN, PG8_SP2>(F.lds + RING_OFF, g, S, E); SEAM(8); }
#else
    if (IN(7)) { for (int rep = 0; rep < REP(7); ++rep) { if (rep) GRID_BAR(); pg8::Gemm g{XB, (const bf16*)(ws + WS_WGU0), M, 2 * FF0, D, D}; pg8::StaticOrder S; S.init(M, 2 * FF0, F.G, cwg); pg8::EpiSwiGLU<false> E{(bf16*)(ws + WS_H0), FF0, 2 * FF0 / 256};
        pg8::gemm_phase<pg8::EpiSwiGLU<false>, pg8::StaticOrder, PG8_ALIGN, PG8_SP2>(F.lds + RING_OFF, g, S, E); } SEAM(7); }
    if (IN(8)) { for (int rep = 0; rep < REP(8); ++rep) { if (rep) GRID_BAR(); pg8::Gemm g{(const bf16*)(ws + WS_H0), (const bf16*)(ws + WS_WD0), M, D, FF0, FF0}; pg8::StaticOrder S; S.init(M, D, F.G, cwg); pg8::EpiResBf16<true> E{XB, T0, ALPHA};
        pg8::gemm_phase<pg8::EpiResBf16<true>, pg8::StaticOrder, PG8_ALIGN, PG8_SP2>(F.lds + RING_OFF, g, S, E); } SEAM(8); }
#endif
    if (IN(9)) { ln_rows(F, T0, inptr(F, 13), inptr(F, 14), XB); SEAM(9); }
    if (IN(10)) { pg8::Gemm g{XB, (const bf16*)(ws + WS_WIN1), M, 3072, D, D}; pg8::StaticOrder S; S.init(M, 3072, F.G, cwg);     pg8::EpiGlaIn E{(bf16*)(ws + WS_QKVG), (float*)(ws + WS_ALOW), 0.08838834764831845f};
        pg8::gemm_phase<pg8::EpiGlaIn, pg8::StaticOrder, PG8_ALIGN, PG8_SP2>(F.lds + RING_OFF, g, S, E); SEAM(10); }
    for (int rep = 0; rep < REP(11); ++rep) { if (rep) GRID_BAR();
    if (IN(11)) { gla_g1(F); SEAM(11); }
    if (IN(12)) { gla_g2(F); SEAM(12); }
    if (IN(13)) { gla_g3(F); if (rep + 1 == REP(11)) SEAM(13); }
    }
    if (IN(14)) { pg8::Gemm g{(const bf16*)(ws + WS_O1), (const bf16*)(ws + WS_WO1), M, D, D, D}; pg8::StaticOrder S; S.init(M, D, F.G, cwg); pg8::EpiResBf16<true> E{XB, T0, ALPHA};
        pg8::gemm_phase<pg8::EpiResBf16<true>, pg8::StaticOrder, PG8_ALIGN, PG8_SP2>(F.lds + RING_OFF, g, S, E); SEAM(14); }
    if (IN(15)) { ln_router(F, T0, inptr(F, 20), inptr(F, 21), XB); SEAM(15); }
    if (IN(16)) { moe_gather(F); SEAM(16); }
#if 0
    if (IN(17)) { moe_tables(F); pg8::Gemm g{(const bf16*)(ws + WS_XG), (const bf16*)(ws + WS_WGU1), MAXSLOTS, NE * 2 * FFE, D, D};
        pg8::PubOrder<pg8::GroupedOrder> S; S.G = F.G; S.c = cwg; S.NT = 2 * FFE / 256; S.KS = 1; S.KL = 0; S.tp = (const PG8_LAS int*)(F.lds + LDSCTL_OFF); S.cnt = (unsigned*)(F.ctl + CW_PANEL1); S.pend = -1;
        pg8::EpiSwiGLU<true> E{(bf16*)(ws + WS_H2), FFE, 2 * FFE / 256};
        pg8::gemm_phase<pg8::EpiSwiGLU<true>, pg8::PubOrder<pg8::GroupedOrder>, PG8_ALIGN, PG8_SP2>(F.lds + RING_OFF, g, S, E); S.publish(); }
    if (IN(18)) { moe_tables(F); pg8::Gemm g{(const bf16*)(ws + WS_H2), (const bf16*)(ws + WS_WD1), MAXSLOTS, NE * D, FFE / MOE_KS, FFE};
        pg8::WaitOrder<pg8::GroupedOrder> S; S.G = F.G; S.NT = D / 256; S.KS = MOE_KS; S.KL = FFE / MOE_KS; S.tp = (const PG8_LAS int*)(F.lds + LDSCTL_OFF);
        { const int n17 = S.tp[8] * (2 * FFE / 256); S.c = (cwg + F.G - ((n17 % F.G) & ~7)) % F.G; }
        S.ready = (const unsigned*)(F.ctl + CW_PANEL1); S.need = 8u * (2 * FFE / 256); S.tmo = (unsigned*)(F.ctl + CW_TMO); pg8::EpiBf16Y E{(bf16*)(ws + WS_YB), (size_t)(WS_YB1 - WS_YB) / 2};
        pg8::gemm_phase<pg8::EpiBf16Y, pg8::WaitOrder<pg8::GroupedOrder>, PG8_ALIGN, PG8_SP2>(F.lds + RING_OFF, g, S, E); SEAM(18); }
#else
#ifndef STAGGER_US
#define STAGGER_US 0
#endif
    if (IN(17)) { for (int rep = 0; rep < REP(17); ++rep) { if (rep) GRID_BAR(); moe_tables(F);
        if (STAGGER_US) { const unsigned long long t0 = __builtin_amdgcn_s_memrealtime(), dl = (unsigned long long)((cwg >> 3) & 3) * (STAGGER_US * 100ull); while (__builtin_amdgcn_s_memrealtime() - t0 < dl) __builtin_amdgcn_s_sleep(8); }
        pg8::Gemm g{(const bf16*)(ws + WS_XG), (const bf16*)(ws + WS_WGU1), MAXSLOTS, NE * 2 * FFE, D, D};
        pg8::GroupedOrder S{F.G, cwg, 2 * FFE / 256, 1, 0, (const PG8_LAS int*)(F.lds + LDSCTL_OFF)}; pg8::EpiSwiGLU<false> E{(bf16*)(ws + WS_H2), FFE, 2 * FFE / 256};
        pg8::gemm_phase<pg8::EpiSwiGLU<false>, pg8::GroupedOrder, PG8_ALIGN, PG8_SP2>(F.lds + RING_OFF, g, S, E); } SEAM(17); }
    if (IN(18)) { for (int rep = 0; rep < REP(18); ++rep) { if (rep) GRID_BAR(); moe_tables(F);
        { pg8::Gemm g{(const bf16*)(ws + WS_H2), (const bf16*)(ws + WS_WD1), MAXSLOTS, NE * D, FFE, FFE}; pg8::MoeDownOrder S{F.G, cwg, 0, (const PG8_LAS int*)(F.lds + LDSCTL_OFF)};
          pg8::EpiBf16Y2 E{(bf16*)(ws + WS_YB), (bf16*)(ws + WS_YB1), 0}; pg8::gemm_phase<pg8::EpiBf16Y2, pg8::MoeDownOrder, PG8_ALIGN, PG8_SP2>(F.lds + RING_OFF, g, S, E); }
        { pg8::Gemm g{(const bf16*)(ws + WS_H2), (const bf16*)(ws + WS_WD1), MAXSLOTS, NE * D, 512, FFE}; pg8::MoeDownOrder S{F.G, cwg, 1, (const PG8_LAS int*)(F.lds + LDSCTL_OFF)};
          pg8::EpiBf16Y2 E{(bf16*)(ws + WS_YB), (bf16*)(ws + WS_YB1), 1}; pg8::gemm_phase<pg8::EpiBf16Y2, pg8::MoeDownOrder, PG8_ALIGN, PG8_SP2>(F.lds + RING_OFF, g, S, E); } } SEAM(18); }
#endif
    if (IN(19)) { moe_final(F); }
#undef IN
#undef SEAM
#undef GRID_BAR
}

extern "C" void kernel_launch(void* const* d_in, const int* in_sizes, int n_in, void* d_out, int out_size, void* d_ws, size_t ws_size, hipStream_t stream) {
    static int grid = 0;
    if (grid == 0) {
        if (n_in != 27 || in_sizes[0] != M * D || out_size != M * D || ws_size < WS_END) { fprintf(stderr, "kernel_launch: unexpected problem shape (n_in %d, in0 %d, out %d, ws %zu); nothing launched\n", n_in, n_in > 0 ? in_sizes[0] : -1, out_size, ws_size); grid = -1; return; }
        if (hipFuncSetAttribute((const void*)fwd, hipFuncAttributeMaxDynamicSharedMemorySize, LDS_BYTES) != hipSuccess) { fprintf(stderr, "kernel_launch: hipFuncSetAttribute failed\n"); grid = -1; return; }
        int dev = 0, cus = 0, per_cu = 0;
        (void)hipGetDevice(&dev); (void)hipDeviceGetAttribute(&cus, hipDeviceAttributeMultiprocessorCount, dev);
        if (hipOccupancyMaxActiveBlocksPerMultiprocessor(&per_cu, (const void*)fwd, NWAVES * 64, LDS_BYTES) != hipSuccess || per_cu < 1) fprintf(stderr, "kernel_launch: note: occupancy query reports %d workgroups per CU\n", per_cu);
        (void)hipGetLastError();
        grid = 256;
        if (cus < 256) fprintf(stderr, "kernel_launch: device has %d CUs; this kernel needs 256 resident workgroups\n", cus);
    }
    if (grid < 0) return;
    if (hipMemsetAsync((char*)d_ws + WS_CTL, 0, CTL_ZERO_BYTES, stream) != hipSuccess) { fprintf(stderr, "kernel_launch: hipMemsetAsync failed\n"); return; }
    Args a{};
    for (int i = 0; i < 27; ++i) a.in[i] = (const float*)d_in[i];
    a.out = (float*)d_out; a.ws = (unsigned char*)d_ws;
#if MK_PER_PHASE
    for (int p = 0; p < N_PHASES; ++p) { a.ph_lo = p; a.ph_hi = p + 1; hipLaunchKernelGGL(fwd, dim3(grid), dim3(NWAVES * 64), LDS_BYTES, stream, a); }
#else
    a.ph_lo = 0; a.ph_hi = N_PHASES;
    hipLaunchKernelGGL(fwd, dim3(grid), dim3(NWAVES * 64), LDS_BYTES, stream, a);
#endif
    const hipError_t le = hipPeekAtLastError();
    if (le != hipSuccess) fprintf(stderr, "kernel_launch: launch failed: %s\n", hipGetErrorName(le));
}
```

```cpp
#include <hip/hip_runtime.h>
#include <cstdio>
#include <cstdint>
namespace pg8 {
#define PG8_LAS __attribute__((address_space(3)))
typedef unsigned short bf16_t;
typedef short bf16x8 __attribute__((ext_vector_type(8)));
typedef float f32x4 __attribute__((ext_vector_type(4)));
typedef unsigned u32x4 __attribute__((ext_vector_type(4)));
constexpr int BM = 256, BK = 64, HALF = 128, HTB = HALF * BK * 2  , STAGE_BYTES = 8 * HTB, NXCD = 8, WGM = 8;

__host__ __device__ __forceinline__ int lds_byte(int r, int c) { const int st = (r >> 4) * 2 + (c >> 5), rr = r & 15, cc = c & 31, ob = rr * 64 + cc * 2; return st * 1024 + (ob ^ (((ob >> 9) & 1) << 5)); }
__host__ __device__ __forceinline__ void stage_rc(int b, int& R, int& C) { const int st = b / 1024, sb = b % 1024, swz = sb ^ (((sb >> 9) & 1) << 5); R = (st >> 1) * 16 + swz / 64; C = (st & 1) * 32 + (swz % 64) / 2; }
__host__ __device__ __forceinline__ int perm32(int rho) { const int n = rho >> 4, i = rho & 15; return 8 * (i >> 2) + 4 * n + (i & 3); }

struct Unit { int pm, pn, ko; };
struct Gemm { const bf16_t* A; const bf16_t* Bt; int M, N, K, ld; };

struct StaticOrder {
    int nM, nN, nwg, G, c;
    __host__ __device__ void init(int M, int N, int G_, int c_) { nM = M / BM; nN = N / BM; nwg = nM * nN; G = G_; c = c_; }
    __host__ __device__ bool next(int i, Unit& u) const {
        const long L = (long)i * G + c; if (L >= nwg) return false;
        int wgid = (int)L; { const int q = nwg / NXCD, r = nwg % NXCD, xcd = wgid % NXCD, off = wgid / NXCD; wgid = (xcd < r ? xcd * (q + 1) : r * (q + 1) + (xcd - r) * q) + off; }
        const int nig = WGM * nN, gid = wgid / nig, fm = gid * WGM, gsz = (nM - fm) < WGM ? (nM - fm) : WGM;
        u.pm = fm + ((wgid % nig) % gsz); u.pn = (wgid % nig) / gsz; u.ko = 0; return true;
    }
    __device__ __forceinline__ void a_ready(const Unit&) const {}
    __device__ __forceinline__ void done(const Unit&) const {}
};
__device__ __forceinline__ unsigned cvt_pk_bf16(float lo, float hi) { unsigned r; asm volatile("v_cvt_pk_bf16_f32 %0, %1, %2" : "=v"(r) : "v"(lo), "v"(hi)); return r; }
typedef float f32x2 __attribute__((ext_vector_type(2)));
typedef __bf16 bf16x2_t_ __attribute__((ext_vector_type(2)));
__device__ __forceinline__ unsigned cvtpk_c(float lo, float hi) { f32x2 v = {lo, hi}; bf16x2_t_ b = __builtin_convertvector(v, bf16x2_t_); return __builtin_bit_cast(unsigned, b); }
__device__ __forceinline__ u32x4 pack8(const f32x4 v0, const f32x4 v1) { u32x4 w; w.x = cvt_pk_bf16(v0[0], v0[1]); w.y = cvt_pk_bf16(v0[2], v0[3]); w.z = cvt_pk_bf16(v1[0], v1[1]); w.w = cvt_pk_bf16(v1[2], v1[3]); return w; }
__device__ __forceinline__ float sigm(float x) { return __builtin_amdgcn_rcpf(1.0f + __builtin_amdgcn_exp2f(-1.44269504088896341f * x)); }
__device__ __forceinline__ float silu1(float x) { return x * __builtin_amdgcn_rcpf(1.0f + __builtin_amdgcn_exp2f(-1.44269504088896341f * x)); }

struct EpiNsaIn {
    static constexpr bool PERM = true, AFTER_DRAIN = false;
    bf16_t *Q, *KV2, *KS, *VS, *KW, *VW; float* GT; float qscale;
    __device__ __forceinline__ void operator()(const f32x4 (&acc)[2][2][4][2], const Unit& u, int wr, int wc, int fr, int fq) const {
        const int pn = u.pn, row0 = u.pm * BM + wr * 64 + fr, c8 = wc * 32 + 8 * fq;
#pragma unroll
        for (int ai = 0; ai < 2; ++ai)
#pragma unroll
            for (int m = 0; m < 4; ++m) { const int row = row0 + ai * HALF + m * 16;
#pragma unroll
                for (int bj = 0; bj < 2; ++bj) { const int col = bj * HALF + c8;
                    f32x4 v0 = acc[ai][bj][m][0], v1 = acc[ai][bj][m][1];
                    if (pn >= 10) { if (col < 48) { float* gp = GT + (size_t)row * 48 + col;
                            *(f32x4*)gp = (f32x4){sigm(v0[0]), sigm(v0[1]), sigm(v0[2]), sigm(v0[3])}; *(f32x4*)(gp + 4) = (f32x4){sigm(v1[0]), sigm(v1[1]), sigm(v1[2]), sigm(v1[3])}; }
                        continue; }
                    bf16_t* dst;
                    if (pn < 4) { v0 = v0 * qscale; v1 = v1 * qscale; dst = Q + (size_t)row * 1024 + pn * 256 + col; }
                    else if (pn < 6) { const int g = col >> 6, d = col & 63; dst = KV2 + (size_t)(pn - 4) * (4096 * 1024) + ((size_t)(((row >> 4) * 4 + g) * 16 + (row & 15))) * 64 + d; }
                    else { bf16_t* base = pn == 6 ? KS : pn == 7 ? VS : pn == 8 ? KW : VW; dst = base + (size_t)row * 256 + col; }
                    *(u32x4*)dst = pack8(v0, v1); } }
    }
};
struct EpiGlaIn {
    static constexpr bool PERM = true, AFTER_DRAIN = false;
    bf16_t* QKVG; float* ALOW; float qscale;
    __device__ __forceinline__ void operator()(const f32x4 (&acc)[2][2][4][2], const Unit& u, int wr, int wc, int fr, int fq) const {
        const int pn = u.pn, row0 = u.pm * BM + wr * 64 + fr, c8 = wc * 32 + 8 * fq;
#pragma unroll
        for (int ai = 0; ai < 2; ++ai)
#pragma unroll
            for (int m = 0; m < 4; ++m) { const int row = row0 + ai * HALF + m * 16;
#pragma unroll
                for (int bj = 0; bj < 2; ++bj) { const int col = bj * HALF + c8;
                    f32x4 v0 = acc[ai][bj][m][0], v1 = acc[ai][bj][m][1];
                    if (pn >= 12) { if (col < 16) { float* gp = ALOW + (size_t)row * 16 + col; *(f32x4*)gp = v0; *(f32x4*)(gp + 4) = v1; } continue; }
                    if (pn < 2) { v0 = v0 * qscale; v1 = v1 * qscale; }
                    *(u32x4*)(QKVG + (size_t)row * 3072 + pn * 256 + col) = pack8(v0, v1); } }
    }
};
struct EpiF32Cmp {
    static constexpr bool PERM = false, AFTER_DRAIN = false;
    float* C;
    __device__ __forceinline__ void operator()(const f32x4 (&acc)[2][2][4][2], const Unit& u, int wr, int wc, int fr, int fq) const {
        const int row0 = u.pm * BM + wr * 64 + fr, col0 = (u.pn & 1) * BM + wc * 32 + 4 * fq;
#pragma unroll
        for (int ai = 0; ai < 2; ++ai)
#pragma unroll
            for (int m = 0; m < 4; ++m) { float* rowp = C + (size_t)(row0 + ai * HALF + m * 16) * 512 + col0;
#pragma unroll
                for (int bj = 0; bj < 2; ++bj)
#pragma unroll
                    for (int n = 0; n < 2; ++n) *(f32x4*)(rowp + bj * HALF + n * 16) = acc[ai][bj][m][n]; }
    }
};
struct EpiResF32 {
    static constexpr bool PERM = false, AFTER_DRAIN = false;
    const float* base; float* out; float alpha;
    __device__ __forceinline__ void operator()(const f32x4 (&acc)[2][2][4][2], const Unit& u, int wr, int wc, int fr, int fq) const {
        const int row0 = u.pm * BM + wr * 64 + fr, col0 = u.pn * BM + wc * 32 + 4 * fq;
#pragma unroll
        for (int ai = 0; ai < 2; ++ai)
#pragma unroll
            for (int m = 0; m < 4; ++m) { const size_t off = (size_t)(row0 + ai * HALF + m * 16) * 1024 + col0;
#pragma unroll
                for (int bj = 0; bj < 2; ++bj)
#pragma unroll
                    for (int n = 0; n < 2; ++n) { const f32x4 bs = *(const f32x4*)(base + off + bj * HALF + n * 16); *(f32x4*)(out + off + bj * HALF + n * 16) = bs * alpha + acc[ai][bj][m][n]; } }
    }
};
template <bool BF> struct EpiResBf16 {
    static constexpr bool PERM = true, AFTER_DRAIN = false;
    const void* base; bf16_t* out; float alpha;
    __device__ __forceinline__ void operator()(const f32x4 (&acc)[2][2][4][2], const Unit& u, int wr, int wc, int fr, int fq) const {
        const int row0 = u.pm * BM + wr * 64 + fr, col0 = u.pn * BM + wc * 32 + 8 * fq;
#pragma unroll
        for (int ai = 0; ai < 2; ++ai)
#pragma unroll
            for (int m = 0; m < 4; ++m) { const size_t off = (size_t)(row0 + ai * HALF + m * 16) * 1024 + col0;
#pragma unroll
                for (int bj = 0; bj < 2; ++bj) { f32x4 b0, b1;
                    if (BF) { const u32x4 r = *(const u32x4*)((const bf16_t*)base + off + bj * HALF);
                        b0 = (f32x4){__uint_as_float(r.x << 16), __uint_as_float(r.x & 0xffff0000u), __uint_as_float(r.y << 16), __uint_as_float(r.y & 0xffff0000u)};
                        b1 = (f32x4){__uint_as_float(r.z << 16), __uint_as_float(r.z & 0xffff0000u), __uint_as_float(r.w << 16), __uint_as_float(r.w & 0xffff0000u)}; }
                    else { b0 = *(const f32x4*)((const float*)base + off + bj * HALF); b1 = *(const f32x4*)((const float*)base + off + bj * HALF + 4); }
                    *(u32x4*)(out + off + bj * HALF) = pack8(b0 * alpha + acc[ai][bj][m][0], b1 * alpha + acc[ai][bj][m][1]); } }
    }
};
__device__ __forceinline__ void store16_sc1(bf16_t* p, const u32x4 v) { asm volatile("global_store_dwordx4 %0, %1, off sc1\n\ts_nop 1" :: "v"(p), "v"(v) : "memory"); }
template <bool SC1> struct EpiSwiGLU {
    static constexpr bool PERM = true, AFTER_DRAIN = false;
    bf16_t* H; int ldh, nt;
    __device__ __forceinline__ void operator()(const f32x4 (&acc)[2][2][4][2], const Unit& u, int wr, int wc, int fr, int fq) const {
        const int row0 = u.pm * BM + wr * 64 + fr, col = (u.pn % nt) * HALF + wc * 32 + 8 * fq;
#pragma unroll
        for (int ai = 0; ai < 2; ++ai)
#pragma unroll
            for (int m = 0; m < 4; ++m) { const f32x4 a0 = acc[ai][0][m][0], a1 = acc[ai][0][m][1], b0 = acc[ai][1][m][0], b1 = acc[ai][1][m][1];
                const f32x4 h0 = (f32x4){silu1(a0[0]) * b0[0], silu1(a0[1]) * b0[1], silu1(a0[2]) * b0[2], silu1(a0[3]) * b0[3]};
                const f32x4 h1 = (f32x4){silu1(a1[0]) * b1[0], silu1(a1[1]) * b1[1], silu1(a1[2]) * b1[2], silu1(a1[3]) * b1[3]};
                bf16_t* dst = H + (size_t)(row0 + ai * HALF + m * 16) * ldh + col;
                if (SC1) store16_sc1(dst, pack8(h0, h1)); else *(u32x4*)dst = pack8(h0, h1); }
    }
};
struct EpiBf16Y {
    static constexpr bool PERM = true, AFTER_DRAIN = false;
    bf16_t* Y; size_t kstride;
    __device__ __forceinline__ void operator()(const f32x4 (&acc)[2][2][4][2], const Unit& u, int wr, int wc, int fr, int fq) const {
        const int row0 = u.pm * BM + wr * 64 + fr, col0 = (u.pn & 3) * BM + wc * 32 + 8 * fq;
#pragma unroll
        for (int ai = 0; ai < 2; ++ai)
#pragma unroll
            for (int m = 0; m < 4; ++m) { bf16_t* rowp = Y + (u.ko ? kstride : (size_t)0) + (size_t)(row0 + ai * HALF + m * 16) * 1024 + col0;
#pragma unroll
                for (int bj = 0; bj < 2; ++bj) *(u32x4*)(rowp + bj * HALF) = pack8(acc[ai][bj][m][0], acc[ai][bj][m][1]); }
    }
};
struct CmpOrder {
    int G, c;
    __device__ __forceinline__ bool next(int i, Unit& u) const { const long L = (long)i * G + c; if (L >= 64) return false; const int pm = (int)L >> 1; u.pm = pm; u.pn = (pm >> 4) * 2 + ((int)L & 1); u.ko = 0; return true; }
    __device__ __forceinline__ void a_ready(const Unit&) const {}
    __device__ __forceinline__ void done(const Unit&) const {}
};
struct GroupedOrder {
    int G, c, NT, KS, KL; const PG8_LAS int* tp;
    __device__ __forceinline__ bool next(int i, Unit& u) const {
        const int nwg = tp[8] * NT * KS; const long L = (long)i * G + c; if (L >= nwg) return false;
        int wgid = (int)L; { const int q = nwg / NXCD, r = nwg % NXCD, xcd = wgid % NXCD, off = wgid / NXCD; wgid = (xcd < r ? xcd * (q + 1) : r * (q + 1) + (xcd - r) * q) + off; }
        const int ks = wgid % KS; wgid /= KS;
        int e = 0;
#pragma unroll
        for (int k = 1; k < 8; ++k) if (wgid >= tp[k] * NT) e = k;
        const int t0 = tp[e], nte = tp[e + 1] - t0, l = wgid - t0 * NT, nig = WGM * NT, gid = l / nig, fm = gid * WGM, gsz = (nte - fm) < WGM ? (nte - fm) : WGM;
        u.pm = t0 + fm + ((l % nig) % gsz); u.pn = e * NT + (l % nig) / gsz; u.ko = ks * KL; return true;
    }
    __device__ __forceinline__ void a_ready(const Unit&) const {}
    __device__ __forceinline__ void done(const Unit&) const {}
};
template <class Base> struct PubOrder : Base {
    unsigned* cnt; mutable int pend;
    __device__ __forceinline__ void publish() const { if (pend >= 0) { if ((threadIdx.x & 63) == 0) __hip_atomic_fetch_add(cnt + 64 * pend, 1u, __ATOMIC_RELAXED, __HIP_MEMORY_SCOPE_AGENT); pend = -1; } }
    __device__ __forceinline__ void a_ready(const Unit&) const { publish(); }
#if defined(PUB_DRAIN) && PUB_DRAIN
    __device__ __forceinline__ void done(const Unit& u) const { asm volatile("s_waitcnt vmcnt(0)" ::: "memory"); pend = u.pm; publish(); }
#else
    __device__ __forceinline__ void done(const Unit& u) const { publish(); pend = u.pm; }
#endif
};
template <class Base> struct WaitOrder : Base {
    const unsigned* ready; unsigned need; unsigned* tmo;
    __device__ __forceinline__ void a_ready(const Unit& u) const {
        if (threadIdx.x < 64) {
            const unsigned long long t0 = __builtin_amdgcn_s_memrealtime(); unsigned polls = 0;
            while ((unsigned)__builtin_amdgcn_readfirstlane(__hip_atomic_load(ready + 64 * u.pm, __ATOMIC_RELAXED, __HIP_MEMORY_SCOPE_AGENT)) < need) {
                if ((++polls & 255u) == 0u && __builtin_amdgcn_readfirstlane(__hip_atomic_load(tmo, __ATOMIC_RELAXED, __HIP_MEMORY_SCOPE_AGENT)) != 0u) break;
                if (__builtin_amdgcn_s_memrealtime() - t0 > 2000000ull) {
                    if (threadIdx.x == 0) { unsigned expect = 0u; __hip_atomic_compare_exchange_strong(tmo + 1, &expect, 0x600u | (unsigned)(u.pm & 0xff), __ATOMIC_RELAXED, __ATOMIC_RELAXED, __HIP_MEMORY_SCOPE_AGENT); __hip_atomic_store(tmo, 1u, __ATOMIC_RELAXED, __HIP_MEMORY_SCOPE_AGENT); }
                    break; }
                __builtin_amdgcn_s_sleep(2); }
            __builtin_amdgcn_fence(__ATOMIC_ACQUIRE, "agent");
            asm volatile("s_waitcnt vmcnt(0)" ::: "memory");
        }
        asm volatile("" ::: "memory"); __builtin_amdgcn_s_barrier(); asm volatile("" ::: "memory");
    }
};
struct MoeDownOrder {
    int G, c, rem; const PG8_LAS int* tp;
    __device__ __forceinline__ int expert_of(int tile) const { int e = 0;
#pragma unroll
        for (int k = 1; k < 8; ++k) if (tile >= tp[k]) e = k;
        return e; }
    __device__ __forceinline__ bool next(int i, Unit& u) const {
        const long L = (long)i * G + c;
        if (!rem) { if (L >= 512) return false;
            int wgid = (int)L; { const int xcd = wgid % NXCD, off = wgid / NXCD; wgid = xcd * 64 + off; }
            const int grp = wgid >> 5, in = wgid & 31; const int tile = grp * 8 + (in & 7), pnl = in >> 3;
            u.pm = tile; u.pn = expert_of(tile) * 4 + pnl; u.ko = 0; return true; }
        const int nrem = tp[8] - 128; if (L >= (long)nrem * 28) return false;
        const int l2 = (int)L, ks = l2 % 7, r = l2 / 7, tile = 128 + (r >> 2);
        u.pm = tile; u.pn = expert_of(tile) * 4 + (r & 3); u.ko = ks * 512; return true;
    }
    __device__ __forceinline__ void a_ready(const Unit&) const {}
    __device__ __forceinline__ void done(const Unit&) const {}
};
struct EpiBf16Y2 {
    static constexpr bool PERM = true, AFTER_DRAIN = false;
    bf16_t* Y; bf16_t* YP; int rem;
    __device__ __forceinline__ void operator()(const f32x4 (&acc)[2][2][4][2], const Unit& u, int wr, int wc, int fr, int fq) const {
        const int row0 = u.pm * BM + wr * 64 + fr, col0 = (u.pn & 3) * BM + wc * 32 + 8 * fq;
        bf16_t* base = rem ? YP + (size_t)(u.ko >> 9) * (2048 * 1024) + (size_t)(row0 - 128 * BM) * 1024 : Y + (size_t)row0 * 1024;
#pragma unroll
        for (int ai = 0; ai < 2; ++ai)
#pragma unroll
            for (int m = 0; m < 4; ++m) { bf16_t* rowp = base + (size_t)(ai * HALF + m * 16) * 1024 + col0;
#pragma unroll
                for (int bj = 0; bj < 2; ++bj) *(u32x4*)(rowp + bj * HALF) = pack8(acc[ai][bj][m][0], acc[ai][bj][m][1]); }
    }
};
template <class Epi, class Sched, bool ALIGN_EPI = false, bool SP2 = false>
__device__ __forceinline__ void gemm_phase(PG8_LAS unsigned char* lds, const Gemm g, const Sched& S, const Epi& E) {
    const int tid = threadIdx.x, wid = __builtin_amdgcn_readfirstlane(tid >> 6), lane = tid & 63, wr = wid >> 2, wc = wid & 3, fr = lane & 15, fq = lane >> 4;
    const int K = g.ld, nt = g.K / BK;
    unsigned voffA[2], voffB[2];
#pragma unroll
    for (int i = 0; i < 2; ++i) { int R, C; stage_rc(tid * 16 + i * 8192, R, C); const int Rb = Epi::PERM ? ((R & ~31) + perm32(R & 31)) : R;
        voffA[i] = (unsigned)(R * K + C) * 2u; voffB[i] = (unsigned)(Rb * K + C) * 2u; }
    const size_t kstep = (size_t)(BK * 2);
    const size_t hstep = (size_t)HALF * K * 2;
    const size_t tstep = 2 * hstep;
    const unsigned ldsw = (unsigned)wid * 1024u;
    const int aoff = lds_byte(wr * 64 + fr, fq * 8), boff = lds_byte(wc * 32 + fr, fq * 8);
#define PG8_SA(b, h) (((b) * 2 + (h)) * HTB)
#define PG8_SB(b, h) ((4 + (b) * 2 + (h)) * HTB)
#define PG8_STAGE(bufoff, gbase, voff) do { _Pragma("unroll") for (int _i = 0; _i < 2; ++_i) \
        __builtin_amdgcn_global_load_lds((const unsigned*)((const char*)(gbase) + (voff)[_i]), (PG8_LAS unsigned*)(lds + (bufoff) + ldsw + _i * 8192), 16, 0, 0); } while (0)
#define PG8_LDA(dst, b, h) do { _Pragma("unroll") for (int m = 0; m < 4; ++m) _Pragma("unroll") for (int k = 0; k < 2; ++k) dst[m][k] = *(const PG8_LAS bf16x8*)(lds + PG8_SA(b, h) + aoff + m * 2048 + k * 1024); } while (0)
#define PG8_LDB(dst, b, h) do { _Pragma("unroll") for (int n = 0; n < 2; ++n) _Pragma("unroll") for (int k = 0; k < 2; ++k) dst[n][k] = *(const PG8_LAS bf16x8*)(lds + PG8_SB(b, h) + boff + n * 2048 + k * 1024); } while (0)
#define PG8_MMA(ai, bj, At, Bt) do { __builtin_amdgcn_s_setprio(1); _Pragma("unroll") for (int m = 0; m < 4; ++m) _Pragma("unroll") for (int n = 0; n < 2; ++n) _Pragma("unroll") for (int k = 0; k < 2; ++k) \
        acc[ai][bj][m][n] = __builtin_amdgcn_mfma_f32_16x16x32_bf16(Bt[n][k], At[m][k], acc[ai][bj][m][n], 0, 0, 0); __builtin_amdgcn_s_setprio(0); } while (0)
#define PG8_WAIT_V(n) asm volatile("s_waitcnt vmcnt(" #n ")" ::: "memory")
#define PG8_WAIT_L(n) asm volatile("s_waitcnt lgkmcnt(" #n ")" ::: "memory")
#define PG8_BAR __builtin_amdgcn_s_barrier()
#define PG8_SCHED __builtin_amdgcn_sched_barrier(0)
    Unit cur, nxt; int ui = 0;
    if (!S.next(0, cur)) return;
    f32x4 acc[2][2][4][2];
#pragma unroll
    for (int a = 0; a < 2; ++a)
#pragma unroll
        for (int b = 0; b < 2; ++b)
#pragma unroll
            for (int m = 0; m < 4; ++m)
#pragma unroll
                for (int n = 0; n < 2; ++n) acc[a][b][m][n] = (f32x4){0.f, 0.f, 0.f, 0.f};
    bf16x8 At[4][2], B0[2][2], B1[2][2];
    const char* cA = (const char*)g.A + (size_t)cur.pm * tstep + (size_t)cur.ko * 2; const char* cB = (const char*)g.Bt + (size_t)cur.pn * tstep + (size_t)cur.ko * 2;
    S.a_ready(cur);
    if constexpr (SP2) {
        PG8_STAGE(PG8_SB(0, 0), cB, voffB); PG8_STAGE(PG8_SB(0, 1), cB + hstep, voffB); PG8_STAGE(PG8_SA(0, 0), cA, voffA); PG8_STAGE(PG8_SA(0, 1), cA + hstep, voffA);
        if (wr == 1) PG8_BAR;
        PG8_WAIT_V(2); PG8_BAR;
        PG8_STAGE(PG8_SB(1, 0), cB + kstep, voffB); PG8_STAGE(PG8_SA(1, 0), cA + kstep, voffA); PG8_STAGE(PG8_SB(1, 1), cB + hstep + kstep, voffB);
        PG8_WAIT_V(6); PG8_BAR;
    } else {
        PG8_STAGE(PG8_SB(0, 0), cB, voffB); PG8_STAGE(PG8_SA(0, 0), cA, voffA); PG8_STAGE(PG8_SB(0, 1), cB + hstep, voffB); PG8_STAGE(PG8_SA(0, 1), cA + hstep, voffA);
        if (wr == 1) PG8_BAR;
        PG8_WAIT_V(4); PG8_BAR;
        PG8_STAGE(PG8_SB(1, 0), cB + kstep, voffB); PG8_STAGE(PG8_SA(1, 0), cA + kstep, voffA); PG8_STAGE(PG8_SB(1, 1), cB + hstep + kstep, voffB);
        PG8_WAIT_V(6); PG8_BAR;
    }
    for (;;) {
        const bool has_next = S.next(ui + 1, nxt);
        const char* nA = has_next ? (const char*)g.A + (size_t)nxt.pm * tstep + (size_t)nxt.ko * 2 : cA; const char* nB = has_next ? (const char*)g.Bt + (size_t)nxt.pn * tstep + (size_t)nxt.ko * 2 : cB;
        for (int t = 0; t < nt; t += 2) {
            const bool last = (t == nt - 2);
            const char* a1 = cA + (size_t)(t + 1) * kstep;
            const char* a2 = last ? nA : cA + (size_t)(t + 2) * kstep; const char* b2 = last ? nB : cB + (size_t)(t + 2) * kstep;
            const char* a3 = a2 + kstep; const char* b3 = b2 + kstep;
            if (last && has_next) S.a_ready(nxt);
            if constexpr (SP2) {
            PG8_LDB(B0, 0, 0); PG8_LDB(B1, 0, 1); PG8_SCHED; PG8_LDA(At, 0, 0); PG8_STAGE(PG8_SA(1, 1), a1 + hstep, voffA);
            PG8_WAIT_V(8); PG8_WAIT_L(0); PG8_BAR; PG8_MMA(0, 0, At, B0); PG8_MMA(0, 1, At, B1); PG8_BAR; PG8_SCHED;
            PG8_LDA(At, 0, 1); PG8_STAGE(PG8_SB(0, 0), b2, voffB); PG8_STAGE(PG8_SB(0, 1), b2 + hstep, voffB); PG8_STAGE(PG8_SA(0, 0), a2, voffA);
            PG8_WAIT_V(8); PG8_WAIT_L(0); PG8_BAR; PG8_MMA(1, 0, At, B0); PG8_MMA(1, 1, At, B1); PG8_BAR; PG8_SCHED;
            PG8_LDB(B0, 1, 0); PG8_LDB(B1, 1, 1); PG8_SCHED; PG8_LDA(At, 1, 0); PG8_STAGE(PG8_SA(0, 1), a2 + hstep, voffA);
            PG8_WAIT_V(8); PG8_WAIT_L(0); PG8_BAR; PG8_MMA(0, 0, At, B0); PG8_MMA(0, 1, At, B1); PG8_BAR; PG8_SCHED;
            PG8_LDA(At, 1, 1); PG8_STAGE(PG8_SB(1, 0), b3, voffB); PG8_STAGE(PG8_SB(1, 1), b3 + hstep, voffB); PG8_STAGE(PG8_SA(1, 0), a3, voffA);
            PG8_WAIT_V(8); PG8_WAIT_L(0); PG8_BAR; PG8_MMA(1, 0, At, B0); PG8_MMA(1, 1, At, B1); PG8_BAR; PG8_SCHED;
            } else {
            PG8_LDB(B0, 0, 0); PG8_SCHED; PG8_LDA(At, 0, 0); PG8_STAGE(PG8_SA(1, 1), a1 + hstep, voffA);
            PG8_WAIT_L(8); PG8_BAR; PG8_WAIT_L(0); PG8_MMA(0, 0, At, B0); PG8_BAR; PG8_SCHED;
            PG8_LDB(B1, 0, 1); PG8_STAGE(PG8_SB(0, 0), b2, voffB);
            PG8_BAR; PG8_WAIT_L(0); PG8_MMA(0, 1, At, B1); PG8_BAR;
            PG8_LDA(At, 0, 1); PG8_STAGE(PG8_SA(0, 0), a2, voffA);
            PG8_BAR; PG8_WAIT_L(0); PG8_MMA(1, 0, At, B0); PG8_BAR; PG8_SCHED;
            PG8_STAGE(PG8_SB(0, 1), b2 + hstep, voffB);
            PG8_WAIT_V(6); PG8_BAR; PG8_MMA(1, 1, At, B1); PG8_BAR;
            PG8_LDB(B0, 1, 0); PG8_SCHED; PG8_LDA(At, 1, 0); PG8_STAGE(PG8_SA(0, 1), a2 + hstep, voffA);
            PG8_WAIT_L(8); PG8_BAR; PG8_WAIT_L(0); PG8_MMA(0, 0, At, B0); PG8_BAR; PG8_SCHED;
            PG8_LDB(B1, 1, 1); PG8_STAGE(PG8_SB(1, 0), b3, voffB);
            PG8_BAR; PG8_WAIT_L(0); PG8_MMA(0, 1, At, B1); PG8_BAR;
            PG8_LDA(At, 1, 1); PG8_STAGE(PG8_SA(1, 0), a3, voffA);
            PG8_BAR; PG8_WAIT_L(0); PG8_MMA(1, 0, At, B0); PG8_BAR; PG8_SCHED;
            PG8_STAGE(PG8_SB(1, 1), b3 + hstep, voffB);
            PG8_WAIT_V(6); PG8_BAR; PG8_MMA(1, 1, At, B1); PG8_BAR;
            }
        }
        if constexpr (ALIGN_EPI) { if (wr == 0) PG8_BAR; }
        if constexpr (!Epi::AFTER_DRAIN) { E(acc, cur, wr, wc, fr, fq); S.done(cur); }
        if (!has_next) break;
#pragma unroll
        for (int a = 0; a < 2; ++a)
#pragma unroll
            for (int b = 0; b < 2; ++b)
#pragma unroll
                for (int m = 0; m < 4; ++m)
#pragma unroll
                    for (int n = 0; n < 2; ++n) acc[a][b][m][n] = (f32x4){0.f, 0.f, 0.f, 0.f};
        cur = nxt; cA = nA; cB = nB; ++ui;
        if constexpr (ALIGN_EPI) { if (wr == 1) PG8_BAR; }
    }
    PG8_WAIT_V(0);
    if constexpr (!ALIGN_EPI) { if (wr == 0) PG8_BAR; }
    PG8_BAR;
    if constexpr (Epi::AFTER_DRAIN) { E.fused(acc, cur, wr, wc, fr, fq, lds, wid, lane); S.done(cur); }
#undef PG8_SA
#undef PG8_SB
#undef PG8_STAGE
#undef PG8_LDA
#undef PG8_LDB
#undef PG8_MMA
#undef PG8_WAIT_V
#undef PG8_WAIT_L
#undef PG8_BAR
#undef PG8_SCHED
}
}
#ifndef PG8_SP2
#define PG8_SP2 true
#endif
#ifndef PG8_ALIGN
#define PG8_ALIGN true
#endif
#define GAS __attribute__((address_space(1)))
#define LAS __attribute__((address_space(3)))
typedef unsigned short bf16;
typedef unsigned v4u __attribute__((ext_vector_type(4)));
typedef float f32x4 __attribute__((ext_vector_type(4)));
typedef short bf16x8 __attribute__((ext_vector_type(8)));
typedef GAS unsigned gu32;
typedef GAS unsigned long long gu64;
#define RLX_AGENT __ATOMIC_RELAXED, __HIP_MEMORY_SCOPE_AGENT
#define LDS_WAIT() asm volatile("s_waitcnt lgkmcnt(0)" ::: "memory")
#define VM_WAIT() asm volatile("s_waitcnt vmcnt(0)" ::: "memory")
__device__ __forceinline__ unsigned long long rt() { return __builtin_amdgcn_s_memrealtime(); }
__device__ __forceinline__ unsigned f2bf(float f) { unsigned u = __builtin_bit_cast(unsigned, f); return (u + 0x7fffu + ((u >> 16) & 1u)) >> 16; }
__device__ __forceinline__ unsigned pk2(float lo, float hi) { return f2bf(lo) | (f2bf(hi) << 16); }

#define XB_TMO      128
#define XB_XCNT(j)  (256  + 64 * (j))
#define XB_XSUB(j)  (1280 + 64 * (j))
#define XB_XGEN(j)  (2304 + 64 * (j))
#define XB_TOP      3328
#define XB_TOPGEN   3392
#define XCD_BAR_WORDS 3456
#define XB_SPIN_CAP (1u << 18)

__device__ __forceinline__ unsigned xb_ld(unsigned* p)              { return __hip_atomic_load(p, __ATOMIC_RELAXED, __HIP_MEMORY_SCOPE_AGENT); }
__device__ __forceinline__ unsigned xb_add(unsigned* p, unsigned v) { return __hip_atomic_fetch_add(p, v, __ATOMIC_RELAXED, __HIP_MEMORY_SCOPE_AGENT); }
__device__ __forceinline__ unsigned xb_xcc_id() { return (unsigned)__builtin_amdgcn_s_getreg((3 << 11) | 20) & 0xFu; }
#define XB_SPIN(cond, bar) do { unsigned _sp = 0; while (cond) { __builtin_amdgcn_s_sleep(1); \
    if ((++_sp & 255u) == 0u) { if (xb_ld(&(bar)[XB_TMO])) break; if (_sp > XB_SPIN_CAP) { atomicAdd(&(bar)[XB_TMO], 1u); break; } } } } while (0)

struct XcdBarrier {
    unsigned* bar; unsigned x;
    volatile LAS unsigned* st;
};

__device__ __forceinline__ XcdBarrier xcd_barrier_post(unsigned* bar, volatile LAS unsigned* st) {
    XcdBarrier b; b.bar = bar; b.x = xb_xcc_id(); b.st = st;
    if (threadIdx.x == 0) (void)xb_add(&bar[XB_XCNT(b.x)], 1u);
    return b;
}
__device__ __forceinline__ void xcd_barrier_complete(unsigned* bar, unsigned x, unsigned& nloc, unsigned& nx) {
    const unsigned G = gridDim.x * gridDim.y * gridDim.z;
    unsigned sum, cnt, mine, sp = 0u;
    for (;;) {
        sum = 0u; cnt = 0u; mine = 0u;
#pragma unroll
        for (unsigned j = 0; j < 16; ++j) { const unsigned c = xb_ld(&bar[XB_XCNT(j)]); sum += c; cnt += (c > 0u) ? 1u : 0u; mine = (j == x) ? c : mine; }
        if (sum == G) break;
        __builtin_amdgcn_s_sleep(1);
        if ((++sp & 255u) == 0u) { if (xb_ld(&bar[XB_TMO])) break; if (sp > XB_SPIN_CAP) { atomicAdd(&bar[XB_TMO], 1u); break; } }
    }
    nloc = mine > 0u ? mine : 1u; nx = cnt > 0u ? cnt : 1u;
}

__device__ __forceinline__ void xcd_barrier(const XcdBarrier& b) {
    asm volatile("s_waitcnt vmcnt(0)" ::: "memory");
    __syncthreads();
    if (threadIdx.x == 0) {
        unsigned* bar = b.bar;
        __builtin_amdgcn_s_waitcnt(0);
        unsigned nloc = b.st[0], nx = b.st[1];
        if (nloc == 0u) { xcd_barrier_complete(bar, b.x, nloc, nx); b.st[0] = nloc; b.st[1] = nx; }
        const unsigned old = xb_add(&bar[XB_XSUB(b.x)], 1u);
        const unsigned gen = old / nloc;
        if (old + 1u == (gen + 1u) * nloc) {
            __builtin_amdgcn_fence(__ATOMIC_RELEASE, "agent");
            asm volatile("s_waitcnt vmcnt(0)" ::: "memory");
            const unsigned og = xb_add(&bar[XB_TOP], 1u);
            const unsigned tg = og / nx;
            if (og + 1u == (tg + 1u) * nx) xb_add(&bar[XB_TOPGEN], 1u);
            else XB_SPIN(xb_ld(&bar[XB_TOPGEN]) == tg, bar);
            __builtin_amdgcn_fence(__ATOMIC_ACQUIRE, "agent");
            xb_add(&bar[XB_XGEN(b.x)], 1u);
            asm volatile("s_waitcnt vmcnt(0)" ::: "memory");
        } else {
            XB_SPIN(xb_ld(&bar[XB_XGEN(b.x)]) == gen, bar);
            __builtin_amdgcn_fence(__ATOMIC_ACQUIRE, "agent");
            asm volatile("s_waitcnt vmcnt(0)" ::: "memory");
        }
    }
    __syncthreads();
}
constexpr int NWAVES = 8;
#ifndef MK_PER_PHASE
#define MK_PER_PHASE 0
#endif
constexpr int N_PHASES = 20;
constexpr int MOE_KS = 1;

constexpr int BATCH = 2, T = 8192, D = 1024, M = BATCH * T;
constexpr int NSA_IN = 2608, NSA_IN_PAD = 2816, FF0 = 2816, GLA_IN = 3088, GLA_IN_PAD = 3328, FFE = 3584, NE = 8;
constexpr int NCMP = 511, MAXTILES = 136, MAXSLOTS = MAXTILES * 256;
constexpr float ALPHA = 1.41421356237309515f;
constexpr float LN_EPS = 1e-5f, RMS_EPS = 1e-6f, LOG2E = 1.44269504088896341f;

constexpr size_t MiB = 1u << 20;
constexpr size_t WS_CTL = 0, CTL_ZERO_BYTES = 1 * MiB;
constexpr size_t WS_PB = 1 * MiB;
constexpr size_t WS_CNTL = WS_PB + 32768;
constexpr size_t WS_TOKE = WS_CNTL + 16384;
constexpr size_t WS_TOKW = WS_TOKE + (size_t)M * 8;
constexpr size_t WS_TOKP = WS_TOKW + (size_t)M * 8;
constexpr size_t WS_TOKS = WS_TOKP + (size_t)M * 8;
static_assert(WS_TOKS + (size_t)M * 8 <= 2 * MiB, "misc region");
constexpr size_t WS_WIN0 = 2 * MiB, WS_W1C = 8 * MiB, WS_WO0 = 10 * MiB, WS_WGU0 = 12 * MiB, WS_WD0 = 23 * MiB, WS_WIN1 = 29 * MiB, WS_WO1 = 36 * MiB, WS_WGU1 = 38 * MiB, WS_WD1 = 150 * MiB;
constexpr size_t WS_XB = 206 * MiB, WS_XRES = 238 * MiB, WS_T0 = 302 * MiB, WS_SCR = 366 * MiB;
constexpr size_t WS_Q = WS_SCR, WS_KV2 = WS_SCR + 32 * MiB, WS_KS = WS_SCR + 48 * MiB, WS_VS = WS_SCR + 56 * MiB, WS_KW = WS_SCR + 64 * MiB, WS_VW = WS_SCR + 72 * MiB;
constexpr size_t WS_GT = WS_SCR + 80 * MiB, WS_UL = WS_SCR + 83 * MiB, WS_KCMP = WS_SCR + 99 * MiB, WS_VCMP = WS_KCMP + 512 * 1024, WS_O = WS_SCR + 100 * MiB, WS_H0 = WS_SCR + 132 * MiB;
constexpr size_t WS_QKVG = WS_SCR, WS_ALOW = WS_SCR + 96 * MiB, WS_BCUM = WS_SCR + 97 * MiB, WS_ZB = WS_SCR + 129 * MiB, WS_DEC = WS_SCR + 257 * MiB, WS_SST = WS_SCR + 258 * MiB, WS_O1 = WS_SCR + 322 * MiB;
constexpr size_t WS_XG = WS_SCR, WS_YB = WS_SCR + 68 * MiB, WS_H2 = WS_SCR + 136 * MiB, WS_YB1 = WS_SCR + 374 * MiB, WS_END = WS_YB1 + 68 * MiB;
static_assert(WS_H2 + (size_t)MAXSLOTS * FFE * 2 <= WS_YB1, "H2 fits");
static_assert(WS_H0 + (size_t)M * FF0 * 2 <= 896 * MiB && WS_O1 + 32 * MiB <= 896 * MiB && WS_END <= 896 * MiB, "d_ws map");
constexpr int CW_TMO = 0, CW_CODE = 1, CW_BAR = 4096;
constexpr int CW_PANEL0 = 16384, CW_PANEL1 = 32768;
static_assert((CW_PANEL1 + 64 * MAXTILES) * 4 <= (int)CTL_ZERO_BYTES, "CTL words inside the memset region");

constexpr int RING_OFF = 0, RING_BYTES = 131072;
constexpr int LDSCTL_OFF = RING_BYTES, MISC_OFF = LDSCTL_OFF + 320;
constexpr int INPTR_OFF = MISC_OFF + 128;
constexpr int LDS_BYTES = 147456;
#ifndef TR_UNROLL
#define TR_UNROLL 8
#endif
typedef float f32x16 __attribute__((ext_vector_type(16)));
typedef short v4i16 __attribute__((ext_vector_type(4)));
typedef unsigned v2u __attribute__((ext_vector_type(2)));
struct Args { const float* in[27]; float* out; unsigned char* ws; int ph_lo, ph_hi; };
struct Frame {
    const Args* A;
    LAS unsigned char* lds;
    volatile LAS unsigned* MISC;
    gu32* ctl;
    int tid, lane, wave;
    int vcu, G, wg;
    unsigned char* ws; float* out;
};
#define inptr(F, k) ((F).A->in[k])
__device__ __forceinline__ float wave_sum(float v) {
#pragma unroll
    for (int o = 1; o < 64; o <<= 1) v += __shfl_xor(v, o);
    return v;
}
__device__ __forceinline__ float bf2f(bf16 h) { return __uint_as_float((unsigned)h << 16); }
__device__ __forceinline__ v4i16 vtr(const LAS unsigned char* p) { return __builtin_amdgcn_ds_read_tr16_b64_v4i16((LAS v4i16*)p); }
__device__ __forceinline__ int crow(int r, int hi) { return (r & 3) + 8 * (r >> 2) + 4 * hi; }

__device__ __forceinline__ void tr_item(const float* src, int ldn, int nvalid, int k0, int n0, bf16* dst, int dld, int drow0, LAS float* scr, int lane) {
    const int n_ = n0 + (lane & 31); const bool ok = n_ < nvalid;
    float tv[32];
#pragma unroll
    for (int i = 0; i < 32; ++i) { const int kk = 2 * i + (lane >> 5); tv[i] = ok ? *(const GAS float*)(src + (size_t)(k0 + kk) * ldn + n_) : 0.f; }
#pragma unroll
    for (int i = 0; i < 32; ++i) { const int kk = 2 * i + (lane >> 5); scr[kk * 33 + (lane & 31)] = tv[i]; }
    LDS_WAIT(); asm volatile("" ::: "memory");
    const int c = lane & 7;
#pragma unroll
    for (int j = 0; j < 4; ++j) { const int n = (lane >> 3) + 8 * j; const LAS float* s = scr + (8 * c) * 33 + n;
        v4u o; o.x = pk2(s[0 * 33], s[1 * 33]); o.y = pk2(s[2 * 33], s[3 * 33]); o.z = pk2(s[4 * 33], s[5 * 33]); o.w = pk2(s[6 * 33], s[7 * 33]);
        *(GAS v4u*)(dst + (size_t)(drow0 + n) * dld + k0 + 8 * c) = o; }
    LDS_WAIT(); asm volatile("" ::: "memory");
}
__device__ __forceinline__ int swiglu_row(int n0, int F_) { return n0 < F_ ? (n0 / 128) * 256 + (n0 % 128) : ((n0 - F_) / 128) * 256 + 128 + ((n0 - F_) % 128); }
#define KBNB(idx, nkb, nnb) const int kb = ((idx) % (8 * (nkb))) / 8, nb = ((idx) / (8 * (nkb))) * 8 + (idx) % 8
__device__ __forceinline__ void p0_items(Frame& F, const int first, const int last, const int gw, const int NGW) {
    LAS float* scr = (LAS float*)(F.lds + RING_OFF + F.wave * 16384);
    const int lane = F.lane;
    unsigned char* ws = F.ws;
    constexpr int I_IN0 = 16 * (NSA_IN_PAD / 32), I_W1 = 4 * 16 * 8, I_WO = 16 * 32, I_GU0 = 16 * (2 * FF0 / 32), I_D0 = (FF0 / 64) * 32, I_IN1 = 16 * (GLA_IN_PAD / 32);
    constexpr int I_GU1E = 16 * (2 * FFE / 32), I_D1E = (FFE / 64) * 32, I_GU1 = NE * I_GU1E, I_D1 = NE * I_D1E;
    constexpr int NITEMS = I_IN0 + I_W1 + I_WO + I_GU0 + I_D0 + I_IN1 + I_WO + I_GU1 + I_D1;
    for (int it = first + gw; it < last; it += NGW) {
        int r = it;
        if (r < I_IN0) { constexpr int nnb = NSA_IN_PAD / 32; KBNB(r, 16, nnb); tr_item(inptr(F, 1), NSA_IN, NSA_IN, 64 * kb, 32 * nb, (bf16*)(ws + WS_WIN0), 1024, 32 * nb, scr, lane); continue; } r -= I_IN0;
        if (r < I_W1) { const int blk = r / 128, q = r % 128; KBNB(q, 16, 8);
            const float* src = ((blk >> 1) ? inptr(F, 6) : inptr(F, 4)) + (size_t)(blk & 1) * 1024 * 256; tr_item(src, 256, 256, 64 * kb, 32 * nb, (bf16*)(ws + WS_W1C), 1024, 256 * blk + 32 * nb, scr, lane); continue; } r -= I_W1;
        if (r < I_WO) { KBNB(r, 16, 32); tr_item(inptr(F, 8), 1024, 1024, 64 * kb, 32 * nb, (bf16*)(ws + WS_WO0), 1024, 32 * nb, scr, lane); continue; } r -= I_WO;
        if (r < I_GU0) { constexpr int nnb = 2 * FF0 / 32; KBNB(r, 16, nnb); tr_item(inptr(F, 11), 2 * FF0, 2 * FF0, 64 * kb, 32 * nb, (bf16*)(ws + WS_WGU0), 1024, swiglu_row(32 * nb, FF0), scr, lane); continue; } r -= I_GU0;
        if (r < I_D0) { KBNB(r, FF0 / 64, 32); tr_item(inptr(F, 12), 1024, 1024, 64 * kb, 32 * nb, (bf16*)(ws + WS_WD0), FF0, 32 * nb, scr, lane); continue; } r -= I_D0;
        if (r < I_IN1) { constexpr int nnb = GLA_IN_PAD / 32; KBNB(r, 16, nnb); tr_item(inptr(F, 15), GLA_IN, GLA_IN, 64 * kb, 32 * nb, (bf16*)(ws + WS_WIN1), 1024, 32 * nb, scr, lane); continue; } r -= I_IN1;
        if (r < I_WO) { KBNB(r, 16, 32); tr_item(inptr(F, 19), 1024, 1024, 64 * kb, 32 * nb, (bf16*)(ws + WS_WO1), 1024, 32 * nb, scr, lane); continue; } r -= I_WO;
        if (r < I_GU1) { constexpr int nnb = 2 * FFE / 32; const int e = r / I_GU1E, q = r % I_GU1E; KBNB(q, 16, nnb);
            tr_item(inptr(F, 23) + (size_t)e * 1024 * 2 * FFE, 2 * FFE, 2 * FFE, 64 * kb, 32 * nb, (bf16*)(ws + WS_WGU1) + (size_t)e * 2 * FFE * 1024, 1024, swiglu_row(32 * nb, FFE), scr, lane); continue; } r -= I_GU1;
        { const int e = r / I_D1E, q = r % I_D1E; KBNB(q, FFE / 64, 32);
            tr_item(inptr(F, 24) + (size_t)e * FFE * 1024, 1024, 1024, 64 * kb, 32 * nb, (bf16*)(ws + WS_WD1) + (size_t)e * 1024 * FFE, FFE, 32 * nb, scr, lane); }
    }
}
namespace p0n { constexpr int I_D1 = NE * (FFE / 64) * 32, I_ALL = 16 * (NSA_IN_PAD / 32) + 4 * 16 * 8 + 16 * 32 + 16 * (2 * FF0 / 32) + (FF0 / 64) * 32 + 16 * (GLA_IN_PAD / 32) + 16 * 32 + NE * 16 * (2 * FFE / 32) + I_D1; }
constexpr int CMP_WGS = 64;
__device__ __forceinline__ void p0_prologue(Frame& F) {
    const int gw = F.vcu * NWAVES + F.wave, NGW = F.G * NWAVES, lane = F.lane;
    unsigned char* ws = F.ws;
    p0_items(F, 0, p0n::I_ALL, gw, NGW);
    { const float* x = inptr(F, 0); bf16* xb = (bf16*)(ws + WS_XB);
      for (int m = gw; m < M; m += NGW) { const GAS f32x4* xr = (const GAS f32x4*)(x + (size_t)m * D) + lane; GAS unsigned long long* o8 = (GAS unsigned long long*)(xb + (size_t)m * D) + lane;
#pragma unroll
          for (int j = 0; j < 4; ++j) { const f32x4 v = xr[64 * j]; o8[64 * j] = (unsigned long long)pk2(v.x, v.y) | ((unsigned long long)pk2(v.z, v.w) << 32); } } }
    { float* pb = (float*)(ws + WS_PB);
      for (int task = gw; task < 64; task += NGW) { const int rp = task & 7, cb = (task >> 3) & 3, kv = task >> 5; const float* pe = kv ? inptr(F, 3) : inptr(F, 2); const float* w1 = kv ? inptr(F, 6) : inptr(F, 4); const int c = 64 * cb + lane;
          float a = 0.f;
          for (int r0 = 256 * rp; r0 < 256 * rp + 256; r0 += 32) { float wv[32], pv[32];
#pragma unroll
              for (int u = 0; u < 32; ++u) { wv[u] = *(const GAS float*)(w1 + (size_t)(r0 + u) * 256 + c); pv[u] = *(const GAS float*)(pe + r0 + u); }
#pragma unroll
              for (int u = 0; u < 32; ++u) a += pv[u] * wv[u]; }
          pb[rp * 512 + kv * 256 + c] = a; } }
}

__device__ __forceinline__ float gelu_tanh(float x) { const float y = 0.7978845608028654f * (x + 0.044715f * x * x * x); const float e = __expf(2.f * y); const float th = 1.f - 2.f / (e + 1.f); return 0.5f * x * (1.f + th); }
__device__ __forceinline__ void cmp_finish(Frame& F) {
    const int gw = F.vcu * NWAVES + F.wave, NGW = F.G * NWAVES, lane = F.lane;
    LAS float* hb = (LAS float*)(F.lds + RING_OFF + F.wave * 1024);
    LAS float* W2L = (LAS float*)(F.lds + RING_OFF + 16384);
    const float* ul = (const float*)(F.ws + WS_UL); const float* pb = (const float*)(F.ws + WS_PB);
    int staged = -1;
    for (int task = gw; task < 8192; task += NGW) {
        const int kv = task >> 12, rem = task & 4095, b = rem >> 11, n = (rem >> 2) & 511, g = rem & 3;
        if (kv != staged) { const float* w2 = kv ? inptr(F, 7) : inptr(F, 5);
            __syncthreads();
            for (int q = F.tid; q < 4096; q += NWAVES * 64) *(LAS f32x4*)(W2L + q * 4) = *(const GAS f32x4*)(w2 + q * 4);
            __syncthreads(); staged = kv; }
        bf16* dst = (bf16*)(F.ws + (kv ? WS_VCMP : WS_KCMP)) + ((size_t)((b * 4 + g) * 512 + n)) * 64;
        if (n == 511) { dst[lane] = 0; continue; }
        const size_t rowU = (size_t)kv * 4096 + (size_t)(b * 512 + n) * 4 + g, rowL = rowU + 4;
        const f32x4 u = *(const f32x4*)(ul + rowU * 512 + lane * 4), lw = *(const f32x4*)(ul + rowL * 512 + 256 + lane * 4);
        f32x4 bs = (f32x4){0.f, 0.f, 0.f, 0.f};
#pragma unroll
        for (int rp = 0; rp < 8; ++rp) bs += *(const f32x4*)(pb + rp * 512 + kv * 256 + lane * 4);
        const f32x4 pre = u + lw + bs;
        *(LAS f32x4*)(hb + lane * 4) = (f32x4){gelu_tanh(pre[0]), gelu_tanh(pre[1]), gelu_tanh(pre[2]), gelu_tanh(pre[3])};
        LDS_WAIT(); asm volatile("" ::: "memory");
        float a0 = 0.f, a1 = 0.f, a2 = 0.f, a3 = 0.f;
#pragma unroll 8
        for (int c = 0; c < 256; c += 4) { const f32x4 h4 = *(const LAS f32x4*)(hb + c);
            a0 += h4[0] * W2L[(c + 0) * 64 + lane]; a1 += h4[1] * W2L[(c + 1) * 64 + lane]; a2 += h4[2] * W2L[(c + 2) * 64 + lane]; a3 += h4[3] * W2L[(c + 3) * 64 + lane]; }
        dst[lane] = (bf16)f2bf((a0 + a1) + (a2 + a3));
        LDS_WAIT(); asm volatile("" ::: "memory");
    }
}

namespace nsa {
constexpr int KB_OFF = 0, VB_OFF = 18432, IMPA_OFF = 36864, IMPB_OFF = 69632, SEL_OFF = 102400, UNI_OFF = 103424, NS_OFF = 103440, SLIST_OFF = 103456, TILE_B = 9216;
static_assert(SLIST_OFF + 512 <= RING_BYTES, "nsa LDS map");
constexpr float THR = 8.f;
__device__ __forceinline__ float dpp_xor1(float v) { return __int_as_float(__builtin_amdgcn_update_dpp(0, __float_as_int(v), 0xB1, 0xF, 0xF, true)); }
__device__ __forceinline__ float dpp_xor2(float v) { return __int_as_float(__builtin_amdgcn_update_dpp(0, __float_as_int(v), 0x4E, 0xF, 0xF, true)); }
__device__ __forceinline__ float max_halves(float v) { const auto rr = __builtin_amdgcn_permlane32_swap(__float_as_uint(v), __float_as_uint(v), false, false); return fmaxf(__uint_as_float(rr[0]), __uint_as_float(rr[1])); }
__device__ __forceinline__ int below(unsigned long long mk) { return (int)__builtin_amdgcn_mbcnt_hi((unsigned)(mk >> 32), __builtin_amdgcn_mbcnt_lo((unsigned)mk, 0u)); }
template <int MODE>
__device__ __forceinline__ void tile(LAS unsigned char* lds, const int kt_off, const int vt_off, const bf16x8 (&qf)[4], const unsigned qaw, f32x16 (&o)[2], float& m, float& l,
                                     const int lane, const float bias, const bool emask, const int d0, const int pstep, const int lim, const float rl, const int impq, const int jbase) {
    const int hi = lane >> 5, qc = lane & 31;
    const v4u qav = (v4u){qaw, 0u, 0u, 0u}; const bf16x8 qaug = __builtin_bit_cast(bf16x8, qav);
    f32x16 p[2];
#pragma unroll
    for (int h2 = 0; h2 < 2; ++h2) {
#pragma unroll
        for (int r = 0; r < 16; ++r) p[h2][r] = 0.f;
#pragma unroll
        for (int ks = 0; ks < 4; ++ks) { const bf16x8 a = *(const LAS bf16x8*)(lds + kt_off + (32 * h2 + qc) * 144 + 32 * ks + 16 * hi);
            p[h2] = __builtin_amdgcn_mfma_f32_32x32x16_bf16(a, qf[ks], p[h2], 0, 0, 0); }
        { const unsigned xb = hi ? 0u : f2bf((float)(32 * h2 + qc)); const v4u kav = (v4u){xb | (xb << 16), 0u, 0u, 0u};
          p[h2] = __builtin_amdgcn_mfma_f32_32x32x16_bf16(__builtin_bit_cast(bf16x8, kav), qaug, p[h2], 0, 0, 0); }
    }
    if (emask) {
#pragma unroll
        for (int h2 = 0; h2 < 2; ++h2)
#pragma unroll
            for (int r = 0; r < 16; ++r) { const int dist = d0 - pstep * (32 * h2 + (r & 3) + 8 * (r >> 2)); p[h2][r] = ((unsigned)dist < (unsigned)lim) ? p[h2][r] : -INFINITY; }
    }
    float mref;
    if (MODE == 1) mref = m - bias;
    else {
        float mx = fmaxf(p[0][0], p[1][0]);
#pragma unroll
        for (int r = 1; r < 16; ++r) mx = fmaxf(fmaxf(mx, p[0][r]), p[1][r]);
        mx = max_halves(mx);
        const float mt = mx + bias;
        const bool up = mt > m + THR;
        if (__any(up)) { const float mn = up ? mt : m; const float f = __builtin_amdgcn_exp2f(m - mn); l *= f; m = mn;
            if (MODE == 2) {
#pragma unroll
                for (int r = 0; r < 16; ++r) { o[0][r] *= f; o[1][r] *= f; } } }
        mref = m - bias;
    }
    float ls0 = 0.f, ls1 = 0.f;
#pragma unroll
    for (int r = 0; r < 16; ++r) { float e0 = __builtin_amdgcn_exp2f(p[0][r] - mref), e1 = __builtin_amdgcn_exp2f(p[1][r] - mref); if (MODE == 1) { e0 *= rl; e1 *= rl; } p[0][r] = e0; p[1][r] = e1; ls0 += e0; ls1 += e1; }
    if (MODE != 1) l += ls0 + ls1;
    if (MODE == 0) return;
    if (MODE == 1) {
        LAS float* IA = (LAS float*)(lds + IMPA_OFF) + impq * 128; LAS float* IB = (LAS float*)(lds + IMPB_OFF) + impq * 128;
#pragma unroll
        for (int h2 = 0; h2 < 2; ++h2)
#pragma unroll
            for (int a4 = 0; a4 < 4; ++a4) {
                float qs = (p[h2][4 * a4] + p[h2][4 * a4 + 1]) + (p[h2][4 * a4 + 2] + p[h2][4 * a4 + 3]), last = p[h2][4 * a4 + 3];
                qs += dpp_xor1(qs); qs += dpp_xor2(qs); last += dpp_xor1(last); last += dpp_xor2(last);
                const int j = jbase + 8 * h2 + 2 * a4 + hi;
                if ((qc & 3) == 0) { IA[j] = qs; if (j + 1 < 128) IB[j + 1] = last; }
            }
    }
    bf16x8 pf[2][2];
#pragma unroll
    for (int h2 = 0; h2 < 2; ++h2)
#pragma unroll
        for (int s2 = 0; s2 < 2; ++s2) { v4u wv; wv.x = pg8::cvtpk_c(p[h2][8 * s2 + 0], p[h2][8 * s2 + 1]); wv.y = pg8::cvtpk_c(p[h2][8 * s2 + 2], p[h2][8 * s2 + 3]);
            wv.z = pg8::cvtpk_c(p[h2][8 * s2 + 4], p[h2][8 * s2 + 5]); wv.w = pg8::cvtpk_c(p[h2][8 * s2 + 6], p[h2][8 * s2 + 7]); pf[h2][s2] = __builtin_bit_cast(bf16x8, wv); }
    const int a = (lane >> 4) & 1, q_ = (lane & 15) >> 2, p_ = lane & 3;
#pragma unroll
    for (int d0_ = 0; d0_ < 2; ++d0_)
#pragma unroll
        for (int h2 = 0; h2 < 2; ++h2)
#pragma unroll
            for (int s2 = 0; s2 < 2; ++s2) {
                const LAS unsigned char* ad = lds + vt_off + (32 * h2 + 16 * s2 + 4 * hi + q_) * 144 + (32 * d0_ + 16 * a + 4 * p_) * 2;
                const v4i16 lo = vtr(ad), hi4 = vtr(ad + 8 * 144);
                const bf16x8 av = (bf16x8){lo[0], lo[1], lo[2], lo[3], hi4[0], hi4[1], hi4[2], hi4[3]};
                o[d0_] = __builtin_amdgcn_mfma_f32_32x32x16_bf16(av, pf[h2][s2], o[d0_], 0, 0, 0);
            }
}
__device__ __forceinline__ void select13(const unsigned (&k0)[4], const unsigned (&k1)[4], const int lane, unsigned long long (&m0)[4], unsigned long long (&m1)[4]) {
    unsigned th[4] = {0u, 0u, 0u, 0u};
    for (int bit = 30; bit >= 0; --bit) {
#pragma unroll
        for (int u = 0; u < 4; ++u) { const unsigned cand = th[u] | (1u << bit); const int cnt = __popcll(__ballot(k0[u] >= cand)) + __popcll(__ballot(k1[u] >= cand)); th[u] = cnt >= 13 ? cand : th[u]; }
    }
#pragma unroll
    for (int u = 0; u < 4; ++u) {
        const unsigned long long gt0 = __ballot(k0[u] > th[u]), gt1 = __ballot(k1[u] > th[u]), eq0 = __ballot(k0[u] == th[u]), eq1 = __ballot(k1[u] == th[u]);
        const int need = 13 - __popcll(gt0) - __popcll(gt1);
        const int r0 = below(eq0), r1 = __popcll(eq0) + below(eq1);
        const bool s0 = (k0[u] > th[u]) || (k0[u] == th[u] && r0 < need), s1 = (k1[u] > th[u]) || (k1[u] == th[u] && r1 < need);
        m0[u] = __ballot(s0); m1[u] = __ballot(s1);
    }
}
}
__device__ __forceinline__ void nsa_attn_phase(Frame& F) {
    using namespace nsa;
    LAS unsigned char* lds = F.lds + RING_OFF;
    const int tid = F.tid, lane = F.lane, w = F.wave, hi = lane >> 5, qc = lane & 31;
    unsigned char* ws = F.ws;
    const bf16* Qp = (const bf16*)(ws + WS_Q); const float* GT = (const float*)(ws + WS_GT); bf16* Op = (bf16*)(ws + WS_O);
    LAS unsigned* SEL = (LAS unsigned*)(lds + SEL_OFF); LAS unsigned* UNI = (LAS unsigned*)(lds + UNI_OFF); LAS int* NSW = (LAS int*)(lds + NS_OFF); LAS int* SLIST = (LAS int*)(lds + SLIST_OFF);
    const int lrow = tid >> 3, lch = tid & 7;
    for (int un = F.wg; un < 1024; un += F.G) {
        const int bg = un & 7, cc = un >> 3, c = ((cc >> 5) & 1) ? (cc & ~31) + 31 - (cc & 31) : cc;
        const int b = bg >> 2, g = bg & 3, t0 = c * 64;
        const int tql = 8 * w + (qc >> 2), hh = qc & 3, t = t0 + tql, head = 4 * g + hh;
        const size_t mrow = (size_t)b * T + t;
        const float slope2 = __builtin_amdgcn_exp2f(-0.5f * (float)(head + 1)) * LOG2E;
        unsigned qaw1, qaw16;
        { const unsigned sh = f2bf(slope2); const float rem = slope2 - __uint_as_float(sh << 16); const unsigned sl = f2bf(rem);
          const unsigned sh16 = f2bf(16.f * __uint_as_float(sh << 16)), sl16 = f2bf(16.f * __uint_as_float(sl << 16));
          qaw1 = hi ? 0u : (sh | (sl << 16)); qaw16 = hi ? 0u : (sh16 | (sl16 << 16)); }
        bf16x8 qf[4];
#pragma unroll
        for (int ks = 0; ks < 4; ++ks) qf[ks] = *(const GAS bf16x8*)(Qp + mrow * 1024 + head * 64 + 16 * ks + 8 * hi);
        const float* gp = GT + mrow * 48 + (g * 4 + hh) * 3; const float g_cmp = gp[0], g_slc = gp[1], g_win = gp[2];
        const int nmax = (4 * c + 2) < 510 ? (4 * c + 2) : 510, ncb = nmax / 64 + 1;
        const int jw0 = c - 8 > 0 ? c - 8 : 0, nw = c - jw0 + 1, S3 = 2 * ncb + nw;
        const unsigned kcb = (unsigned)WS_KCMP + (unsigned)(b * 4 + g) * 65536u, kvb = ((unsigned)b * T * 256u + (unsigned)g * 64u) * 2u;
        const unsigned thr64 = (unsigned)(lrow * 128 + lch * 16), thr256 = (unsigned)(lrow * 512 + lch * 16);
        int ns = 1;
#define NSA_FETCH(s, kr, vr) do { const int s_ = (s); unsigned ko_, vo_ = 0u; \
            if (s_ < ncb) { ko_ = kcb + (unsigned)s_ * 8192u + thr64; } \
            else if (s_ < 2 * ncb) { ko_ = kcb + (unsigned)(s_ - ncb) * 8192u + thr64; vo_ = ko_ + (unsigned)(WS_VCMP - WS_KCMP); } \
            else if (s_ < S3) { ko_ = (unsigned)WS_KW + kvb + (unsigned)(c - (s_ - 2 * ncb)) * 32768u + thr256; vo_ = ko_ + (unsigned)(WS_VW - WS_KW); } \
            else { ko_ = (unsigned)WS_KS + kvb + (unsigned)SLIST[ns - 1 - (s_ - S3)] * 32768u + thr256; vo_ = ko_ + (unsigned)(WS_VS - WS_KS); } \
            kr = *(const GAS v4u*)(ws + ko_); if (s_ >= ncb) vr = *(const GAS v4u*)(ws + vo_); } while (0)
#define NSA_COMMIT(s, kr, vr) do { const int bo_ = ((s) & 1) * TILE_B + lrow * 144 + lch * 16; *(LAS v4u*)(lds + KB_OFF + bo_) = kr; if ((s) >= ncb) *(LAS v4u*)(lds + VB_OFF + bo_) = vr; } while (0)
        __syncthreads();
        if (c <= 15) {
            int ln = lane; asm volatile("" : "+v"(ln));
            if (ln < 8) { const int q = 8 * w + ln; SEL[q * 4 + 0] = (2u << c) - 1u; SEL[q * 4 + 1] = 0u; SEL[q * 4 + 2] = 0u; SEL[q * 4 + 3] = 0u; }
            if (w == 0 && ln <= c) SLIST[ln] = ln;
            ns = c + 1; }
        else if (tid < 4) UNI[tid] = 0u;
        int ST = S3 + ns;
        v4u krA = (v4u){0u, 0u, 0u, 0u}, vrA = krA, krB = krA, vrB = krA;
        NSA_FETCH(0, krA, vrA); NSA_COMMIT(0, krA, vrA); NSA_FETCH(1, krB, vrB);
        __syncthreads();
        float m = -1e30f, l = 0.f, rl = 0.f; f32x16 o[2]; unsigned otp[2][8];
#pragma unroll
        for (int r = 0; r < 16; ++r) { o[0][r] = 0.f; o[1][r] = 0.f; }
#pragma unroll
        for (int r = 0; r < 8; ++r) { otp[0][r] = 0u; otp[1][r] = 0u; }
        for (int s = 0; s < ST; ++s) {
            const bool has_next = s + 1 < ST;
            if (s + 2 < ST) { if (s & 1) NSA_FETCH(s + 2, krB, vrB); else NSA_FETCH(s + 2, krA, vrA); }
            const int kt = KB_OFF + (s & 1) * TILE_B, vt = VB_OFF + (s & 1) * TILE_B;
            if (s < 2 * ncb) { const int kb = s < ncb ? s : s - ncb; const int pos0 = 1024 * kb + 31;
                const float bias = slope2 * (float)(pos0 - t); const bool em = 1024 * kb + 1039 > t0; const int d0 = t - pos0 - 64 * hi;
                if (s < ncb) tile<0>(lds, kt, vt, qf, qaw16, o, m, l, lane, bias, em, d0, 16, 0x7fffffff, 0.f, tql, 0);
#if defined(PROBE_NSA) && PROBE_NSA == 7
                if (s < ncb) { float m2 = m, l2 = l; tile<0>(lds, kt, vt, qf, qaw16, o, m2, l2, lane, bias, em, d0, 16, 0x7fffffff, 0.f, tql, 0); asm volatile("" :: "v"(m2), "v"(l2)); }
#endif
                else tile<1>(lds, kt, vt, qf, qaw16, o, m, l, lane, bias, em, d0, 16, 0x7fffffff, rl, tql, 16 * kb); }
            else { int j; float bias; int lim;
                if (s < S3) { j = c - (s - 2 * ncb); bias = slope2 * (float)(64 * j - t); lim = 512; }
                else { j = SLIST[ns - 1 - (s - S3)]; const bool selq = (SEL[tql * 4 + (j >> 5)] >> (j & 31)) & 1u; bias = selq ? slope2 * (float)(64 * j - t) : -INFINITY; lim = 0x7fffffff; }
                const bool em = (j == c) || (s < S3 && c >= 8 && j == c - 8);
                tile<2>(lds, kt, vt, qf, qaw1, o, m, l, lane, bias, em, t - 64 * j - 4 * hi, 1, lim, 0.f, 0, 0); }
            if (s == ncb - 1) { const float lt0 = l + __shfl_xor(l, 32); rl = 1.0f / fmaxf(lt0, 1e-30f); }
            if (s == 2 * ncb - 1) {
#pragma unroll
                for (int r = 0; r < 8; ++r) { otp[0][r] = pg8::cvtpk_c(g_cmp * o[0][2 * r], g_cmp * o[0][2 * r + 1]); otp[1][r] = pg8::cvtpk_c(g_cmp * o[1][2 * r], g_cmp * o[1][2 * r + 1]); }
#pragma unroll
                for (int r = 0; r < 16; ++r) { o[0][r] = 0.f; o[1][r] = 0.f; }
                m = -1e30f; l = 0.f; }
            if (s == S3 - 1) { const float lt = l + __shfl_xor(l, 32); const float sc = g_win / fmaxf(lt, 1e-30f);
#pragma unroll
                for (int r = 0; r < 8; ++r) { otp[0][r] = pg8::cvtpk_c(__uint_as_float(otp[0][r] << 16) + sc * o[0][2 * r], __uint_as_float(otp[0][r] & 0xffff0000u) + sc * o[0][2 * r + 1]);
                    otp[1][r] = pg8::cvtpk_c(__uint_as_float(otp[1][r] << 16) + sc * o[1][2 * r], __uint_as_float(otp[1][r] & 0xffff0000u) + sc * o[1][2 * r + 1]); }
#pragma unroll
                for (int r = 0; r < 16; ++r) { o[0][r] = 0.f; o[1][r] = 0.f; }
                m = -1e30f; l = 0.f; }
            if (has_next) { if (s & 1) NSA_COMMIT(s + 1, krA, vrA); else NSA_COMMIT(s + 1, krB, vrB); }
            __syncthreads();
            if (s == 2 * ncb - 1 && c >= 16) {
                {
                    unsigned long long uo0 = 0ull, uo1 = 0ull;
#if defined(PROBE_NSA) && PROBE_NSA == 6
                    for (int qq = 0; qq < 16; qq += 4) { const int qi = qq & 7;
#else
                    for (int qi = 0; qi < 8; qi += 4) {
#endif
                        unsigned k0[4], k1[4]; unsigned long long m0[4], m1[4];
#pragma unroll
                        for (int u = 0; u < 4; ++u) { const int q = 8 * w + qi + u;
                            const LAS float* ia = (const LAS float*)(lds + IMPA_OFF) + q * 128; const LAS float* ib = (const LAS float*)(lds + IMPB_OFF) + q * 128;
                            const float v0 = ia[lane] + ib[lane], v1 = ia[lane + 64] + ib[lane + 64];
                            k0[u] = (lane >= 1 && lane <= c - 2) ? __float_as_uint(v0) + 1u : 0u; k1[u] = (lane + 64 <= c - 2) ? __float_as_uint(v1) + 1u : 0u; }
                        select13(k0, k1, lane, m0, m1);
#pragma unroll
                        for (int u = 0; u < 4; ++u) { const int q = 8 * w + qi + u;
                            m0[u] |= 1ull;
                            if (c - 1 < 64) m0[u] |= 1ull << (c - 1); else m1[u] |= 1ull << (c - 1 - 64);
                            if (c < 64) m0[u] |= 1ull << c; else m1[u] |= 1ull << (c - 64);
                            uo0 |= m0[u]; uo1 |= m1[u];
                            if (lane == 0) { SEL[q * 4 + 0] = (unsigned)m0[u]; SEL[q * 4 + 1] = (unsigned)(m0[u] >> 32); SEL[q * 4 + 2] = (unsigned)m1[u]; SEL[q * 4 + 3] = (unsigned)(m1[u] >> 32); } }
                    }
                    if (lane == 0) { __hip_atomic_fetch_or(UNI + 0, (unsigned)uo0, __ATOMIC_RELAXED, __HIP_MEMORY_SCOPE_WORKGROUP); __hip_atomic_fetch_or(UNI + 1, (unsigned)(uo0 >> 32), __ATOMIC_RELAXED, __HIP_MEMORY_SCOPE_WORKGROUP);
                        __hip_atomic_fetch_or(UNI + 2, (unsigned)uo1, __ATOMIC_RELAXED, __HIP_MEMORY_SCOPE_WORKGROUP); __hip_atomic_fetch_or(UNI + 3, (unsigned)(uo1 >> 32), __ATOMIC_RELAXED, __HIP_MEMORY_SCOPE_WORKGROUP); }
                }
                __syncthreads();
                if (w == 0) {
                    const unsigned long long u0 = (unsigned long long)UNI[0] | ((unsigned long long)UNI[1] << 32), u1 = (unsigned long long)UNI[2] | ((unsigned long long)UNI[3] << 32);
                    if ((u0 >> lane) & 1ull) SLIST[below(u0)] = lane;
                    if ((u1 >> lane) & 1ull) SLIST[__popcll(u0) + below(u1)] = 64 + lane;
                    if (lane == 0) NSW[0] = __popcll(u0) + __popcll(u1);
                }
                __syncthreads();
                ns = __builtin_amdgcn_readfirstlane(NSW[0]); ST = S3 + ns;
            }
        }
        { const float lt = l + __shfl_xor(l, 32); const float sc = g_slc / fmaxf(lt, 1e-30f);
          bf16* orow = Op + mrow * 1024 + head * 64;
#pragma unroll
          for (int d0 = 0; d0 < 2; ++d0)
#pragma unroll
              for (int a4 = 0; a4 < 4; ++a4) { const unsigned p0_ = otp[d0][2 * a4], p1_ = otp[d0][2 * a4 + 1]; v2u wv;
                  wv.x = pg8::cvtpk_c(__uint_as_float(p0_ << 16) + sc * o[d0][4 * a4], __uint_as_float(p0_ & 0xffff0000u) + sc * o[d0][4 * a4 + 1]);
                  wv.y = pg8::cvtpk_c(__uint_as_float(p1_ << 16) + sc * o[d0][4 * a4 + 2], __uint_as_float(p1_ & 0xffff0000u) + sc * o[d0][4 * a4 + 3]);
                  *(GAS v2u*)(orow + 32 * d0 + 8 * a4 + 4 * hi) = wv; } }
#undef NSA_FETCH
#undef NSA_COMMIT
    }
}

__device__ __forceinline__ f32x4 bf4(const v2u a) { return (f32x4){__uint_as_float(a.x << 16), __uint_as_float(a.x & 0xffff0000u), __uint_as_float(a.y << 16), __uint_as_float(a.y & 0xffff0000u)}; }
__device__ __forceinline__ void ln_rows(Frame& F, const bf16* tin, const float* gain, const float* bias, bf16* xb) {
    const int gw = F.vcu * NWAVES + F.wave, NGW = F.G * NWAVES, lane = F.lane;
    f32x4 gv[4], bv[4];
#pragma unroll
    for (int j = 0; j < 4; ++j) { gv[j] = *((const GAS f32x4*)gain + lane + 64 * j); bv[j] = *((const GAS f32x4*)bias + lane + 64 * j); }
    for (int m0 = gw; m0 < M; m0 += 8 * NGW) {
        v2u raw[8][4];
#pragma unroll
        for (int k = 0; k < 8; ++k) { const int m = m0 + k * NGW; if (m < M) { const GAS v2u* xr = (const GAS v2u*)(tin + (size_t)m * D) + lane;
#pragma unroll
            for (int j = 0; j < 4; ++j) raw[k][j] = xr[64 * j]; } }
#pragma unroll
        for (int k = 0; k < 8; ++k) { const int m = m0 + k * NGW; if (m >= M) break;
            f32x4 v[4]; float s = 0.f;
#pragma unroll
            for (int j = 0; j < 4; ++j) { v[j] = bf4(raw[k][j]); s += (v[j].x + v[j].y) + (v[j].z + v[j].w); }
            const float mean = wave_sum(s) * (1.f / D); float s2 = 0.f;
#pragma unroll
            for (int j = 0; j < 4; ++j) { v[j] = v[j] - mean; s2 += (v[j].x * v[j].x + v[j].y * v[j].y) + (v[j].z * v[j].z + v[j].w * v[j].w); }
            const float rstd = 1.f / sqrtf(wave_sum(s2) * (1.f / D) + LN_EPS);
            GAS unsigned long long* o8 = (GAS unsigned long long*)(xb + (size_t)m * D) + lane;
#pragma unroll
            for (int j = 0; j < 4; ++j) { const f32x4 y = v[j] * rstd * gv[j] + bv[j]; o8[64 * j] = (unsigned long long)pk2(y.x, y.y) | ((unsigned long long)pk2(y.z, y.w) << 32); }
        }
    }
}
namespace gla {
constexpr int ALS_OFF = 0, SEG_OFF = 4096, KH_OFF = 8192, KH_STR = 272, VH1_OFF = KH_OFF + 64 * KH_STR, VH_STR = 528, ZL_OFF = VH1_OFF + 64 * VH_STR, ZL_STR = 272;
constexpr int QS_OFF = 0, QS_STR = 272, AL_OFF = 64 * QS_STR, AL_STR = 144, VH3_OFF = AL_OFF + 64 * AL_STR, ST_OFF = VH3_OFF + 64 * VH_STR, ST_STR = 272, QT_OFF = ST_OFF, KT_OFF = ST_OFF + 64 * QS_STR, SSQ_OFF = ST_OFF + 256 * ST_STR;
constexpr int OL_OFF = ST_OFF, OL_STR = 1040;
static_assert(SSQ_OFF + 1024 <= RING_BYTES && ZL_OFF + 256 * ZL_STR <= RING_BYTES && KT_OFF + 64 * QS_STR <= SSQ_OFF && OL_OFF + 64 * OL_STR <= SSQ_OFF, "gla LDS map");
__device__ __forceinline__ bf16x8 trfrag(const LAS unsigned char* p, int rowstep4) { const v4i16 lo = vtr(p), hi4 = vtr(p + rowstep4); return (bf16x8){lo[0], lo[1], lo[2], lo[3], hi4[0], hi4[1], hi4[2], hi4[3]}; }
}
__device__ __forceinline__ void gla_load_v(LAS unsigned char* lds, int off, const bf16* qkvg, size_t m0, int vcol0, int tid) {
#pragma unroll
    for (int k = 0; k < 4; ++k) { const int q = tid + 512 * k, row = q >> 5, ch = q & 31;
        const v4u v = *(const GAS v4u*)(qkvg + (m0 + row) * 3072 + vcol0 + ch * 8); *(LAS v4u*)(lds + off + row * gla::VH_STR + ch * 16) = v; }
}
__device__ __forceinline__ void gla_g1(Frame& F) {
    using namespace gla;
    LAS unsigned char* lds = F.lds + RING_OFF; const int tid = F.tid, lane = F.lane, w = F.wave, hi = lane >> 5, qc = lane & 31;
    unsigned char* ws = F.ws; const bf16* qkvg = (const bf16*)(ws + WS_QKVG); const bf16* xbrows = (const bf16*)(ws + WS_XB); const bf16* wat = (const bf16*)(ws + WS_WIN1) + (size_t)3072 * 1024;
    float* bcum = (float*)(ws + WS_BCUM); bf16* zb = (bf16*)(ws + WS_ZB); float* dec = (float*)(ws + WS_DEC);
    const float* wg2 = inptr(F, 16); const float* bg2 = inptr(F, 17);
    LAS float* ALS = (LAS float*)(lds + ALS_OFF); LAS float* SEG = (LAS float*)(lds + SEG_OFF);
    const int d = tid & 127, ig = tid >> 7;
    for (int un = F.wg; un < 1024; un += F.G) {
        const int bh = un >> 7, n = un & 127, b = bh >> 2, h = bh & 3; const size_t m0 = (size_t)b * T + 64 * n;
        __syncthreads();
        { typedef float f32x4_ __attribute__((ext_vector_type(4)));
          const bf16* xbp = xbrows + (m0 + (lane & 15)) * 1024 + 128 * w + 8 * (lane >> 4); const bf16* wbp = wat + (size_t)(lane & 15) * 1024 + 128 * w + 8 * (lane >> 4);
          bf16x8 bq[4], aq[4][4];
#pragma unroll
          for (int ks = 0; ks < 4; ++ks) bq[ks] = *(const GAS bf16x8*)(wbp + 32 * ks);
#pragma unroll
          for (int rb = 0; rb < 4; ++rb)
#pragma unroll
              for (int ks = 0; ks < 4; ++ks) aq[rb][ks] = *(const GAS bf16x8*)(xbp + (size_t)rb * 16 * 1024 + 32 * ks);
          LAS float* PART = (LAS float*)(lds + ZL_OFF) + w * 1024;
#pragma unroll
          for (int rb = 0; rb < 4; ++rb) { f32x4_ pa = (f32x4_){0.f, 0.f, 0.f, 0.f};
#pragma unroll
              for (int ks = 0; ks < 4; ++ks) pa = __builtin_amdgcn_mfma_f32_16x16x32_bf16(aq[rb][ks], bq[ks], pa, 0, 0, 0);
#pragma unroll
              for (int j = 0; j < 4; ++j) PART[(16 * rb + 4 * (lane >> 4) + j) * 16 + (lane & 15)] = pa[j]; } }
        gla_load_v(lds, VH1_OFF, qkvg, m0, 1024 + h * 256, tid);
        bf16 kraw[16];
#pragma unroll
        for (int ii = 0; ii < 16; ++ii) kraw[ii] = *(const GAS bf16*)(qkvg + (m0 + 16 * ig + ii) * 3072 + 512 + h * 128 + d);
        float wg[16];
#pragma unroll
        for (int r = 0; r < 16; ++r) wg[r] = wg2[r * 512 + h * 128 + d];
        const float bgv = bg2[h * 128 + d];
        __syncthreads();
        { const LAS float* P0 = (const LAS float*)(lds + ZL_OFF) + 2 * tid; float s0 = 0.f, s1 = 0.f;
#pragma unroll
          for (int k = 0; k < 8; ++k) { s0 += P0[k * 1024]; s1 += P0[k * 1024 + 1]; }
          ALS[2 * tid] = s0; ALS[2 * tid + 1] = s1; }
        __syncthreads();
        float cs[16]; float run = 0.f;
#pragma unroll
        for (int ii = 0; ii < 16; ++ii) { const int i = 16 * ig + ii; float z = bgv;
#pragma unroll
            for (int r = 0; r < 16; ++r) z += ALS[i * 16 + r] * wg[r];
            const float la = (fminf(z, 0.f) - __logf(1.f + __expf(-fabsf(z)))) * (1.f / 16.f);
            run += la; cs[ii] = run; }
        SEG[ig * 128 + d] = run;
        __syncthreads();
        float pre = 0.f, tot = 0.f;
#pragma unroll
        for (int k = 0; k < 4; ++k) { const float sv = SEG[k * 128 + d]; if (k < ig) pre += sv; tot += sv; }
#pragma unroll
        for (int ii = 0; ii < 16; ++ii) { const int i = 16 * ig + ii; cs[ii] += pre;
            *(LAS bf16*)(lds + KH_OFF + i * KH_STR + d * 2) = (bf16)f2bf(bf2f(kraw[ii]) * __expf(tot - cs[ii])); }
#pragma unroll
        for (int ii = 0; ii < 16; ++ii) *(GAS float*)(bcum + (m0 + 16 * ig + ii) * 512 + h * 128 + d) = cs[ii];
        if (ig == 0) dec[(size_t)(bh * 128 + n) * 128 + d] = __expf(tot);
        __syncthreads();
        f32x16 acc[4];
#pragma unroll
        for (int db = 0; db < 4; ++db)
#pragma unroll
            for (int r = 0; r < 16; ++r) acc[db][r] = 0.f;
        const int a = (lane >> 4) & 1, q_ = (lane & 15) >> 2, p_ = lane & 3;
#pragma unroll
        for (int s = 0; s < 4; ++s) {
            const bf16x8 bfr = trfrag(lds + VH1_OFF + (16 * s + 8 * hi + q_) * VH_STR + (32 * w + 16 * a + 4 * p_) * 2, 4 * VH_STR);
#pragma unroll
            for (int db = 0; db < 4; ++db) { const bf16x8 afr = trfrag(lds + KH_OFF + (16 * s + 8 * hi + q_) * KH_STR + (32 * db + 16 * a + 4 * p_) * 2, 4 * KH_STR);
                acc[db] = __builtin_amdgcn_mfma_f32_32x32x16_bf16(afr, bfr, acc[db], 0, 0, 0); }
        }
#pragma unroll
        for (int db = 0; db < 4; ++db)
#pragma unroll
            for (int a4 = 0; a4 < 4; ++a4) { v2u wv; wv.x = pg8::cvtpk_c(acc[db][4 * a4], acc[db][4 * a4 + 1]); wv.y = pg8::cvtpk_c(acc[db][4 * a4 + 2], acc[db][4 * a4 + 3]);
                *(LAS v2u*)(lds + ZL_OFF + (32 * w + qc) * ZL_STR + (32 * db + 8 * a4 + 4 * hi) * 2) = wv; }
        __syncthreads();
        { bf16* zu = zb + (size_t)(bh * 128 + n) * 256 * 128;
#pragma unroll
          for (int k = 0; k < 8; ++k) { const int q = tid + 512 * k, row = q >> 4, ch = q & 15; *(GAS v4u*)(zu + row * 128 + ch * 8) = *(const LAS v4u*)(lds + ZL_OFF + row * ZL_STR + ch * 16); } }
    }
}
__device__ __forceinline__ void gla_g2(Frame& F) {
    unsigned char* ws = F.ws; const bf16* zb = (const bf16*)(ws + WS_ZB); const float* dec = (const float*)(ws + WS_DEC); bf16* sst = (bf16*)(ws + WS_SST);
    for (int p = F.wg * 512 + F.tid; p < 131072; p += F.G * 512) {
        const int bh = p >> 14, e = (p >> 6) & 255, d2 = p & 63;
        float s0 = 0.f, s1 = 0.f;
        for (int n0 = 0; n0 < 128; n0 += 8) {
            pg8::f32x2 dv[8]; unsigned zz[8];
#pragma unroll
            for (int k = 0; k < 8; ++k) { const size_t cn = (size_t)(bh * 128 + n0 + k); dv[k] = *(const GAS pg8::f32x2*)(dec + cn * 128 + 2 * d2); zz[k] = *(const GAS unsigned*)(zb + (cn * 256 + e) * 128 + 2 * d2); }
#pragma unroll
            for (int k = 0; k < 8; ++k) { const size_t cn = (size_t)(bh * 128 + n0 + k);
                *(GAS unsigned*)(sst + (cn * 256 + e) * 128 + 2 * d2) = pk2(s0, s1);
                s0 = s0 * dv[k].x + __uint_as_float(zz[k] << 16); s1 = s1 * dv[k].y + __uint_as_float(zz[k] & 0xffff0000u); }
        }
    }
}
__device__ __forceinline__ void gla_g3(Frame& F) {
    using namespace gla;
    LAS unsigned char* lds = F.lds + RING_OFF; const int tid = F.tid, lane = F.lane, w = F.wave, hi = lane >> 5, qc = lane & 31;
    unsigned char* ws = F.ws; const bf16* qkvg = (const bf16*)(ws + WS_QKVG); const float* bcum = (const float*)(ws + WS_BCUM); const bf16* sst = (const bf16*)(ws + WS_SST);
    bf16* o1 = (bf16*)(ws + WS_O1); const float* hng = inptr(F, 18);
    LAS float* SSQ = (LAS float*)(lds + SSQ_OFF);
    const int d = tid & 127, ig = tid >> 7;
    const int a = (lane >> 4) & 1, q_ = (lane & 15) >> 2, p_ = lane & 3;
    for (int un = F.wg; un < 1024; un += F.G) {
        const int bh = un >> 7, n = un & 127, b = bh >> 2, h = bh & 3; const size_t m0 = (size_t)b * T + 64 * n;
        __syncthreads();
        gla_load_v(lds, VH3_OFF, qkvg, m0, 1024 + h * 256, tid);
        v4u sreg[8];
        { const bf16* sp = sst + (size_t)(bh * 128 + n) * 256 * 128;
#pragma unroll
          for (int k = 0; k < 8; ++k) { const int q = tid + 512 * k, row = q >> 4, ch = q & 15; sreg[k] = *(const GAS v4u*)(sp + row * 128 + ch * 8); } }
        { const float bref = bcum[(m0 + 32) * 512 + h * 128 + d];
          float bb[16]; bf16 qr[16], kr[16];
#pragma unroll
          for (int ii = 0; ii < 16; ++ii) { const size_t mi = m0 + 16 * ig + ii; bb[ii] = *(const GAS float*)(bcum + mi * 512 + h * 128 + d);
              qr[ii] = *(const GAS bf16*)(qkvg + mi * 3072 + h * 128 + d); kr[ii] = *(const GAS bf16*)(qkvg + mi * 3072 + 512 + h * 128 + d); }
#pragma unroll
          for (int ii = 0; ii < 16; ++ii) { const int i = 16 * ig + ii; const float qv = bf2f(qr[ii]), kv = bf2f(kr[ii]);
              *(LAS bf16*)(lds + QT_OFF + i * QS_STR + d * 2) = (bf16)f2bf(qv * __expf(bb[ii] - bref));
              *(LAS bf16*)(lds + KT_OFF + i * QS_STR + d * 2) = (bf16)f2bf(kv * __expf(bref - bb[ii]));
              *(LAS bf16*)(lds + QS_OFF + i * QS_STR + d * 2) = (bf16)f2bf(qv * __expf(bb[ii])); } }
        __syncthreads();
        if (w < 4) {
            const int jb = w >> 1, ib = w & 1; f32x16 acc;
#pragma unroll
            for (int r = 0; r < 16; ++r) acc[r] = 0.f;
#pragma unroll
            for (int s = 0; s < 8; ++s) { const bf16x8 afr = *(const LAS bf16x8*)(lds + KT_OFF + (32 * jb + qc) * QS_STR + 32 * s + 16 * hi), bfr = *(const LAS bf16x8*)(lds + QT_OFF + (32 * ib + qc) * QS_STR + 32 * s + 16 * hi);
                acc = __builtin_amdgcn_mfma_f32_32x32x16_bf16(afr, bfr, acc, 0, 0, 0); }
            const int i = 32 * ib + qc;
#pragma unroll
            for (int a4 = 0; a4 < 4; ++a4) { float v[4];
#pragma unroll
                for (int k = 0; k < 4; ++k) { const int j = 32 * jb + 8 * a4 + 4 * hi + k; v[k] = (j <= i) ? acc[4 * a4 + k] : 0.f; }
                v2u wv; wv.x = pg8::cvtpk_c(v[0], v[1]); wv.y = pg8::cvtpk_c(v[2], v[3]);
                *(LAS v2u*)(lds + AL_OFF + i * AL_STR + (32 * jb + 8 * a4 + 4 * hi) * 2) = wv; }
        }
        __syncthreads();
#pragma unroll
        for (int k = 0; k < 8; ++k) { const int q = tid + 512 * k, row = q >> 4, ch = q & 15; *(LAS v4u*)(lds + ST_OFF + row * ST_STR + ch * 16) = sreg[k]; }
        v4u ggr[4];
#pragma unroll
        for (int k = 0; k < 4; ++k) { const int q = tid + 512 * k, row = q >> 5, ch = q & 31; ggr[k] = *(const GAS v4u*)(qkvg + (m0 + row) * 3072 + 2048 + h * 256 + ch * 8); }
        __syncthreads();
        const int ib = w & 1, eq = w >> 1; f32x16 acc2[2];
#pragma unroll
        for (int r = 0; r < 16; ++r) { acc2[0][r] = 0.f; acc2[1][r] = 0.f; }
#pragma unroll
        for (int s = 0; s < 4; ++s) { const bf16x8 bfr = *(const LAS bf16x8*)(lds + AL_OFF + (32 * ib + qc) * AL_STR + 32 * s + 16 * hi);
#pragma unroll
            for (int e2 = 0; e2 < 2; ++e2) { const bf16x8 afr = trfrag(lds + VH3_OFF + (16 * s + 8 * hi + q_) * VH_STR + (32 * (2 * eq + e2) + 16 * a + 4 * p_) * 2, 4 * VH_STR);
                acc2[e2] = __builtin_amdgcn_mfma_f32_32x32x16_bf16(afr, bfr, acc2[e2], 0, 0, 0); } }
#pragma unroll
        for (int s = 0; s < 8; ++s) { const bf16x8 bfr = *(const LAS bf16x8*)(lds + QS_OFF + (32 * ib + qc) * QS_STR + 32 * s + 16 * hi);
#pragma unroll
            for (int e2 = 0; e2 < 2; ++e2) { const bf16x8 afr = *(const LAS bf16x8*)(lds + ST_OFF + (32 * (2 * eq + e2) + qc) * ST_STR + 32 * s + 16 * hi);
                acc2[e2] = __builtin_amdgcn_mfma_f32_32x32x16_bf16(afr, bfr, acc2[e2], 0, 0, 0); } }
        float ss = 0.f;
#pragma unroll
        for (int r = 0; r < 16; ++r) ss += acc2[0][r] * acc2[0][r] + acc2[1][r] * acc2[1][r];
        ss += __shfl_xor(ss, 32);
        const int i = 32 * ib + qc;
        if (hi == 0) SSQ[i * 4 + eq] = ss;
        __syncthreads();
#pragma unroll
        for (int e2 = 0; e2 < 2; ++e2)
#pragma unroll
            for (int a4 = 0; a4 < 4; ++a4) *(LAS f32x4*)(lds + OL_OFF + i * OL_STR + (32 * (2 * eq + e2) + 8 * a4 + 4 * hi) * 4) = (f32x4){acc2[e2][4 * a4], acc2[e2][4 * a4 + 1], acc2[e2][4 * a4 + 2], acc2[e2][4 * a4 + 3]};
        __syncthreads();
#pragma unroll
        for (int k = 0; k < 4; ++k) { const int q = tid + 512 * k, row = q >> 5, ch = q & 31;
            const float tot = (SSQ[row * 4 + 0] + SSQ[row * 4 + 1]) + (SSQ[row * 4 + 2] + SSQ[row * 4 + 3]); const float rstd = 1.f / sqrtf(tot * (1.f / 256.f) + RMS_EPS);
            const f32x4 oa = *(const LAS f32x4*)(lds + OL_OFF + row * OL_STR + ch * 32), ob = *(const LAS f32x4*)(lds + OL_OFF + row * OL_STR + ch * 32 + 16);
            const v4u gg = ggr[k];
            const f32x4 na = *(const GAS f32x4*)(hng + h * 256 + ch * 8), nb = *(const GAS f32x4*)(hng + h * 256 + ch * 8 + 4);
            const float g0 = __uint_as_float(gg.x << 16), g1 = __uint_as_float(gg.x & 0xffff0000u), g2 = __uint_as_float(gg.y << 16), g3 = __uint_as_float(gg.y & 0xffff0000u);
            const float g4 = __uint_as_float(gg.z << 16), g5 = __uint_as_float(gg.z & 0xffff0000u), g6 = __uint_as_float(gg.w << 16), g7 = __uint_as_float(gg.w & 0xffff0000u);
            v4u wv; wv.x = pg8::cvtpk_c(oa[0] * rstd * na[0] * pg8::silu1(g0), oa[1] * rstd * na[1] * pg8::silu1(g1)); wv.y = pg8::cvtpk_c(oa[2] * rstd * na[2] * pg8::silu1(g2), oa[3] * rstd * na[3] * pg8::silu1(g3));
            wv.z = pg8::cvtpk_c(ob[0] * rstd * nb[0] * pg8::silu1(g4), ob[1] * rstd * nb[1] * pg8::silu1(g5)); wv.w = pg8::cvtpk_c(ob[2] * rstd * nb[2] * pg8::silu1(g6), ob[3] * rstd * nb[3] * pg8::silu1(g7));
            *(GAS v4u*)(o1 + (m0 + row) * 1024 + h * 256 + ch * 8) = wv; }
    }
}
__device__ __forceinline__ void ln_router(Frame& F, const bf16* tin, const float* gain, const float* bias, bf16* xb) {
    LAS unsigned char* lds = F.lds + RING_OFF; const int lane = F.lane, w = F.wave;
    unsigned char* ws = F.ws; const float* wr = inptr(F, 22);
    int* toke = (int*)(ws + WS_TOKE); float* tokw = (float*)(ws + WS_TOKW); int* tokp = (int*)(ws + WS_TOKP); int* cntl = (int*)(ws + WS_CNTL);
    const int RPW = M / F.G, RPV = RPW / NWAVES;
    LAS int* EL = (LAS int*)lds;
    f32x4 gv[4], bv[4];
#pragma unroll
    for (int j = 0; j < 4; ++j) { gv[j] = *((const GAS f32x4*)gain + lane + 64 * j); bv[j] = *((const GAS f32x4*)bias + lane + 64 * j); }
    LAS float* WL = (LAS float*)(lds + 1024);
    __syncthreads();
    for (int c = F.tid; c < D; c += NWAVES * 64) { const f32x4 w0 = *(const GAS f32x4*)(wr + (size_t)c * 8), w1 = *(const GAS f32x4*)(wr + (size_t)c * 8 + 4);
        const int rec = (4 * (c >> 8) + (c & 3)) * 64 + ((c & 255) >> 2); *(LAS f32x4*)(WL + rec * 8) = w0; *(LAS f32x4*)(WL + rec * 8 + 4) = w1; }
    v2u raw[8][4];
#pragma unroll
    for (int rr = 0; rr < 8; ++rr) if (rr < RPV) { const GAS v2u* xr = (const GAS v2u*)(tin + (size_t)(F.wg * RPW + w * RPV + rr) * D) + lane;
#pragma unroll
        for (int j = 0; j < 4; ++j) raw[rr][j] = xr[64 * j]; }
    __syncthreads();
#pragma unroll
    for (int rr = 0; rr < 8; ++rr) { if (rr >= RPV) break;
        const int lr = w * RPV + rr, m = F.wg * RPW + lr;
        f32x4 v[4]; float s = 0.f;
#pragma unroll
        for (int j = 0; j < 4; ++j) { v[j] = bf4(raw[rr][j]); s += (v[j].x + v[j].y) + (v[j].z + v[j].w); }
        const float mean = wave_sum(s) * (1.f / D); float s2 = 0.f;
#pragma unroll
        for (int j = 0; j < 4; ++j) { v[j] = v[j] - mean; s2 += (v[j].x * v[j].x + v[j].y * v[j].y) + (v[j].z * v[j].z + v[j].w * v[j].w); }
        const float rstd = 1.f / sqrtf(wave_sum(s2) * (1.f / D) + LN_EPS);
        GAS unsigned long long* o8 = (GAS unsigned long long*)(xb + (size_t)m * D) + lane;
        float lg[8];
#pragma unroll
        for (int e = 0; e < 8; ++e) lg[e] = 0.f;
#pragma unroll
        for (int j = 0; j < 4; ++j) { const f32x4 y = v[j] * rstd * gv[j] + bv[j]; o8[64 * j] = (unsigned long long)pk2(y.x, y.y) | ((unsigned long long)pk2(y.z, y.w) << 32);
#pragma unroll
            for (int k = 0; k < 4; ++k) { const LAS float* rp = WL + ((4 * j + k) * 64 + lane) * 8; const f32x4 w0 = *(const LAS f32x4*)rp, w1 = *(const LAS f32x4*)(rp + 4);
                lg[0] += y[k] * w0[0]; lg[1] += y[k] * w0[1]; lg[2] += y[k] * w0[2]; lg[3] += y[k] * w0[3]; lg[4] += y[k] * w1[0]; lg[5] += y[k] * w1[1]; lg[6] += y[k] * w1[2]; lg[7] += y[k] * w1[3]; } }
#pragma unroll
        for (int e = 0; e < 8; ++e) lg[e] = wave_sum(lg[e]);
        int e1 = 0; float v1 = lg[0];
#pragma unroll
        for (int e = 1; e < 8; ++e) if (lg[e] > v1) { v1 = lg[e]; e1 = e; }
        int e2 = -1; float v2 = -3.4e38f;
#pragma unroll
        for (int e = 0; e < 8; ++e) if (e != e1 && lg[e] > v2) { v2 = lg[e]; e2 = e; }
        const float w2 = 1.f / (1.f + __expf(v1 - v2)), w1 = 1.f - w2;
        if (lane == 0) { toke[m * 2] = e1; toke[m * 2 + 1] = e2; tokw[m * 2] = w1; tokw[m * 2 + 1] = w2; EL[lr] = e1; EL[RPW + lr] = e2; }
    }
    __syncthreads();
    if (w == 0) {
        const bool act = lane < RPW; int base[8];
#pragma unroll
        for (int e = 0; e < 8; ++e) base[e] = 0;
        const unsigned long long ltm = (1ull << lane) - 1ull;
#pragma unroll
        for (int k = 0; k < 2; ++k) { const int ek = act ? EL[k * RPW + lane] : -1; int pos = 0;
#pragma unroll
            for (int e = 0; e < 8; ++e) { const unsigned long long mk = __ballot(ek == e); if (ek == e) pos = base[e] + __popcll(mk & ltm); base[e] += __popcll(mk); }
            if (act) tokp[(F.wg * RPW + lane) * 2 + k] = pos; }
        if (lane < 8) { int cv = 0;
#pragma unroll
            for (int e = 0; e < 8; ++e) if (lane == e) cv = base[e];
            cntl[F.wg * 8 + lane] = cv; }
    }
}
__device__ __forceinline__ void moe_tables(Frame& F) {
    LAS int* TP = (LAS int*)(F.lds + LDSCTL_OFF); LAS int* BASE = TP + 16; LAS int* ACC = TP + 32;
    const int* cntl = (const int*)(F.ws + WS_CNTL);
    __syncthreads();
    if (F.tid < 16) ACC[F.tid] = 0;
    __syncthreads();
    int tot = 0, pre = 0; const int e = F.tid & 7;
    for (int wq = F.tid >> 3; wq < F.G; wq += 64) { const int cv = __hip_atomic_load(cntl + wq * 8 + e, __ATOMIC_RELAXED, __HIP_MEMORY_SCOPE_AGENT); tot += cv; if (wq < F.wg) pre += cv; }
    __hip_atomic_fetch_add(ACC + e, tot, __ATOMIC_RELAXED, __HIP_MEMORY_SCOPE_WORKGROUP); __hip_atomic_fetch_add(ACC + 8 + e, pre, __ATOMIC_RELAXED, __HIP_MEMORY_SCOPE_WORKGROUP);
    __syncthreads();
    if (F.tid == 0) { int tp = 0;
        for (int k = 0; k < 8; ++k) { TP[k] = tp; BASE[k] = tp * 256 + ACC[8 + k]; tp += (ACC[k] + 255) >> 8; }
        TP[8] = tp; }
    __syncthreads();
}
__device__ __forceinline__ void moe_gather(Frame& F) {
    moe_tables(F);
    LAS int* BASE = (LAS int*)(F.lds + LDSCTL_OFF) + 16;
    unsigned char* ws = F.ws; const int* toke = (const int*)(ws + WS_TOKE); const int* tokp = (const int*)(ws + WS_TOKP); int* toks = (int*)(ws + WS_TOKS);
    const bf16* xb = (const bf16*)(ws + WS_XB); bf16* xg = (bf16*)(ws + WS_XG);
    const int RPW = M / F.G;
    for (int q0 = F.wave; q0 < 2 * RPW; q0 += 4 * NWAVES) {
        int mm[4], sl[4]; v4u ra[4], rb[4];
#pragma unroll
        for (int u = 0; u < 4; ++u) { const int q = q0 + u * NWAVES; const bool ok = q < 2 * RPW; const int m = F.wg * RPW + (q >> 1), k = q & 1; mm[u] = ok ? m * 2 + k : -1;
            const int e = ok ? toke[m * 2 + k] : 0; sl[u] = BASE[e] + (ok ? tokp[m * 2 + k] : 0); }
#pragma unroll
        for (int u = 0; u < 4; ++u) if (mm[u] >= 0) { const GAS v4u* src = (const GAS v4u*)(xb + (size_t)(mm[u] >> 1) * D) + F.lane; ra[u] = src[0]; rb[u] = src[64]; }
#pragma unroll
        for (int u = 0; u < 4; ++u) if (mm[u] >= 0) { if (F.lane == 0) toks[mm[u]] = sl[u]; GAS v4u* dst = (GAS v4u*)(xg + (size_t)sl[u] * D) + F.lane; dst[0] = ra[u]; dst[64] = rb[u]; }
    }
}
__device__ __forceinline__ void moe_final(Frame& F) {
    const int gw = F.vcu * NWAVES + F.wave, NGW = F.G * NWAVES, lane = F.lane;
    unsigned char* ws = F.ws; const bf16* xres = (const bf16*)(ws + WS_XB); const bf16* yb = (const bf16*)(ws + WS_YB); constexpr size_t KSTR = (WS_YB1 - WS_YB) / 2;
    const int* toks = (const int*)(ws + WS_TOKS); const float* tokw = (const float*)(ws + WS_TOKW); const float* gain = inptr(F, 25); const float* bias = inptr(F, 26);
    f32x4 gv[4], bv[4];
#pragma unroll
    for (int j = 0; j < 4; ++j) { gv[j] = *((const GAS f32x4*)gain + lane + 64 * j); bv[j] = *((const GAS f32x4*)bias + lane + 64 * j); }
    for (int m0 = gw; m0 < M; m0 += 4 * NGW) {
        int s1[4], s2[4]; float w1[4], w2[4];
#pragma unroll
        for (int k = 0; k < 4; ++k) { const int m = m0 + k * NGW; const bool ok = m < M; s1[k] = ok ? toks[m * 2] : 0; s2[k] = ok ? toks[m * 2 + 1] : 0; w1[k] = ok ? tokw[m * 2] : 0.f; w2[k] = ok ? tokw[m * 2 + 1] : 0.f; }
        v2u xr_[4][4], ya_[4][4], yc_[4][4];
#pragma unroll
        for (int k = 0; k < 4; ++k) { const int m = m0 + k * NGW; if (m < M) {
            const GAS v2u* xr = (const GAS v2u*)(xres + (size_t)m * D) + lane;
            const GAS v2u* y1 = (const GAS v2u*)(s1[k] < 32768 ? yb + (size_t)s1[k] * D : yb + KSTR + (size_t)(s1[k] - 32768) * D) + lane;
            const GAS v2u* y2 = (const GAS v2u*)(s2[k] < 32768 ? yb + (size_t)s2[k] * D : yb + KSTR + (size_t)(s2[k] - 32768) * D) + lane;
#pragma unroll
            for (int j = 0; j < 4; ++j) { xr_[k][j] = xr[64 * j]; ya_[k][j] = y1[64 * j]; yc_[k][j] = y2[64 * j]; } } }
#pragma unroll
        for (int k = 0; k < 4; ++k) { const int m = m0 + k * NGW; if (m >= M) break;
            f32x4 v[4], ya[4], yc[4];
#pragma unroll
            for (int j = 0; j < 4; ++j) { ya[j] = bf4(ya_[k][j]); yc[j] = bf4(yc_[k][j]); }
            if (s1[k] >= 32768) { for (int ks = 1; ks < 7; ++ks) { const GAS v2u* y1 = (const GAS v2u*)(yb + KSTR + ((size_t)ks * 2048 + (s1[k] - 32768)) * D) + lane;
#pragma unroll
                for (int j = 0; j < 4; ++j) ya[j] += bf4(y1[64 * j]); } }
            if (s2[k] >= 32768) { for (int ks = 1; ks < 7; ++ks) { const GAS v2u* y2 = (const GAS v2u*)(yb + KSTR + ((size_t)ks * 2048 + (s2[k] - 32768)) * D) + lane;
#pragma unroll
                for (int j = 0; j < 4; ++j) yc[j] += bf4(y2[64 * j]); } }
            float s = 0.f;
#pragma unroll
            for (int j = 0; j < 4; ++j) { const f32x4 x = bf4(xr_[k][j]); v[j] = x * ALPHA + (ya[j] * w1[k] + yc[j] * w2[k]); s += (v[j].x + v[j].y) + (v[j].z + v[j].w); }
            const float mean = wave_sum(s) * (1.f / D); float q2 = 0.f;
#pragma unroll
            for (int j = 0; j < 4; ++j) { v[j] = v[j] - mean; q2 += (v[j].x * v[j].x + v[j].y * v[j].y) + (v[j].z * v[j].z + v[j].w * v[j].w); }
            const float rstd = 1.f / sqrtf(wave_sum(q2) * (1.f / D) + LN_EPS);
            GAS f32x4* xo = (GAS f32x4*)(F.out + (size_t)m * D) + lane;
#pragma unroll
            for (int j = 0; j < 4; ++j) xo[64 * j] = v[j] * rstd * gv[j] + bv[j];
        }
    }
}
__global__ void __launch_bounds__(NWAVES * 64, 2) fwd(Args args) {
    extern __shared__ __attribute__((aligned(16))) unsigned char lds[];
    Frame F;
    F.A = &args;
    F.lds = (LAS unsigned char*)lds;
    F.MISC = (volatile LAS unsigned*)(F.lds + MISC_OFF);
    F.tid = threadIdx.x; F.lane = F.tid & 63; F.wave = __builtin_amdgcn_readfirstlane(F.tid >> 6);
    F.G = gridDim.x; F.wg = blockIdx.x; { const int bx = blockIdx.x; F.vcu = (F.G % 8 == 0) ? (bx % 8) * (F.G / 8) + bx / 8 : bx; }
    F.ws = args.ws; F.out = args.out;
    unsigned char* ws = args.ws;
    F.ctl = (gu32*)(ws + WS_CTL);
    for (int u = F.tid; u < (LDS_BYTES - LDSCTL_OFF) / 4; u += NWAVES * 64) ((LAS unsigned*)(F.lds + LDSCTL_OFF))[u] = 0u;
    __syncthreads();
    XcdBarrier bar; bar.bar = (unsigned*)(F.ctl + CW_BAR); bar.x = 0; bar.st = nullptr;
    if (!MK_PER_PHASE) bar = xcd_barrier_post((unsigned*)(F.ctl + CW_BAR), F.MISC + 8);
#define GRID_BAR() do { if (!MK_PER_PHASE) xcd_barrier(bar); } while (0)
    const int lo = args.ph_lo, hi = args.ph_hi;
#define IN(k) (lo <= (k) && (k) < hi)
#define SEAM(k) do { if (IN((k) + 1)) GRID_BAR(); } while (0)
    bf16* XB = (bf16*)(ws + WS_XB); bf16* T0 = (bf16*)(ws + WS_T0);
    const int cwg = (int)blockIdx.x;

#ifndef HANDOFF
#define HANDOFF 0
#endif
#ifndef PROBE_REP
#define PROBE_REP -1
#endif
#define REP(k) (PROBE_REP == (k) ? 2 : 1)
    if (IN(0)) { for (int rep = 0; rep < REP(0); ++rep) { if (rep) GRID_BAR(); p0_prologue(F); } SEAM(0); }
    if (IN(1)) { pg8::Gemm g{XB, (const bf16*)(ws + WS_WIN0), M, NSA_IN_PAD, D, D}; pg8::StaticOrder S; S.init(M, NSA_IN_PAD, F.G, cwg);
        pg8::EpiNsaIn E{(bf16*)(ws + WS_Q), (bf16*)(ws + WS_KV2), (bf16*)(ws + WS_KS), (bf16*)(ws + WS_VS), (bf16*)(ws + WS_KW), (bf16*)(ws + WS_VW), (float*)(ws + WS_GT), 0.125f * LOG2E};
        pg8::gemm_phase<pg8::EpiNsaIn, pg8::StaticOrder, PG8_ALIGN, PG8_SP2>(F.lds + RING_OFF, g, S, E); SEAM(1); }
    if (IN(2)) { pg8::Gemm g{(const bf16*)(ws + WS_KV2), (const bf16*)(ws + WS_W1C), 8192, 1024, 1024, 1024}; pg8::CmpOrder S{F.G, cwg}; pg8::EpiF32Cmp E{(float*)(ws + WS_UL)};
        pg8::gemm_phase<pg8::EpiF32Cmp, pg8::CmpOrder, PG8_ALIGN, PG8_SP2>(F.lds + RING_OFF, g, S, E);
        SEAM(2); }
    if (IN(3)) { cmp_finish(F); SEAM(3); }
    if (IN(4)) { for (int rep = 0; rep < REP(4); ++rep) { if (rep) GRID_BAR(); nsa_attn_phase(F); } SEAM(4); }
    if (IN(5)) { pg8::Gemm g{(const bf16*)(ws + WS_O), (const bf16*)(ws + WS_WO0), M, D, D, D}; pg8::StaticOrder S; S.init(M, D, F.G, cwg); pg8::EpiResBf16<true> E{XB, T0, ALPHA};
        pg8::gemm_phase<pg8::EpiResBf16<true>, pg8::StaticOrder, PG8_ALIGN, PG8_SP2>(F.lds + RING_OFF, g, S, E); SEAM(5); }
    if (IN(6)) { ln_rows(F, T0, inptr(F, 9), inptr(F, 10), XB); SEAM(6); }
#if HANDOFF
    if (IN(7)) { pg8::Gemm g{XB, (const bf16*)(ws + WS_WGU0), M, 2 * FF0, D, D}; pg8::PubOrder<pg8::StaticOrder> S; S.init(M, 2 * FF0, F.G, cwg); S.cnt = (unsigned*)(F.ctl + CW_PANEL0); S.pend = -1; pg8::EpiSwiGLU<true> E{(bf16*)(ws + WS_H0), FF0, 2 * FF0 / 256};
        pg8::gemm_phase<pg8::EpiSwiGLU<true>, pg8::PubOrder<pg8::StaticOrder>, PG8_ALIGN, PG8_SP2>(F.lds + RING_OFF, g, S, E); S.publish(); }
    if (IN(8)) { pg8::Gemm g{(const bf16*)(ws + WS_H0), (const bf16*)(ws + WS_WD0), M, D, FF0, FF0}; pg8::WaitOrder<pg8::StaticOrder> S; S.init(M, D, F.G, (cwg + F.G - (M / 256 * (2 * FF0 / 256)) % F.G) % F.G); S.ready = (const unsigned*)(F.ctl + CW_PANEL0); S.need = 8u * (2 * FF0 / 256); S.tmo = (unsigned*)(F.ctl + CW_TMO);
        pg8::EpiResBf16<true> E{XB, T0, ALPHA};
        pg8::gemm_phase<pg8::EpiResBf16<true>, pg8::WaitOrder<pg8::StaticOrder>, PG8_ALIGN, PG8_SP2>(F.lds + RING_OFF, g, S, E); SEAM(8); }
#else
    if (IN(7)) { for (int rep = 0; rep < REP(7); ++rep) { if (rep) GRID_BAR(); pg8::Gemm g{XB, (const bf16*)(ws + WS_WGU0), M, 2 * FF0, D, D}; pg8::StaticOrder S; S.init(M, 2 * FF0, F.G, cwg); pg8::EpiSwiGLU<false> E{(bf16*)(ws + WS_H0), FF0, 2 * FF0 / 256};
        pg8::gemm_phase<pg8::EpiSwiGLU<false>, pg8::StaticOrder, PG8_ALIGN, PG8_SP2>(F.lds + RING_OFF, g, S, E); } SEAM(7); }
    if (IN(8)) { for (int rep = 0; rep < REP(8); ++rep) { if (rep) GRID_BAR(); pg8::Gemm g{(const bf16*)(ws + WS_H0), (const bf16*)(ws + WS_WD0), M, D, FF0, FF0}; pg8::StaticOrder S; S.init(M, D, F.G, cwg); pg8::EpiResBf16<true> E{XB, T0, ALPHA};
        pg8::gemm_phase<pg8::EpiResBf16<true>, pg8::StaticOrder, PG8_ALIGN, PG8_SP2>(F.lds + RING_OFF, g, S, E); } SEAM(8); }
#endif
    if (IN(9)) { ln_rows(F, T0, inptr(F, 13), inptr(F, 14), XB); SEAM(9); }
    if (IN(10)) { pg8::Gemm g{XB, (const bf16*)(ws + WS_WIN1), M, 3072, D, D}; pg8::StaticOrder S; S.init(M, 3072, F.G, cwg);     pg8::EpiGlaIn E{(bf16*)(ws + WS_QKVG), (float*)(ws + WS_ALOW), 0.08838834764831845f};
        pg8::gemm_phase<pg8::EpiGlaIn, pg8::StaticOrder, PG8_ALIGN, PG8_SP2>(F.lds + RING_OFF, g, S, E); SEAM(10); }
    for (int rep = 0; rep < REP(11); ++rep) { if (rep) GRID_BAR();
    if (IN(11)) { gla_g1(F); SEAM(11); }
    if (IN(12)) { gla_g2(F); SEAM(12); }
    if (IN(13)) { gla_g3(F); if (rep + 1 == REP(11)) SEAM(13); }
    }
    if (IN(14)) { pg8::Gemm g{(const bf16*)(ws + WS_O1), (const bf16*)(ws + WS_WO1), M, D, D, D}; pg8::StaticOrder S; S.init(M, D, F.G, cwg); pg8::EpiResBf16<true> E{XB, T0, ALPHA};
        pg8::gemm_phase<pg8::EpiResBf16<true>, pg8::StaticOrder, PG8_ALIGN, PG8_SP2>(F.lds + RING_OFF, g, S, E); SEAM(14); }
    if (IN(15)) { ln_router(F, T0, inptr(F, 20), inptr(F, 21), XB); SEAM(15); }
    if (IN(16)) { moe_gather(F); SEAM(16); }
#if 0
    if (IN(17)) { moe_tables(F); pg8::Gemm g{(const bf16*)(ws + WS_XG), (const bf16*)(ws + WS_WGU1), MAXSLOTS, NE * 2 * FFE, D, D};
        pg8::PubOrder<pg8::GroupedOrder> S; S.G = F.G; S.c = cwg; S.NT = 2 * FFE / 256; S.KS = 1; S.KL = 0; S.tp = (const PG8_LAS int*)(F.lds + LDSCTL_OFF); S.cnt = (unsigned*)(F.ctl + CW_PANEL1); S.pend = -1;
        pg8::EpiSwiGLU<true> E{(bf16*)(ws + WS_H2), FFE, 2 * FFE / 256};
        pg8::gemm_phase<pg8::EpiSwiGLU<true>, pg8::PubOrder<pg8::GroupedOrder>, PG8_ALIGN, PG8_SP2>(F.lds + RING_OFF, g, S, E); S.publish(); }
    if (IN(18)) { moe_tables(F); pg8::Gemm g{(const bf16*)(ws + WS_H2), (const bf16*)(ws + WS_WD1), MAXSLOTS, NE * D, FFE / MOE_KS, FFE};
        pg8::WaitOrder<pg8::GroupedOrder> S; S.G = F.G; S.NT = D / 256; S.KS = MOE_KS; S.KL = FFE / MOE_KS; S.tp = (const PG8_LAS int*)(F.lds + LDSCTL_OFF);
        { const int n17 = S.tp[8] * (2 * FFE / 256); S.c = (cwg + F.G - ((n17 % F.G) & ~7)) % F.G; }
        S.ready = (const unsigned*)(F.ctl + CW_PANEL1); S.need = 8u * (2 * FFE / 256); S.tmo = (unsigned*)(F.ctl + CW_TMO); pg8::EpiBf16Y E{(bf16*)(ws + WS_YB), (size_t)(WS_YB1 - WS_YB) / 2};
        pg8::gemm_phase<pg8::EpiBf16Y, pg8::WaitOrder<pg8::GroupedOrder>, PG8_ALIGN, PG8_SP2>(F.lds + RING_OFF, g, S, E); SEAM(18); }
#else
#ifndef STAGGER_US
#define STAGGER_US 0
#endif
    if (IN(17)) { for (int rep = 0; rep < REP(17); ++rep) { if (rep) GRID_BAR(); moe_tables(F);
        if (STAGGER_US) { const unsigned long long t0 = __builtin_amdgcn_s_memrealtime(), dl = (unsigned long long)((cwg >> 3) & 3) * (STAGGER_US * 100ull); while (__builtin_amdgcn_s_memrealtime() - t0 < dl) __builtin_amdgcn_s_sleep(8); }
        pg8::Gemm g{(const bf16*)(ws + WS_XG), (const bf16*)(ws + WS_WGU1), MAXSLOTS, NE * 2 * FFE, D, D};
        pg8::GroupedOrder S{F.G, cwg, 2 * FFE / 256, 1, 0, (const PG8_LAS int*)(F.lds + LDSCTL_OFF)}; pg8::EpiSwiGLU<false> E{(bf16*)(ws + WS_H2), FFE, 2 * FFE / 256};
        pg8::gemm_phase<pg8::EpiSwiGLU<false>, pg8::GroupedOrder, PG8_ALIGN, PG8_SP2>(F.lds + RING_OFF, g, S, E); } SEAM(17); }
    if (IN(18)) { for (int rep = 0; rep < REP(18); ++rep) { if (rep) GRID_BAR(); moe_tables(F);
        { pg8::Gemm g{(const bf16*)(ws + WS_H2), (const bf16*)(ws + WS_WD1), MAXSLOTS, NE * D, FFE, FFE}; pg8::MoeDownOrder S{F.G, cwg, 0, (const PG8_LAS int*)(F.lds + LDSCTL_OFF)};
          pg8::EpiBf16Y2 E{(bf16*)(ws + WS_YB), (bf16*)(ws + WS_YB1), 0}; pg8::gemm_phase<pg8::EpiBf16Y2, pg8::MoeDownOrder, PG8_ALIGN, PG8_SP2>(F.lds + RING_OFF, g, S, E); }
        { pg8::Gemm g{(const bf16*)(ws + WS_H2), (const bf16*)(ws + WS_WD1), MAXSLOTS, NE * D, 512, FFE}; pg8::MoeDownOrder S{F.G, cwg, 1, (const PG8_LAS int*)(F.lds + LDSCTL_OFF)};
          pg8::EpiBf16Y2 E{(bf16*)(ws + WS_YB), (bf16*)(ws + WS_YB1), 1}; pg8::gemm_phase<pg8::EpiBf16Y2, pg8::MoeDownOrder, PG8_ALIGN, PG8_SP2>(F.lds + RING_OFF, g, S, E); } } SEAM(18); }
#endif
    if (IN(19)) { moe_final(F); }
#undef IN
#undef SEAM
#undef GRID_BAR
}

extern "C" void kernel_launch(void* const* d_in, const int* in_sizes, int n_in, void* d_out, int out_size, void* d_ws, size_t ws_size, hipStream_t stream) {
    static int grid = 0;
    if (grid == 0) {
        if (n_in != 27 || in_sizes[0] != M * D || out_size != M * D || ws_size < WS_END) { fprintf(stderr, "kernel_launch: unexpected problem shape (n_in %d, in0 %d, out %d, ws %zu); nothing launched\n", n_in, n_in > 0 ? in_sizes[0] : -1, out_size, ws_size); grid = -1; return; }
        if (hipFuncSetAttribute((const void*)fwd, hipFuncAttributeMaxDynamicSharedMemorySize, LDS_BYTES) != hipSuccess) { fprintf(stderr, "kernel_launch: hipFuncSetAttribute failed\n"); grid = -1; return; }
        int dev = 0, cus = 0, per_cu = 0;
        (void)hipGetDevice(&dev); (void)hipDeviceGetAttribute(&cus, hipDeviceAttributeMultiprocessorCount, dev);
        if (hipOccupancyMaxActiveBlocksPerMultiprocessor(&per_cu, (const void*)fwd, NWAVES * 64, LDS_BYTES) != hipSuccess || per_cu < 1) fprintf(stderr, "kernel_launch: note: occupancy query reports %d workgroups per CU\n", per_cu);
        (void)hipGetLastError();
        grid = 256;
        if (cus < 256) fprintf(stderr, "kernel_launch: device has %d CUs; this kernel needs 256 resident workgroups\n", cus);
    }
    if (grid < 0) return;
    if (hipMemsetAsync((char*)d_ws + WS_CTL, 0, CTL_ZERO_BYTES, stream) != hipSuccess) { fprintf(stderr, "kernel_launch: hipMemsetAsync failed\n"); return; }
    Args a{};
    for (int i = 0; i < 27; ++i) a.in[i] = (const float*)d_in[i];
    a.out = (float*)d_out; a.ws = (unsigned char*)d_ws;
#if MK_PER_PHASE
    for (int p = 0; p < N_PHASES; ++p) { a.ph_lo = p; a.ph_hi = p + 1; hipLaunchKernelGGL(fwd, dim3(grid), dim3(NWAVES * 64), LDS_BYTES, stream, a); }
#else
    a.ph_lo = 0; a.ph_hi = N_PHASES;
    hipLaunchKernelGGL(fwd, dim3(grid), dim3(NWAVES * 64), LDS_BYTES, stream, a);
#endif
    const hipError_t le = hipPeekAtLastError();
    if (le != hipSuccess) fprintf(stderr, "kernel_launch: launch failed: %s\n", hipGetErrorName(le));
}
```

```cpp
#include <hip/hip_runtime.h>
#include <cstdio>
#include <cstdint>
namespace pg8 {
#define PG8_LAS __attribute__((address_space(3)))
typedef unsigned short bf16_t;
typedef short bf16x8 __attribute__((ext_vector_type(8)));
typedef float f32x4 __attribute__((ext_vector_type(4)));
typedef unsigned u32x4 __attribute__((ext_vector_type(4)));
constexpr int BM = 256, BK = 64, HALF = 128, HTB = HALF * BK * 2  , STAGE_BYTES = 8 * HTB, NXCD = 8, WGM = 8;

__host__ __device__ __forceinline__ int lds_byte(int r, int c) { const int st = (r >> 4) * 2 + (c >> 5), rr = r & 15, cc = c & 31, ob = rr * 64 + cc * 2; return st * 1024 + (ob ^ (((ob >> 9) & 1) << 5)); }
__host__ __device__ __forceinline__ void stage_rc(int b, int& R, int& C) { const int st = b / 1024, sb = b % 1024, swz = sb ^ (((sb >> 9) & 1) << 5); R = (st >> 1) * 16 + swz / 64; C = (st & 1) * 32 + (swz % 64) / 2; }
__host__ __device__ __forceinline__ int perm32(int rho) { const int n = rho >> 4, i = rho & 15; return 8 * (i >> 2) + 4 * n + (i & 3); }

struct Unit { int pm, pn, ko; };
struct Gemm { const bf16_t* A; const bf16_t* Bt; int M, N, K, ld; };

struct StaticOrder {
    int nM, nN, nwg, G, c;
    __host__ __device__ void init(int M, int N, int G_, int c_) { nM = M / BM; nN = N / BM; nwg = nM * nN; G = G_; c = c_; }
    __host__ __device__ bool next(int i, Unit& u) const {
        const long L = (long)i * G + c; if (L >= nwg) return false;
        int wgid = (int)L; { const int q = nwg / NXCD, r = nwg % NXCD, xcd = wgid % NXCD, off = wgid / NXCD; wgid = (xcd < r ? xcd * (q + 1) : r * (q + 1) + (xcd - r) * q) + off; }
        const int nig = WGM * nN, gid = wgid / nig, fm = gid * WGM, gsz = (nM - fm) < WGM ? (nM - fm) : WGM;
        u.pm = fm + ((wgid % nig) % gsz); u.pn = (wgid % nig) / gsz; u.ko = 0; return true;
    }
    __device__ __forceinline__ void a_ready(const Unit&) const {}
    __device__ __forceinline__ void done(const Unit&) const {}
};
__device__ __forceinline__ unsigned cvt_pk_bf16(float lo, float hi) { unsigned r; asm volatile("v_cvt_pk_bf16_f32 %0, %1, %2" : "=v"(r) : "v"(lo), "v"(hi)); return r; }
typedef float f32x2 __attribute__((ext_vector_type(2)));
typedef __bf16 bf16x2_t_ __attribute__((ext_vector_type(2)));
__device__ __forceinline__ unsigned cvtpk_c(float lo, float hi) { f32x2 v = {lo, hi}; bf16x2_t_ b = __builtin_convertvector(v, bf16x2_t_); return __builtin_bit_cast(unsigned, b); }
__device__ __forceinline__ u32x4 pack8(const f32x4 v0, const f32x4 v1) { u32x4 w; w.x = cvt_pk_bf16(v0[0], v0[1]); w.y = cvt_pk_bf16(v0[2], v0[3]); w.z = cvt_pk_bf16(v1[0], v1[1]); w.w = cvt_pk_bf16(v1[2], v1[3]); return w; }
__device__ __forceinline__ float sigm(float x) { return __builtin_amdgcn_rcpf(1.0f + __builtin_amdgcn_exp2f(-1.44269504088896341f * x)); }
__device__ __forceinline__ float silu1(float x) { return x * __builtin_amdgcn_rcpf(1.0f + __builtin_amdgcn_exp2f(-1.44269504088896341f * x)); }

struct EpiNsaIn {
    static constexpr bool PERM = true, AFTER_DRAIN = false;
    bf16_t *Q, *KV2, *KS, *VS, *KW, *VW; float* GT; float qscale;
    __device__ __forceinline__ void operator()(const f32x4 (&acc)[2][2][4][2], const Unit& u, int wr, int wc, int fr, int fq) const {
        const int pn = u.pn, row0 = u.pm * BM + wr * 64 + fr, c8 = wc * 32 + 8 * fq;
#pragma unroll
        for (int ai = 0; ai < 2; ++ai)
#pragma unroll
            for (int m = 0; m < 4; ++m) { const int row = row0 + ai * HALF + m * 16;
#pragma unroll
                for (int bj = 0; bj < 2; ++bj) { const int col = bj * HALF + c8;
                    f32x4 v0 = acc[ai][bj][m][0], v1 = acc[ai][bj][m][1];
                    if (pn >= 10) { if (col < 48) { float* gp = GT + (size_t)row * 48 + col;
                            *(f32x4*)gp = (f32x4){sigm(v0[0]), sigm(v0[1]), sigm(v0[2]), sigm(v0[3])}; *(f32x4*)(gp + 4) = (f32x4){sigm(v1[0]), sigm(v1[1]), sigm(v1[2]), sigm(v1[3])}; }
                        continue; }
                    bf16_t* dst;
                    if (pn < 4) { v0 = v0 * qscale; v1 = v1 * qscale; dst = Q + (size_t)row * 1024 + pn * 256 + col; }
                    else if (pn < 6) { const int g = col >> 6, d = col & 63; dst = KV2 + (size_t)(pn - 4) * (4096 * 1024) + ((size_t)(((row >> 4) * 4 + g) * 16 + (row & 15))) * 64 + d; }
                    else { bf16_t* base = pn == 6 ? KS : pn == 7 ? VS : pn == 8 ? KW : VW; dst = base + (size_t)row * 256 + col; }
                    *(u32x4*)dst = pack8(v0, v1); } }
    }
};
struct EpiGlaIn {
    static constexpr bool PERM = true, AFTER_DRAIN = false;
    bf16_t* QKVG; float* ALOW; float qscale;
    __device__ __forceinline__ void operator()(const f32x4 (&acc)[2][2][4][2], const Unit& u, int wr, int wc, int fr, int fq) const {
        const int pn = u.pn, row0 = u.pm * BM + wr * 64 + fr, c8 = wc * 32 + 8 * fq;
#pragma unroll
        for (int ai = 0; ai < 2; ++ai)
#pragma unroll
            for (int m = 0; m < 4; ++m) { const int row = row0 + ai * HALF + m * 16;
#pragma unroll
                for (int bj = 0; bj < 2; ++bj) { const int col = bj * HALF + c8;
                    f32x4 v0 = acc[ai][bj][m][0], v1 = acc[ai][bj][m][1];
                    if (pn >= 12) { if (col < 16) { float* gp = ALOW + (size_t)row * 16 + col; *(f32x4*)gp = v0; *(f32x4*)(gp + 4) = v1; } continue; }
                    if (pn < 2) { v0 = v0 * qscale; v1 = v1 * qscale; }
                    *(u32x4*)(QKVG + (size_t)row * 3072 + pn * 256 + col) = pack8(v0, v1); } }
    }
};
struct EpiF32Cmp {
    static constexpr bool PERM = false, AFTER_DRAIN = false;
    float* C;
    __device__ __forceinline__ void operator()(const f32x4 (&acc)[2][2][4][2], const Unit& u, int wr, int wc, int fr, int fq) const {
        const int row0 = u.pm * BM + wr * 64 + fr, col0 = (u.pn & 1) * BM + wc * 32 + 4 * fq;
#pragma unroll
        for (int ai = 0; ai < 2; ++ai)
#pragma unroll
            for (int m = 0; m < 4; ++m) { float* rowp = C + (size_t)(row0 + ai * HALF + m * 16) * 512 + col0;
#pragma unroll
                for (int bj = 0; bj < 2; ++bj)
#pragma unroll
                    for (int n = 0; n < 2; ++n) *(f32x4*)(rowp + bj * HALF + n * 16) = acc[ai][bj][m][n]; }
    }
};
struct EpiResF32 {
    static constexpr bool PERM = false, AFTER_DRAIN = false;
    const float* base; float* out; float alpha;
    __device__ __forceinline__ void operator()(const f32x4 (&acc)[2][2][4][2], const Unit& u, int wr, int wc, int fr, int fq) const {
        const int row0 = u.pm * BM + wr * 64 + fr, col0 = u.pn * BM + wc * 32 + 4 * fq;
#pragma unroll
        for (int ai = 0; ai < 2; ++ai)
#pragma unroll
            for (int m = 0; m < 4; ++m) { const size_t off = (size_t)(row0 + ai * HALF + m * 16) * 1024 + col0;
#pragma unroll
                for (int bj = 0; bj < 2; ++bj)
#pragma unroll
                    for (int n = 0; n < 2; ++n) { const f32x4 bs = *(const f32x4*)(base + off + bj * HALF + n * 16); *(f32x4*)(out + off + bj * HALF + n * 16) = bs * alpha + acc[ai][bj][m][n]; } }
    }
};
template <bool BF> struct EpiResBf16 {
    static constexpr bool PERM = true, AFTER_DRAIN = false;
    const void* base; bf16_t* out; float alpha;
    __device__ __forceinline__ void operator()(const f32x4 (&acc)[2][2][4][2], const Unit& u, int wr, int wc, int fr, int fq) const {
        const int row0 = u.pm * BM + wr * 64 + fr, col0 = u.pn * BM + wc * 32 + 8 * fq;
#pragma unroll
        for (int ai = 0; ai < 2; ++ai)
#pragma unroll
            for (int m = 0; m < 4; ++m) { const size_t off = (size_t)(row0 + ai * HALF + m * 16) * 1024 + col0;
#pragma unroll
                for (int bj = 0; bj < 2; ++bj) { f32x4 b0, b1;
                    if (BF) { const u32x4 r = *(const u32x4*)((const bf16_t*)base + off + bj * HALF);
                        b0 = (f32x4){__uint_as_float(r.x << 16), __uint_as_float(r.x & 0xffff0000u), __uint_as_float(r.y << 16), __uint_as_float(r.y & 0xffff0000u)};
                        b1 = (f32x4){__uint_as_float(r.z << 16), __uint_as_float(r.z & 0xffff0000u), __uint_as_float(r.w << 16), __uint_as_float(r.w & 0xffff0000u)}; }
                    else { b0 = *(const f32x4*)((const float*)base + off + bj * HALF); b1 = *(const f32x4*)((const float*)base + off + bj * HALF + 4); }
                    *(u32x4*)(out + off + bj * HALF) = pack8(b0 * alpha + acc[ai][bj][m][0], b1 * alpha + acc[ai][bj][m][1]); } }
    }
};
__device__ __forceinline__ void store16_sc1(bf16_t* p, const u32x4 v) { asm volatile("global_store_dwordx4 %0, %1, off sc1\n\ts_nop 1" :: "v"(p), "v"(v) : "memory"); }
template <bool SC1> struct EpiSwiGLU {
    static constexpr bool PERM = true, AFTER_DRAIN = false;
    bf16_t* H; int ldh, nt;
    __device__ __forceinline__ void operator()(const f32x4 (&acc)[2][2][4][2], const Unit& u, int wr, int wc, int fr, int fq) const {
        const int row0 = u.pm * BM + wr * 64 + fr, col = (u.pn % nt) * HALF + wc * 32 + 8 * fq;
#pragma unroll
        for (int ai = 0; ai < 2; ++ai)
#pragma unroll
            for (int m = 0; m < 4; ++m) { const f32x4 a0 = acc[ai][0][m][0], a1 = acc[ai][0][m][1], b0 = acc[ai][1][m][0], b1 = acc[ai][1][m][1];
                const f32x4 h0 = (f32x4){silu1(a0[0]) * b0[0], silu1(a0[1]) * b0[1], silu1(a0[2]) * b0[2], silu1(a0[3]) * b0[3]};
                const f32x4 h1 = (f32x4){silu1(a1[0]) * b1[0], silu1(a1[1]) * b1[1], silu1(a1[2]) * b1[2], silu1(a1[3]) * b1[3]};
                bf16_t* dst = H + (size_t)(row0 + ai * HALF + m * 16) * ldh + col;
                if (SC1) store16_sc1(dst, pack8(h0, h1)); else *(u32x4*)dst = pack8(h0, h1); }
    }
};
struct EpiNull {
    static constexpr bool PERM = true, AFTER_DRAIN = false;
    float* sink;
    __device__ __forceinline__ void operator()(const f32x4 (&acc)[2][2][4][2], const Unit& u, int wr, int wc, int fr, int fq) const {
        f32x4 s = (f32x4){0.f, 0.f, 0.f, 0.f};
#pragma unroll
        for (int ai = 0; ai < 2; ++ai)
#pragma unroll
            for (int bj = 0; bj < 2; ++bj)
#pragma unroll
                for (int m = 0; m < 4; ++m) { s += acc[ai][bj][m][0]; s += acc[ai][bj][m][1]; }
        if (s[0] + s[1] + s[2] + s[3] == 1.2345e30f) sink[0] = 1.f;
    }
};
struct EpiBf16Y {
    static constexpr bool PERM = true, AFTER_DRAIN = false;
    bf16_t* Y; size_t kstride;
    __device__ __forceinline__ void operator()(const f32x4 (&acc)[2][2][4][2], const Unit& u, int wr, int wc, int fr, int fq) const {
        const int row0 = u.pm * BM + wr * 64 + fr, col0 = (u.pn & 3) * BM + wc * 32 + 8 * fq;
#pragma unroll
        for (int ai = 0; ai < 2; ++ai)
#pragma unroll
            for (int m = 0; m < 4; ++m) { bf16_t* rowp = Y + (u.ko ? kstride : (size_t)0) + (size_t)(row0 + ai * HALF + m * 16) * 1024 + col0;
#pragma unroll
                for (int bj = 0; bj < 2; ++bj) *(u32x4*)(rowp + bj * HALF) = pack8(acc[ai][bj][m][0], acc[ai][bj][m][1]); }
    }
};
struct CmpOrder {
    int G, c;
    __device__ __forceinline__ bool next(int i, Unit& u) const { const long L = (long)i * G + c; if (L >= 64) return false; const int pm = (int)L >> 1; u.pm = pm; u.pn = (pm >> 4) * 2 + ((int)L & 1); u.ko = 0; return true; }
    __device__ __forceinline__ void a_ready(const Unit&) const {}
    __device__ __forceinline__ void done(const Unit&) const {}
};
struct GroupedOrder {
    int G, c, NT, KS, KL; const PG8_LAS int* tp;
    __device__ __forceinline__ bool next(int i, Unit& u) const {
        int tpu[9];
#pragma unroll
        for (int k = 0; k < 9; ++k) tpu[k] = __builtin_amdgcn_readfirstlane(tp[k]);
        const int nwg = tpu[8] * NT * KS; const long L = (long)i * G + c; if (L >= nwg) return false;
        int wgid = (int)L; { const int q = nwg / NXCD, r = nwg % NXCD, xcd = wgid % NXCD, off = wgid / NXCD; wgid = (xcd < r ? xcd * (q + 1) : r * (q + 1) + (xcd - r) * q) + off; }
        const int ks = wgid % KS; wgid /= KS;
        int e = 0;
#pragma unroll
        for (int k = 1; k < 8; ++k) if (wgid >= tpu[k] * NT) e = k;
        int t0 = 0, t1 = 0;
#pragma unroll
        for (int k = 0; k < 8; ++k) if (e == k) { t0 = tpu[k]; t1 = tpu[k + 1]; }
        const int nte = t1 - t0, l = wgid - t0 * NT, nig = WGM * NT, gid = l / nig, fm = gid * WGM, gsz = (nte - fm) < WGM ? (nte - fm) : WGM;
        u.pm = t0 + fm + ((l % nig) % gsz); u.pn = e * NT + (l % nig) / gsz; u.ko = ks * KL;
#if defined(PROBE_SAMEB)
        if (KL == -1) { u.ko = 0; if (PROBE_SAMEB & 1) u.pn = (l % nig) / gsz; if (PROBE_SAMEB & 2) u.pm = (u.pm & 15); }
#endif
        return true;
    }
    __device__ __forceinline__ void a_ready(const Unit&) const {}
    __device__ __forceinline__ void done(const Unit&) const {}
};
template <class Base> struct PubOrder : Base {
    unsigned* cnt; mutable int pend;
    __device__ __forceinline__ void publish() const { if (pend >= 0) { if ((threadIdx.x & 63) == 0) __hip_atomic_fetch_add(cnt + 64 * pend, 1u, __ATOMIC_RELAXED, __HIP_MEMORY_SCOPE_AGENT); pend = -1; } }
    __device__ __forceinline__ void a_ready(const Unit&) const { publish(); }
#if defined(PUB_DRAIN) && PUB_DRAIN
    __device__ __forceinline__ void done(const Unit& u) const { asm volatile("s_waitcnt vmcnt(0)" ::: "memory"); pend = u.pm; publish(); }
#else
    __device__ __forceinline__ void done(const Unit& u) const { publish(); pend = u.pm; }
#endif
};
template <class Base> struct WaitOrder : Base {
    const unsigned* ready; unsigned need; unsigned* tmo;
    __device__ __forceinline__ void a_ready(const Unit& u) const {
        if (threadIdx.x < 64) {
            const unsigned long long t0 = __builtin_amdgcn_s_memrealtime(); unsigned polls = 0;
            while ((unsigned)__builtin_amdgcn_readfirstlane(__hip_atomic_load(ready + 64 * u.pm, __ATOMIC_RELAXED, __HIP_MEMORY_SCOPE_AGENT)) < need) {
                if ((++polls & 255u) == 0u && __builtin_amdgcn_readfirstlane(__hip_atomic_load(tmo, __ATOMIC_RELAXED, __HIP_MEMORY_SCOPE_AGENT)) != 0u) break;
                if (__builtin_amdgcn_s_memrealtime() - t0 > 2000000ull) {
                    if (threadIdx.x == 0) { unsigned expect = 0u; __hip_atomic_compare_exchange_strong(tmo + 1, &expect, 0x600u | (unsigned)(u.pm & 0xff), __ATOMIC_RELAXED, __ATOMIC_RELAXED, __HIP_MEMORY_SCOPE_AGENT); __hip_atomic_store(tmo, 1u, __ATOMIC_RELAXED, __HIP_MEMORY_SCOPE_AGENT); }
                    break; }
                __builtin_amdgcn_s_sleep(2); }
            __builtin_amdgcn_fence(__ATOMIC_ACQUIRE, "agent");
            asm volatile("s_waitcnt vmcnt(0)" ::: "memory");
        }
        asm volatile("" ::: "memory"); __builtin_amdgcn_s_barrier(); asm volatile("" ::: "memory");
    }
};
struct MoeDownOrder {
    int G, c, rem; const PG8_LAS int* tp;
    __device__ __forceinline__ int expert_of(int tile) const { int e = 0;
#pragma unroll
        for (int k = 1; k < 8; ++k) if (tile >= __builtin_amdgcn_readfirstlane(tp[k])) e = k;
        return e; }
    __device__ __forceinline__ bool next(int i, Unit& u) const {
        const long L = (long)i * G + c;
        if (!rem) { if (L >= 512) return false;
            int wgid = (int)L; { const int xcd = wgid % NXCD, off = wgid / NXCD; wgid = xcd * 64 + off; }
            const int grp = wgid >> 5, in = wgid & 31; const int tile = grp * 8 + (in & 7), pnl = in >> 3;
            u.pm = tile; u.pn = expert_of(tile) * 4 + pnl; u.ko = 0; return true; }
        const int nrem = __builtin_amdgcn_readfirstlane(tp[8]) - 128; if (L >= (long)nrem * 28) return false;
        const int l2 = (int)L, ks = l2 % 7, r = l2 / 7, tile = 128 + (r >> 2);
        u.pm = tile; u.pn = expert_of(tile) * 4 + (r & 3); u.ko = ks * 512; return true;
    }
    __device__ __forceinline__ void a_ready(const Unit&) const {}
    __device__ __forceinline__ void done(const Unit&) const {}
};
struct EpiBf16Y2 {
    static constexpr bool PERM = true, AFTER_DRAIN = false;
    bf16_t* Y; bf16_t* YP; int rem;
    __device__ __forceinline__ void operator()(const f32x4 (&acc)[2][2][4][2], const Unit& u, int wr, int wc, int fr, int fq) const {
        const int row0 = u.pm * BM + wr * 64 + fr, col0 = (u.pn & 3) * BM + wc * 32 + 8 * fq;
        bf16_t* base = rem ? YP + (size_t)(u.ko >> 9) * (2048 * 1024) + (size_t)(row0 - 128 * BM) * 1024 : Y + (size_t)row0 * 1024;
#pragma unroll
        for (int ai = 0; ai < 2; ++ai)
#pragma unroll
            for (int m = 0; m < 4; ++m) { bf16_t* rowp = base + (size_t)(ai * HALF + m * 16) * 1024 + col0;
#pragma unroll
                for (int bj = 0; bj < 2; ++bj) *(u32x4*)(rowp + bj * HALF) = pack8(acc[ai][bj][m][0], acc[ai][bj][m][1]); }
    }
};
template <class Epi, class Sched, bool ALIGN_EPI = false, bool SP2 = false>
__device__ __forceinline__ void gemm_phase(PG8_LAS unsigned char* lds, const Gemm g, const Sched& S, const Epi& E) {
    const int tid = threadIdx.x, wid = __builtin_amdgcn_readfirstlane(tid >> 6), lane = tid & 63, wr = wid >> 2, wc = wid & 3, fr = lane & 15, fq = lane >> 4;
    const int K = g.ld, nt = g.K / BK;
    unsigned voffA[2], voffB[2];
#pragma unroll
    for (int i = 0; i < 2; ++i) { int R, C; stage_rc(tid * 16 + i * 8192, R, C); const int Rb = Epi::PERM ? ((R & ~31) + perm32(R & 31)) : R;
        voffA[i] = (unsigned)(R * K + C) * 2u; voffB[i] = (unsigned)(Rb * K + C) * 2u; }
    const size_t kstep = (size_t)(BK * 2);
    const size_t hstep = (size_t)HALF * K * 2;
    const size_t tstep = 2 * hstep;
    const unsigned ldsw = (unsigned)wid * 1024u;
    const int aoff = lds_byte(wr * 64 + fr, fq * 8), boff = lds_byte(wc * 32 + fr, fq * 8);
#define PG8_SA(b, h) (((b) * 2 + (h)) * HTB)
#define PG8_SB(b, h) ((4 + (b) * 2 + (h)) * HTB)
#define PG8_STAGE(bufoff, gbase, voff) do { _Pragma("unroll") for (int _i = 0; _i < 2; ++_i) \
        __builtin_amdgcn_global_load_lds((const unsigned*)((const char*)(gbase) + (voff)[_i]), (PG8_LAS unsigned*)(lds + (bufoff) + ldsw + _i * 8192), 16, 0, 0); } while (0)
#define PG8_LDA(dst, b, h) do { _Pragma("unroll") for (int m = 0; m < 4; ++m) _Pragma("unroll") for (int k = 0; k < 2; ++k) dst[m][k] = *(const PG8_LAS bf16x8*)(lds + PG8_SA(b, h) + aoff + m * 2048 + k * 1024); } while (0)
#define PG8_LDB(dst, b, h) do { _Pragma("unroll") for (int n = 0; n < 2; ++n) _Pragma("unroll") for (int k = 0; k < 2; ++k) dst[n][k] = *(const PG8_LAS bf16x8*)(lds + PG8_SB(b, h) + boff + n * 2048 + k * 1024); } while (0)
#define PG8_MMA(ai, bj, At, Bt) do { __builtin_amdgcn_s_setprio(1); _Pragma("unroll") for (int m = 0; m < 4; ++m) _Pragma("unroll") for (int n = 0; n < 2; ++n) _Pragma("unroll") for (int k = 0; k < 2; ++k) \
        acc[ai][bj][m][n] = __builtin_amdgcn_mfma_f32_16x16x32_bf16(Bt[n][k], At[m][k], acc[ai][bj][m][n], 0, 0, 0); __builtin_amdgcn_s_setprio(0); } while (0)
#define PG8_WAIT_V(n) asm volatile("s_waitcnt vmcnt(" #n ")" ::: "memory")
#define PG8_WAIT_L(n) asm volatile("s_waitcnt lgkmcnt(" #n ")" ::: "memory")
#define PG8_BAR __builtin_amdgcn_s_barrier()
#define PG8_SCHED __builtin_amdgcn_sched_barrier(0)
    Unit cur, nxt; int ui = 0;
    if (!S.next(0, cur)) return;
    f32x4 acc[2][2][4][2];
#pragma unroll
    for (int a = 0; a < 2; ++a)
#pragma unroll
        for (int b = 0; b < 2; ++b)
#pragma unroll
            for (int m = 0; m < 4; ++m)
#pragma unroll
                for (int n = 0; n < 2; ++n) acc[a][b][m][n] = (f32x4){0.f, 0.f, 0.f, 0.f};
    bf16x8 At[4][2], B0[2][2], B1[2][2];
    const char* cA = (const char*)g.A + (size_t)cur.pm * tstep + (size_t)cur.ko * 2; const char* cB = (const char*)g.Bt + (size_t)cur.pn * tstep + (size_t)cur.ko * 2;
    S.a_ready(cur);
    if constexpr (SP2) {
        PG8_STAGE(PG8_SB(0, 0), cB, voffB); PG8_STAGE(PG8_SB(0, 1), cB + hstep, voffB); PG8_STAGE(PG8_SA(0, 0), cA, voffA); PG8_STAGE(PG8_SA(0, 1), cA + hstep, voffA);
        if (wr == 1) PG8_BAR;
        PG8_WAIT_V(2); PG8_BAR;
        PG8_STAGE(PG8_SB(1, 0), cB + kstep, voffB); PG8_STAGE(PG8_SA(1, 0), cA + kstep, voffA); PG8_STAGE(PG8_SB(1, 1), cB + hstep + kstep, voffB);
        PG8_WAIT_V(6); PG8_BAR;
    } else {
        PG8_STAGE(PG8_SB(0, 0), cB, voffB); PG8_STAGE(PG8_SA(0, 0), cA, voffA); PG8_STAGE(PG8_SB(0, 1), cB + hstep, voffB); PG8_STAGE(PG8_SA(0, 1), cA + hstep, voffA);
        if (wr == 1) PG8_BAR;
        PG8_WAIT_V(4); PG8_BAR;
        PG8_STAGE(PG8_SB(1, 0), cB + kstep, voffB); PG8_STAGE(PG8_SA(1, 0), cA + kstep, voffA); PG8_STAGE(PG8_SB(1, 1), cB + hstep + kstep, voffB);
        PG8_WAIT_V(6); PG8_BAR;
    }
    for (;;) {
        const bool has_next = S.next(ui + 1, nxt);
        const char* nA = has_next ? (const char*)g.A + (size_t)nxt.pm * tstep + (size_t)nxt.ko * 2 : cA; const char* nB = has_next ? (const char*)g.Bt + (size_t)nxt.pn * tstep + (size_t)nxt.ko * 2 : cB;
        for (int t = 0; t < nt; t += 2) {
            const bool last = (t == nt - 2);
            const char* a1 = cA + (size_t)(t + 1) * kstep;
            const char* a2 = last ? nA : cA + (size_t)(t + 2) * kstep; const char* b2 = last ? nB : cB + (size_t)(t + 2) * kstep;
            const char* a3 = a2 + kstep; const char* b3 = b2 + kstep;
            if (last && has_next) S.a_ready(nxt);
            if constexpr (SP2) {
            PG8_LDB(B0, 0, 0); PG8_LDB(B1, 0, 1); PG8_SCHED; PG8_LDA(At, 0, 0); PG8_STAGE(PG8_SA(1, 1), a1 + hstep, voffA);
            PG8_WAIT_V(8); PG8_WAIT_L(0); PG8_BAR; PG8_MMA(0, 0, At, B0); PG8_MMA(0, 1, At, B1); PG8_BAR; PG8_SCHED;
            PG8_LDA(At, 0, 1); PG8_STAGE(PG8_SB(0, 0), b2, voffB); PG8_STAGE(PG8_SB(0, 1), b2 + hstep, voffB); PG8_STAGE(PG8_SA(0, 0), a2, voffA);
            PG8_WAIT_V(8); PG8_WAIT_L(0); PG8_BAR; PG8_MMA(1, 0, At, B0); PG8_MMA(1, 1, At, B1); PG8_BAR; PG8_SCHED;
            PG8_LDB(B0, 1, 0); PG8_LDB(B1, 1, 1); PG8_SCHED; PG8_LDA(At, 1, 0); PG8_STAGE(PG8_SA(0, 1), a2 + hstep, voffA);
            PG8_WAIT_V(8); PG8_WAIT_L(0); PG8_BAR; PG8_MMA(0, 0, At, B0); PG8_MMA(0, 1, At, B1); PG8_BAR; PG8_SCHED;
            PG8_LDA(At, 1, 1); PG8_STAGE(PG8_SB(1, 0), b3, voffB); PG8_STAGE(PG8_SB(1, 1), b3 + hstep, voffB); PG8_STAGE(PG8_SA(1, 0), a3, voffA);
            PG8_WAIT_V(8); PG8_WAIT_L(0); PG8_BAR; PG8_MMA(1, 0, At, B0); PG8_MMA(1, 1, At, B1); PG8_BAR; PG8_SCHED;
            } else {
            PG8_LDB(B0, 0, 0); PG8_SCHED; PG8_LDA(At, 0, 0); PG8_STAGE(PG8_SA(1, 1), a1 + hstep, voffA);
            PG8_WAIT_L(8); PG8_BAR; PG8_WAIT_L(0); PG8_MMA(0, 0, At, B0); PG8_BAR; PG8_SCHED;
            PG8_LDB(B1, 0, 1); PG8_STAGE(PG8_SB(0, 0), b2, voffB);
            PG8_BAR; PG8_WAIT_L(0); PG8_MMA(0, 1, At, B1); PG8_BAR;
            PG8_LDA(At, 0, 1); PG8_STAGE(PG8_SA(0, 0), a2, voffA);
            PG8_BAR; PG8_WAIT_L(0); PG8_MMA(1, 0, At, B0); PG8_BAR; PG8_SCHED;
            PG8_STAGE(PG8_SB(0, 1), b2 + hstep, voffB);
            PG8_WAIT_V(6); PG8_BAR; PG8_MMA(1, 1, At, B1); PG8_BAR;
            PG8_LDB(B0, 1, 0); PG8_SCHED; PG8_LDA(At, 1, 0); PG8_STAGE(PG8_SA(0, 1), a2 + hstep, voffA);
            PG8_WAIT_L(8); PG8_BAR; PG8_WAIT_L(0); PG8_MMA(0, 0, At, B0); PG8_BAR; PG8_SCHED;
            PG8_LDB(B1, 1, 1); PG8_STAGE(PG8_SB(1, 0), b3, voffB);
            PG8_BAR; PG8_WAIT_L(0); PG8_MMA(0, 1, At, B1); PG8_BAR;
            PG8_LDA(At, 1, 1); PG8_STAGE(PG8_SA(1, 0), a3, voffA);
            PG8_BAR; PG8_WAIT_L(0); PG8_MMA(1, 0, At, B0); PG8_BAR; PG8_SCHED;
            PG8_STAGE(PG8_SB(1, 1), b3 + hstep, voffB);
            PG8_WAIT_V(6); PG8_BAR; PG8_MMA(1, 1, At, B1); PG8_BAR;
            }
        }
        if constexpr (ALIGN_EPI) { if (wr == 0) PG8_BAR; }
        if constexpr (!Epi::AFTER_DRAIN) { E(acc, cur, wr, wc, fr, fq); S.done(cur); }
        if (!has_next) break;
#pragma unroll
        for (int a = 0; a < 2; ++a)
#pragma unroll
            for (int b = 0; b < 2; ++b)
#pragma unroll
                for (int m = 0; m < 4; ++m)
#pragma unroll
                    for (int n = 0; n < 2; ++n) acc[a][b][m][n] = (f32x4){0.f, 0.f, 0.f, 0.f};
        cur = nxt; cA = nA; cB = nB; ++ui;
        if constexpr (ALIGN_EPI) { if (wr == 1) PG8_BAR; }
    }
    PG8_WAIT_V(0);
    if constexpr (!ALIGN_EPI) { if (wr == 0) PG8_BAR; }
    PG8_BAR;
    if constexpr (Epi::AFTER_DRAIN) { E.fused(acc, cur, wr, wc, fr, fq, lds, wid, lane); S.done(cur); }
#undef PG8_SA
#undef PG8_SB
#undef PG8_STAGE
#undef PG8_LDA
#undef PG8_LDB
#undef PG8_MMA
#undef PG8_WAIT_V
#undef PG8_WAIT_L
#undef PG8_BAR
#undef PG8_SCHED
}
}
#ifndef PG8_SP2
#define PG8_SP2 true
#endif
#ifndef PG8_ALIGN
#define PG8_ALIGN true
#endif
#define GAS __attribute__((address_space(1)))
#define LAS __attribute__((address_space(3)))
typedef unsigned short bf16;
typedef unsigned v4u __attribute__((ext_vector_type(4)));
typedef float f32x4 __attribute__((ext_vector_type(4)));
typedef short bf16x8 __attribute__((ext_vector_type(8)));
typedef GAS unsigned gu32;
typedef GAS unsigned long long gu64;
#define RLX_AGENT __ATOMIC_RELAXED, __HIP_MEMORY_SCOPE_AGENT
#define LDS_WAIT() asm volatile("s_waitcnt lgkmcnt(0)" ::: "memory")
#define VM_WAIT() asm volatile("s_waitcnt vmcnt(0)" ::: "memory")
__device__ __forceinline__ unsigned long long rt() { return __builtin_amdgcn_s_memrealtime(); }
__device__ __forceinline__ unsigned f2bf(float f) { unsigned u = __builtin_bit_cast(unsigned, f); return (u + 0x7fffu + ((u >> 16) & 1u)) >> 16; }
__device__ __forceinline__ unsigned pk2(float lo, float hi) { return f2bf(lo) | (f2bf(hi) << 16); }

#define XB_TMO      128
#define XB_XCNT(j)  (256  + 64 * (j))
#define XB_XSUB(j)  (1280 + 64 * (j))
#define XB_XGEN(j)  (2304 + 64 * (j))
#define XB_TOP      3328
#define XB_TOPGEN   3392
#define XCD_BAR_WORDS 3456
#define XB_SPIN_CAP (1u << 18)

__device__ __forceinline__ unsigned xb_ld(unsigned* p)              { return __hip_atomic_load(p, __ATOMIC_RELAXED, __HIP_MEMORY_SCOPE_AGENT); }
__device__ __forceinline__ unsigned xb_add(unsigned* p, unsigned v) { return __hip_atomic_fetch_add(p, v, __ATOMIC_RELAXED, __HIP_MEMORY_SCOPE_AGENT); }
__device__ __forceinline__ unsigned xb_xcc_id() { return (unsigned)__builtin_amdgcn_s_getreg((3 << 11) | 20) & 0xFu; }
#define XB_SPIN(cond, bar) do { unsigned _sp = 0; while (cond) { __builtin_amdgcn_s_sleep(1); \
    if ((++_sp & 255u) == 0u) { if (xb_ld(&(bar)[XB_TMO])) break; if (_sp > XB_SPIN_CAP) { atomicAdd(&(bar)[XB_TMO], 1u); break; } } } } while (0)

struct XcdBarrier {
    unsigned* bar; unsigned x;
    volatile LAS unsigned* st;
};

__device__ __forceinline__ XcdBarrier xcd_barrier_post(unsigned* bar, volatile LAS unsigned* st) {
    XcdBarrier b; b.bar = bar; b.x = xb_xcc_id(); b.st = st;
    if (threadIdx.x == 0) (void)xb_add(&bar[XB_XCNT(b.x)], 1u);
    return b;
}
__device__ __forceinline__ void xcd_barrier_complete(unsigned* bar, unsigned x, unsigned& nloc, unsigned& nx) {
    const unsigned G = gridDim.x * gridDim.y * gridDim.z;
    unsigned sum, cnt, mine, sp = 0u;
    for (;;) {
        sum = 0u; cnt = 0u; mine = 0u;
#pragma unroll
        for (unsigned j = 0; j < 16; ++j) { const unsigned c = xb_ld(&bar[XB_XCNT(j)]); sum += c; cnt += (c > 0u) ? 1u : 0u; mine = (j == x) ? c : mine; }
        if (sum == G) break;
        __builtin_amdgcn_s_sleep(1);
        if ((++sp & 255u) == 0u) { if (xb_ld(&bar[XB_TMO])) break; if (sp > XB_SPIN_CAP) { atomicAdd(&bar[XB_TMO], 1u); break; } }
    }
    nloc = mine > 0u ? mine : 1u; nx = cnt > 0u ? cnt : 1u;
}

__device__ __forceinline__ void xcd_barrier(const XcdBarrier& b) {
    asm volatile("s_waitcnt vmcnt(0)" ::: "memory");
    __syncthreads();
    if (threadIdx.x == 0) {
        unsigned* bar = b.bar;
        __builtin_amdgcn_s_waitcnt(0);
        unsigned nloc = b.st[0], nx = b.st[1];
        if (nloc == 0u) { xcd_barrier_complete(bar, b.x, nloc, nx); b.st[0] = nloc; b.st[1] = nx; }
        const unsigned old = xb_add(&bar[XB_XSUB(b.x)], 1u);
        const unsigned gen = old / nloc;
        if (old + 1u == (gen + 1u) * nloc) {
            __builtin_amdgcn_fence(__ATOMIC_RELEASE, "agent");
            asm volatile("s_waitcnt vmcnt(0)" ::: "memory");
            const unsigned og = xb_add(&bar[XB_TOP], 1u);
            const unsigned tg = og / nx;
            if (og + 1u == (tg + 1u) * nx) xb_add(&bar[XB_TOPGEN], 1u);
            else XB_SPIN(xb_ld(&bar[XB_TOPGEN]) == tg, bar);
            __builtin_amdgcn_fence(__ATOMIC_ACQUIRE, "agent");
            xb_add(&bar[XB_XGEN(b.x)], 1u);
            asm volatile("s_waitcnt vmcnt(0)" ::: "memory");
        } else {
            XB_SPIN(xb_ld(&bar[XB_XGEN(b.x)]) == gen, bar);
            __builtin_amdgcn_fence(__ATOMIC_ACQUIRE, "agent");
            asm volatile("s_waitcnt vmcnt(0)" ::: "memory");
        }
    }
    __syncthreads();
}
constexpr int NWAVES = 8;
#ifndef MK_PER_PHASE
#define MK_PER_PHASE 0
#endif
constexpr int N_PHASES = 20;
constexpr int MOE_KS = 1;

constexpr int BATCH = 2, T = 8192, D = 1024, M = BATCH * T;
constexpr int NSA_IN = 2608, NSA_IN_PAD = 2816, FF0 = 2816, GLA_IN = 3088, GLA_IN_PAD = 3328, FFE = 3584, NE = 8;
constexpr int NCMP = 511, MAXTILES = 136, MAXSLOTS = MAXTILES * 256;
constexpr float ALPHA = 1.41421356237309515f;
constexpr float LN_EPS = 1e-5f, RMS_EPS = 1e-6f, LOG2E = 1.44269504088896341f;

constexpr size_t MiB = 1u << 20;
constexpr size_t WS_CTL = 0, CTL_ZERO_BYTES = 1 * MiB;
constexpr size_t WS_PB = 1 * MiB;
constexpr size_t WS_CNTL = WS_PB + 32768;
constexpr size_t WS_TOKE = WS_CNTL + 16384;
constexpr size_t WS_TOKW = WS_TOKE + (size_t)M * 8;
constexpr size_t WS_TOKP = WS_TOKW + (size_t)M * 8;
constexpr size_t WS_TOKS = WS_TOKP + (size_t)M * 8;
static_assert(WS_TOKS + (size_t)M * 8 <= 2 * MiB, "misc region");
constexpr size_t WS_WIN0 = 2 * MiB, WS_W1C = 8 * MiB, WS_WO0 = 10 * MiB, WS_WGU0 = 12 * MiB, WS_WD0 = 23 * MiB, WS_WIN1 = 29 * MiB, WS_WO1 = 36 * MiB, WS_WGU1 = 38 * MiB, WS_WD1 = 150 * MiB;
constexpr size_t WS_XB = 206 * MiB, WS_XRES = 238 * MiB, WS_T0 = 302 * MiB, WS_SCR = 366 * MiB;
constexpr size_t WS_Q = WS_SCR, WS_KV2 = WS_SCR + 32 * MiB, WS_KS = WS_SCR + 48 * MiB, WS_VS = WS_SCR + 56 * MiB, WS_KW = WS_SCR + 64 * MiB, WS_VW = WS_SCR + 72 * MiB;
constexpr size_t WS_GT = WS_SCR + 80 * MiB, WS_UL = WS_SCR + 83 * MiB, WS_KCMP = WS_SCR + 99 * MiB, WS_VCMP = WS_KCMP + 512 * 1024, WS_O = WS_SCR + 100 * MiB, WS_H0 = WS_SCR + 132 * MiB;
constexpr size_t WS_QKVG = WS_SCR, WS_ALOW = WS_SCR + 96 * MiB, WS_BCUM = WS_SCR + 97 * MiB, WS_ZB = WS_SCR + 129 * MiB, WS_DEC = WS_SCR + 257 * MiB, WS_SST = WS_SCR + 258 * MiB, WS_O1 = WS_SCR + 322 * MiB;
constexpr size_t WS_XG = WS_SCR, WS_YB = WS_SCR + 68 * MiB, WS_H2 = WS_SCR + 136 * MiB, WS_YB1 = WS_SCR + 374 * MiB, WS_END = WS_YB1 + 68 * MiB;
static_assert(WS_H2 + (size_t)MAXSLOTS * FFE * 2 <= WS_YB1, "H2 fits");
static_assert(WS_H0 + (size_t)M * FF0 * 2 <= 896 * MiB && WS_O1 + 32 * MiB <= 896 * MiB && WS_END <= 896 * MiB, "d_ws map");
constexpr int CW_TMO = 0, CW_CODE = 1, CW_BAR = 4096;
constexpr int CW_PANEL0 = 16384, CW_PANEL1 = 32768;
static_assert((CW_PANEL1 + 64 * MAXTILES) * 4 <= (int)CTL_ZERO_BYTES, "CTL words inside the memset region");

constexpr int RING_OFF = 0, RING_BYTES = 131072;
constexpr int LDSCTL_OFF = RING_BYTES, MISC_OFF = LDSCTL_OFF + 320;
constexpr int INPTR_OFF = MISC_OFF + 128;
constexpr int LDS_BYTES = 147456;
#ifndef TR_UNROLL
#define TR_UNROLL 8
#endif
typedef float f32x16 __attribute__((ext_vector_type(16)));
typedef short v4i16 __attribute__((ext_vector_type(4)));
typedef unsigned v2u __attribute__((ext_vector_type(2)));
struct Args { const float* in[27]; float* out; unsigned char* ws; int ph_lo, ph_hi; };
struct Frame {
    const Args* A;
    LAS unsigned char* lds;
    volatile LAS unsigned* MISC;
    gu32* ctl;
    int tid, lane, wave;
    int vcu, G, wg;
    unsigned char* ws; float* out;
};
#define inptr(F, k) ((F).A->in[k])
__device__ __forceinline__ float wave_sum(float v) {
#pragma unroll
    for (int o = 1; o < 64; o <<= 1) v += __shfl_xor(v, o);
    return v;
}
__device__ __forceinline__ float bf2f(bf16 h) { return __uint_as_float((unsigned)h << 16); }
__device__ __forceinline__ v4i16 vtr(const LAS unsigned char* p) { return __builtin_amdgcn_ds_read_tr16_b64_v4i16((LAS v4i16*)p); }
__device__ __forceinline__ int crow(int r, int hi) { return (r & 3) + 8 * (r >> 2) + 4 * hi; }

__device__ __forceinline__ void tr_item(const float* src, int ldn, int nvalid, int k0, int n0, bf16* dst, int dld, int drow0, LAS float* scr, int lane) {
    const int n_ = n0 + (lane & 31); const bool ok = n_ < nvalid;
    float tv[32];
#pragma unroll
    for (int i = 0; i < 32; ++i) { const int kk = 2 * i + (lane >> 5); tv[i] = ok ? *(const GAS float*)(src + (size_t)(k0 + kk) * ldn + n_) : 0.f; }
#pragma unroll
    for (int i = 0; i < 32; ++i) { const int kk = 2 * i + (lane >> 5); scr[kk * 33 + (lane & 31)] = tv[i]; }
    LDS_WAIT(); asm volatile("" ::: "memory");
    const int c = lane & 7;
#pragma unroll
    for (int j = 0; j < 4; ++j) { const int n = (lane >> 3) + 8 * j; const LAS float* s = scr + (8 * c) * 33 + n;
        v4u o; o.x = pk2(s[0 * 33], s[1 * 33]); o.y = pk2(s[2 * 33], s[3 * 33]); o.z = pk2(s[4 * 33], s[5 * 33]); o.w = pk2(s[6 * 33], s[7 * 33]);
        *(GAS v4u*)(dst + (size_t)(drow0 + n) * dld + k0 + 8 * c) = o; }
    LDS_WAIT(); asm volatile("" ::: "memory");
}
__device__ __forceinline__ int swiglu_row(int n0, int F_) { return n0 < F_ ? (n0 / 128) * 256 + (n0 % 128) : ((n0 - F_) / 128) * 256 + 128 + ((n0 - F_) % 128); }
#define KBNB(idx, nkb, nnb) const int kb = ((idx) % (8 * (nkb))) / 8, nb = ((idx) / (8 * (nkb))) * 8 + (idx) % 8
__device__ __forceinline__ void p0_items(Frame& F, const int first, const int last, const int gw, const int NGW) {
    LAS float* scr = (LAS float*)(F.lds + RING_OFF + F.wave * 16384);
    const int lane = F.lane;
    unsigned char* ws = F.ws;
    constexpr int I_IN0 = 16 * (NSA_IN_PAD / 32), I_W1 = 4 * 16 * 8, I_WO = 16 * 32, I_GU0 = 16 * (2 * FF0 / 32), I_D0 = (FF0 / 64) * 32, I_IN1 = 16 * (GLA_IN_PAD / 32);
    constexpr int I_GU1E = 16 * (2 * FFE / 32), I_D1E = (FFE / 64) * 32, I_GU1 = NE * I_GU1E, I_D1 = NE * I_D1E;
    constexpr int NITEMS = I_IN0 + I_W1 + I_WO + I_GU0 + I_D0 + I_IN1 + I_WO + I_GU1 + I_D1;
    for (int it = first + gw; it < last; it += NGW) {
        int r = it;
        if (r < I_IN0) { constexpr int nnb = NSA_IN_PAD / 32; KBNB(r, 16, nnb); tr_item(inptr(F, 1), NSA_IN, NSA_IN, 64 * kb, 32 * nb, (bf16*)(ws + WS_WIN0), 1024, 32 * nb, scr, lane); continue; } r -= I_IN0;
        if (r < I_W1) { const int blk = r / 128, q = r % 128; KBNB(q, 16, 8);
            const float* src = ((blk >> 1) ? inptr(F, 6) : inptr(F, 4)) + (size_t)(blk & 1) * 1024 * 256; tr_item(src, 256, 256, 64 * kb, 32 * nb, (bf16*)(ws + WS_W1C), 1024, 256 * blk + 32 * nb, scr, lane); continue; } r -= I_W1;
        if (r < I_WO) { KBNB(r, 16, 32); tr_item(inptr(F, 8), 1024, 1024, 64 * kb, 32 * nb, (bf16*)(ws + WS_WO0), 1024, 32 * nb, scr, lane); continue; } r -= I_WO;
        if (r < I_GU0) { constexpr int nnb = 2 * FF0 / 32; KBNB(r, 16, nnb); tr_item(inptr(F, 11), 2 * FF0, 2 * FF0, 64 * kb, 32 * nb, (bf16*)(ws + WS_WGU0), 1024, swiglu_row(32 * nb, FF0), scr, lane); continue; } r -= I_GU0;
        if (r < I_D0) { KBNB(r, FF0 / 64, 32); tr_item(inptr(F, 12), 1024, 1024, 64 * kb, 32 * nb, (bf16*)(ws + WS_WD0), FF0, 32 * nb, scr, lane); continue; } r -= I_D0;
        if (r < I_IN1) { constexpr int nnb = GLA_IN_PAD / 32; KBNB(r, 16, nnb); tr_item(inptr(F, 15), GLA_IN, GLA_IN, 64 * kb, 32 * nb, (bf16*)(ws + WS_WIN1), 1024, 32 * nb, scr, lane); continue; } r -= I_IN1;
        if (r < I_WO) { KBNB(r, 16, 32); tr_item(inptr(F, 19), 1024, 1024, 64 * kb, 32 * nb, (bf16*)(ws + WS_WO1), 1024, 32 * nb, scr, lane); continue; } r -= I_WO;
        if (r < I_GU1) { constexpr int nnb = 2 * FFE / 32; const int e = r / I_GU1E, q = r % I_GU1E; KBNB(q, 16, nnb);
            tr_item(inptr(F, 23) + (size_t)e * 1024 * 2 * FFE, 2 * FFE, 2 * FFE, 64 * kb, 32 * nb, (bf16*)(ws + WS_WGU1) + (size_t)e * 2 * FFE * 1024, 1024, swiglu_row(32 * nb, FFE), scr, lane); continue; } r -= I_GU1;
        { const int e = r / I_D1E, q = r % I_D1E; KBNB(q, FFE / 64, 32);
            tr_item(inptr(F, 24) + (size_t)e * FFE * 1024, 1024, 1024, 64 * kb, 32 * nb, (bf16*)(ws + WS_WD1) + (size_t)e * 1024 * FFE, FFE, 32 * nb, scr, lane); }
    }
}
namespace p0n { constexpr int I_D1 = NE * (FFE / 64) * 32, I_ALL = 16 * (NSA_IN_PAD / 32) + 4 * 16 * 8 + 16 * 32 + 16 * (2 * FF0 / 32) + (FF0 / 64) * 32 + 16 * (GLA_IN_PAD / 32) + 16 * 32 + NE * 16 * (2 * FFE / 32) + I_D1; }
constexpr int CMP_WGS = 64;
__device__ __forceinline__ void p0_prologue(Frame& F) {
    const int gw = F.vcu * NWAVES + F.wave, NGW = F.G * NWAVES, lane = F.lane;
    unsigned char* ws = F.ws;
    p0_items(F, 0, p0n::I_ALL, gw, NGW);
    { const float* x = inptr(F, 0); bf16* xb = (bf16*)(ws + WS_XB);
      for (int m = gw; m < M; m += NGW) { const GAS f32x4* xr = (const GAS f32x4*)(x + (size_t)m * D) + lane; GAS unsigned long long* o8 = (GAS unsigned long long*)(xb + (size_t)m * D) + lane;
#pragma unroll
          for (int j = 0; j < 4; ++j) { const f32x4 v = xr[64 * j]; o8[64 * j] = (unsigned long long)pk2(v.x, v.y) | ((unsigned long long)pk2(v.z, v.w) << 32); } } }
    { float* pb = (float*)(ws + WS_PB);
      for (int task = gw; task < 64; task += NGW) { const int rp = task & 7, cb = (task >> 3) & 3, kv = task >> 5; const float* pe = kv ? inptr(F, 3) : inptr(F, 2); const float* w1 = kv ? inptr(F, 6) : inptr(F, 4); const int c = 64 * cb + lane;
          float a = 0.f;
          for (int r0 = 256 * rp; r0 < 256 * rp + 256; r0 += 32) { float wv[32], pv[32];
#pragma unroll
              for (int u = 0; u < 32; ++u) { wv[u] = *(const GAS float*)(w1 + (size_t)(r0 + u) * 256 + c); pv[u] = *(const GAS float*)(pe + r0 + u); }
#pragma unroll
              for (int u = 0; u < 32; ++u) a += pv[u] * wv[u]; }
          pb[rp * 512 + kv * 256 + c] = a; } }
}

__device__ __forceinline__ float gelu_tanh(float x) { const float y = 0.7978845608028654f * (x + 0.044715f * x * x * x); const float e = __expf(2.f * y); const float th = 1.f - 2.f / (e + 1.f); return 0.5f * x * (1.f + th); }
__device__ __forceinline__ void cmp_finish(Frame& F) {
    const int gw = F.vcu * NWAVES + F.wave, NGW = F.G * NWAVES, lane = F.lane;
    LAS float* hb = (LAS float*)(F.lds + RING_OFF + F.wave * 1024);
    LAS float* W2L = (LAS float*)(F.lds + RING_OFF + 16384);
    const float* ul = (const float*)(F.ws + WS_UL); const float* pb = (const float*)(F.ws + WS_PB);
    int staged = -1;
    for (int task = gw; task < 8192; task += NGW) {
        const int kv = task >> 12, rem = task & 4095, b = rem >> 11, n = (rem >> 2) & 511, g = rem & 3;
        if (kv != staged) { const float* w2 = kv ? inptr(F, 7) : inptr(F, 5);
            __syncthreads();
            for (int q = F.tid; q < 4096; q += NWAVES * 64) *(LAS f32x4*)(W2L + q * 4) = *(const GAS f32x4*)(w2 + q * 4);
            __syncthreads(); staged = kv; }
        bf16* dst = (bf16*)(F.ws + (kv ? WS_VCMP : WS_KCMP)) + ((size_t)((b * 4 + g) * 512 + n)) * 64;
        if (n == 511) { dst[lane] = 0; continue; }
        const size_t rowU = (size_t)kv * 4096 + (size_t)(b * 512 + n) * 4 + g, rowL = rowU + 4;
        const f32x4 u = *(const f32x4*)(ul + rowU * 512 + lane * 4), lw = *(const f32x4*)(ul + rowL * 512 + 256 + lane * 4);
        f32x4 bs = (f32x4){0.f, 0.f, 0.f, 0.f};
#pragma unroll
        for (int rp = 0; rp < 8; ++rp) bs += *(const f32x4*)(pb + rp * 512 + kv * 256 + lane * 4);
        const f32x4 pre = u + lw + bs;
        *(LAS f32x4*)(hb + lane * 4) = (f32x4){gelu_tanh(pre[0]), gelu_tanh(pre[1]), gelu_tanh(pre[2]), gelu_tanh(pre[3])};
        LDS_WAIT(); asm volatile("" ::: "memory");
        float a0 = 0.f, a1 = 0.f, a2 = 0.f, a3 = 0.f;
#pragma unroll 8
        for (int c = 0; c < 256; c += 4) { const f32x4 h4 = *(const LAS f32x4*)(hb + c);
            a0 += h4[0] * W2L[(c + 0) * 64 + lane]; a1 += h4[1] * W2L[(c + 1) * 64 + lane]; a2 += h4[2] * W2L[(c + 2) * 64 + lane]; a3 += h4[3] * W2L[(c + 3) * 64 + lane]; }
        dst[lane] = (bf16)f2bf((a0 + a1) + (a2 + a3));
        LDS_WAIT(); asm volatile("" ::: "memory");
    }
}

namespace nsa {
constexpr int KB_OFF = 0, VB_OFF = 18432, IMPA_OFF = 36864, IMPB_OFF = 69632, SEL_OFF = 102400, UNI_OFF = 103424, NS_OFF = 103440, SLIST_OFF = 103456, TILE_B = 9216;
static_assert(SLIST_OFF + 512 <= RING_BYTES, "nsa LDS map");
constexpr float THR = 8.f;
__device__ __forceinline__ float dpp_xor1(float v) { return __int_as_float(__builtin_amdgcn_update_dpp(0, __float_as_int(v), 0xB1, 0xF, 0xF, true)); }
__device__ __forceinline__ float dpp_xor2(float v) { return __int_as_float(__builtin_amdgcn_update_dpp(0, __float_as_int(v), 0x4E, 0xF, 0xF, true)); }
__device__ __forceinline__ float max_halves(float v) { const auto rr = __builtin_amdgcn_permlane32_swap(__float_as_uint(v), __float_as_uint(v), false, false); return fmaxf(__uint_as_float(rr[0]), __uint_as_float(rr[1])); }
__device__ __forceinline__ int below(unsigned long long mk) { return (int)__builtin_amdgcn_mbcnt_hi((unsigned)(mk >> 32), __builtin_amdgcn_mbcnt_lo((unsigned)mk, 0u)); }
template <int MODE>
__device__ __forceinline__ void tile(LAS unsigned char* lds, const int kt_off, const int vt_off, const bf16x8 (&qf)[4], const unsigned qaw, f32x16 (&o)[2], float& m, float& l,
                                     const int lane, const float bias, const bool emask, const int d0, const int pstep, const int lim, const float rl, const int impq, const int jbase) {
    const int hi = lane >> 5, qc = lane & 31;
    const v4u qav = (v4u){qaw, 0u, 0u, 0u}; const bf16x8 qaug = __builtin_bit_cast(bf16x8, qav);
    f32x16 p[2];
    bf16x8 kf[2][4];
#pragma unroll
    for (int h2 = 0; h2 < 2; ++h2)
#pragma unroll
        for (int ks = 0; ks < 4; ++ks) kf[h2][ks] = *(const LAS bf16x8*)(lds + kt_off + (32 * h2 + qc) * 144 + 32 * ks + 16 * hi);
    __builtin_amdgcn_sched_barrier(0);
#pragma unroll
    for (int h2 = 0; h2 < 2; ++h2)
#pragma unroll
        for (int r = 0; r < 16; ++r) p[h2][r] = 0.f;
#pragma unroll
    for (int ks = 0; ks < 4; ++ks)
#pragma unroll
        for (int h2 = 0; h2 < 2; ++h2) p[h2] = __builtin_amdgcn_mfma_f32_32x32x16_bf16(kf[h2][ks], qf[ks], p[h2], 0, 0, 0);
#pragma unroll
    for (int h2 = 0; h2 < 2; ++h2) { const unsigned xb = hi ? 0u : f2bf((float)(32 * h2 + qc)); const v4u kav = (v4u){xb | (xb << 16), 0u, 0u, 0u};
        p[h2] = __builtin_amdgcn_mfma_f32_32x32x16_bf16(__builtin_bit_cast(bf16x8, kav), qaug, p[h2], 0, 0, 0); }
    v4i16 vlo[2][2][2], vhi[2][2][2];
    if (MODE != 0) {
        const int a_ = (lane >> 4) & 1, q_ = (lane & 15) >> 2, p_ = lane & 3;
#pragma unroll
        for (int d0_ = 0; d0_ < 2; ++d0_)
#pragma unroll
            for (int h2 = 0; h2 < 2; ++h2)
#pragma unroll
                for (int s2 = 0; s2 < 2; ++s2) { const LAS unsigned char* ad = lds + vt_off + (32 * h2 + 16 * s2 + 4 * hi + q_) * 144 + (32 * d0_ + 16 * a_ + 4 * p_) * 2;
                    vlo[d0_][h2][s2] = vtr(ad); vhi[d0_][h2][s2] = vtr(ad + 8 * 144); }
        __builtin_amdgcn_sched_barrier(0);
    }
    if (emask) {
#pragma unroll
        for (int h2 = 0; h2 < 2; ++h2)
#pragma unroll
            for (int r = 0; r < 16; ++r) { const int dist = d0 - pstep * (32 * h2 + (r & 3) + 8 * (r >> 2)); p[h2][r] = ((unsigned)dist < (unsigned)lim) ? p[h2][r] : -INFINITY; }
    }
    float mref;
    if (MODE == 1) mref = m - bias;
    else {
        float mx = fmaxf(p[0][0], p[1][0]);
#pragma unroll
        for (int r = 1; r < 16; ++r) mx = fmaxf(fmaxf(mx, p[0][r]), p[1][r]);
        mx = max_halves(mx);
        const float mt = mx + bias;
        const bool up = mt > m + THR;
        if (__any(up)) { const float mn = up ? mt : m; const float f = __builtin_amdgcn_exp2f(m - mn); l *= f; m = mn;
            if (MODE == 2) {
#pragma unroll
                for (int r = 0; r < 16; ++r) { o[0][r] *= f; o[1][r] *= f; } } }
        mref = m - bias;
    }
    float ls0 = 0.f, ls1 = 0.f;
#pragma unroll
    for (int r = 0; r < 16; ++r) { float e0 = __builtin_amdgcn_exp2f(p[0][r] - mref), e1 = __builtin_amdgcn_exp2f(p[1][r] - mref); if (MODE == 1) { e0 *= rl; e1 *= rl; } p[0][r] = e0; p[1][r] = e1; ls0 += e0; ls1 += e1; }
    if (MODE != 1) l += ls0 + ls1;
    if (MODE == 0) return;
    if (MODE == 1) {
        LAS float* IA = (LAS float*)(lds + IMPA_OFF) + impq * 128; LAS float* IB = (LAS float*)(lds + IMPB_OFF) + impq * 128;
#pragma unroll
        for (int h2 = 0; h2 < 2; ++h2)
#pragma unroll
            for (int a4 = 0; a4 < 4; ++a4) {
                float qs = (p[h2][4 * a4] + p[h2][4 * a4 + 1]) + (p[h2][4 * a4 + 2] + p[h2][4 * a4 + 3]), last = p[h2][4 * a4 + 3];
                qs += dpp_xor1(qs); qs += dpp_xor2(qs); last += dpp_xor1(last); last += dpp_xor2(last);
                const int j = jbase + 8 * h2 + 2 * a4 + hi;
                if ((qc & 3) == 0) { IA[j] = qs; if (j + 1 < 128) IB[j + 1] = last; }
            }
    }
    bf16x8 pf[2][2];
#pragma unroll
    for (int h2 = 0; h2 < 2; ++h2)
#pragma unroll
        for (int s2 = 0; s2 < 2; ++s2) { v4u wv; wv.x = pg8::cvtpk_c(p[h2][8 * s2 + 0], p[h2][8 * s2 + 1]); wv.y = pg8::cvtpk_c(p[h2][8 * s2 + 2], p[h2][8 * s2 + 3]);
            wv.z = pg8::cvtpk_c(p[h2][8 * s2 + 4], p[h2][8 * s2 + 5]); wv.w = pg8::cvtpk_c(p[h2][8 * s2 + 6], p[h2][8 * s2 + 7]); pf[h2][s2] = __builtin_bit_cast(bf16x8, wv); }
#pragma unroll
    for (int h2 = 0; h2 < 2; ++h2)
#pragma unroll
        for (int s2 = 0; s2 < 2; ++s2)
#pragma unroll
            for (int d0_ = 0; d0_ < 2; ++d0_) {
                const v4i16 lo = vlo[d0_][h2][s2], hi4 = vhi[d0_][h2][s2];
                const bf16x8 av = (bf16x8){lo[0], lo[1], lo[2], lo[3], hi4[0], hi4[1], hi4[2], hi4[3]};
                o[d0_] = __builtin_amdgcn_mfma_f32_32x32x16_bf16(av, pf[h2][s2], o[d0_], 0, 0, 0);
            }
}
__device__ __forceinline__ void select13(const unsigned (&k0)[4], const unsigned (&k1)[4], const int lane, unsigned long long (&m0)[4], unsigned long long (&m1)[4]) {
    unsigned th[4] = {0u, 0u, 0u, 0u};
    for (int bit = 30; bit >= 0; --bit) {
#pragma unroll
        for (int u = 0; u < 4; ++u) { const unsigned cand = th[u] | (1u << bit); const int cnt = __popcll(__ballot(k0[u] >= cand)) + __popcll(__ballot(k1[u] >= cand)); th[u] = cnt >= 13 ? cand : th[u]; }
    }
#pragma unroll
    for (int u = 0; u < 4; ++u) {
        const unsigned long long gt0 = __ballot(k0[u] > th[u]), gt1 = __ballot(k1[u] > th[u]), eq0 = __ballot(k0[u] == th[u]), eq1 = __ballot(k1[u] == th[u]);
        const int need = 13 - __popcll(gt0) - __popcll(gt1);
        const int r0 = below(eq0), r1 = __popcll(eq0) + below(eq1);
        const bool s0 = (k0[u] > th[u]) || (k0[u] == th[u] && r0 < need), s1 = (k1[u] > th[u]) || (k1[u] == th[u] && r1 < need);
        m0[u] = __ballot(s0); m1[u] = __ballot(s1);
    }
}
}
__device__ __forceinline__ void nsa_attn_phase(Frame& F) {
    using namespace nsa;
    LAS unsigned char* lds = F.lds + RING_OFF;
    const int tid = F.tid, lane = F.lane, w = F.wave, hi = lane >> 5, qc = lane & 31;
    unsigned char* ws = F.ws;
    const bf16* Qp = (const bf16*)(ws + WS_Q); const float* GT = (const float*)(ws + WS_GT); bf16* Op = (bf16*)(ws + WS_O);
    LAS unsigned* SEL = (LAS unsigned*)(lds + SEL_OFF); LAS unsigned* UNI = (LAS unsigned*)(lds + UNI_OFF); LAS int* NSW = (LAS int*)(lds + NS_OFF); LAS int* SLIST = (LAS int*)(lds + SLIST_OFF);
    const int lrow = tid >> 3, lch = tid & 7;
    for (int un = F.wg; un < 1024; un += F.G) {
        const int bg = un & 7, cc = un >> 3, c = ((cc >> 5) & 1) ? (cc & ~31) + 31 - (cc & 31) : cc;
        const int b = bg >> 2, g = bg & 3, t0 = c * 64;
        const int tql = 8 * w + (qc >> 2), hh = qc & 3, t = t0 + tql, head = 4 * g + hh;
        const size_t mrow = (size_t)b * T + t;
        const float slope2 = __builtin_amdgcn_exp2f(-0.5f * (float)(head + 1)) * LOG2E;
        unsigned qaw1, qaw16;
        { const unsigned sh = f2bf(slope2); const float rem = slope2 - __uint_as_float(sh << 16); const unsigned sl = f2bf(rem);
          const unsigned sh16 = f2bf(16.f * __uint_as_float(sh << 16)), sl16 = f2bf(16.f * __uint_as_float(sl << 16));
          qaw1 = hi ? 0u : (sh | (sl << 16)); qaw16 = hi ? 0u : (sh16 | (sl16 << 16)); }
        bf16x8 qf[4];
#pragma unroll
        for (int ks = 0; ks < 4; ++ks) qf[ks] = *(const GAS bf16x8*)(Qp + mrow * 1024 + head * 64 + 16 * ks + 8 * hi);
        const float* gp = GT + mrow * 48 + (g * 4 + hh) * 3; const float g_cmp = gp[0], g_slc = gp[1], g_win = gp[2];
        const int nmax = (4 * c + 2) < 510 ? (4 * c + 2) : 510, ncb = nmax / 64 + 1;
        const int jw0 = c - 8 > 0 ? c - 8 : 0, nw = c - jw0 + 1, S3 = 2 * ncb + nw;
        const unsigned kcb = (unsigned)WS_KCMP + (unsigned)(b * 4 + g) * 65536u, kvb = ((unsigned)b * T * 256u + (unsigned)g * 64u) * 2u;
        int ns = 1;
#define NSA_FETCH(s, kr, vr) do { const int s_ = (s); unsigned sb_, dv_ = 0u; int tt_ = tid; asm volatile("" : "+v"(tt_));     \
            if (s_ < ncb) { sb_ = kcb + (unsigned)s_ * 8192u; } \
            else if (s_ < 2 * ncb) { sb_ = kcb + (unsigned)(s_ - ncb) * 8192u; dv_ = (unsigned)(WS_VCMP - WS_KCMP); } \
            else if (s_ < S3) { sb_ = (unsigned)WS_KW + kvb + (unsigned)(c - (s_ - 2 * ncb)) * 32768u; dv_ = (unsigned)(WS_VW - WS_KW); } \
            else { sb_ = (unsigned)WS_KS + kvb + (unsigned)__builtin_amdgcn_readfirstlane(SLIST[ns - 1 - (s_ - S3)]) * 32768u; dv_ = (unsigned)(WS_VS - WS_KS); } \
            const unsigned ko_ = sb_ + (unsigned)((tt_ >> 3) * (s_ < 2 * ncb ? 128 : 512) + (tt_ & 7) * 16); \
            kr = *(const GAS v4u*)(ws + ko_); if (s_ >= ncb) vr = *(const GAS v4u*)(ws + ko_ + dv_); } while (0)
#define NSA_COMMIT(s, kr, vr) do { const int bo_ = ((s) & 1) * TILE_B + lrow * 144 + lch * 16; *(LAS v4u*)(lds + KB_OFF + bo_) = kr; if ((s) >= ncb) *(LAS v4u*)(lds + VB_OFF + bo_) = vr; } while (0)
        __syncthreads();
        if (c <= 15) {
            int ln = lane; asm volatile("" : "+v"(ln));
            if (ln < 8) { const int q = 8 * w + ln; SEL[q * 4 + 0] = (2u << c) - 1u; SEL[q * 4 + 1] = 0u; SEL[q * 4 + 2] = 0u; SEL[q * 4 + 3] = 0u; }
            if (w == 0 && ln <= c) SLIST[ln] = ln;
            ns = c + 1; }
        else if (tid < 4) UNI[tid] = 0u;
        int ST = S3 + ns;
        v4u krA = (v4u){0u, 0u, 0u, 0u}, vrA = krA, krB = krA, vrB = krA;
        NSA_FETCH(0, krA, vrA); NSA_COMMIT(0, krA, vrA); NSA_FETCH(1, krB, vrB);
        __syncthreads();
        float m = -1e30f, l = 0.f, rl = 0.f; f32x16 o[2]; unsigned otp[2][8];
#pragma unroll
        for (int r = 0; r < 16; ++r) { o[0][r] = 0.f; o[1][r] = 0.f; }
#pragma unroll
        for (int r = 0; r < 8; ++r) { otp[0][r] = 0u; otp[1][r] = 0u; }
#define NSA_PRE(s) const bool has_next = (s) + 1 < ST; if ((s) + 2 < ST) { if ((s) & 1) NSA_FETCH((s) + 2, krB, vrB); else NSA_FETCH((s) + 2, krA, vrA); } \
        const int kt = KB_OFF + ((s) & 1) * TILE_B, vt = VB_OFF + ((s) & 1) * TILE_B
#define NSA_POST(s) do { if (has_next) { if ((s) & 1) NSA_COMMIT((s) + 1, krA, vrA); else NSA_COMMIT((s) + 1, krB, vrB); } __syncthreads(); } while (0)
        int s = 0;
        for (; s < ncb; ++s) { NSA_PRE(s); const int pos0 = 1024 * s + 31;
            const float bias = slope2 * (float)(pos0 - t); const bool em = 1024 * s + 1039 > t0; const int d0 = t - pos0 - 64 * hi;
            tile<0>(lds, kt, vt, qf, qaw16, o, m, l, lane, bias, em, d0, 16, 0x7fffffff, 0.f, tql, 0);
            NSA_POST(s); }
        { const float lt0 = l + __shfl_xor(l, 32); rl = 1.0f / fmaxf(lt0, 1e-30f); }
        for (; s < 2 * ncb; ++s) { NSA_PRE(s); const int kb = s - ncb; const int pos0 = 1024 * kb + 31;
            const float bias = slope2 * (float)(pos0 - t); const bool em = 1024 * kb + 1039 > t0; const int d0 = t - pos0 - 64 * hi;
            tile<1>(lds, kt, vt, qf, qaw16, o, m, l, lane, bias, em, d0, 16, 0x7fffffff, rl, tql, 16 * kb);
            NSA_POST(s); }
        {
#pragma unroll
            for (int r = 0; r < 8; ++r) { otp[0][r] = pg8::cvtpk_c(g_cmp * o[0][2 * r], g_cmp * o[0][2 * r + 1]); otp[1][r] = pg8::cvtpk_c(g_cmp * o[1][2 * r], g_cmp * o[1][2 * r + 1]); }
#pragma unroll
            for (int r = 0; r < 16; ++r) { o[0][r] = 0.f; o[1][r] = 0.f; }
            m = -1e30f; l = 0.f; }
        if (c >= 16) {
                {
                    unsigned long long uo0 = 0ull, uo1 = 0ull;
                    for (int qi = 0; qi < 8; qi += 4) {
                        unsigned k0[4], k1[4]; unsigned long long m0[4], m1[4];
                        int lnq = lane; asm volatile("" : "+v"(lnq));
#pragma unroll
                        for (int u = 0; u < 4; ++u) { const int q = 8 * w + qi + u;
                            const LAS float* ia = (const LAS float*)(lds + IMPA_OFF) + q * 128; const LAS float* ib = (const LAS float*)(lds + IMPB_OFF) + q * 128;
                            const float v0 = ia[lnq] + ib[lnq], v1 = ia[lnq + 64] + ib[lnq + 64];
                            k0[u] = (lane >= 1 && lane <= c - 2) ? __float_as_uint(v0) + 1u : 0u; k1[u] = (lane + 64 <= c - 2) ? __float_as_uint(v1) + 1u : 0u; }
                        select13(k0, k1, lane, m0, m1);
#pragma unroll
                        for (int u = 0; u < 4; ++u) { const int q = 8 * w + qi + u;
                            m0[u] |= 1ull;
                            if (c - 1 < 64) m0[u] |= 1ull << (c - 1); else m1[u] |= 1ull << (c - 1 - 64);
                            if (c < 64) m0[u] |= 1ull << c; else m1[u] |= 1ull << (c - 64);
                            uo0 |= m0[u]; uo1 |= m1[u];
                            if (lane == 0) { SEL[q * 4 + 0] = (unsigned)m0[u]; SEL[q * 4 + 1] = (unsigned)(m0[u] >> 32); SEL[q * 4 + 2] = (unsigned)m1[u]; SEL[q * 4 + 3] = (unsigned)(m1[u] >> 32); } }
                    }
                    if (lane == 0) { __hip_atomic_fetch_or(UNI + 0, (unsigned)uo0, __ATOMIC_RELAXED, __HIP_MEMORY_SCOPE_WORKGROUP); __hip_atomic_fetch_or(UNI + 1, (unsigned)(uo0 >> 32), __ATOMIC_RELAXED, __HIP_MEMORY_SCOPE_WORKGROUP);
                        __hip_atomic_fetch_or(UNI + 2, (unsigned)uo1, __ATOMIC_RELAXED, __HIP_MEMORY_SCOPE_WORKGROUP); __hip_atomic_fetch_or(UNI + 3, (unsigned)(uo1 >> 32), __ATOMIC_RELAXED, __HIP_MEMORY_SCOPE_WORKGROUP); }
                }
                __syncthreads();
                if (w == 0) {
                    const unsigned long long u0 = (unsigned long long)UNI[0] | ((unsigned long long)UNI[1] << 32), u1 = (unsigned long long)UNI[2] | ((unsigned long long)UNI[3] << 32);
                    if ((u0 >> lane) & 1ull) SLIST[below(u0)] = lane;
                    if ((u1 >> lane) & 1ull) SLIST[__popcll(u0) + below(u1)] = 64 + lane;
                    if (lane == 0) NSW[0] = __popcll(u0) + __popcll(u1);
                }
                __syncthreads();
                ns = __builtin_amdgcn_readfirstlane(NSW[0]); ST = S3 + ns;
        }
        for (; s < S3; ++s) { NSA_PRE(s); const int j = c - (s - 2 * ncb); const float bias = slope2 * (float)(64 * j - t);
            const bool em = (j == c) || (c >= 8 && j == c - 8);
            tile<2>(lds, kt, vt, qf, qaw1, o, m, l, lane, bias, em, t - 64 * j - 4 * hi, 1, 512, 0.f, 0, 0);
            NSA_POST(s); }
        { const float lt = l + __shfl_xor(l, 32); const float sc = g_win / fmaxf(lt, 1e-30f);
#pragma unroll
            for (int r = 0; r < 8; ++r) { otp[0][r] = pg8::cvtpk_c(__uint_as_float(otp[0][r] << 16) + sc * o[0][2 * r], __uint_as_float(otp[0][r] & 0xffff0000u) + sc * o[0][2 * r + 1]);
                otp[1][r] = pg8::cvtpk_c(__uint_as_float(otp[1][r] << 16) + sc * o[1][2 * r], __uint_as_float(otp[1][r] & 0xffff0000u) + sc * o[1][2 * r + 1]); }
#pragma unroll
            for (int r = 0; r < 16; ++r) { o[0][r] = 0.f; o[1][r] = 0.f; }
            m = -1e30f; l = 0.f; }
        for (; s < ST; ++s) { NSA_PRE(s); const int j = SLIST[ns - 1 - (s - S3)]; const bool selq = (SEL[tql * 4 + (j >> 5)] >> (j & 31)) & 1u;
            const float bias = selq ? slope2 * (float)(64 * j - t) : -INFINITY;
            tile<2>(lds, kt, vt, qf, qaw1, o, m, l, lane, bias, j == c, t - 64 * j - 4 * hi, 1, 0x7fffffff, 0.f, 0, 0);
            NSA_POST(s); }
#undef NSA_PRE
#undef NSA_POST
        { const float lt = l + __shfl_xor(l, 32); const float sc = g_slc / fmaxf(lt, 1e-30f);
          bf16* orow = Op + mrow * 1024 + head * 64;
#pragma unroll
          for (int d0 = 0; d0 < 2; ++d0)
#pragma unroll
              for (int a4 = 0; a4 < 4; ++a4) { const unsigned p0_ = otp[d0][2 * a4], p1_ = otp[d0][2 * a4 + 1]; v2u wv;
                  wv.x = pg8::cvtpk_c(__uint_as_float(p0_ << 16) + sc * o[d0][4 * a4], __uint_as_float(p0_ & 0xffff0000u) + sc * o[d0][4 * a4 + 1]);
                  wv.y = pg8::cvtpk_c(__uint_as_float(p1_ << 16) + sc * o[d0][4 * a4 + 2], __uint_as_float(p1_ & 0xffff0000u) + sc * o[d0][4 * a4 + 3]);
                  *(GAS v2u*)(orow + 32 * d0 + 8 * a4 + 4 * hi) = wv; } }
#undef NSA_FETCH
#undef NSA_COMMIT
    }
}

__device__ __forceinline__ f32x4 bf4(const v2u a) { return (f32x4){__uint_as_float(a.x << 16), __uint_as_float(a.x & 0xffff0000u), __uint_as_float(a.y << 16), __uint_as_float(a.y & 0xffff0000u)}; }
__device__ __forceinline__ void ln_rows(Frame& F, const bf16* tin, const float* gain, const float* bias, bf16* xb) {
    const int gw = F.vcu * NWAVES + F.wave, NGW = F.G * NWAVES, lane = F.lane;
    f32x4 gv[4], bv[4];
#pragma unroll
    for (int j = 0; j < 4; ++j) { gv[j] = *((const GAS f32x4*)gain + lane + 64 * j); bv[j] = *((const GAS f32x4*)bias + lane + 64 * j); }
    for (int m0 = gw; m0 < M; m0 += 8 * NGW) {
        v2u raw[8][4];
#pragma unroll
        for (int k = 0; k < 8; ++k) { const int m = m0 + k * NGW; if (m < M) { const GAS v2u* xr = (const GAS v2u*)(tin + (size_t)m * D) + lane;
#pragma unroll
            for (int j = 0; j < 4; ++j) raw[k][j] = xr[64 * j]; } }
#pragma unroll
        for (int k = 0; k < 8; ++k) { const int m = m0 + k * NGW; if (m >= M) break;
            f32x4 v[4]; float s = 0.f;
#pragma unroll
            for (int j = 0; j < 4; ++j) { v[j] = bf4(raw[k][j]); s += (v[j].x + v[j].y) + (v[j].z + v[j].w); }
            const float mean = wave_sum(s) * (1.f / D); float s2 = 0.f;
#pragma unroll
            for (int j = 0; j < 4; ++j) { v[j] = v[j] - mean; s2 += (v[j].x * v[j].x + v[j].y * v[j].y) + (v[j].z * v[j].z + v[j].w * v[j].w); }
            const float rstd = 1.f / sqrtf(wave_sum(s2) * (1.f / D) + LN_EPS);
            GAS unsigned long long* o8 = (GAS unsigned long long*)(xb + (size_t)m * D) + lane;
#pragma unroll
            for (int j = 0; j < 4; ++j) { const f32x4 y = v[j] * rstd * gv[j] + bv[j]; o8[64 * j] = (unsigned long long)pk2(y.x, y.y) | ((unsigned long long)pk2(y.z, y.w) << 32); }
        }
    }
}
namespace gla {
constexpr int ALS_OFF = 0, SEG_OFF = 4096, KH_OFF = 8192, KH_STR = 272, VH1_OFF = KH_OFF + 64 * KH_STR, VH_STR = 528, ZL_OFF = VH1_OFF + 64 * VH_STR, ZL_STR = 272;
constexpr int QS_OFF = 0, QS_STR = 272, AL_OFF = 64 * QS_STR, AL_STR = 144, VH3_OFF = AL_OFF + 64 * AL_STR, ST_OFF = VH3_OFF + 64 * VH_STR, ST_STR = 272, QT_OFF = ST_OFF, KT_OFF = ST_OFF + 64 * QS_STR, SSQ_OFF = ST_OFF + 256 * ST_STR;
constexpr int OL_OFF = ST_OFF, OL_STR = 1040;
static_assert(SSQ_OFF + 1024 <= RING_BYTES && ZL_OFF + 256 * ZL_STR <= RING_BYTES && KT_OFF + 64 * QS_STR <= SSQ_OFF && OL_OFF + 64 * OL_STR <= SSQ_OFF, "gla LDS map");
__device__ __forceinline__ bf16x8 trfrag(const LAS unsigned char* p, int rowstep4) { const v4i16 lo = vtr(p), hi4 = vtr(p + rowstep4); return (bf16x8){lo[0], lo[1], lo[2], lo[3], hi4[0], hi4[1], hi4[2], hi4[3]}; }
}
__device__ __forceinline__ void gla_load_v(LAS unsigned char* lds, int off, const bf16* qkvg, size_t m0, int vcol0, int tid) {
#pragma unroll
    for (int k = 0; k < 4; ++k) { const int q = tid + 512 * k, row = q >> 5, ch = q & 31;
        const v4u v = *(const GAS v4u*)(qkvg + (m0 + row) * 3072 + vcol0 + ch * 8); *(LAS v4u*)(lds + off + row * gla::VH_STR + ch * 16) = v; }
}
__device__ __forceinline__ void gla_g1(Frame& F) {
    using namespace gla;
    LAS unsigned char* lds = F.lds + RING_OFF; const int tid = F.tid, lane = F.lane, w = F.wave, hi = lane >> 5, qc = lane & 31;
    unsigned char* ws = F.ws; const bf16* qkvg = (const bf16*)(ws + WS_QKVG); const bf16* xbrows = (const bf16*)(ws + WS_XB); const bf16* wat = (const bf16*)(ws + WS_WIN1) + (size_t)3072 * 1024;
    float* bcum = (float*)(ws + WS_BCUM); bf16* zb = (bf16*)(ws + WS_ZB); float* dec = (float*)(ws + WS_DEC);
    const float* wg2 = inptr(F, 16); const float* bg2 = inptr(F, 17);
    LAS float* ALS = (LAS float*)(lds + ALS_OFF); LAS float* SEG = (LAS float*)(lds + SEG_OFF);
    const int d = tid & 127, ig = tid >> 7;
    for (int un = F.wg; un < 1024; un += F.G) {
        const int bh = un >> 7, n = un & 127, b = bh >> 2, h = bh & 3; const size_t m0 = (size_t)b * T + 64 * n;
        __syncthreads();
        { typedef float f32x4_ __attribute__((ext_vector_type(4)));
          const bf16* xbp = xbrows + (m0 + (lane & 15)) * 1024 + 128 * w + 8 * (lane >> 4); const bf16* wbp = wat + (size_t)(lane & 15) * 1024 + 128 * w + 8 * (lane >> 4);
          bf16x8 bq[4], aq[4][4];
#pragma unroll
          for (int ks = 0; ks < 4; ++ks) bq[ks] = *(const GAS bf16x8*)(wbp + 32 * ks);
#pragma unroll
          for (int rb = 0; rb < 4; ++rb)
#pragma unroll
              for (int ks = 0; ks < 4; ++ks) aq[rb][ks] = *(const GAS bf16x8*)(xbp + (size_t)rb * 16 * 1024 + 32 * ks);
          LAS float* PART = (LAS float*)(lds + ZL_OFF) + w * 1024;
#pragma unroll
          for (int rb = 0; rb < 4; ++rb) { f32x4_ pa = (f32x4_){0.f, 0.f, 0.f, 0.f};
#pragma unroll
              for (int ks = 0; ks < 4; ++ks) pa = __builtin_amdgcn_mfma_f32_16x16x32_bf16(aq[rb][ks], bq[ks], pa, 0, 0, 0);
#pragma unroll
              for (int j = 0; j < 4; ++j) PART[(16 * rb + 4 * (lane >> 4) + j) * 16 + (lane & 15)] = pa[j]; } }
        gla_load_v(lds, VH1_OFF, qkvg, m0, 1024 + h * 256, tid);
        bf16 kraw[16];
#pragma unroll
        for (int ii = 0; ii < 16; ++ii) kraw[ii] = *(const GAS bf16*)(qkvg + (m0 + 16 * ig + ii) * 3072 + 512 + h * 128 + d);
        float wg[16];
#pragma unroll
        for (int r = 0; r < 16; ++r) wg[r] = wg2[r * 512 + h * 128 + d];
        const float bgv = bg2[h * 128 + d];
        __syncthreads();
        { const LAS float* P0 = (const LAS float*)(lds + ZL_OFF) + 2 * tid; float s0 = 0.f, s1 = 0.f;
#pragma unroll
          for (int k = 0; k < 8; ++k) { s0 += P0[k * 1024]; s1 += P0[k * 1024 + 1]; }
          ALS[2 * tid] = s0; ALS[2 * tid + 1] = s1; }
        __syncthreads();
        float cs[16]; float run = 0.f;
#pragma unroll
        for (int ii = 0; ii < 16; ++ii) { const int i = 16 * ig + ii; float z = bgv;
#pragma unroll
            for (int r = 0; r < 16; ++r) z += ALS[i * 16 + r] * wg[r];
            const float la = (fminf(z, 0.f) - __logf(1.f + __expf(-fabsf(z)))) * (1.f / 16.f);
            run += la; cs[ii] = run; }
        SEG[ig * 128 + d] = run;
        __syncthreads();
        float pre = 0.f, tot = 0.f;
#pragma unroll
        for (int k = 0; k < 4; ++k) { const float sv = SEG[k * 128 + d]; if (k < ig) pre += sv; tot += sv; }
#pragma unroll
        for (int ii = 0; ii < 16; ++ii) { const int i = 16 * ig + ii; cs[ii] += pre;
            *(LAS bf16*)(lds + KH_OFF + i * KH_STR + d * 2) = (bf16)f2bf(bf2f(kraw[ii]) * __expf(tot - cs[ii])); }
#pragma unroll
        for (int ii = 0; ii < 16; ++ii) *(GAS float*)(bcum + (m0 + 16 * ig + ii) * 512 + h * 128 + d) = cs[ii];
        if (ig == 0) dec[(size_t)(bh * 128 + n) * 128 + d] = __expf(tot);
        __syncthreads();
        f32x16 acc[4];
#pragma unroll
        for (int db = 0; db < 4; ++db)
#pragma unroll
            for (int r = 0; r < 16; ++r) acc[db][r] = 0.f;
        const int a = (lane >> 4) & 1, q_ = (lane & 15) >> 2, p_ = lane & 3;
#pragma unroll
        for (int s = 0; s < 4; ++s) {
            const bf16x8 bfr = trfrag(lds + VH1_OFF + (16 * s + 8 * hi + q_) * VH_STR + (32 * w + 16 * a + 4 * p_) * 2, 4 * VH_STR);
#pragma unroll
            for (int db = 0; db < 4; ++db) { const bf16x8 afr = trfrag(lds + KH_OFF + (16 * s + 8 * hi + q_) * KH_STR + (32 * db + 16 * a + 4 * p_) * 2, 4 * KH_STR);
                acc[db] = __builtin_amdgcn_mfma_f32_32x32x16_bf16(afr, bfr, acc[db], 0, 0, 0); }
        }
#pragma unroll
        for (int db = 0; db < 4; ++db)
#pragma unroll
            for (int a4 = 0; a4 < 4; ++a4) { v2u wv; wv.x = pg8::cvtpk_c(acc[db][4 * a4], acc[db][4 * a4 + 1]); wv.y = pg8::cvtpk_c(acc[db][4 * a4 + 2], acc[db][4 * a4 + 3]);
                *(LAS v2u*)(lds + ZL_OFF + (32 * w + qc) * ZL_STR + (32 * db + 8 * a4 + 4 * hi) * 2) = wv; }
        __syncthreads();
        { bf16* zu = zb + (size_t)(bh * 128 + n) * 256 * 128;
#pragma unroll
          for (int k = 0; k < 8; ++k) { const int q = tid + 512 * k, row = q >> 4, ch = q & 15; *(GAS v4u*)(zu + row * 128 + ch * 8) = *(const LAS v4u*)(lds + ZL_OFF + row * ZL_STR + ch * 16); } }
    }
}
__device__ __forceinline__ void gla_g2(Frame& F) {
    unsigned char* ws = F.ws; const bf16* zb = (const bf16*)(ws + WS_ZB); const float* dec = (const float*)(ws + WS_DEC); bf16* sst = (bf16*)(ws + WS_SST);
    for (int p = F.wg * 512 + F.tid; p < 131072; p += F.G * 512) {
        const int bh = p >> 14, e = (p >> 6) & 255, d2 = p & 63;
        float s0 = 0.f, s1 = 0.f;
        for (int n0 = 0; n0 < 128; n0 += 8) {
            pg8::f32x2 dv[8]; unsigned zz[8];
#pragma unroll
            for (int k = 0; k < 8; ++k) { const size_t cn = (size_t)(bh * 128 + n0 + k); dv[k] = *(const GAS pg8::f32x2*)(dec + cn * 128 + 2 * d2); zz[k] = *(const GAS unsigned*)(zb + (cn * 256 + e) * 128 + 2 * d2); }
#pragma unroll
            for (int k = 0; k < 8; ++k) { const size_t cn = (size_t)(bh * 128 + n0 + k);
                *(GAS unsigned*)(sst + (cn * 256 + e) * 128 + 2 * d2) = pk2(s0, s1);
                s0 = s0 * dv[k].x + __uint_as_float(zz[k] << 16); s1 = s1 * dv[k].y + __uint_as_float(zz[k] & 0xffff0000u); }
        }
    }
}
__device__ __forceinline__ void gla_g3(Frame& F) {
    using namespace gla;
    LAS unsigned char* lds = F.lds + RING_OFF; const int tid = F.tid, lane = F.lane, w = F.wave, hi = lane >> 5, qc = lane & 31;
    unsigned char* ws = F.ws; const bf16* qkvg = (const bf16*)(ws + WS_QKVG); const float* bcum = (const float*)(ws + WS_BCUM); const bf16* sst = (const bf16*)(ws + WS_SST);
    bf16* o1 = (bf16*)(ws + WS_O1); const float* hng = inptr(F, 18);
    LAS float* SSQ = (LAS float*)(lds + SSQ_OFF);
    const int d = tid & 127, ig = tid >> 7;
    const int a = (lane >> 4) & 1, q_ = (lane & 15) >> 2, p_ = lane & 3;
    for (int un = F.wg; un < 1024; un += F.G) {
        const int bh = un >> 7, n = un & 127, b = bh >> 2, h = bh & 3; const size_t m0 = (size_t)b * T + 64 * n;
        __syncthreads();
        gla_load_v(lds, VH3_OFF, qkvg, m0, 1024 + h * 256, tid);
        v4u sreg[8];
        { const bf16* sp = sst + (size_t)(bh * 128 + n) * 256 * 128;
#pragma unroll
          for (int k = 0; k < 8; ++k) { const int q = tid + 512 * k, row = q >> 4, ch = q & 15; sreg[k] = *(const GAS v4u*)(sp + row * 128 + ch * 8); } }
        { const float bref = bcum[(m0 + 32) * 512 + h * 128 + d];
          float bb[16]; bf16 qr[16], kr[16];
#pragma unroll
          for (int ii = 0; ii < 16; ++ii) { const size_t mi = m0 + 16 * ig + ii; bb[ii] = *(const GAS float*)(bcum + mi * 512 + h * 128 + d);
              qr[ii] = *(const GAS bf16*)(qkvg + mi * 3072 + h * 128 + d); kr[ii] = *(const GAS bf16*)(qkvg + mi * 3072 + 512 + h * 128 + d); }
#pragma unroll
          for (int ii = 0; ii < 16; ++ii) { const int i = 16 * ig + ii; const float qv = bf2f(qr[ii]), kv = bf2f(kr[ii]);
              *(LAS bf16*)(lds + QT_OFF + i * QS_STR + d * 2) = (bf16)f2bf(qv * __expf(bb[ii] - bref));
              *(LAS bf16*)(lds + KT_OFF + i * QS_STR + d * 2) = (bf16)f2bf(kv * __expf(bref - bb[ii]));
              *(LAS bf16*)(lds + QS_OFF + i * QS_STR + d * 2) = (bf16)f2bf(qv * __expf(bb[ii])); } }
        __syncthreads();
        if (w < 4) {
            const int jb = w >> 1, ib = w & 1; f32x16 acc;
#pragma unroll
            for (int r = 0; r < 16; ++r) acc[r] = 0.f;
#pragma unroll
            for (int s = 0; s < 8; ++s) { const bf16x8 afr = *(const LAS bf16x8*)(lds + KT_OFF + (32 * jb + qc) * QS_STR + 32 * s + 16 * hi), bfr = *(const LAS bf16x8*)(lds + QT_OFF + (32 * ib + qc) * QS_STR + 32 * s + 16 * hi);
                acc = __builtin_amdgcn_mfma_f32_32x32x16_bf16(afr, bfr, acc, 0, 0, 0); }
            const int i = 32 * ib + qc;
#pragma unroll
            for (int a4 = 0; a4 < 4; ++a4) { float v[4];
#pragma unroll
                for (int k = 0; k < 4; ++k) { const int j = 32 * jb + 8 * a4 + 4 * hi + k; v[k] = (j <= i) ? acc[4 * a4 + k] : 0.f; }
                v2u wv; wv.x = pg8::cvtpk_c(v[0], v[1]); wv.y = pg8::cvtpk_c(v[2], v[3]);
                *(LAS v2u*)(lds + AL_OFF + i * AL_STR + (32 * jb + 8 * a4 + 4 * hi) * 2) = wv; }
        }
        __syncthreads();
#pragma unroll
        for (int k = 0; k < 8; ++k) { const int q = tid + 512 * k, row = q >> 4, ch = q & 15; *(LAS v4u*)(lds + ST_OFF + row * ST_STR + ch * 16) = sreg[k]; }
        v4u ggr[4];
#pragma unroll
        for (int k = 0; k < 4; ++k) { const int q = tid + 512 * k, row = q >> 5, ch = q & 31; ggr[k] = *(const GAS v4u*)(qkvg + (m0 + row) * 3072 + 2048 + h * 256 + ch * 8); }
        __syncthreads();
        const int ib = w & 1, eq = w >> 1; f32x16 acc2[2];
#pragma unroll
        for (int r = 0; r < 16; ++r) { acc2[0][r] = 0.f; acc2[1][r] = 0.f; }
#pragma unroll
        for (int s = 0; s < 4; ++s) { const bf16x8 bfr = *(const LAS bf16x8*)(lds + AL_OFF + (32 * ib + qc) * AL_STR + 32 * s + 16 * hi);
#pragma unroll
            for (int e2 = 0; e2 < 2; ++e2) { const bf16x8 afr = trfrag(lds + VH3_OFF + (16 * s + 8 * hi + q_) * VH_STR + (32 * (2 * eq + e2) + 16 * a + 4 * p_) * 2, 4 * VH_STR);
                acc2[e2] = __builtin_amdgcn_mfma_f32_32x32x16_bf16(afr, bfr, acc2[e2], 0, 0, 0); } }
#pragma unroll
        for (int s = 0; s < 8; ++s) { const bf16x8 bfr = *(const LAS bf16x8*)(lds + QS_OFF + (32 * ib + qc) * QS_STR + 32 * s + 16 * hi);
#pragma unroll
            for (int e2 = 0; e2 < 2; ++e2) { const bf16x8 afr = *(const LAS bf16x8*)(lds + ST_OFF + (32 * (2 * eq + e2) + qc) * ST_STR + 32 * s + 16 * hi);
                acc2[e2] = __builtin_amdgcn_mfma_f32_32x32x16_bf16(afr, bfr, acc2[e2], 0, 0, 0); } }
        float ss = 0.f;
#pragma unroll
        for (int r = 0; r < 16; ++r) ss += acc2[0][r] * acc2[0][r] + acc2[1][r] * acc2[1][r];
        ss += __shfl_xor(ss, 32);
        const int i = 32 * ib + qc;
        if (hi == 0) SSQ[i * 4 + eq] = ss;
        __syncthreads();
#pragma unroll
        for (int e2 = 0; e2 < 2; ++e2)
#pragma unroll
            for (int a4 = 0; a4 < 4; ++a4) *(LAS f32x4*)(lds + OL_OFF + i * OL_STR + (32 * (2 * eq + e2) + 8 * a4 + 4 * hi) * 4) = (f32x4){acc2[e2][4 * a4], acc2[e2][4 * a4 + 1], acc2[e2][4 * a4 + 2], acc2[e2][4 * a4 + 3]};
        __syncthreads();
#pragma unroll
        for (int k = 0; k < 4; ++k) { const int q = tid + 512 * k, row = q >> 5, ch = q & 31;
            const float tot = (SSQ[row * 4 + 0] + SSQ[row * 4 + 1]) + (SSQ[row * 4 + 2] + SSQ[row * 4 + 3]); const float rstd = 1.f / sqrtf(tot * (1.f / 256.f) + RMS_EPS);
            const f32x4 oa = *(const LAS f32x4*)(lds + OL_OFF + row * OL_STR + ch * 32), ob = *(const LAS f32x4*)(lds + OL_OFF + row * OL_STR + ch * 32 + 16);
            const v4u gg = ggr[k];
            const f32x4 na = *(const GAS f32x4*)(hng + h * 256 + ch * 8), nb = *(const GAS f32x4*)(hng + h * 256 + ch * 8 + 4);
            const float g0 = __uint_as_float(gg.x << 16), g1 = __uint_as_float(gg.x & 0xffff0000u), g2 = __uint_as_float(gg.y << 16), g3 = __uint_as_float(gg.y & 0xffff0000u);
            const float g4 = __uint_as_float(gg.z << 16), g5 = __uint_as_float(gg.z & 0xffff0000u), g6 = __uint_as_float(gg.w << 16), g7 = __uint_as_float(gg.w & 0xffff0000u);
            v4u wv; wv.x = pg8::cvtpk_c(oa[0] * rstd * na[0] * pg8::silu1(g0), oa[1] * rstd * na[1] * pg8::silu1(g1)); wv.y = pg8::cvtpk_c(oa[2] * rstd * na[2] * pg8::silu1(g2), oa[3] * rstd * na[3] * pg8::silu1(g3));
            wv.z = pg8::cvtpk_c(ob[0] * rstd * nb[0] * pg8::silu1(g4), ob[1] * rstd * nb[1] * pg8::silu1(g5)); wv.w = pg8::cvtpk_c(ob[2] * rstd * nb[2] * pg8::silu1(g6), ob[3] * rstd * nb[3] * pg8::silu1(g7));
            *(GAS v4u*)(o1 + (m0 + row) * 1024 + h * 256 + ch * 8) = wv; }
    }
}
__device__ __forceinline__ void ln_router(Frame& F, const bf16* tin, const float* gain, const float* bias, bf16* xb) {
    LAS unsigned char* lds = F.lds + RING_OFF; const int lane = F.lane, w = F.wave;
    unsigned char* ws = F.ws; const float* wr = inptr(F, 22);
    int* toke = (int*)(ws + WS_TOKE); float* tokw = (float*)(ws + WS_TOKW); int* tokp = (int*)(ws + WS_TOKP); int* cntl = (int*)(ws + WS_CNTL);
    const int RPW = M / F.G, RPV = RPW / NWAVES;
    LAS int* EL = (LAS int*)lds;
    f32x4 gv[4], bv[4];
#pragma unroll
    for (int j = 0; j < 4; ++j) { gv[j] = *((const GAS f32x4*)gain + lane + 64 * j); bv[j] = *((const GAS f32x4*)bias + lane + 64 * j); }
    LAS float* WL = (LAS float*)(lds + 1024);
    __syncthreads();
    for (int c = F.tid; c < D; c += NWAVES * 64) { const f32x4 w0 = *(const GAS f32x4*)(wr + (size_t)c * 8), w1 = *(const GAS f32x4*)(wr + (size_t)c * 8 + 4);
        const int rec = (4 * (c >> 8) + (c & 3)) * 64 + ((c & 255) >> 2); *(LAS f32x4*)(WL + rec * 8) = w0; *(LAS f32x4*)(WL + rec * 8 + 4) = w1; }
    v2u raw[8][4];
#pragma unroll
    for (int rr = 0; rr < 8; ++rr) if (rr < RPV) { const GAS v2u* xr = (const GAS v2u*)(tin + (size_t)(F.wg * RPW + w * RPV + rr) * D) + lane;
#pragma unroll
        for (int j = 0; j < 4; ++j) raw[rr][j] = xr[64 * j]; }
    __syncthreads();
#pragma unroll
    for (int rr = 0; rr < 8; ++rr) { if (rr >= RPV) break;
        const int lr = w * RPV + rr, m = F.wg * RPW + lr;
        f32x4 v[4]; float s = 0.f;
#pragma unroll
        for (int j = 0; j < 4; ++j) { v[j] = bf4(raw[rr][j]); s += (v[j].x + v[j].y) + (v[j].z + v[j].w); }
        const float mean = wave_sum(s) * (1.f / D); float s2 = 0.f;
#pragma unroll
        for (int j = 0; j < 4; ++j) { v[j] = v[j] - mean; s2 += (v[j].x * v[j].x + v[j].y * v[j].y) + (v[j].z * v[j].z + v[j].w * v[j].w); }
        const float rstd = 1.f / sqrtf(wave_sum(s2) * (1.f / D) + LN_EPS);
        GAS unsigned long long* o8 = (GAS unsigned long long*)(xb + (size_t)m * D) + lane;
        float lg[8];
#pragma unroll
        for (int e = 0; e < 8; ++e) lg[e] = 0.f;
#pragma unroll
        for (int j = 0; j < 4; ++j) { const f32x4 y = v[j] * rstd * gv[j] + bv[j]; o8[64 * j] = (unsigned long long)pk2(y.x, y.y) | ((unsigned long long)pk2(y.z, y.w) << 32);
#pragma unroll
            for (int k = 0; k < 4; ++k) { const LAS float* rp = WL + ((4 * j + k) * 64 + lane) * 8; const f32x4 w0 = *(const LAS f32x4*)rp, w1 = *(const LAS f32x4*)(rp + 4);
                lg[0] += y[k] * w0[0]; lg[1] += y[k] * w0[1]; lg[2] += y[k] * w0[2]; lg[3] += y[k] * w0[3]; lg[4] += y[k] * w1[0]; lg[5] += y[k] * w1[1]; lg[6] += y[k] * w1[2]; lg[7] += y[k] * w1[3]; } }
#pragma unroll
        for (int e = 0; e < 8; ++e) lg[e] = wave_sum(lg[e]);
        int e1 = 0; float v1 = lg[0];
#pragma unroll
        for (int e = 1; e < 8; ++e) if (lg[e] > v1) { v1 = lg[e]; e1 = e; }
        int e2 = -1; float v2 = -3.4e38f;
#pragma unroll
        for (int e = 0; e < 8; ++e) if (e != e1 && lg[e] > v2) { v2 = lg[e]; e2 = e; }
        const float w2 = 1.f / (1.f + __expf(v1 - v2)), w1 = 1.f - w2;
        if (lane == 0) { toke[m * 2] = e1; toke[m * 2 + 1] = e2; tokw[m * 2] = w1; tokw[m * 2 + 1] = w2; EL[lr] = e1; EL[RPW + lr] = e2; }
    }
    __syncthreads();
    if (w == 0) {
        const bool act = lane < RPW; int base[8];
#pragma unroll
        for (int e = 0; e < 8; ++e) base[e] = 0;
        const unsigned long long ltm = (1ull << lane) - 1ull;
#pragma unroll
        for (int k = 0; k < 2; ++k) { const int ek = act ? EL[k * RPW + lane] : -1; int pos = 0;
#pragma unroll
            for (int e = 0; e < 8; ++e) { const unsigned long long mk = __ballot(ek == e); if (ek == e) pos = base[e] + __popcll(mk & ltm); base[e] += __popcll(mk); }
            if (act) tokp[(F.wg * RPW + lane) * 2 + k] = pos; }
        if (lane < 8) { int cv = 0;
#pragma unroll
            for (int e = 0; e < 8; ++e) if (lane == e) cv = base[e];
            cntl[F.wg * 8 + lane] = cv; }
    }
}
__device__ __forceinline__ void moe_tables(Frame& F) {
    LAS int* TP = (LAS int*)(F.lds + LDSCTL_OFF); LAS int* BASE = TP + 16; LAS int* ACC = TP + 32;
    const int* cntl = (const int*)(F.ws + WS_CNTL);
    __syncthreads();
    if (F.tid < 16) ACC[F.tid] = 0;
    __syncthreads();
    int tot = 0, pre = 0; const int e = F.tid & 7;
    for (int wq = F.tid >> 3; wq < F.G; wq += 64) { const int cv = __hip_atomic_load(cntl + wq * 8 + e, __ATOMIC_RELAXED, __HIP_MEMORY_SCOPE_AGENT); tot += cv; if (wq < F.wg) pre += cv; }
    __hip_atomic_fetch_add(ACC + e, tot, __ATOMIC_RELAXED, __HIP_MEMORY_SCOPE_WORKGROUP); __hip_atomic_fetch_add(ACC + 8 + e, pre, __ATOMIC_RELAXED, __HIP_MEMORY_SCOPE_WORKGROUP);
    __syncthreads();
    if (F.tid == 0) { int tp = 0;
        for (int k = 0; k < 8; ++k) { TP[k] = tp; BASE[k] = tp * 256 + ACC[8 + k]; tp += (ACC[k] + 255) >> 8; }
        TP[8] = tp; }
    __syncthreads();
}
__device__ __forceinline__ void moe_gather(Frame& F) {
    moe_tables(F);
    LAS int* BASE = (LAS int*)(F.lds + LDSCTL_OFF) + 16;
    unsigned char* ws = F.ws; const int* toke = (const int*)(ws + WS_TOKE); const int* tokp = (const int*)(ws + WS_TOKP); int* toks = (int*)(ws + WS_TOKS);
    const bf16* xb = (const bf16*)(ws + WS_XB); bf16* xg = (bf16*)(ws + WS_XG);
    const int RPW = M / F.G;
    for (int q0 = F.wave; q0 < 2 * RPW; q0 += 4 * NWAVES) {
        int mm[4], sl[4]; v4u ra[4], rb[4];
#pragma unroll
        for (int u = 0; u < 4; ++u) { const int q = q0 + u * NWAVES; const bool ok = q < 2 * RPW; const int m = F.wg * RPW + (q >> 1), k = q & 1; mm[u] = ok ? m * 2 + k : -1;
            const int e = ok ? toke[m * 2 + k] : 0; sl[u] = BASE[e] + (ok ? tokp[m * 2 + k] : 0); }
#pragma unroll
        for (int u = 0; u < 4; ++u) if (mm[u] >= 0) { const GAS v4u* src = (const GAS v4u*)(xb + (size_t)(mm[u] >> 1) * D) + F.lane; ra[u] = src[0]; rb[u] = src[64]; }
#pragma unroll
        for (int u = 0; u < 4; ++u) if (mm[u] >= 0) { if (F.lane == 0) toks[mm[u]] = sl[u]; GAS v4u* dst = (GAS v4u*)(xg + (size_t)sl[u] * D) + F.lane; dst[0] = ra[u]; dst[64] = rb[u]; }
    }
}
__device__ __forceinline__ void moe_final(Frame& F) {
    const int gw = F.vcu * NWAVES + F.wave, NGW = F.G * NWAVES, lane = F.lane;
    unsigned char* ws = F.ws; const bf16* xres = (const bf16*)(ws + WS_XB); const bf16* yb = (const bf16*)(ws + WS_YB); constexpr size_t KSTR = (WS_YB1 - WS_YB) / 2;
    const int* toks = (const int*)(ws + WS_TOKS); const float* tokw = (const float*)(ws + WS_TOKW); const float* gain = inptr(F, 25); const float* bias = inptr(F, 26);
    f32x4 gv[4], bv[4];
#pragma unroll
    for (int j = 0; j < 4; ++j) { gv[j] = *((const GAS f32x4*)gain + lane + 64 * j); bv[j] = *((const GAS f32x4*)bias + lane + 64 * j); }
    for (int m0 = gw; m0 < M; m0 += 4 * NGW) {
        int s1[4], s2[4]; float w1[4], w2[4];
#pragma unroll
        for (int k = 0; k < 4; ++k) { const int m = m0 + k * NGW; const bool ok = m < M; s1[k] = ok ? toks[m * 2] : 0; s2[k] = ok ? toks[m * 2 + 1] : 0; w1[k] = ok ? tokw[m * 2] : 0.f; w2[k] = ok ? tokw[m * 2 + 1] : 0.f; }
        v2u xr_[4][4], ya_[4][4], yc_[4][4];
#pragma unroll
        for (int k = 0; k < 4; ++k) { const int m = m0 + k * NGW; if (m < M) {
            const GAS v2u* xr = (const GAS v2u*)(xres + (size_t)m * D) + lane;
            const GAS v2u* y1 = (const GAS v2u*)(s1[k] < 32768 ? yb + (size_t)s1[k] * D : yb + KSTR + (size_t)(s1[k] - 32768) * D) + lane;
            const GAS v2u* y2 = (const GAS v2u*)(s2[k] < 32768 ? yb + (size_t)s2[k] * D : yb + KSTR + (size_t)(s2[k] - 32768) * D) + lane;
#pragma unroll
            for (int j = 0; j < 4; ++j) { xr_[k][j] = xr[64 * j]; ya_[k][j] = y1[64 * j]; yc_[k][j] = y2[64 * j]; } } }
#pragma unroll
        for (int k = 0; k < 4; ++k) { const int m = m0 + k * NGW; if (m >= M) break;
            f32x4 v[4], ya[4], yc[4];
#pragma unroll
            for (int j = 0; j < 4; ++j) { ya[j] = bf4(ya_[k][j]); yc[j] = bf4(yc_[k][j]); }
            if (s1[k] >= 32768) { for (int ks = 1; ks < 7; ++ks) { const GAS v2u* y1 = (const GAS v2u*)(yb + KSTR + ((size_t)ks * 2048 + (s1[k] - 32768)) * D) + lane;
#pragma unroll
                for (int j = 0; j < 4; ++j) ya[j] += bf4(y1[64 * j]); } }
            if (s2[k] >= 32768) { for (int ks = 1; ks < 7; ++ks) { const GAS v2u* y2 = (const GAS v2u*)(yb + KSTR + ((size_t)ks * 2048 + (s2[k] - 32768)) * D) + lane;
#pragma unroll
                for (int j = 0; j < 4; ++j) yc[j] += bf4(y2[64 * j]); } }
            float s = 0.f;
#pragma unroll
            for (int j = 0; j < 4; ++j) { const f32x4 x = bf4(xr_[k][j]); v[j] = x * ALPHA + (ya[j] * w1[k] + yc[j] * w2[k]); s += (v[j].x + v[j].y) + (v[j].z + v[j].w); }
            const float mean = wave_sum(s) * (1.f / D); float q2 = 0.f;
#pragma unroll
            for (int j = 0; j < 4; ++j) { v[j] = v[j] - mean; q2 += (v[j].x * v[j].x + v[j].y * v[j].y) + (v[j].z * v[j].z + v[j].w * v[j].w); }
            const float rstd = 1.f / sqrtf(wave_sum(q2) * (1.f / D) + LN_EPS);
            GAS f32x4* xo = (GAS f32x4*)(F.out + (size_t)m * D) + lane;
#pragma unroll
            for (int j = 0; j < 4; ++j) xo[64 * j] = v[j] * rstd * gv[j] + bv[j];
        }
    }
}
__global__ void __launch_bounds__(NWAVES * 64, 2) fwd(Args args) {
    extern __shared__ __attribute__((aligned(16))) unsigned char lds[];
    Frame F;
    F.A = &args;
    F.lds = (LAS unsigned char*)lds;
    F.MISC = (volatile LAS unsigned*)(F.lds + MISC_OFF);
    F.tid = threadIdx.x; F.lane = F.tid & 63; F.wave = __builtin_amdgcn_readfirstlane(F.tid >> 6);
    F.G = gridDim.x; F.wg = blockIdx.x; { const int bx = blockIdx.x; F.vcu = (F.G % 8 == 0) ? (bx % 8) * (F.G / 8) + bx / 8 : bx; }
    F.ws = args.ws; F.out = args.out;
    unsigned char* ws = args.ws;
    F.ctl = (gu32*)(ws + WS_CTL);
    for (int u = F.tid; u < (LDS_BYTES - LDSCTL_OFF) / 4; u += NWAVES * 64) ((LAS unsigned*)(F.lds + LDSCTL_OFF))[u] = 0u;
    __syncthreads();
    XcdBarrier bar; bar.bar = (unsigned*)(F.ctl + CW_BAR); bar.x = 0; bar.st = nullptr;
    if (!MK_PER_PHASE) bar = xcd_barrier_post((unsigned*)(F.ctl + CW_BAR), F.MISC + 8);
#define GRID_BAR() do { if (!MK_PER_PHASE) xcd_barrier(bar); } while (0)
    const int lo = args.ph_lo, hi = args.ph_hi;
#define IN(k) (lo <= (k) && (k) < hi)
#define SEAM(k) do { if (IN((k) + 1)) GRID_BAR(); } while (0)
    bf16* XB = (bf16*)(ws + WS_XB); bf16* T0 = (bf16*)(ws + WS_T0);
    const int cwg = (int)blockIdx.x;

#ifndef HANDOFF
#define HANDOFF 0
#endif
#ifndef PROBE_REP
#define PROBE_REP -1
#endif
#define REP(k) (PROBE_REP == (k) ? 2 : 1)
    if (IN(0)) { for (int rep = 0; rep < REP(0); ++rep) { if (rep) GRID_BAR(); p0_prologue(F); } SEAM(0); }
    if (IN(1)) { pg8::Gemm g{XB, (const bf16*)(ws + WS_WIN0), M, NSA_IN_PAD, D, D}; pg8::StaticOrder S; S.init(M, NSA_IN_PAD, F.G, cwg);
        pg8::EpiNsaIn E{(bf16*)(ws + WS_Q), (bf16*)(ws + WS_KV2), (bf16*)(ws + WS_KS), (bf16*)(ws + WS_VS), (bf16*)(ws + WS_KW), (bf16*)(ws + WS_VW), (float*)(ws + WS_GT), 0.125f * LOG2E};
        pg8::gemm_phase<pg8::EpiNsaIn, pg8::StaticOrder, PG8_ALIGN, PG8_SP2>(F.lds + RING_OFF, g, S, E); SEAM(1); }
    if (IN(2)) { pg8::Gemm g{(const bf16*)(ws + WS_KV2), (const bf16*)(ws + WS_W1C), 8192, 1024, 1024, 1024}; pg8::CmpOrder S{F.G, cwg}; pg8::EpiF32Cmp E{(float*)(ws + WS_UL)};
        pg8::gemm_phase<pg8::EpiF32Cmp, pg8::CmpOrder, PG8_ALIGN, PG8_SP2>(F.lds + RING_OFF, g, S, E);
        SEAM(2); }
    if (IN(3)) { cmp_finish(F); SEAM(3); }
    if (IN(4)) { for (int rep = 0; rep < REP(4); ++rep) { if (rep) GRID_BAR(); nsa_attn_phase(F); } SEAM(4); }
    if (IN(5)) { pg8::Gemm g{(const bf16*)(ws + WS_O), (const bf16*)(ws + WS_WO0), M, D, D, D}; pg8::StaticOrder S; S.init(M, D, F.G, cwg); pg8::EpiResBf16<true> E{XB, T0, ALPHA};
        pg8::gemm_phase<pg8::EpiResBf16<true>, pg8::StaticOrder, PG8_ALIGN, PG8_SP2>(F.lds + RING_OFF, g, S, E); SEAM(5); }
    if (IN(6)) { ln_rows(F, T0, inptr(F, 9), inptr(F, 10), XB); SEAM(6); }
#if HANDOFF
    if (IN(7)) { pg8::Gemm g{XB, (const bf16*)(ws + WS_WGU0), M, 2 * FF0, D, D}; pg8::PubOrder<pg8::StaticOrder> S; S.init(M, 2 * FF0, F.G, cwg); S.cnt = (unsigned*)(F.ctl + CW_PANEL0); S.pend = -1; pg8::EpiSwiGLU<true> E{(bf16*)(ws + WS_H0), FF0, 2 * FF0 / 256};
        pg8::gemm_phase<pg8::EpiSwiGLU<true>, pg8::PubOrder<pg8::StaticOrder>, PG8_ALIGN, PG8_SP2>(F.lds + RING_OFF, g, S, E); S.publish(); }
    if (IN(8)) { pg8::Gemm g{(const bf16*)(ws + WS_H0), (const bf16*)(ws + WS_WD0), M, D, FF0, FF0}; pg8::WaitOrder<pg8::StaticOrder> S; S.init(M, D, F.G, (cwg + F.G - (M / 256 * (2 * FF0 / 256)) % F.G) % F.G); S.ready = (const unsigned*)(F.ctl + CW_PANEL0); S.need = 8u * (2 * FF0 / 256); S.tmo = (unsigned*)(F.ctl + CW_TMO);
        pg8::EpiResBf16<true> E{XB, T0, ALPHA};
        pg8::gemm_phase<pg8::EpiResBf16<true>, pg8::WaitOrder<pg8::StaticOrder>, PG8_ALIGN, PG8_SP2>(F.lds + RING_OFF, g, S, E); SEAM(8); }
#else
    if (IN(7)) { for (int rep = 0; rep < REP(7); ++rep) { if (rep) GRID_BAR(); pg8::Gemm g{XB, (const bf16*)(ws + WS_WGU0), M, 2 * FF0, D, D}; pg8::StaticOrder S; S.init(M, 2 * FF0, F.G, cwg); pg8::EpiSwiGLU<false> E{(bf16*)(ws + WS_H0), FF0, 2 * FF0 / 256};
        pg8::gemm_phase<pg8::EpiSwiGLU<false>, pg8::StaticOrder, PG8_ALIGN, PG8_SP2>(F.lds + RING_OFF, g, S, E);
#if defined(PROBE_NULL) && PROBE_NULL == 7
        GRID_BAR(); { pg8::EpiNull EN{(float*)(ws + WS_CTL + 65536)}; pg8::gemm_phase<pg8::EpiNull, pg8::StaticOrder, PG8_ALIGN, PG8_SP2>(F.lds + RING_OFF, g, S, EN); }
#endif
        } SEAM(7); }
    if (IN(8)) { for (int rep = 0; rep < REP(8); ++rep) { if (rep) GRID_BAR(); pg8::Gemm g{(const bf16*)(ws + WS_H0), (const bf16*)(ws + WS_WD0), M, D, FF0, FF0}; pg8::StaticOrder S; S.init(M, D, F.G, cwg); pg8::EpiResBf16<true> E{XB, T0, ALPHA};
        pg8::gemm_phase<pg8::EpiResBf16<true>, pg8::StaticOrder, PG8_ALIGN, PG8_SP2>(F.lds + RING_OFF, g, S, E); } SEAM(8); }
#endif
    if (IN(9)) { ln_rows(F, T0, inptr(F, 13), inptr(F, 14), XB); SEAM(9); }
    if (IN(10)) { pg8::Gemm g{XB, (const bf16*)(ws + WS_WIN1), M, 3072, D, D}; pg8::StaticOrder S; S.init(M, 3072, F.G, cwg);     pg8::EpiGlaIn E{(bf16*)(ws + WS_QKVG), (float*)(ws + WS_ALOW), 0.08838834764831845f};
        pg8::gemm_phase<pg8::EpiGlaIn, pg8::StaticOrder, PG8_ALIGN, PG8_SP2>(F.lds + RING_OFF, g, S, E); SEAM(10); }
    for (int rep = 0; rep < REP(11); ++rep) { if (rep) GRID_BAR();
    if (IN(11)) { gla_g1(F); SEAM(11); }
    if (IN(12)) { gla_g2(F); SEAM(12); }
    if (IN(13)) { gla_g3(F); if (rep + 1 == REP(11)) SEAM(13); }
    }
    if (IN(14)) { pg8::Gemm g{(const bf16*)(ws + WS_O1), (const bf16*)(ws + WS_WO1), M, D, D, D}; pg8::StaticOrder S; S.init(M, D, F.G, cwg); pg8::EpiResBf16<true> E{XB, T0, ALPHA};
        pg8::gemm_phase<pg8::EpiResBf16<true>, pg8::StaticOrder, PG8_ALIGN, PG8_SP2>(F.lds + RING_OFF, g, S, E); SEAM(14); }
    if (IN(15)) { ln_router(F, T0, inptr(F, 20), inptr(F, 21), XB); SEAM(15); }
    if (IN(16)) { moe_gather(F); SEAM(16); }
#if 0
    if (IN(17)) { moe_tables(F); pg8::Gemm g{(const bf16*)(ws + WS_XG), (const bf16*)(ws + WS_WGU1), MAXSLOTS, NE * 2 * FFE, D, D};
        pg8::PubOrder<pg8::GroupedOrder> S; S.G = F.G; S.c = cwg; S.NT = 2 * FFE / 256; S.KS = 1; S.KL = 0; S.tp = (const PG8_LAS int*)(F.lds + LDSCTL_OFF); S.cnt = (unsigned*)(F.ctl + CW_PANEL1); S.pend = -1;
        pg8::EpiSwiGLU<true> E{(bf16*)(ws + WS_H2), FFE, 2 * FFE / 256};
        pg8::gemm_phase<pg8::EpiSwiGLU<true>, pg8::PubOrder<pg8::GroupedOrder>, PG8_ALIGN, PG8_SP2>(F.lds + RING_OFF, g, S, E); S.publish(); }
    if (IN(18)) { moe_tables(F); pg8::Gemm g{(const bf16*)(ws + WS_H2), (const bf16*)(ws + WS_WD1), MAXSLOTS, NE * D, FFE / MOE_KS, FFE};
        pg8::WaitOrder<pg8::GroupedOrder> S; S.G = F.G; S.NT = D / 256; S.KS = MOE_KS; S.KL = FFE / MOE_KS; S.tp = (const PG8_LAS int*)(F.lds + LDSCTL_OFF);
        { const int n17 = S.tp[8] * (2 * FFE / 256); S.c = (cwg + F.G - ((n17 % F.G) & ~7)) % F.G; }
        S.ready = (const unsigned*)(F.ctl + CW_PANEL1); S.need = 8u * (2 * FFE / 256); S.tmo = (unsigned*)(F.ctl + CW_TMO); pg8::EpiBf16Y E{(bf16*)(ws + WS_YB), (size_t)(WS_YB1 - WS_YB) / 2};
        pg8::gemm_phase<pg8::EpiBf16Y, pg8::WaitOrder<pg8::GroupedOrder>, PG8_ALIGN, PG8_SP2>(F.lds + RING_OFF, g, S, E); SEAM(18); }
#else
#ifndef STAGGER_US
#define STAGGER_US 0
#endif
    if (IN(17)) { for (int rep = 0; rep < REP(17); ++rep) { if (rep) GRID_BAR(); moe_tables(F);
        if (STAGGER_US) { const unsigned long long t0 = __builtin_amdgcn_s_memrealtime(), dl = (unsigned long long)((cwg >> 3) & 3) * (STAGGER_US * 100ull); while (__builtin_amdgcn_s_memrealtime() - t0 < dl) __builtin_amdgcn_s_sleep(8); }
        pg8::Gemm g{(const bf16*)(ws + WS_XG), (const bf16*)(ws + WS_WGU1), MAXSLOTS, NE * 2 * FFE, D, D};
        pg8::GroupedOrder S{F.G, cwg, 2 * FFE / 256, 1, 0, (const PG8_LAS int*)(F.lds + LDSCTL_OFF)}; pg8::EpiSwiGLU<false> E{(bf16*)(ws + WS_H2), FFE, 2 * FFE / 256};
        pg8::gemm_phase<pg8::EpiSwiGLU<false>, pg8::GroupedOrder, PG8_ALIGN, PG8_SP2>(F.lds + RING_OFF, g, S, E);
#if defined(PROBE_NULL) && PROBE_NULL == 177
        GRID_BAR(); { pg8::Gemm g7{XB, (const bf16*)(ws + WS_WGU0), M, 2 * FF0, D, D}; pg8::StaticOrder S7; S7.init(M, 2 * FF0, F.G, cwg); pg8::EpiNull EN{(float*)(ws + WS_CTL + 65536)};
          pg8::gemm_phase<pg8::EpiNull, pg8::StaticOrder, PG8_ALIGN, PG8_SP2>(F.lds + RING_OFF, g7, S7, EN); }
#endif
#if defined(PROBE_NULL) && PROBE_NULL == 178
        GRID_BAR(); { pg8::Gemm g7{XB, (const bf16*)(ws + WS_WGU1), M, 2 * FFE, D, D}; pg8::StaticOrder S7; S7.init(M, 2 * FFE, F.G, cwg); pg8::EpiNull EN{(float*)(ws + WS_CTL + 65536)};
          pg8::gemm_phase<pg8::EpiNull, pg8::StaticOrder, PG8_ALIGN, PG8_SP2>(F.lds + RING_OFF, g7, S7, EN); GRID_BAR(); g7.Bt += (size_t)2 * FFE * D;
          pg8::gemm_phase<pg8::EpiNull, pg8::StaticOrder, PG8_ALIGN, PG8_SP2>(F.lds + RING_OFF, g7, S7, EN); }
#endif
#if defined(PROBE_NULL) && PROBE_NULL == 17
        GRID_BAR(); { pg8::EpiNull EN{(float*)(ws + WS_CTL + 65536)};
#if defined(PROBE_SAMEB)
          S.KL = -1;
#endif
          pg8::gemm_phase<pg8::EpiNull, pg8::GroupedOrder, PG8_ALIGN, PG8_SP2>(F.lds + RING_OFF, g, S, EN); }
#endif
        } SEAM(17); }
    if (IN(18)) { for (int rep = 0; rep < REP(18); ++rep) { if (rep) GRID_BAR(); moe_tables(F);
        { pg8::Gemm g{(const bf16*)(ws + WS_H2), (const bf16*)(ws + WS_WD1), MAXSLOTS, NE * D, FFE, FFE}; pg8::MoeDownOrder S{F.G, cwg, 0, (const PG8_LAS int*)(F.lds + LDSCTL_OFF)};
          pg8::EpiBf16Y2 E{(bf16*)(ws + WS_YB), (bf16*)(ws + WS_YB1), 0}; pg8::gemm_phase<pg8::EpiBf16Y2, pg8::MoeDownOrder, PG8_ALIGN, PG8_SP2>(F.lds + RING_OFF, g, S, E); }
        { pg8::Gemm g{(const bf16*)(ws + WS_H2), (const bf16*)(ws + WS_WD1), MAXSLOTS, NE * D, 512, FFE}; pg8::MoeDownOrder S{F.G, cwg, 1, (const PG8_LAS int*)(F.lds + LDSCTL_OFF)};
          pg8::EpiBf16Y2 E{(bf16*)(ws + WS_YB), (bf16*)(ws + WS_YB1), 1}; pg8::gemm_phase<pg8::EpiBf16Y2, pg8::MoeDownOrder, PG8_ALIGN, PG8_SP2>(F.lds + RING_OFF, g, S, E); } } SEAM(18); }
#endif
    if (IN(19)) { moe_final(F); }
#undef IN
#undef SEAM
#undef GRID_BAR
}

extern "C" void kernel_launch(void* const* d_in, const int* in_sizes, int n_in, void* d_out, int out_size, void* d_ws, size_t ws_size, hipStream_t stream) {
    static int grid = 0;
    if (grid == 0) {
        if (n_in != 27 || in_sizes[0] != M * D || out_size != M * D || ws_size < WS_END) { fprintf(stderr, "kernel_launch: unexpected problem shape (n_in %d, in0 %d, out %d, ws %zu); nothing launched\n", n_in, n_in > 0 ? in_sizes[0] : -1, out_size, ws_size); grid = -1; return; }
        if (hipFuncSetAttribute((const void*)fwd, hipFuncAttributeMaxDynamicSharedMemorySize, LDS_BYTES) != hipSuccess) { fprintf(stderr, "kernel_launch: hipFuncSetAttribute failed\n"); grid = -1; return; }
        int dev = 0, cus = 0, per_cu = 0;
        (void)hipGetDevice(&dev); (void)hipDeviceGetAttribute(&cus, hipDeviceAttributeMultiprocessorCount, dev);
        if (hipOccupancyMaxActiveBlocksPerMultiprocessor(&per_cu, (const void*)fwd, NWAVES * 64, LDS_BYTES) != hipSuccess || per_cu < 1) fprintf(stderr, "kernel_launch: note: occupancy query reports %d workgroups per CU\n", per_cu);
        (void)hipGetLastError();
        grid = 256;
        if (cus < 256) fprintf(stderr, "kernel_launch: device has %d CUs; this kernel needs 256 resident workgroups\n", cus);
    }
    if (grid < 0) return;
    if (hipMemsetAsync((char*)d_ws + WS_CTL, 0, CTL_ZERO_BYTES, stream) != hipSuccess) { fprintf(stderr, "kernel_launch: hipMemsetAsync failed\n"); return; }
    Args a{};
    for (int i = 0; i < 27; ++i) a.in[i] = (const float*)d_in[i];
    a.out = (float*)d_out; a.ws = (unsigned char*)d_ws;
#if MK_PER_PHASE
    for (int p = 0; p < N_PHASES; ++p) { a.ph_lo = p; a.ph_hi = p + 1; hipLaunchKernelGGL(fwd, dim3(grid), dim3(NWAVES * 64), LDS_BYTES, stream, a); }
#else
    a.ph_lo = 0; a.ph_hi = N_PHASES;
    hipLaunchKernelGGL(fwd, dim3(grid), dim3(NWAVES * 64), LDS_BYTES, stream, a);
#endif
    const hipError_t le = hipPeekAtLastError();
    if (le != hipSuccess) fprintf(stderr, "kernel_launch: launch failed: %s\n", hipGetErrorName(le));
}
```

```cpp
#include <hip/hip_runtime.h>
#include <cstdio>
#include <cstdint>
namespace pg8 {
#define PG8_LAS __attribute__((address_space(3)))
typedef unsigned short bf16_t;
typedef short bf16x8 __attribute__((ext_vector_type(8)));
typedef float f32x4 __attribute__((ext_vector_type(4)));
typedef unsigned u32x4 __attribute__((ext_vector_type(4)));
constexpr int BM = 256, BK = 64, HALF = 128, HTB = HALF * BK * 2  , STAGE_BYTES = 8 * HTB, NXCD = 8, WGM = 8;

__host__ __device__ __forceinline__ int lds_byte(int r, int c) { const int st = (r >> 4) * 2 + (c >> 5), rr = r & 15, cc = c & 31, ob = rr * 64 + cc * 2; return st * 1024 + (ob ^ (((ob >> 9) & 1) << 5)); }
__host__ __device__ __forceinline__ void stage_rc(int b, int& R, int& C) { const int st = b / 1024, sb = b % 1024, swz = sb ^ (((sb >> 9) & 1) << 5); R = (st >> 1) * 16 + swz / 64; C = (st & 1) * 32 + (swz % 64) / 2; }
__host__ __device__ __forceinline__ int perm32(int rho) { const int n = rho >> 4, i = rho & 15; return 8 * (i >> 2) + 4 * n + (i & 3); }

struct Unit { int pm, pn, ko; };
struct Gemm { const bf16_t* A; const bf16_t* Bt; int M, N, K, ld; };

struct StaticOrder {
    int nM, nN, nwg, G, c;
    __host__ __device__ void init(int M, int N, int G_, int c_) { nM = M / BM; nN = N / BM; nwg = nM * nN; G = G_; c = c_; }
    __host__ __device__ bool next(int i, Unit& u) const {
        const long L = (long)i * G + c; if (L >= nwg) return false;
        int wgid = (int)L; { const int q = nwg / NXCD, r = nwg % NXCD, xcd = wgid % NXCD, off = wgid / NXCD; wgid = (xcd < r ? xcd * (q + 1) : r * (q + 1) + (xcd - r) * q) + off; }
        const int nig = WGM * nN, gid = wgid / nig, fm = gid * WGM, gsz = (nM - fm) < WGM ? (nM - fm) : WGM;
        u.pm = fm + ((wgid % nig) % gsz); u.pn = (wgid % nig) / gsz; u.ko = 0; return true;
    }
    __device__ __forceinline__ void a_ready(const Unit&) const {}
    __device__ __forceinline__ void done(const Unit&) const {}
};
__device__ __forceinline__ unsigned cvt_pk_bf16(float lo, float hi) { unsigned r; asm volatile("v_cvt_pk_bf16_f32 %0, %1, %2" : "=v"(r) : "v"(lo), "v"(hi)); return r; }
typedef float f32x2 __attribute__((ext_vector_type(2)));
typedef __bf16 bf16x2_t_ __attribute__((ext_vector_type(2)));
__device__ __forceinline__ unsigned cvtpk_c(float lo, float hi) { f32x2 v = {lo, hi}; bf16x2_t_ b = __builtin_convertvector(v, bf16x2_t_); return __builtin_bit_cast(unsigned, b); }
__device__ __forceinline__ u32x4 pack8(const f32x4 v0, const f32x4 v1) { u32x4 w; w.x = cvt_pk_bf16(v0[0], v0[1]); w.y = cvt_pk_bf16(v0[2], v0[3]); w.z = cvt_pk_bf16(v1[0], v1[1]); w.w = cvt_pk_bf16(v1[2], v1[3]); return w; }
__device__ __forceinline__ float sigm(float x) { return __builtin_amdgcn_rcpf(1.0f + __builtin_amdgcn_exp2f(-1.44269504088896341f * x)); }
__device__ __forceinline__ float silu1(float x) { return x * __builtin_amdgcn_rcpf(1.0f + __builtin_amdgcn_exp2f(-1.44269504088896341f * x)); }

struct EpiNsaIn {
    static constexpr bool PERM = true, AFTER_DRAIN = false;
    bf16_t *Q, *KV2, *KS, *VS, *KW, *VW; float* GT; float qscale;
    __device__ __forceinline__ void operator()(const f32x4 (&acc)[2][2][4][2], const Unit& u, int wr, int wc, int fr, int fq) const {
        const int pn = u.pn, row0 = u.pm * BM + wr * 64 + fr, c8 = wc * 32 + 8 * fq;
#pragma unroll
        for (int ai = 0; ai < 2; ++ai)
#pragma unroll
            for (int m = 0; m < 4; ++m) { const int row = row0 + ai * HALF + m * 16;
#pragma unroll
                for (int bj = 0; bj < 2; ++bj) { const int col = bj * HALF + c8;
                    f32x4 v0 = acc[ai][bj][m][0], v1 = acc[ai][bj][m][1];
                    if (pn >= 10) { if (col < 48) { float* gp = GT + (size_t)row * 48 + col;
                            *(f32x4*)gp = (f32x4){sigm(v0[0]), sigm(v0[1]), sigm(v0[2]), sigm(v0[3])}; *(f32x4*)(gp + 4) = (f32x4){sigm(v1[0]), sigm(v1[1]), sigm(v1[2]), sigm(v1[3])}; }
                        continue; }
                    bf16_t* dst;
                    if (pn < 4) { v0 = v0 * qscale; v1 = v1 * qscale; dst = Q + (size_t)row * 1024 + pn * 256 + col; }
                    else if (pn < 6) { const int g = col >> 6, d = col & 63; dst = KV2 + (size_t)(pn - 4) * (4096 * 1024) + ((size_t)(((row >> 4) * 4 + g) * 16 + (row & 15))) * 64 + d; }
                    else { bf16_t* base = pn == 6 ? KS : pn == 7 ? VS : pn == 8 ? KW : VW; dst = base + (size_t)row * 256 + col; }
                    *(u32x4*)dst = pack8(v0, v1); } }
    }
};
struct EpiGlaIn {
    static constexpr bool PERM = true, AFTER_DRAIN = false;
    bf16_t* QKVG; float* ALOW; float qscale;
    __device__ __forceinline__ void operator()(const f32x4 (&acc)[2][2][4][2], const Unit& u, int wr, int wc, int fr, int fq) const {
        const int pn = u.pn, row0 = u.pm * BM + wr * 64 + fr, c8 = wc * 32 + 8 * fq;
#pragma unroll
        for (int ai = 0; ai < 2; ++ai)
#pragma unroll
            for (int m = 0; m < 4; ++m) { const int row = row0 + ai * HALF + m * 16;
#pragma unroll
                for (int bj = 0; bj < 2; ++bj) { const int col = bj * HALF + c8;
                    f32x4 v0 = acc[ai][bj][m][0], v1 = acc[ai][bj][m][1];
                    if (pn >= 12) { if (col < 16) { float* gp = ALOW + (size_t)row * 16 + col; *(f32x4*)gp = v0; *(f32x4*)(gp + 4) = v1; } continue; }
                    if (pn < 2) { v0 = v0 * qscale; v1 = v1 * qscale; }
                    *(u32x4*)(QKVG + (size_t)row * 3072 + pn * 256 + col) = pack8(v0, v1); } }
    }
};
struct EpiF32Cmp {
    static constexpr bool PERM = false, AFTER_DRAIN = false;
    float* C;
    __device__ __forceinline__ void operator()(const f32x4 (&acc)[2][2][4][2], const Unit& u, int wr, int wc, int fr, int fq) const {
        const int row0 = u.pm * BM + wr * 64 + fr, col0 = (u.pn & 1) * BM + wc * 32 + 4 * fq;
#pragma unroll
        for (int ai = 0; ai < 2; ++ai)
#pragma unroll
            for (int m = 0; m < 4; ++m) { float* rowp = C + (size_t)(row0 + ai * HALF + m * 16) * 512 + col0;
#pragma unroll
                for (int bj = 0; bj < 2; ++bj)
#pragma unroll
                    for (int n = 0; n < 2; ++n) *(f32x4*)(rowp + bj * HALF + n * 16) = acc[ai][bj][m][n]; }
    }
};
struct EpiResF32 {
    static constexpr bool PERM = false, AFTER_DRAIN = false;
    const float* base; float* out; float alpha;
    __device__ __forceinline__ void operator()(const f32x4 (&acc)[2][2][4][2], const Unit& u, int wr, int wc, int fr, int fq) const {
        const int row0 = u.pm * BM + wr * 64 + fr, col0 = u.pn * BM + wc * 32 + 4 * fq;
#pragma unroll
        for (int ai = 0; ai < 2; ++ai)
#pragma unroll
            for (int m = 0; m < 4; ++m) { const size_t off = (size_t)(row0 + ai * HALF + m * 16) * 1024 + col0;
#pragma unroll
                for (int bj = 0; bj < 2; ++bj)
#pragma unroll
                    for (int n = 0; n < 2; ++n) { const f32x4 bs = *(const f32x4*)(base + off + bj * HALF + n * 16); *(f32x4*)(out + off + bj * HALF + n * 16) = bs * alpha + acc[ai][bj][m][n]; } }
    }
};
template <bool BF> struct EpiResBf16 {
    static constexpr bool PERM = true, AFTER_DRAIN = false;
    const void* base; bf16_t* out; float alpha;
    __device__ __forceinline__ void operator()(const f32x4 (&acc)[2][2][4][2], const Unit& u, int wr, int wc, int fr, int fq) const {
        const int row0 = u.pm * BM + wr * 64 + fr, col0 = u.pn * BM + wc * 32 + 8 * fq;
#pragma unroll
        for (int ai = 0; ai < 2; ++ai)
#pragma unroll
            for (int m = 0; m < 4; ++m) { const size_t off = (size_t)(row0 + ai * HALF + m * 16) * 1024 + col0;
#pragma unroll
                for (int bj = 0; bj < 2; ++bj) { f32x4 b0, b1;
                    if (BF) { const u32x4 r = *(const u32x4*)((const bf16_t*)base + off + bj * HALF);
                        b0 = (f32x4){__uint_as_float(r.x << 16), __uint_as_float(r.x & 0xffff0000u), __uint_as_float(r.y << 16), __uint_as_float(r.y & 0xffff0000u)};
                        b1 = (f32x4){__uint_as_float(r.z << 16), __uint_as_float(r.z & 0xffff0000u), __uint_as_float(r.w << 16), __uint_as_float(r.w & 0xffff0000u)}; }
                    else { b0 = *(const f32x4*)((const float*)base + off + bj * HALF); b1 = *(const f32x4*)((const float*)base + off + bj * HALF + 4); }
                    *(u32x4*)(out + off + bj * HALF) = pack8(b0 * alpha + acc[ai][bj][m][0], b1 * alpha + acc[ai][bj][m][1]); } }
    }
};
__device__ __forceinline__ void store16_sc1(bf16_t* p, const u32x4 v) { asm volatile("global_store_dwordx4 %0, %1, off sc1\n\ts_nop 1" :: "v"(p), "v"(v) : "memory"); }
template <bool SC1> struct EpiSwiGLU {
    static constexpr bool PERM = true, AFTER_DRAIN = false;
    bf16_t* H; int ldh, nt;
    __device__ __forceinline__ void operator()(const f32x4 (&acc)[2][2][4][2], const Unit& u, int wr, int wc, int fr, int fq) const {
        const int row0 = u.pm * BM + wr * 64 + fr, col = (u.pn % nt) * HALF + wc * 32 + 8 * fq;
#pragma unroll
        for (int ai = 0; ai < 2; ++ai)
#pragma unroll
            for (int m = 0; m < 4; ++m) { const f32x4 a0 = acc[ai][0][m][0], a1 = acc[ai][0][m][1], b0 = acc[ai][1][m][0], b1 = acc[ai][1][m][1];
                const f32x4 h0 = (f32x4){silu1(a0[0]) * b0[0], silu1(a0[1]) * b0[1], silu1(a0[2]) * b0[2], silu1(a0[3]) * b0[3]};
                const f32x4 h1 = (f32x4){silu1(a1[0]) * b1[0], silu1(a1[1]) * b1[1], silu1(a1[2]) * b1[2], silu1(a1[3]) * b1[3]};
                bf16_t* dst = H + (size_t)(row0 + ai * HALF + m * 16) * ldh + col;
                if (SC1) store16_sc1(dst, pack8(h0, h1)); else *(u32x4*)dst = pack8(h0, h1); }
    }
};
struct EpiNull {
    static constexpr bool PERM = true, AFTER_DRAIN = false;
    float* sink;
    __device__ __forceinline__ void operator()(const f32x4 (&acc)[2][2][4][2], const Unit& u, int wr, int wc, int fr, int fq) const {
        f32x4 s = (f32x4){0.f, 0.f, 0.f, 0.f};
#pragma unroll
        for (int ai = 0; ai < 2; ++ai)
#pragma unroll
            for (int bj = 0; bj < 2; ++bj)
#pragma unroll
                for (int m = 0; m < 4; ++m) { s += acc[ai][bj][m][0]; s += acc[ai][bj][m][1]; }
        if (s[0] + s[1] + s[2] + s[3] == 1.2345e30f) sink[0] = 1.f;
    }
};
struct EpiBf16Y {
    static constexpr bool PERM = true, AFTER_DRAIN = false;
    bf16_t* Y; size_t kstride;
    __device__ __forceinline__ void operator()(const f32x4 (&acc)[2][2][4][2], const Unit& u, int wr, int wc, int fr, int fq) const {
        const int row0 = u.pm * BM + wr * 64 + fr, col0 = (u.pn & 3) * BM + wc * 32 + 8 * fq;
#pragma unroll
        for (int ai = 0; ai < 2; ++ai)
#pragma unroll
            for (int m = 0; m < 4; ++m) { bf16_t* rowp = Y + (u.ko ? kstride : (size_t)0) + (size_t)(row0 + ai * HALF + m * 16) * 1024 + col0;
#pragma unroll
                for (int bj = 0; bj < 2; ++bj) *(u32x4*)(rowp + bj * HALF) = pack8(acc[ai][bj][m][0], acc[ai][bj][m][1]); }
    }
};
struct CmpOrder {
    int G, c;
    __device__ __forceinline__ bool next(int i, Unit& u) const { const long L = (long)i * G + c; if (L >= 64) return false; const int pm = (int)L >> 1; u.pm = pm; u.pn = (pm >> 4) * 2 + ((int)L & 1); u.ko = 0; return true; }
    __device__ __forceinline__ void a_ready(const Unit&) const {}
    __device__ __forceinline__ void done(const Unit&) const {}
};
struct GroupedOrder {
    int G, c, NT, KS, KL; const PG8_LAS int* tp;
    __device__ __forceinline__ bool next(int i, Unit& u) const {
        int tpu[9];
#pragma unroll
        for (int k = 0; k < 9; ++k) tpu[k] = __builtin_amdgcn_readfirstlane(tp[k]);
        const int nwg = tpu[8] * NT * KS; const long L = (long)i * G + c; if (L >= nwg) return false;
        int wgid = (int)L; { const int q = nwg / NXCD, r = nwg % NXCD, xcd = wgid % NXCD, off = wgid / NXCD; wgid = (xcd < r ? xcd * (q + 1) : r * (q + 1) + (xcd - r) * q) + off; }
        const int ks = wgid % KS; wgid /= KS;
        int e = 0;
#pragma unroll
        for (int k = 1; k < 8; ++k) if (wgid >= tpu[k] * NT) e = k;
        int t0 = 0, t1 = 0;
#pragma unroll
        for (int k = 0; k < 8; ++k) if (e == k) { t0 = tpu[k]; t1 = tpu[k + 1]; }
        const int nte = t1 - t0, l = wgid - t0 * NT, nig = WGM * NT, gid = l / nig, fm = gid * WGM, gsz = (nte - fm) < WGM ? (nte - fm) : WGM;
        u.pm = t0 + fm + ((l % nig) % gsz); u.pn = e * NT + (l % nig) / gsz; u.ko = ks * KL;
#if defined(PROBE_SAMEB)
        if (KL == -1) { u.ko = 0; if (PROBE_SAMEB & 1) u.pn = (l % nig) / gsz; if (PROBE_SAMEB & 2) u.pm = (u.pm & 15); }
#endif
        return true;
    }
    __device__ __forceinline__ void a_ready(const Unit&) const {}
    __device__ __forceinline__ void done(const Unit&) const {}
};
template <class Base> struct PubOrder : Base {
    unsigned* cnt; mutable int pend;
    __device__ __forceinline__ void publish() const { if (pend >= 0) { if ((threadIdx.x & 63) == 0) __hip_atomic_fetch_add(cnt + 64 * pend, 1u, __ATOMIC_RELAXED, __HIP_MEMORY_SCOPE_AGENT); pend = -1; } }
    __device__ __forceinline__ void a_ready(const Unit&) const { publish(); }
#if defined(PUB_DRAIN) && PUB_DRAIN
    __device__ __forceinline__ void done(const Unit& u) const { asm volatile("s_waitcnt vmcnt(0)" ::: "memory"); pend = u.pm; publish(); }
#else
    __device__ __forceinline__ void done(const Unit& u) const { publish(); pend = u.pm; }
#endif
};
template <class Base> struct WaitOrder : Base {
    const unsigned* ready; unsigned need; unsigned* tmo;
    __device__ __forceinline__ void a_ready(const Unit& u) const {
        if (threadIdx.x < 64) {
            const unsigned long long t0 = __builtin_amdgcn_s_memrealtime(); unsigned polls = 0;
            while ((unsigned)__builtin_amdgcn_readfirstlane(__hip_atomic_load(ready + 64 * u.pm, __ATOMIC_RELAXED, __HIP_MEMORY_SCOPE_AGENT)) < need) {
                if ((++polls & 255u) == 0u && __builtin_amdgcn_readfirstlane(__hip_atomic_load(tmo, __ATOMIC_RELAXED, __HIP_MEMORY_SCOPE_AGENT)) != 0u) break;
                if (__builtin_amdgcn_s_memrealtime() - t0 > 2000000ull) {
                    if (threadIdx.x == 0) { unsigned expect = 0u; __hip_atomic_compare_exchange_strong(tmo + 1, &expect, 0x600u | (unsigned)(u.pm & 0xff), __ATOMIC_RELAXED, __ATOMIC_RELAXED, __HIP_MEMORY_SCOPE_AGENT); __hip_atomic_store(tmo, 1u, __ATOMIC_RELAXED, __HIP_MEMORY_SCOPE_AGENT); }
                    break; }
                __builtin_amdgcn_s_sleep(2); }
            __builtin_amdgcn_fence(__ATOMIC_ACQUIRE, "agent");
            asm volatile("s_waitcnt vmcnt(0)" ::: "memory");
        }
        asm volatile("" ::: "memory"); __builtin_amdgcn_s_barrier(); asm volatile("" ::: "memory");
    }
};
struct MoeDownOrder {
    int G, c, rem; const PG8_LAS int* tp;
    __device__ __forceinline__ int expert_of(int tile) const { int e = 0;
#pragma unroll
        for (int k = 1; k < 8; ++k) if (tile >= __builtin_amdgcn_readfirstlane(tp[k])) e = k;
        return e; }
    __device__ __forceinline__ bool next(int i, Unit& u) const {
        const long L = (long)i * G + c;
        if (!rem) { if (L >= 512) return false;
            int wgid = (int)L; { const int xcd = wgid % NXCD, off = wgid / NXCD; wgid = xcd * 64 + off; }
            const int grp = wgid >> 5, in = wgid & 31; const int tile = grp * 8 + (in & 7), pnl = in >> 3;
            u.pm = tile; u.pn = expert_of(tile) * 4 + pnl; u.ko = 0; return true; }
        const int nrem = __builtin_amdgcn_readfirstlane(tp[8]) - 128; if (L >= (long)nrem * 28) return false;
        const int l2 = (int)L, ks = l2 % 7, r = l2 / 7, tile = 128 + (r >> 2);
        u.pm = tile; u.pn = expert_of(tile) * 4 + (r & 3); u.ko = ks * 512; return true;
    }
    __device__ __forceinline__ void a_ready(const Unit&) const {}
    __device__ __forceinline__ void done(const Unit&) const {}
};
struct EpiBf16Y2 {
    static constexpr bool PERM = true, AFTER_DRAIN = false;
    bf16_t* Y; bf16_t* YP; int rem;
    __device__ __forceinline__ void operator()(const f32x4 (&acc)[2][2][4][2], const Unit& u, int wr, int wc, int fr, int fq) const {
        const int row0 = u.pm * BM + wr * 64 + fr, col0 = (u.pn & 3) * BM + wc * 32 + 8 * fq;
        bf16_t* base = rem ? YP + (size_t)(u.ko >> 9) * (2048 * 1024) + (size_t)(row0 - 128 * BM) * 1024 : Y + (size_t)row0 * 1024;
#pragma unroll
        for (int ai = 0; ai < 2; ++ai)
#pragma unroll
            for (int m = 0; m < 4; ++m) { bf16_t* rowp = base + (size_t)(ai * HALF + m * 16) * 1024 + col0;
#pragma unroll
                for (int bj = 0; bj < 2; ++bj) *(u32x4*)(rowp + bj * HALF) = pack8(acc[ai][bj][m][0], acc[ai][bj][m][1]); }
    }
};
template <class Epi, class Sched, bool ALIGN_EPI = false, bool SP2 = false>
__device__ __forceinline__ void gemm_phase(PG8_LAS unsigned char* lds, const Gemm g, const Sched& S, const Epi& E) {
    const int tid = threadIdx.x, wid = __builtin_amdgcn_readfirstlane(tid >> 6), lane = tid & 63, wr = wid >> 2, wc = wid & 3, fr = lane & 15, fq = lane >> 4;
    const int K = g.ld, nt = g.K / BK;
    unsigned voffA[2], voffB[2];
#pragma unroll
    for (int i = 0; i < 2; ++i) { int R, C; stage_rc(tid * 16 + i * 8192, R, C); const int Rb = Epi::PERM ? ((R & ~31) + perm32(R & 31)) : R;
        voffA[i] = (unsigned)(R * K + C) * 2u; voffB[i] = (unsigned)(Rb * K + C) * 2u; }
    const size_t kstep = (size_t)(BK * 2);
    const size_t hstep = (size_t)HALF * K * 2;
    const size_t tstep = 2 * hstep;
    const unsigned ldsw = (unsigned)wid * 1024u;
    const int aoff = lds_byte(wr * 64 + fr, fq * 8), boff = lds_byte(wc * 32 + fr, fq * 8);
#define PG8_SA(b, h) (((b) * 2 + (h)) * HTB)
#define PG8_SB(b, h) ((4 + (b) * 2 + (h)) * HTB)
#define PG8_STAGE(bufoff, gbase, voff) do { _Pragma("unroll") for (int _i = 0; _i < 2; ++_i) \
        __builtin_amdgcn_global_load_lds((const unsigned*)((const char*)(gbase) + (voff)[_i]), (PG8_LAS unsigned*)(lds + (bufoff) + ldsw + _i * 8192), 16, 0, 0); } while (0)
#define PG8_LDA(dst, b, h) do { _Pragma("unroll") for (int m = 0; m < 4; ++m) _Pragma("unroll") for (int k = 0; k < 2; ++k) dst[m][k] = *(const PG8_LAS bf16x8*)(lds + PG8_SA(b, h) + aoff + m * 2048 + k * 1024); } while (0)
#define PG8_LDB(dst, b, h) do { _Pragma("unroll") for (int n = 0; n < 2; ++n) _Pragma("unroll") for (int k = 0; k < 2; ++k) dst[n][k] = *(const PG8_LAS bf16x8*)(lds + PG8_SB(b, h) + boff + n * 2048 + k * 1024); } while (0)
#define PG8_MMA(ai, bj, At, Bt) do { __builtin_amdgcn_s_setprio(1); _Pragma("unroll") for (int m = 0; m < 4; ++m) _Pragma("unroll") for (int n = 0; n < 2; ++n) _Pragma("unroll") for (int k = 0; k < 2; ++k) \
        acc[ai][bj][m][n] = __builtin_amdgcn_mfma_f32_16x16x32_bf16(Bt[n][k], At[m][k], acc[ai][bj][m][n], 0, 0, 0); __builtin_amdgcn_s_setprio(0); } while (0)
#define PG8_WAIT_V(n) asm volatile("s_waitcnt vmcnt(" #n ")" ::: "memory")
#define PG8_WAIT_L(n) asm volatile("s_waitcnt lgkmcnt(" #n ")" ::: "memory")
#define PG8_BAR __builtin_amdgcn_s_barrier()
#define PG8_SCHED __builtin_amdgcn_sched_barrier(0)
    Unit cur, nxt; int ui = 0;
    if (!S.next(0, cur)) return;
    f32x4 acc[2][2][4][2];
#pragma unroll
    for (int a = 0; a < 2; ++a)
#pragma unroll
        for (int b = 0; b < 2; ++b)
#pragma unroll
            for (int m = 0; m < 4; ++m)
#pragma unroll
                for (int n = 0; n < 2; ++n) acc[a][b][m][n] = (f32x4){0.f, 0.f, 0.f, 0.f};
    bf16x8 At[4][2], B0[2][2], B1[2][2];
    const char* cA = (const char*)g.A + (size_t)cur.pm * tstep + (size_t)cur.ko * 2; const char* cB = (const char*)g.Bt + (size_t)cur.pn * tstep + (size_t)cur.ko * 2;
    S.a_ready(cur);
    if constexpr (SP2) {
        PG8_STAGE(PG8_SB(0, 0), cB, voffB); PG8_STAGE(PG8_SB(0, 1), cB + hstep, voffB); PG8_STAGE(PG8_SA(0, 0), cA, voffA); PG8_STAGE(PG8_SA(0, 1), cA + hstep, voffA);
        if (wr == 1) PG8_BAR;
        PG8_WAIT_V(2); PG8_BAR;
        PG8_STAGE(PG8_SB(1, 0), cB + kstep, voffB); PG8_STAGE(PG8_SA(1, 0), cA + kstep, voffA); PG8_STAGE(PG8_SB(1, 1), cB + hstep + kstep, voffB);
        PG8_WAIT_V(6); PG8_BAR;
    } else {
        PG8_STAGE(PG8_SB(0, 0), cB, voffB); PG8_STAGE(PG8_SA(0, 0), cA, voffA); PG8_STAGE(PG8_SB(0, 1), cB + hstep, voffB); PG8_STAGE(PG8_SA(0, 1), cA + hstep, voffA);
        if (wr == 1) PG8_BAR;
        PG8_WAIT_V(4); PG8_BAR;
        PG8_STAGE(PG8_SB(1, 0), cB + kstep, voffB); PG8_STAGE(PG8_SA(1, 0), cA + kstep, voffA); PG8_STAGE(PG8_SB(1, 1), cB + hstep + kstep, voffB);
        PG8_WAIT_V(6); PG8_BAR;
    }
    for (;;) {
        const bool has_next = S.next(ui + 1, nxt);
        const char* nA = has_next ? (const char*)g.A + (size_t)nxt.pm * tstep + (size_t)nxt.ko * 2 : cA; const char* nB = has_next ? (const char*)g.Bt + (size_t)nxt.pn * tstep + (size_t)nxt.ko * 2 : cB;
        for (int t = 0; t < nt; t += 2) {
            const bool last = (t == nt - 2);
            const char* a1 = cA + (size_t)(t + 1) * kstep;
            const char* a2 = last ? nA : cA + (size_t)(t + 2) * kstep; const char* b2 = last ? nB : cB + (size_t)(t + 2) * kstep;
            const char* a3 = a2 + kstep; const char* b3 = b2 + kstep;
            if (last && has_next) S.a_ready(nxt);
            if constexpr (SP2) {
            PG8_LDB(B0, 0, 0); PG8_LDB(B1, 0, 1); PG8_SCHED; PG8_LDA(At, 0, 0); PG8_STAGE(PG8_SA(1, 1), a1 + hstep, voffA);
            PG8_WAIT_V(8); PG8_WAIT_L(0); PG8_BAR; PG8_MMA(0, 0, At, B0); PG8_MMA(0, 1, At, B1); PG8_BAR; PG8_SCHED;
            PG8_LDA(At, 0, 1); PG8_STAGE(PG8_SB(0, 0), b2, voffB); PG8_STAGE(PG8_SB(0, 1), b2 + hstep, voffB); PG8_STAGE(PG8_SA(0, 0), a2, voffA);
            PG8_WAIT_V(8); PG8_WAIT_L(0); PG8_BAR; PG8_MMA(1, 0, At, B0); PG8_MMA(1, 1, At, B1); PG8_BAR; PG8_SCHED;
            PG8_LDB(B0, 1, 0); PG8_LDB(B1, 1, 1); PG8_SCHED; PG8_LDA(At, 1, 0); PG8_STAGE(PG8_SA(0, 1), a2 + hstep, voffA);
            PG8_WAIT_V(8); PG8_WAIT_L(0); PG8_BAR; PG8_MMA(0, 0, At, B0); PG8_MMA(0, 1, At, B1); PG8_BAR; PG8_SCHED;
            PG8_LDA(At, 1, 1); PG8_STAGE(PG8_SB(1, 0), b3, voffB); PG8_STAGE(PG8_SB(1, 1), b3 + hstep, voffB); PG8_STAGE(PG8_SA(1, 0), a3, voffA);
            PG8_WAIT_V(8); PG8_WAIT_L(0); PG8_BAR; PG8_MMA(1, 0, At, B0); PG8_MMA(1, 1, At, B1); PG8_BAR; PG8_SCHED;
            } else {
            PG8_LDB(B0, 0, 0); PG8_SCHED; PG8_LDA(At, 0, 0); PG8_STAGE(PG8_SA(1, 1), a1 + hstep, voffA);
            PG8_WAIT_L(8); PG8_BAR; PG8_WAIT_L(0); PG8_MMA(0, 0, At, B0); PG8_BAR; PG8_SCHED;
            PG8_LDB(B1, 0, 1); PG8_STAGE(PG8_SB(0, 0), b2, voffB);
            PG8_BAR; PG8_WAIT_L(0); PG8_MMA(0, 1, At, B1); PG8_BAR;
            PG8_LDA(At, 0, 1); PG8_STAGE(PG8_SA(0, 0), a2, voffA);
            PG8_BAR; PG8_WAIT_L(0); PG8_MMA(1, 0, At, B0); PG8_BAR; PG8_SCHED;
            PG8_STAGE(PG8_SB(0, 1), b2 + hstep, voffB);
            PG8_WAIT_V(6); PG8_BAR; PG8_MMA(1, 1, At, B1); PG8_BAR;
            PG8_LDB(B0, 1, 0); PG8_SCHED; PG8_LDA(At, 1, 0); PG8_STAGE(PG8_SA(0, 1), a2 + hstep, voffA);
            PG8_WAIT_L(8); PG8_BAR; PG8_WAIT_L(0); PG8_MMA(0, 0, At, B0); PG8_BAR; PG8_SCHED;
            PG8_LDB(B1, 1, 1); PG8_STAGE(PG8_SB(1, 0), b3, voffB);
            PG8_BAR; PG8_WAIT_L(0); PG8_MMA(0, 1, At, B1); PG8_BAR;
            PG8_LDA(At, 1, 1); PG8_STAGE(PG8_SA(1, 0), a3, voffA);
            PG8_BAR; PG8_WAIT_L(0); PG8_MMA(1, 0, At, B0); PG8_BAR; PG8_SCHED;
            PG8_STAGE(PG8_SB(1, 1), b3 + hstep, voffB);
            PG8_WAIT_V(6); PG8_BAR; PG8_MMA(1, 1, At, B1); PG8_BAR;
            }
        }
        if constexpr (ALIGN_EPI) { if (wr == 0) PG8_BAR; }
        if constexpr (!Epi::AFTER_DRAIN) { E(acc, cur, wr, wc, fr, fq); S.done(cur); }
        if (!has_next) break;
#pragma unroll
        for (int a = 0; a < 2; ++a)
#pragma unroll
            for (int b = 0; b < 2; ++b)
#pragma unroll
                for (int m = 0; m < 4; ++m)
#pragma unroll
                    for (int n = 0; n < 2; ++n) acc[a][b][m][n] = (f32x4){0.f, 0.f, 0.f, 0.f};
        cur = nxt; cA = nA; cB = nB; ++ui;
        if constexpr (ALIGN_EPI) { if (wr == 1) PG8_BAR; }
    }
    PG8_WAIT_V(0);
    if constexpr (!ALIGN_EPI) { if (wr == 0) PG8_BAR; }
    PG8_BAR;
    if constexpr (Epi::AFTER_DRAIN) { E.fused(acc, cur, wr, wc, fr, fq, lds, wid, lane); S.done(cur); }
#undef PG8_SA
#undef PG8_SB
#undef PG8_STAGE
#undef PG8_LDA
#undef PG8_LDB
#undef PG8_MMA
#undef PG8_WAIT_V
#undef PG8_WAIT_L
#undef PG8_BAR
#undef PG8_SCHED
}
}
#ifndef PG8_SP2
#define PG8_SP2 true
#endif
#ifndef PG8_ALIGN
#define PG8_ALIGN true
#endif
#define GAS __attribute__((address_space(1)))
#define LAS __attribute__((address_space(3)))
typedef unsigned short bf16;
typedef unsigned v4u __attribute__((ext_vector_type(4)));
typedef float f32x4 __attribute__((ext_vector_type(4)));
typedef short bf16x8 __attribute__((ext_vector_type(8)));
typedef GAS unsigned gu32;
typedef GAS unsigned long long gu64;
#define RLX_AGENT __ATOMIC_RELAXED, __HIP_MEMORY_SCOPE_AGENT
#define LDS_WAIT() asm volatile("s_waitcnt lgkmcnt(0)" ::: "memory")
#define VM_WAIT() asm volatile("s_waitcnt vmcnt(0)" ::: "memory")
__device__ __forceinline__ unsigned long long rt() { return __builtin_amdgcn_s_memrealtime(); }
__device__ __forceinline__ unsigned f2bf(float f) { unsigned u = __builtin_bit_cast(unsigned, f); return (u + 0x7fffu + ((u >> 16) & 1u)) >> 16; }
__device__ __forceinline__ unsigned pk2(float lo, float hi) { return f2bf(lo) | (f2bf(hi) << 16); }

#define XB_TMO      128
#define XB_XCNT(j)  (256  + 64 * (j))
#define XB_XSUB(j)  (1280 + 64 * (j))
#define XB_XGEN(j)  (2304 + 64 * (j))
#define XB_TOP      3328
#define XB_TOPGEN   3392
#define XCD_BAR_WORDS 3456
#define XB_SPIN_CAP (1u << 18)

__device__ __forceinline__ unsigned xb_ld(unsigned* p)              { return __hip_atomic_load(p, __ATOMIC_RELAXED, __HIP_MEMORY_SCOPE_AGENT); }
__device__ __forceinline__ unsigned xb_add(unsigned* p, unsigned v) { return __hip_atomic_fetch_add(p, v, __ATOMIC_RELAXED, __HIP_MEMORY_SCOPE_AGENT); }
__device__ __forceinline__ unsigned xb_xcc_id() { return (unsigned)__builtin_amdgcn_s_getreg((3 << 11) | 20) & 0xFu; }
#define XB_SPIN(cond, bar) do { unsigned _sp = 0; while (cond) { __builtin_amdgcn_s_sleep(1); \
    if ((++_sp & 255u) == 0u) { if (xb_ld(&(bar)[XB_TMO])) break; if (_sp > XB_SPIN_CAP) { atomicAdd(&(bar)[XB_TMO], 1u); break; } } } } while (0)

struct XcdBarrier {
    unsigned* bar; unsigned x;
    volatile LAS unsigned* st;
};

__device__ __forceinline__ XcdBarrier xcd_barrier_post(unsigned* bar, volatile LAS unsigned* st) {
    XcdBarrier b; b.bar = bar; b.x = xb_xcc_id(); b.st = st;
    if (threadIdx.x == 0) (void)xb_add(&bar[XB_XCNT(b.x)], 1u);
    return b;
}
__device__ __forceinline__ void xcd_barrier_complete(unsigned* bar, unsigned x, unsigned& nloc, unsigned& nx) {
    const unsigned G = gridDim.x * gridDim.y * gridDim.z;
    unsigned sum, cnt, mine, sp = 0u;
    for (;;) {
        sum = 0u; cnt = 0u; mine = 0u;
#pragma unroll
        for (unsigned j = 0; j < 16; ++j) { const unsigned c = xb_ld(&bar[XB_XCNT(j)]); sum += c; cnt += (c > 0u) ? 1u : 0u; mine = (j == x) ? c : mine; }
        if (sum == G) break;
        __builtin_amdgcn_s_sleep(1);
        if ((++sp & 255u) == 0u) { if (xb_ld(&bar[XB_TMO])) break; if (sp > XB_SPIN_CAP) { atomicAdd(&bar[XB_TMO], 1u); break; } }
    }
    nloc = mine > 0u ? mine : 1u; nx = cnt > 0u ? cnt : 1u;
}

__device__ __forceinline__ void xcd_barrier(const XcdBarrier& b) {
    asm volatile("s_waitcnt vmcnt(0)" ::: "memory");
    __syncthreads();
    if (threadIdx.x == 0) {
        unsigned* bar = b.bar;
        __builtin_amdgcn_s_waitcnt(0);
        unsigned nloc = b.st[0], nx = b.st[1];
        if (nloc == 0u) { xcd_barrier_complete(bar, b.x, nloc, nx); b.st[0] = nloc; b.st[1] = nx; }
        const unsigned old = xb_add(&bar[XB_XSUB(b.x)], 1u);
        const unsigned gen = old / nloc;
        if (old + 1u == (gen + 1u) * nloc) {
            __builtin_amdgcn_fence(__ATOMIC_RELEASE, "agent");
            asm volatile("s_waitcnt vmcnt(0)" ::: "memory");
            const unsigned og = xb_add(&bar[XB_TOP], 1u);
            const unsigned tg = og / nx;
            if (og + 1u == (tg + 1u) * nx) xb_add(&bar[XB_TOPGEN], 1u);
            else XB_SPIN(xb_ld(&bar[XB_TOPGEN]) == tg, bar);
            __builtin_amdgcn_fence(__ATOMIC_ACQUIRE, "agent");
            xb_add(&bar[XB_XGEN(b.x)], 1u);
            asm volatile("s_waitcnt vmcnt(0)" ::: "memory");
        } else {
            XB_SPIN(xb_ld(&bar[XB_XGEN(b.x)]) == gen, bar);
            __builtin_amdgcn_fence(__ATOMIC_ACQUIRE, "agent");
            asm volatile("s_waitcnt vmcnt(0)" ::: "memory");
        }
    }
    __syncthreads();
}
constexpr int NWAVES = 8;
#ifndef MK_PER_PHASE
#define MK_PER_PHASE 0
#endif
constexpr int N_PHASES = 20;
constexpr int MOE_KS = 1;

constexpr int BATCH = 2, T = 8192, D = 1024, M = BATCH * T;
constexpr int NSA_IN = 2608, NSA_IN_PAD = 2816, FF0 = 2816, GLA_IN = 3088, GLA_IN_PAD = 3328, FFE = 3584, NE = 8;
constexpr int NCMP = 511, MAXTILES = 136, MAXSLOTS = MAXTILES * 256;
constexpr float ALPHA = 1.41421356237309515f;
constexpr float LN_EPS = 1e-5f, RMS_EPS = 1e-6f, LOG2E = 1.44269504088896341f;

constexpr size_t MiB = 1u << 20;
constexpr size_t WS_CTL = 0, CTL_ZERO_BYTES = 1 * MiB;
constexpr size_t WS_PB = 1 * MiB;
constexpr size_t WS_CNTL = WS_PB + 32768;
constexpr size_t WS_TOKE = WS_CNTL + 16384;
constexpr size_t WS_TOKW = WS_TOKE + (size_t)M * 8;
constexpr size_t WS_TOKP = WS_TOKW + (size_t)M * 8;
constexpr size_t WS_TOKS = WS_TOKP + (size_t)M * 8;
static_assert(WS_TOKS + (size_t)M * 8 <= 2 * MiB, "misc region");
constexpr size_t WS_WIN0 = 2 * MiB, WS_W1C = 8 * MiB, WS_WO0 = 10 * MiB, WS_WGU0 = 12 * MiB, WS_WD0 = 23 * MiB, WS_WIN1 = 29 * MiB, WS_WO1 = 36 * MiB, WS_WGU1 = 38 * MiB, WS_WD1 = 150 * MiB;
constexpr size_t WS_XB = 206 * MiB, WS_XRES = 238 * MiB, WS_T0 = 302 * MiB, WS_SCR = 366 * MiB;
constexpr size_t WS_Q = WS_SCR, WS_KV2 = WS_SCR + 32 * MiB, WS_KS = WS_SCR + 48 * MiB, WS_VS = WS_SCR + 56 * MiB, WS_KW = WS_SCR + 64 * MiB, WS_VW = WS_SCR + 72 * MiB;
constexpr size_t WS_GT = WS_SCR + 80 * MiB, WS_UL = WS_SCR + 83 * MiB, WS_KCMP = WS_SCR + 99 * MiB, WS_VCMP = WS_KCMP + 512 * 1024, WS_O = WS_SCR + 100 * MiB, WS_H0 = WS_SCR + 132 * MiB;
constexpr size_t WS_QKVG = WS_SCR, WS_ALOW = WS_SCR + 96 * MiB, WS_BCUM = WS_SCR + 97 * MiB, WS_ZB = WS_SCR + 129 * MiB, WS_DEC = WS_SCR + 257 * MiB, WS_SST = WS_SCR + 258 * MiB, WS_O1 = WS_SCR + 322 * MiB;
constexpr size_t WS_XG = WS_SCR, WS_YB = WS_SCR + 68 * MiB, WS_H2 = WS_SCR + 136 * MiB, WS_YB1 = WS_SCR + 374 * MiB, WS_END = WS_YB1 + 68 * MiB;
static_assert(WS_H2 + (size_t)MAXSLOTS * FFE * 2 <= WS_YB1, "H2 fits");
static_assert(WS_H0 + (size_t)M * FF0 * 2 <= 896 * MiB && WS_O1 + 32 * MiB <= 896 * MiB && WS_END <= 896 * MiB, "d_ws map");
constexpr int CW_TMO = 0, CW_CODE = 1, CW_BAR = 4096;
constexpr int CW_PANEL0 = 16384, CW_PANEL1 = 32768;
static_assert((CW_PANEL1 + 64 * MAXTILES) * 4 <= (int)CTL_ZERO_BYTES, "CTL words inside the memset region");

constexpr int RING_OFF = 0, RING_BYTES = 131072;
constexpr int LDSCTL_OFF = RING_BYTES, MISC_OFF = LDSCTL_OFF + 320;
constexpr int INPTR_OFF = MISC_OFF + 128;
constexpr int LDS_BYTES = 147456;
#ifndef TR_UNROLL
#define TR_UNROLL 8
#endif
typedef float f32x16 __attribute__((ext_vector_type(16)));
typedef short v4i16 __attribute__((ext_vector_type(4)));
typedef unsigned v2u __attribute__((ext_vector_type(2)));
struct Args { const float* in[27]; float* out; unsigned char* ws; int ph_lo, ph_hi; };
struct Frame {
    const Args* A;
    LAS unsigned char* lds;
    volatile LAS unsigned* MISC;
    gu32* ctl;
    int tid, lane, wave;
    int vcu, G, wg;
    unsigned char* ws; float* out;
};
#define inptr(F, k) ((F).A->in[k])
__device__ __forceinline__ float wave_sum(float v) {
    v += __int_as_float(__builtin_amdgcn_update_dpp(0, __float_as_int(v), 0xB1, 0xF, 0xF, true));
    v += __int_as_float(__builtin_amdgcn_update_dpp(0, __float_as_int(v), 0x4E, 0xF, 0xF, true));
    v += __int_as_float(__builtin_amdgcn_update_dpp(0, __float_as_int(v), 0x141, 0xF, 0xF, true));
    v += __int_as_float(__builtin_amdgcn_update_dpp(0, __float_as_int(v), 0x140, 0xF, 0xF, true));
    { const auto rr = __builtin_amdgcn_permlane16_swap(__float_as_uint(v), __float_as_uint(v), false, false); v = __uint_as_float(rr[0]) + __uint_as_float(rr[1]); }
    { const auto rr = __builtin_amdgcn_permlane32_swap(__float_as_uint(v), __float_as_uint(v), false, false); v = __uint_as_float(rr[0]) + __uint_as_float(rr[1]); }
    return v;
}
__device__ __forceinline__ float bf2f(bf16 h) { return __uint_as_float((unsigned)h << 16); }
__device__ __forceinline__ v4i16 vtr(const LAS unsigned char* p) { return __builtin_amdgcn_ds_read_tr16_b64_v4i16((LAS v4i16*)p); }
__device__ __forceinline__ int crow(int r, int hi) { return (r & 3) + 8 * (r >> 2) + 4 * hi; }

__device__ __forceinline__ void tr_item(const float* src, int ldn, int nvalid, int k0, int n0, bf16* dst, int dld, int drow0, LAS float* scr, int lane) {
    const int n_ = n0 + (lane & 31); const bool ok = n_ < nvalid;
    float tv[32];
#pragma unroll
    for (int i = 0; i < 32; ++i) { const int kk = 2 * i + (lane >> 5); tv[i] = ok ? *(const GAS float*)(src + (size_t)(k0 + kk) * ldn + n_) : 0.f; }
#pragma unroll
    for (int i = 0; i < 32; ++i) { const int kk = 2 * i + (lane >> 5); scr[kk * 33 + (lane & 31)] = tv[i]; }
    LDS_WAIT(); asm volatile("" ::: "memory");
    const int c = lane & 7;
#pragma unroll
    for (int j = 0; j < 4; ++j) { const int n = (lane >> 3) + 8 * j; const LAS float* s = scr + (8 * c) * 33 + n;
        v4u o; o.x = pk2(s[0 * 33], s[1 * 33]); o.y = pk2(s[2 * 33], s[3 * 33]); o.z = pk2(s[4 * 33], s[5 * 33]); o.w = pk2(s[6 * 33], s[7 * 33]);
        *(GAS v4u*)(dst + (size_t)(drow0 + n) * dld + k0 + 8 * c) = o; }
    LDS_WAIT(); asm volatile("" ::: "memory");
}
__device__ __forceinline__ int swiglu_row(int n0, int F_) { return n0 < F_ ? (n0 / 128) * 256 + (n0 % 128) : ((n0 - F_) / 128) * 256 + 128 + ((n0 - F_) % 128); }
#define KBNB(idx, nkb, nnb) const int kb = ((idx) % (8 * (nkb))) / 8, nb = ((idx) / (8 * (nkb))) * 8 + (idx) % 8
__device__ __forceinline__ void p0_items(Frame& F, const int first, const int last, const int gw, const int NGW) {
    LAS float* scr = (LAS float*)(F.lds + RING_OFF + F.wave * 16384);
    const int lane = F.lane;
    unsigned char* ws = F.ws;
    constexpr int I_IN0 = 16 * (NSA_IN_PAD / 32), I_W1 = 4 * 16 * 8, I_WO = 16 * 32, I_GU0 = 16 * (2 * FF0 / 32), I_D0 = (FF0 / 64) * 32, I_IN1 = 16 * (GLA_IN_PAD / 32);
    constexpr int I_GU1E = 16 * (2 * FFE / 32), I_D1E = (FFE / 64) * 32, I_GU1 = NE * I_GU1E, I_D1 = NE * I_D1E;
    constexpr int NITEMS = I_IN0 + I_W1 + I_WO + I_GU0 + I_D0 + I_IN1 + I_WO + I_GU1 + I_D1;
    for (int it = first + gw; it < last; it += NGW) {
        int r = it;
        if (r < I_IN0) { constexpr int nnb = NSA_IN_PAD / 32; KBNB(r, 16, nnb); tr_item(inptr(F, 1), NSA_IN, NSA_IN, 64 * kb, 32 * nb, (bf16*)(ws + WS_WIN0), 1024, 32 * nb, scr, lane); continue; } r -= I_IN0;
        if (r < I_W1) { const int blk = r / 128, q = r % 128; KBNB(q, 16, 8);
            const float* src = ((blk >> 1) ? inptr(F, 6) : inptr(F, 4)) + (size_t)(blk & 1) * 1024 * 256; tr_item(src, 256, 256, 64 * kb, 32 * nb, (bf16*)(ws + WS_W1C), 1024, 256 * blk + 32 * nb, scr, lane); continue; } r -= I_W1;
        if (r < I_WO) { KBNB(r, 16, 32); tr_item(inptr(F, 8), 1024, 1024, 64 * kb, 32 * nb, (bf16*)(ws + WS_WO0), 1024, 32 * nb, scr, lane); continue; } r -= I_WO;
        if (r < I_GU0) { constexpr int nnb = 2 * FF0 / 32; KBNB(r, 16, nnb); tr_item(inptr(F, 11), 2 * FF0, 2 * FF0, 64 * kb, 32 * nb, (bf16*)(ws + WS_WGU0), 1024, swiglu_row(32 * nb, FF0), scr, lane); continue; } r -= I_GU0;
        if (r < I_D0) { KBNB(r, FF0 / 64, 32); tr_item(inptr(F, 12), 1024, 1024, 64 * kb, 32 * nb, (bf16*)(ws + WS_WD0), FF0, 32 * nb, scr, lane); continue; } r -= I_D0;
        if (r < I_IN1) { constexpr int nnb = GLA_IN_PAD / 32; KBNB(r, 16, nnb); tr_item(inptr(F, 15), GLA_IN, GLA_IN, 64 * kb, 32 * nb, (bf16*)(ws + WS_WIN1), 1024, 32 * nb, scr, lane); continue; } r -= I_IN1;
        if (r < I_WO) { KBNB(r, 16, 32); tr_item(inptr(F, 19), 1024, 1024, 64 * kb, 32 * nb, (bf16*)(ws + WS_WO1), 1024, 32 * nb, scr, lane); continue; } r -= I_WO;
        if (r < I_GU1) { constexpr int nnb = 2 * FFE / 32; const int e = r / I_GU1E, q = r % I_GU1E; KBNB(q, 16, nnb);
            tr_item(inptr(F, 23) + (size_t)e * 1024 * 2 * FFE, 2 * FFE, 2 * FFE, 64 * kb, 32 * nb, (bf16*)(ws + WS_WGU1) + (size_t)e * 2 * FFE * 1024, 1024, swiglu_row(32 * nb, FFE), scr, lane); continue; } r -= I_GU1;
        { const int e = r / I_D1E, q = r % I_D1E; KBNB(q, FFE / 64, 32);
            tr_item(inptr(F, 24) + (size_t)e * FFE * 1024, 1024, 1024, 64 * kb, 32 * nb, (bf16*)(ws + WS_WD1) + (size_t)e * 1024 * FFE, FFE, 32 * nb, scr, lane); }
    }
}
namespace p0n { constexpr int I_D1 = NE * (FFE / 64) * 32, I_ALL = 16 * (NSA_IN_PAD / 32) + 4 * 16 * 8 + 16 * 32 + 16 * (2 * FF0 / 32) + (FF0 / 64) * 32 + 16 * (GLA_IN_PAD / 32) + 16 * 32 + NE * 16 * (2 * FFE / 32) + I_D1; }
constexpr int CMP_WGS = 64;
__device__ __forceinline__ void p0_prologue(Frame& F) {
    const int gw = F.vcu * NWAVES + F.wave, NGW = F.G * NWAVES, lane = F.lane;
    unsigned char* ws = F.ws;
    p0_items(F, 0, p0n::I_ALL, gw, NGW);
    { const float* x = inptr(F, 0); bf16* xb = (bf16*)(ws + WS_XB);
      for (int m = gw; m < M; m += NGW) { const GAS f32x4* xr = (const GAS f32x4*)(x + (size_t)m * D) + lane; GAS unsigned long long* o8 = (GAS unsigned long long*)(xb + (size_t)m * D) + lane;
#pragma unroll
          for (int j = 0; j < 4; ++j) { const f32x4 v = xr[64 * j]; o8[64 * j] = (unsigned long long)pk2(v.x, v.y) | ((unsigned long long)pk2(v.z, v.w) << 32); } } }
    { float* pb = (float*)(ws + WS_PB);
      for (int task = gw; task < 64; task += NGW) { const int rp = task & 7, cb = (task >> 3) & 3, kv = task >> 5; const float* pe = kv ? inptr(F, 3) : inptr(F, 2); const float* w1 = kv ? inptr(F, 6) : inptr(F, 4); const int c = 64 * cb + lane;
          float a = 0.f;
          for (int r0 = 256 * rp; r0 < 256 * rp + 256; r0 += 32) { float wv[32], pv[32];
#pragma unroll
              for (int u = 0; u < 32; ++u) { wv[u] = *(const GAS float*)(w1 + (size_t)(r0 + u) * 256 + c); pv[u] = *(const GAS float*)(pe + r0 + u); }
#pragma unroll
              for (int u = 0; u < 32; ++u) a += pv[u] * wv[u]; }
          pb[rp * 512 + kv * 256 + c] = a; } }
}

__device__ __forceinline__ float gelu_tanh(float x) { const float y = 0.7978845608028654f * (x + 0.044715f * x * x * x); const float e = __expf(2.f * y); const float th = 1.f - 2.f / (e + 1.f); return 0.5f * x * (1.f + th); }
__device__ __forceinline__ void cmp_finish(Frame& F) {
    const int gw = F.vcu * NWAVES + F.wave, NGW = F.G * NWAVES, lane = F.lane;
    LAS float* hb = (LAS float*)(F.lds + RING_OFF + F.wave * 1024);
    LAS float* W2L = (LAS float*)(F.lds + RING_OFF + 16384);
    const float* ul = (const float*)(F.ws + WS_UL); const float* pb = (const float*)(F.ws + WS_PB);
    int staged = -1;
    for (int task = gw; task < 8192; task += NGW) {
        const int kv = task >> 12, rem = task & 4095, b = rem >> 11, n = (rem >> 2) & 511, g = rem & 3;
        if (kv != staged) { const float* w2 = kv ? inptr(F, 7) : inptr(F, 5);
            __syncthreads();
            for (int q = F.tid; q < 4096; q += NWAVES * 64) *(LAS f32x4*)(W2L + q * 4) = *(const GAS f32x4*)(w2 + q * 4);
            __syncthreads(); staged = kv; }
        bf16* dst = (bf16*)(F.ws + (kv ? WS_VCMP : WS_KCMP)) + ((size_t)((b * 4 + g) * 512 + n)) * 64;
        if (n == 511) { dst[lane] = 0; continue; }
        const size_t rowU = (size_t)kv * 4096 + (size_t)(b * 512 + n) * 4 + g, rowL = rowU + 4;
        const f32x4 u = *(const f32x4*)(ul + rowU * 512 + lane * 4), lw = *(const f32x4*)(ul + rowL * 512 + 256 + lane * 4);
        f32x4 bs = (f32x4){0.f, 0.f, 0.f, 0.f};
#pragma unroll
        for (int rp = 0; rp < 8; ++rp) bs += *(const f32x4*)(pb + rp * 512 + kv * 256 + lane * 4);
        const f32x4 pre = u + lw + bs;
        *(LAS f32x4*)(hb + lane * 4) = (f32x4){gelu_tanh(pre[0]), gelu_tanh(pre[1]), gelu_tanh(pre[2]), gelu_tanh(pre[3])};
        LDS_WAIT(); asm volatile("" ::: "memory");
        float a0 = 0.f, a1 = 0.f, a2 = 0.f, a3 = 0.f;
#pragma unroll 8
        for (int c = 0; c < 256; c += 4) { const f32x4 h4 = *(const LAS f32x4*)(hb + c);
            a0 += h4[0] * W2L[(c + 0) * 64 + lane]; a1 += h4[1] * W2L[(c + 1) * 64 + lane]; a2 += h4[2] * W2L[(c + 2) * 64 + lane]; a3 += h4[3] * W2L[(c + 3) * 64 + lane]; }
        dst[lane] = (bf16)f2bf((a0 + a1) + (a2 + a3));
        LDS_WAIT(); asm volatile("" ::: "memory");
    }
}

namespace nsa {
constexpr int KB_OFF = 0, VB_OFF = 18432, IMPA_OFF = 36864, IMPB_OFF = 69632, SEL_OFF = 102400, UNI_OFF = 103424, NS_OFF = 103440, SLIST_OFF = 103456, TILE_B = 9216;
static_assert(SLIST_OFF + 512 <= RING_BYTES, "nsa LDS map");
constexpr float THR = 8.f;
__device__ __forceinline__ float dpp_xor1(float v) { return __int_as_float(__builtin_amdgcn_update_dpp(0, __float_as_int(v), 0xB1, 0xF, 0xF, true)); }
__device__ __forceinline__ float dpp_xor2(float v) { return __int_as_float(__builtin_amdgcn_update_dpp(0, __float_as_int(v), 0x4E, 0xF, 0xF, true)); }
__device__ __forceinline__ float max_halves(float v) { const auto rr = __builtin_amdgcn_permlane32_swap(__float_as_uint(v), __float_as_uint(v), false, false); return fmaxf(__uint_as_float(rr[0]), __uint_as_float(rr[1])); }
__device__ __forceinline__ int below(unsigned long long mk) { return (int)__builtin_amdgcn_mbcnt_hi((unsigned)(mk >> 32), __builtin_amdgcn_mbcnt_lo((unsigned)mk, 0u)); }
template <int MODE>
__device__ __forceinline__ void tile(LAS unsigned char* lds, const int kt_off, const int vt_off, const bf16x8 (&qf)[4], const unsigned qaw, f32x16 (&o)[2], float& m, float& l,
                                     const int lane, const float bias, const bool emask, const int d0, const int pstep, const int lim, const float rl, const int impq, const int jbase) {
    const int hi = lane >> 5, qc = lane & 31;
    const v4u qav = (v4u){qaw, 0u, 0u, 0u}; const bf16x8 qaug = __builtin_bit_cast(bf16x8, qav);
    f32x16 p[2];
    bf16x8 kf[2][4];
#pragma unroll
    for (int h2 = 0; h2 < 2; ++h2)
#pragma unroll
        for (int ks = 0; ks < 4; ++ks) kf[h2][ks] = *(const LAS bf16x8*)(lds + kt_off + (32 * h2 + qc) * 144 + 32 * ks + 16 * hi);
    __builtin_amdgcn_sched_barrier(0);
#pragma unroll
    for (int h2 = 0; h2 < 2; ++h2)
#pragma unroll
        for (int r = 0; r < 16; ++r) p[h2][r] = 0.f;
#pragma unroll
    for (int ks = 0; ks < 4; ++ks)
#pragma unroll
        for (int h2 = 0; h2 < 2; ++h2) p[h2] = __builtin_amdgcn_mfma_f32_32x32x16_bf16(kf[h2][ks], qf[ks], p[h2], 0, 0, 0);
#pragma unroll
    for (int h2 = 0; h2 < 2; ++h2) { const unsigned xb = hi ? 0u : f2bf((float)(32 * h2 + qc)); const v4u kav = (v4u){xb | (xb << 16), 0u, 0u, 0u};
        p[h2] = __builtin_amdgcn_mfma_f32_32x32x16_bf16(__builtin_bit_cast(bf16x8, kav), qaug, p[h2], 0, 0, 0); }
    v4i16 vlo[2][2][2], vhi[2][2][2];
    if (MODE != 0) {
        const int a_ = (lane >> 4) & 1, q_ = (lane & 15) >> 2, p_ = lane & 3;
#pragma unroll
        for (int d0_ = 0; d0_ < 2; ++d0_)
#pragma unroll
            for (int h2 = 0; h2 < 2; ++h2)
#pragma unroll
                for (int s2 = 0; s2 < 2; ++s2) { const LAS unsigned char* ad = lds + vt_off + (32 * h2 + 16 * s2 + 4 * hi + q_) * 144 + (32 * d0_ + 16 * a_ + 4 * p_) * 2;
                    vlo[d0_][h2][s2] = vtr(ad); vhi[d0_][h2][s2] = vtr(ad + 8 * 144); }
        __builtin_amdgcn_sched_barrier(0);
    }
    if (emask) {
#pragma unroll
        for (int h2 = 0; h2 < 2; ++h2)
#pragma unroll
            for (int r = 0; r < 16; ++r) { const int dist = d0 - pstep * (32 * h2 + (r & 3) + 8 * (r >> 2)); p[h2][r] = ((unsigned)dist < (unsigned)lim) ? p[h2][r] : -INFINITY; }
    }
    float mref;
    if (MODE == 1) mref = m - bias;
    else {
        float mx = fmaxf(p[0][0], p[1][0]);
#pragma unroll
        for (int r = 1; r < 16; ++r) mx = fmaxf(fmaxf(mx, p[0][r]), p[1][r]);
        mx = max_halves(mx);
        const float mt = mx + bias;
        const bool up = mt > m + THR;
        if (__any(up)) { const float mn = up ? mt : m; const float f = __builtin_amdgcn_exp2f(m - mn); l *= f; m = mn;
            if (MODE == 2) {
#pragma unroll
                for (int r = 0; r < 16; ++r) { o[0][r] *= f; o[1][r] *= f; } } }
        mref = m - bias;
    }
    float ls0 = 0.f, ls1 = 0.f;
#pragma unroll
    for (int r = 0; r < 16; ++r) { float e0 = __builtin_amdgcn_exp2f(p[0][r] - mref), e1 = __builtin_amdgcn_exp2f(p[1][r] - mref); if (MODE == 1) { e0 *= rl; e1 *= rl; } p[0][r] = e0; p[1][r] = e1; ls0 += e0; ls1 += e1; }
    if (MODE != 1) l += ls0 + ls1;
    if (MODE == 0) return;
    if (MODE == 1) {
        LAS float* IA = (LAS float*)(lds + IMPA_OFF) + impq * 128; LAS float* IB = (LAS float*)(lds + IMPB_OFF) + impq * 128;
#pragma unroll
        for (int h2 = 0; h2 < 2; ++h2)
#pragma unroll
            for (int a4 = 0; a4 < 4; ++a4) {
                float qs = (p[h2][4 * a4] + p[h2][4 * a4 + 1]) + (p[h2][4 * a4 + 2] + p[h2][4 * a4 + 3]), last = p[h2][4 * a4 + 3];
                qs += dpp_xor1(qs); qs += dpp_xor2(qs); last += dpp_xor1(last); last += dpp_xor2(last);
                const int j = jbase + 8 * h2 + 2 * a4 + hi;
                if ((qc & 3) == 0) { IA[j] = qs; if (j + 1 < 128) IB[j + 1] = last; }
            }
    }
    bf16x8 pf[2][2];
#pragma unroll
    for (int h2 = 0; h2 < 2; ++h2)
#pragma unroll
        for (int s2 = 0; s2 < 2; ++s2) { v4u wv; wv.x = pg8::cvtpk_c(p[h2][8 * s2 + 0], p[h2][8 * s2 + 1]); wv.y = pg8::cvtpk_c(p[h2][8 * s2 + 2], p[h2][8 * s2 + 3]);
            wv.z = pg8::cvtpk_c(p[h2][8 * s2 + 4], p[h2][8 * s2 + 5]); wv.w = pg8::cvtpk_c(p[h2][8 * s2 + 6], p[h2][8 * s2 + 7]); pf[h2][s2] = __builtin_bit_cast(bf16x8, wv); }
#pragma unroll
    for (int h2 = 0; h2 < 2; ++h2)
#pragma unroll
        for (int s2 = 0; s2 < 2; ++s2)
#pragma unroll
            for (int d0_ = 0; d0_ < 2; ++d0_) {
                const v4i16 lo = vlo[d0_][h2][s2], hi4 = vhi[d0_][h2][s2];
                const bf16x8 av = (bf16x8){lo[0], lo[1], lo[2], lo[3], hi4[0], hi4[1], hi4[2], hi4[3]};
                o[d0_] = __builtin_amdgcn_mfma_f32_32x32x16_bf16(av, pf[h2][s2], o[d0_], 0, 0, 0);
            }
}
__device__ __forceinline__ void select13(const unsigned (&k0)[4], const unsigned (&k1)[4], const int lane, unsigned long long (&m0)[4], unsigned long long (&m1)[4]) {
    unsigned th[4] = {0u, 0u, 0u, 0u};
    for (int bit = 30; bit >= 0; --bit) {
#pragma unroll
        for (int u = 0; u < 4; ++u) { const unsigned cand = th[u] | (1u << bit); const int cnt = __popcll(__ballot(k0[u] >= cand)) + __popcll(__ballot(k1[u] >= cand)); th[u] = cnt >= 13 ? cand : th[u]; }
    }
#pragma unroll
    for (int u = 0; u < 4; ++u) {
        const unsigned long long gt0 = __ballot(k0[u] > th[u]), gt1 = __ballot(k1[u] > th[u]), eq0 = __ballot(k0[u] == th[u]), eq1 = __ballot(k1[u] == th[u]);
        const int need = 13 - __popcll(gt0) - __popcll(gt1);
        const int r0 = below(eq0), r1 = __popcll(eq0) + below(eq1);
        const bool s0 = (k0[u] > th[u]) || (k0[u] == th[u] && r0 < need), s1 = (k1[u] > th[u]) || (k1[u] == th[u] && r1 < need);
        m0[u] = __ballot(s0); m1[u] = __ballot(s1);
    }
}
}
__device__ __forceinline__ void nsa_attn_phase(Frame& F) {
    using namespace nsa;
    LAS unsigned char* lds = F.lds + RING_OFF;
    const int tid = F.tid, lane = F.lane, w = F.wave, hi = lane >> 5, qc = lane & 31;
    unsigned char* ws = F.ws;
    const bf16* Qp = (const bf16*)(ws + WS_Q); const float* GT = (const float*)(ws + WS_GT); bf16* Op = (bf16*)(ws + WS_O);
    LAS unsigned* SEL = (LAS unsigned*)(lds + SEL_OFF); LAS unsigned* UNI = (LAS unsigned*)(lds + UNI_OFF); LAS int* NSW = (LAS int*)(lds + NS_OFF); LAS int* SLIST = (LAS int*)(lds + SLIST_OFF);
    const int lrow = tid >> 3, lch = tid & 7;
    for (int un = F.wg; un < 1024; un += F.G) {
        const int bg = un & 7, cc = un >> 3, c = ((cc >> 5) & 1) ? (cc & ~31) + 31 - (cc & 31) : cc;
        const int b = bg >> 2, g = bg & 3, t0 = c * 64;
        const int tql = 8 * w + (qc >> 2), hh = qc & 3, t = t0 + tql, head = 4 * g + hh;
        const size_t mrow = (size_t)b * T + t;
        const float slope2 = __builtin_amdgcn_exp2f(-0.5f * (float)(head + 1)) * LOG2E;
        unsigned qaw1, qaw16;
        { const unsigned sh = f2bf(slope2); const float rem = slope2 - __uint_as_float(sh << 16); const unsigned sl = f2bf(rem);
          const unsigned sh16 = f2bf(16.f * __uint_as_float(sh << 16)), sl16 = f2bf(16.f * __uint_as_float(sl << 16));
          qaw1 = hi ? 0u : (sh | (sl << 16)); qaw16 = hi ? 0u : (sh16 | (sl16 << 16)); }
        bf16x8 qf[4];
#pragma unroll
        for (int ks = 0; ks < 4; ++ks) qf[ks] = *(const GAS bf16x8*)(Qp + mrow * 1024 + head * 64 + 16 * ks + 8 * hi);
        const float* gp = GT + mrow * 48 + (g * 4 + hh) * 3; const float g_cmp = gp[0], g_slc = gp[1], g_win = gp[2];
        const int nmax = (4 * c + 2) < 510 ? (4 * c + 2) : 510, ncb = nmax / 64 + 1;
        const int jw0 = c - 8 > 0 ? c - 8 : 0, nw = c - jw0 + 1, S3 = 2 * ncb + nw;
        const unsigned kcb = (unsigned)WS_KCMP + (unsigned)(b * 4 + g) * 65536u, kvb = ((unsigned)b * T * 256u + (unsigned)g * 64u) * 2u;
        int ns = 1;
#define NSA_FETCH(s, kr, vr) do { const int s_ = (s); unsigned sb_, dv_ = 0u; int tt_ = tid; asm volatile("" : "+v"(tt_));     \
            if (s_ < ncb) { sb_ = kcb + (unsigned)s_ * 8192u; } \
            else if (s_ < 2 * ncb) { sb_ = kcb + (unsigned)(s_ - ncb) * 8192u; dv_ = (unsigned)(WS_VCMP - WS_KCMP); } \
            else if (s_ < S3) { sb_ = (unsigned)WS_KW + kvb + (unsigned)(c - (s_ - 2 * ncb)) * 32768u; dv_ = (unsigned)(WS_VW - WS_KW); } \
            else { sb_ = (unsigned)WS_KS + kvb + (unsigned)__builtin_amdgcn_readfirstlane(SLIST[ns - 1 - (s_ - S3)]) * 32768u; dv_ = (unsigned)(WS_VS - WS_KS); } \
            const unsigned ko_ = sb_ + (unsigned)((tt_ >> 3) * (s_ < 2 * ncb ? 128 : 512) + (tt_ & 7) * 16); \
            kr = *(const GAS v4u*)(ws + ko_); vr = *(const GAS v4u*)(ws + ko_ + dv_); } while (0)
#define NSA_COMMIT(s, kr, vr) do { const int bo_ = ((s) & 1) * TILE_B + lrow * 144 + lch * 16; *(LAS v4u*)(lds + KB_OFF + bo_) = kr; if ((s) >= ncb) *(LAS v4u*)(lds + VB_OFF + bo_) = vr; } while (0)
        __syncthreads();
        if (c <= 15) {
            int ln = lane; asm volatile("" : "+v"(ln));
            if (ln < 8) { const int q = 8 * w + ln; SEL[q * 4 + 0] = (2u << c) - 1u; SEL[q * 4 + 1] = 0u; SEL[q * 4 + 2] = 0u; SEL[q * 4 + 3] = 0u; }
            if (w == 0 && ln <= c) SLIST[ln] = ln;
            ns = c + 1; }
        else if (tid < 4) UNI[tid] = 0u;
        int ST = S3 + ns;
        v4u krA = (v4u){0u, 0u, 0u, 0u}, vrA = krA;
        NSA_FETCH(0, krA, vrA); NSA_COMMIT(0, krA, vrA); NSA_FETCH(1, krA, vrA);
        asm volatile("s_waitcnt lgkmcnt(0)" ::: "memory"); __builtin_amdgcn_s_barrier(); asm volatile("" ::: "memory");
        float m = -1e30f, l = 0.f, rl = 0.f; f32x16 o[2]; unsigned otp[2][8];
#pragma unroll
        for (int r = 0; r < 16; ++r) { o[0][r] = 0.f; o[1][r] = 0.f; }
#pragma unroll
        for (int r = 0; r < 8; ++r) { otp[0][r] = 0u; otp[1][r] = 0u; }
#define NSA_PRE(s) const bool has_next = (s) + 1 < ST; \
        const int kt = KB_OFF + ((s) & 1) * TILE_B, vt = VB_OFF + ((s) & 1) * TILE_B
#define NSA_POST(s) do { if (has_next) NSA_COMMIT((s) + 1, krA, vrA); { const int sf_ = (s) + 2 < ST ? (s) + 2 : ST - 1; NSA_FETCH(sf_, krA, vrA); } asm volatile("s_waitcnt lgkmcnt(0)" ::: "memory"); __builtin_amdgcn_s_barrier(); asm volatile("" ::: "memory"); } while (0)
        int s = 0;
        for (; s < ncb; ++s) { NSA_PRE(s); const int pos0 = 1024 * s + 31;
            const float bias = slope2 * (float)(pos0 - t); const bool em = 1024 * s + 1039 > t0; const int d0 = t - pos0 - 64 * hi;
            tile<0>(lds, kt, vt, qf, qaw16, o, m, l, lane, bias, em, d0, 16, 0x7fffffff, 0.f, tql, 0);
            NSA_POST(s); }
        { const float lt0 = l + __shfl_xor(l, 32); rl = 1.0f / fmaxf(lt0, 1e-30f); }
        for (; s < 2 * ncb; ++s) { NSA_PRE(s); const int kb = s - ncb; const int pos0 = 1024 * kb + 31;
            const float bias = slope2 * (float)(pos0 - t); const bool em = 1024 * kb + 1039 > t0; const int d0 = t - pos0 - 64 * hi;
            tile<1>(lds, kt, vt, qf, qaw16, o, m, l, lane, bias, em, d0, 16, 0x7fffffff, rl, tql, 16 * kb);
            NSA_POST(s); }
        {
#pragma unroll
            for (int r = 0; r < 8; ++r) { otp[0][r] = pg8::cvtpk_c(g_cmp * o[0][2 * r], g_cmp * o[0][2 * r + 1]); otp[1][r] = pg8::cvtpk_c(g_cmp * o[1][2 * r], g_cmp * o[1][2 * r + 1]); }
#pragma unroll
            for (int r = 0; r < 16; ++r) { o[0][r] = 0.f; o[1][r] = 0.f; }
            m = -1e30f; l = 0.f; }
        if (c >= 16) {
                {
                    unsigned long long uo0 = 0ull, uo1 = 0ull;
                    for (int qi = 0; qi < 8; qi += 4) {
                        unsigned k0[4], k1[4]; unsigned long long m0[4], m1[4];
                        int lnq = lane; asm volatile("" : "+v"(lnq));
#pragma unroll
                        for (int u = 0; u < 4; ++u) { const int q = 8 * w + qi + u;
                            const LAS float* ia = (const LAS float*)(lds + IMPA_OFF) + q * 128; const LAS float* ib = (const LAS float*)(lds + IMPB_OFF) + q * 128;
                            const float v0 = ia[lnq] + ib[lnq], v1 = ia[lnq + 64] + ib[lnq + 64];
                            k0[u] = (lane >= 1 && lane <= c - 2) ? __float_as_uint(v0) + 1u : 0u; k1[u] = (lane + 64 <= c - 2) ? __float_as_uint(v1) + 1u : 0u; }
                        select13(k0, k1, lane, m0, m1);
#pragma unroll
                        for (int u = 0; u < 4; ++u) { const int q = 8 * w + qi + u;
                            m0[u] |= 1ull;
                            if (c - 1 < 64) m0[u] |= 1ull << (c - 1); else m1[u] |= 1ull << (c - 1 - 64);
                            if (c < 64) m0[u] |= 1ull << c; else m1[u] |= 1ull << (c - 64);
                            uo0 |= m0[u]; uo1 |= m1[u];
                            if (lane == 0) { SEL[q * 4 + 0] = (unsigned)m0[u]; SEL[q * 4 + 1] = (unsigned)(m0[u] >> 32); SEL[q * 4 + 2] = (unsigned)m1[u]; SEL[q * 4 + 3] = (unsigned)(m1[u] >> 32); } }
                    }
                    if (lane == 0) { __hip_atomic_fetch_or(UNI + 0, (unsigned)uo0, __ATOMIC_RELAXED, __HIP_MEMORY_SCOPE_WORKGROUP); __hip_atomic_fetch_or(UNI + 1, (unsigned)(uo0 >> 32), __ATOMIC_RELAXED, __HIP_MEMORY_SCOPE_WORKGROUP);
                        __hip_atomic_fetch_or(UNI + 2, (unsigned)uo1, __ATOMIC_RELAXED, __HIP_MEMORY_SCOPE_WORKGROUP); __hip_atomic_fetch_or(UNI + 3, (unsigned)(uo1 >> 32), __ATOMIC_RELAXED, __HIP_MEMORY_SCOPE_WORKGROUP); }
                }
                __syncthreads();
                if (w == 0) {
                    const unsigned long long u0 = (unsigned long long)UNI[0] | ((unsigned long long)UNI[1] << 32), u1 = (unsigned long long)UNI[2] | ((unsigned long long)UNI[3] << 32);
                    if ((u0 >> lane) & 1ull) SLIST[below(u0)] = lane;
                    if ((u1 >> lane) & 1ull) SLIST[__popcll(u0) + below(u1)] = 64 + lane;
                    if (lane == 0) NSW[0] = __popcll(u0) + __popcll(u1);
                }
                __syncthreads();
                ns = __builtin_amdgcn_readfirstlane(NSW[0]); ST = S3 + ns;
        }
        for (; s < S3; ++s) { NSA_PRE(s); const int j = c - (s - 2 * ncb); const float bias = slope2 * (float)(64 * j - t);
            const bool em = (j == c) || (c >= 8 && j == c - 8);
            tile<2>(lds, kt, vt, qf, qaw1, o, m, l, lane, bias, em, t - 64 * j - 4 * hi, 1, 512, 0.f, 0, 0);
            NSA_POST(s); }
        { const float lt = l + __shfl_xor(l, 32); const float sc = g_win / fmaxf(lt, 1e-30f);
#pragma unroll
            for (int r = 0; r < 8; ++r) { otp[0][r] = pg8::cvtpk_c(__uint_as_float(otp[0][r] << 16) + sc * o[0][2 * r], __uint_as_float(otp[0][r] & 0xffff0000u) + sc * o[0][2 * r + 1]);
                otp[1][r] = pg8::cvtpk_c(__uint_as_float(otp[1][r] << 16) + sc * o[1][2 * r], __uint_as_float(otp[1][r] & 0xffff0000u) + sc * o[1][2 * r + 1]); }
#pragma unroll
            for (int r = 0; r < 16; ++r) { o[0][r] = 0.f; o[1][r] = 0.f; }
            m = -1e30f; l = 0.f; }
        for (; s < ST; ++s) { NSA_PRE(s); const int j = SLIST[ns - 1 - (s - S3)]; const bool selq = (SEL[tql * 4 + (j >> 5)] >> (j & 31)) & 1u;
            const float bias = selq ? slope2 * (float)(64 * j - t) : -INFINITY;
            tile<2>(lds, kt, vt, qf, qaw1, o, m, l, lane, bias, j == c, t - 64 * j - 4 * hi, 1, 0x7fffffff, 0.f, 0, 0);
            NSA_POST(s); }
#undef NSA_PRE
#undef NSA_POST
        { const float lt = l + __shfl_xor(l, 32); const float sc = g_slc / fmaxf(lt, 1e-30f);
          bf16* orow = Op + mrow * 1024 + head * 64;
#pragma unroll
          for (int d0 = 0; d0 < 2; ++d0)
#pragma unroll
              for (int a4 = 0; a4 < 4; ++a4) { const unsigned p0_ = otp[d0][2 * a4], p1_ = otp[d0][2 * a4 + 1]; v2u wv;
                  wv.x = pg8::cvtpk_c(__uint_as_float(p0_ << 16) + sc * o[d0][4 * a4], __uint_as_float(p0_ & 0xffff0000u) + sc * o[d0][4 * a4 + 1]);
                  wv.y = pg8::cvtpk_c(__uint_as_float(p1_ << 16) + sc * o[d0][4 * a4 + 2], __uint_as_float(p1_ & 0xffff0000u) + sc * o[d0][4 * a4 + 3]);
                  *(GAS v2u*)(orow + 32 * d0 + 8 * a4 + 4 * hi) = wv; } }
#undef NSA_FETCH
#undef NSA_COMMIT
    }
}

__device__ __forceinline__ f32x4 bf4(const v2u a) { return (f32x4){__uint_as_float(a.x << 16), __uint_as_float(a.x & 0xffff0000u), __uint_as_float(a.y << 16), __uint_as_float(a.y & 0xffff0000u)}; }
__device__ __forceinline__ void ln_rows(Frame& F, const bf16* tin, const float* gain, const float* bias, bf16* xb) {
    const int gw = F.vcu * NWAVES + F.wave, NGW = F.G * NWAVES, lane = F.lane;
    f32x4 gv[4], bv[4];
#pragma unroll
    for (int j = 0; j < 4; ++j) { gv[j] = *((const GAS f32x4*)gain + lane + 64 * j); bv[j] = *((const GAS f32x4*)bias + lane + 64 * j); }
    for (int m0 = gw; m0 < M; m0 += 8 * NGW) {
        v2u raw[8][4];
#pragma unroll
        for (int k = 0; k < 8; ++k) { const int m = m0 + k * NGW; if (m < M) { const GAS v2u* xr = (const GAS v2u*)(tin + (size_t)m * D) + lane;
#pragma unroll
            for (int j = 0; j < 4; ++j) raw[k][j] = xr[64 * j]; } }
#pragma unroll
        for (int k = 0; k < 8; ++k) { const int m = m0 + k * NGW; if (m >= M) break;
            f32x4 v[4]; float s = 0.f;
#pragma unroll
            for (int j = 0; j < 4; ++j) { v[j] = bf4(raw[k][j]); s += (v[j].x + v[j].y) + (v[j].z + v[j].w); }
            const float mean = wave_sum(s) * (1.f / D); float s2 = 0.f;
#pragma unroll
            for (int j = 0; j < 4; ++j) { v[j] = v[j] - mean; s2 += (v[j].x * v[j].x + v[j].y * v[j].y) + (v[j].z * v[j].z + v[j].w * v[j].w); }
            const float rstd = 1.f / sqrtf(wave_sum(s2) * (1.f / D) + LN_EPS);
            GAS unsigned long long* o8 = (GAS unsigned long long*)(xb + (size_t)m * D) + lane;
#pragma unroll
            for (int j = 0; j < 4; ++j) { const f32x4 y = v[j] * rstd * gv[j] + bv[j]; o8[64 * j] = (unsigned long long)pk2(y.x, y.y) | ((unsigned long long)pk2(y.z, y.w) << 32); }
        }
    }
}
namespace gla {
constexpr int ALS_OFF = 0, SEG_OFF = 4096, KH_OFF = 8192, KH_STR = 272, VH1_OFF = KH_OFF + 64 * KH_STR, VH_STR = 528, ZL_OFF = VH1_OFF + 64 * VH_STR, ZL_STR = 272;
constexpr int QS_OFF = 0, QS_STR = 272, AL_OFF = 64 * QS_STR, AL_STR = 144, VH3_OFF = AL_OFF + 64 * AL_STR, ST_OFF = VH3_OFF + 64 * VH_STR, ST_STR = 272, QT_OFF = ST_OFF, KT_OFF = ST_OFF + 64 * QS_STR, SSQ_OFF = ST_OFF + 256 * ST_STR;
constexpr int OL_OFF = ST_OFF, OL_STR = 1040;
static_assert(SSQ_OFF + 1024 <= RING_BYTES && ZL_OFF + 256 * ZL_STR <= RING_BYTES && KT_OFF + 64 * QS_STR <= SSQ_OFF && OL_OFF + 64 * OL_STR <= SSQ_OFF, "gla LDS map");
__device__ __forceinline__ bf16x8 trfrag(const LAS unsigned char* p, int rowstep4) { const v4i16 lo = vtr(p), hi4 = vtr(p + rowstep4); return (bf16x8){lo[0], lo[1], lo[2], lo[3], hi4[0], hi4[1], hi4[2], hi4[3]}; }
}
__device__ __forceinline__ void gla_load_v(LAS unsigned char* lds, int off, const bf16* qkvg, size_t m0, int vcol0, int tid) {
#pragma unroll
    for (int k = 0; k < 4; ++k) { const int q = tid + 512 * k, row = q >> 5, ch = q & 31;
        const v4u v = *(const GAS v4u*)(qkvg + (m0 + row) * 3072 + vcol0 + ch * 8); *(LAS v4u*)(lds + off + row * gla::VH_STR + ch * 16) = v; }
}
__device__ __forceinline__ void gla_g1(Frame& F) {
    using namespace gla;
    LAS unsigned char* lds = F.lds + RING_OFF; const int tid = F.tid, lane = F.lane, w = F.wave, hi = lane >> 5, qc = lane & 31;
    unsigned char* ws = F.ws; const bf16* qkvg = (const bf16*)(ws + WS_QKVG); const bf16* xbrows = (const bf16*)(ws + WS_XB); const bf16* wat = (const bf16*)(ws + WS_WIN1) + (size_t)3072 * 1024;
    float* bcum = (float*)(ws + WS_BCUM); bf16* zb = (bf16*)(ws + WS_ZB); float* dec = (float*)(ws + WS_DEC);
    const float* wg2 = inptr(F, 16); const float* bg2 = inptr(F, 17);
    LAS float* ALS = (LAS float*)(lds + ALS_OFF); LAS float* SEG = (LAS float*)(lds + SEG_OFF);
    const int d = tid & 127, ig = tid >> 7;
    for (int un = F.wg; un < 1024; un += F.G) {
        const int bh = un >> 7, n = un & 127, b = bh >> 2, h = bh & 3; const size_t m0 = (size_t)b * T + 64 * n;
        __syncthreads();
        { typedef float f32x4_ __attribute__((ext_vector_type(4)));
          const bf16* xbp = xbrows + (m0 + (lane & 15)) * 1024 + 128 * w + 8 * (lane >> 4); const bf16* wbp = wat + (size_t)(lane & 15) * 1024 + 128 * w + 8 * (lane >> 4);
          bf16x8 bq[4], aq[4][4];
#pragma unroll
          for (int ks = 0; ks < 4; ++ks) bq[ks] = *(const GAS bf16x8*)(wbp + 32 * ks);
#pragma unroll
          for (int rb = 0; rb < 4; ++rb)
#pragma unroll
              for (int ks = 0; ks < 4; ++ks) aq[rb][ks] = *(const GAS bf16x8*)(xbp + (size_t)rb * 16 * 1024 + 32 * ks);
          LAS float* PART = (LAS float*)(lds + ZL_OFF) + w * 1024;
#pragma unroll
          for (int rb = 0; rb < 4; ++rb) { f32x4_ pa = (f32x4_){0.f, 0.f, 0.f, 0.f};
#pragma unroll
              for (int ks = 0; ks < 4; ++ks) pa = __builtin_amdgcn_mfma_f32_16x16x32_bf16(aq[rb][ks], bq[ks], pa, 0, 0, 0);
#pragma unroll
              for (int j = 0; j < 4; ++j) PART[(16 * rb + 4 * (lane >> 4) + j) * 16 + (lane & 15)] = pa[j]; } }
        gla_load_v(lds, VH1_OFF, qkvg, m0, 1024 + h * 256, tid);
        bf16 kraw[16];
#pragma unroll
        for (int ii = 0; ii < 16; ++ii) kraw[ii] = *(const GAS bf16*)(qkvg + (m0 + 16 * ig + ii) * 3072 + 512 + h * 128 + d);
        float wg[16];
#pragma unroll
        for (int r = 0; r < 16; ++r) wg[r] = wg2[r * 512 + h * 128 + d];
        const float bgv = bg2[h * 128 + d];
        __syncthreads();
        { const LAS float* P0 = (const LAS float*)(lds + ZL_OFF) + 2 * tid; float s0 = 0.f, s1 = 0.f;
#pragma unroll
          for (int k = 0; k < 8; ++k) { s0 += P0[k * 1024]; s1 += P0[k * 1024 + 1]; }
          ALS[2 * tid] = s0; ALS[2 * tid + 1] = s1; }
        __syncthreads();
        float cs[16]; float run = 0.f;
#pragma unroll
        for (int ii = 0; ii < 16; ++ii) { const int i = 16 * ig + ii; float z = bgv;
#pragma unroll
            for (int r = 0; r < 16; ++r) z += ALS[i * 16 + r] * wg[r];
            const float la = (fminf(z, 0.f) - __logf(1.f + __expf(-fabsf(z)))) * (1.f / 16.f);
            run += la; cs[ii] = run; }
        SEG[ig * 128 + d] = run;
        __syncthreads();
        float pre = 0.f, tot = 0.f;
#pragma unroll
        for (int k = 0; k < 4; ++k) { const float sv = SEG[k * 128 + d]; if (k < ig) pre += sv; tot += sv; }
#pragma unroll
        for (int ii = 0; ii < 16; ++ii) { const int i = 16 * ig + ii; cs[ii] += pre;
            *(LAS bf16*)(lds + KH_OFF + i * KH_STR + d * 2) = (bf16)f2bf(bf2f(kraw[ii]) * __expf(tot - cs[ii])); }
#pragma unroll
        for (int ii = 0; ii < 16; ++ii) *(GAS float*)(bcum + (m0 + 16 * ig + ii) * 512 + h * 128 + d) = cs[ii];
        if (ig == 0) dec[(size_t)(bh * 128 + n) * 128 + d] = __expf(tot);
        __syncthreads();
        f32x16 acc[4];
#pragma unroll
        for (int db = 0; db < 4; ++db)
#pragma unroll
            for (int r = 0; r < 16; ++r) acc[db][r] = 0.f;
        const int a = (lane >> 4) & 1, q_ = (lane & 15) >> 2, p_ = lane & 3;
#pragma unroll
        for (int s = 0; s < 4; ++s) {
            const bf16x8 bfr = trfrag(lds + VH1_OFF + (16 * s + 8 * hi + q_) * VH_STR + (32 * w + 16 * a + 4 * p_) * 2, 4 * VH_STR);
#pragma unroll
            for (int db = 0; db < 4; ++db) { const bf16x8 afr = trfrag(lds + KH_OFF + (16 * s + 8 * hi + q_) * KH_STR + (32 * db + 16 * a + 4 * p_) * 2, 4 * KH_STR);
                acc[db] = __builtin_amdgcn_mfma_f32_32x32x16_bf16(afr, bfr, acc[db], 0, 0, 0); }
        }
#pragma unroll
        for (int db = 0; db < 4; ++db)
#pragma unroll
            for (int a4 = 0; a4 < 4; ++a4) { v2u wv; wv.x = pg8::cvtpk_c(acc[db][4 * a4], acc[db][4 * a4 + 1]); wv.y = pg8::cvtpk_c(acc[db][4 * a4 + 2], acc[db][4 * a4 + 3]);
                *(LAS v2u*)(lds + ZL_OFF + (32 * w + qc) * ZL_STR + (32 * db + 8 * a4 + 4 * hi) * 2) = wv; }
        __syncthreads();
        { bf16* zu = zb + (size_t)(bh * 128 + n) * 256 * 128;
#pragma unroll
          for (int k = 0; k < 8; ++k) { const int q = tid + 512 * k, row = q >> 4, ch = q & 15; *(GAS v4u*)(zu + row * 128 + ch * 8) = *(const LAS v4u*)(lds + ZL_OFF + row * ZL_STR + ch * 16); } }
    }
}
__device__ __forceinline__ void gla_g2(Frame& F) {
    unsigned char* ws = F.ws; const bf16* zb = (const bf16*)(ws + WS_ZB); const float* dec = (const float*)(ws + WS_DEC); bf16* sst = (bf16*)(ws + WS_SST);
    for (int p = F.wg * 512 + F.tid; p < 131072; p += F.G * 512) {
        const int bh = p >> 14, e = (p >> 6) & 255, d2 = p & 63;
        float s0 = 0.f, s1 = 0.f;
        for (int n0 = 0; n0 < 128; n0 += 8) {
            pg8::f32x2 dv[8]; unsigned zz[8];
#pragma unroll
            for (int k = 0; k < 8; ++k) { const size_t cn = (size_t)(bh * 128 + n0 + k); dv[k] = *(const GAS pg8::f32x2*)(dec + cn * 128 + 2 * d2); zz[k] = *(const GAS unsigned*)(zb + (cn * 256 + e) * 128 + 2 * d2); }
#pragma unroll
            for (int k = 0; k < 8; ++k) { const size_t cn = (size_t)(bh * 128 + n0 + k);
                *(GAS unsigned*)(sst + (cn * 256 + e) * 128 + 2 * d2) = pk2(s0, s1);
                s0 = s0 * dv[k].x + __uint_as_float(zz[k] << 16); s1 = s1 * dv[k].y + __uint_as_float(zz[k] & 0xffff0000u); }
        }
    }
}
__device__ __forceinline__ void gla_g3(Frame& F) {
    using namespace gla;
    LAS unsigned char* lds = F.lds + RING_OFF; const int tid = F.tid, lane = F.lane, w = F.wave, hi = lane >> 5, qc = lane & 31;
    unsigned char* ws = F.ws; const bf16* qkvg = (const bf16*)(ws + WS_QKVG); const float* bcum = (const float*)(ws + WS_BCUM); const bf16* sst = (const bf16*)(ws + WS_SST);
    bf16* o1 = (bf16*)(ws + WS_O1); const float* hng = inptr(F, 18);
    LAS float* SSQ = (LAS float*)(lds + SSQ_OFF);
    const int d = tid & 127, ig = tid >> 7;
    const int a = (lane >> 4) & 1, q_ = (lane & 15) >> 2, p_ = lane & 3;
    for (int un = F.wg; un < 1024; un += F.G) {
        const int bh = un >> 7, n = un & 127, b = bh >> 2, h = bh & 3; const size_t m0 = (size_t)b * T + 64 * n;
        __syncthreads();
        gla_load_v(lds, VH3_OFF, qkvg, m0, 1024 + h * 256, tid);
        v4u sreg[8];
        { const bf16* sp = sst + (size_t)(bh * 128 + n) * 256 * 128;
#pragma unroll
          for (int k = 0; k < 8; ++k) { const int q = tid + 512 * k, row = q >> 4, ch = q & 15; sreg[k] = *(const GAS v4u*)(sp + row * 128 + ch * 8); } }
        { const float bref = bcum[(m0 + 32) * 512 + h * 128 + d];
          float bb[16]; bf16 qr[16], kr[16];
#pragma unroll
          for (int ii = 0; ii < 16; ++ii) { const size_t mi = m0 + 16 * ig + ii; bb[ii] = *(const GAS float*)(bcum + mi * 512 + h * 128 + d);
              qr[ii] = *(const GAS bf16*)(qkvg + mi * 3072 + h * 128 + d); kr[ii] = *(const GAS bf16*)(qkvg + mi * 3072 + 512 + h * 128 + d); }
#pragma unroll
          for (int ii = 0; ii < 16; ++ii) { const int i = 16 * ig + ii; const float qv = bf2f(qr[ii]), kv = bf2f(kr[ii]);
              *(LAS bf16*)(lds + QT_OFF + i * QS_STR + d * 2) = (bf16)f2bf(qv * __expf(bb[ii] - bref));
              *(LAS bf16*)(lds + KT_OFF + i * QS_STR + d * 2) = (bf16)f2bf(kv * __expf(bref - bb[ii]));
              *(LAS bf16*)(lds + QS_OFF + i * QS_STR + d * 2) = (bf16)f2bf(qv * __expf(bb[ii])); } }
        __syncthreads();
        if (w < 4) {
            const int jb = w >> 1, ib = w & 1; f32x16 acc;
#pragma unroll
            for (int r = 0; r < 16; ++r) acc[r] = 0.f;
#pragma unroll
            for (int s = 0; s < 8; ++s) { const bf16x8 afr = *(const LAS bf16x8*)(lds + KT_OFF + (32 * jb + qc) * QS_STR + 32 * s + 16 * hi), bfr = *(const LAS bf16x8*)(lds + QT_OFF + (32 * ib + qc) * QS_STR + 32 * s + 16 * hi);
                acc = __builtin_amdgcn_mfma_f32_32x32x16_bf16(afr, bfr, acc, 0, 0, 0); }
            const int i = 32 * ib + qc;
#pragma unroll
            for (int a4 = 0; a4 < 4; ++a4) { float v[4];
#pragma unroll
                for (int k = 0; k < 4; ++k) { const int j = 32 * jb + 8 * a4 + 4 * hi + k; v[k] = (j <= i) ? acc[4 * a4 + k] : 0.f; }
                v2u wv; wv.x = pg8::cvtpk_c(v[0], v[1]); wv.y = pg8::cvtpk_c(v[2], v[3]);
                *(LAS v2u*)(lds + AL_OFF + i * AL_STR + (32 * jb + 8 * a4 + 4 * hi) * 2) = wv; }
        }
        __syncthreads();
#pragma unroll
        for (int k = 0; k < 8; ++k) { const int q = tid + 512 * k, row = q >> 4, ch = q & 15; *(LAS v4u*)(lds + ST_OFF + row * ST_STR + ch * 16) = sreg[k]; }
        v4u ggr[4];
#pragma unroll
        for (int k = 0; k < 4; ++k) { const int q = tid + 512 * k, row = q >> 5, ch = q & 31; ggr[k] = *(const GAS v4u*)(qkvg + (m0 + row) * 3072 + 2048 + h * 256 + ch * 8); }
        __syncthreads();
        const int ib = w & 1, eq = w >> 1; f32x16 acc2[2];
#pragma unroll
        for (int r = 0; r < 16; ++r) { acc2[0][r] = 0.f; acc2[1][r] = 0.f; }
#pragma unroll
        for (int s = 0; s < 4; ++s) { const bf16x8 bfr = *(const LAS bf16x8*)(lds + AL_OFF + (32 * ib + qc) * AL_STR + 32 * s + 16 * hi);
#pragma unroll
            for (int e2 = 0; e2 < 2; ++e2) { const bf16x8 afr = trfrag(lds + VH3_OFF + (16 * s + 8 * hi + q_) * VH_STR + (32 * (2 * eq + e2) + 16 * a + 4 * p_) * 2, 4 * VH_STR);
                acc2[e2] = __builtin_amdgcn_mfma_f32_32x32x16_bf16(afr, bfr, acc2[e2], 0, 0, 0); } }
#pragma unroll
        for (int s = 0; s < 8; ++s) { const bf16x8 bfr = *(const LAS bf16x8*)(lds + QS_OFF + (32 * ib + qc) * QS_STR + 32 * s + 16 * hi);
#pragma unroll
            for (int e2 = 0; e2 < 2; ++e2) { const bf16x8 afr = *(const LAS bf16x8*)(lds + ST_OFF + (32 * (2 * eq + e2) + qc) * ST_STR + 32 * s + 16 * hi);
                acc2[e2] = __builtin_amdgcn_mfma_f32_32x32x16_bf16(afr, bfr, acc2[e2], 0, 0, 0); } }
        float ss = 0.f;
#pragma unroll
        for (int r = 0; r < 16; ++r) ss += acc2[0][r] * acc2[0][r] + acc2[1][r] * acc2[1][r];
        ss += __shfl_xor(ss, 32);
        const int i = 32 * ib + qc;
        if (hi == 0) SSQ[i * 4 + eq] = ss;
        __syncthreads();
#pragma unroll
        for (int e2 = 0; e2 < 2; ++e2)
#pragma unroll
            for (int a4 = 0; a4 < 4; ++a4) *(LAS f32x4*)(lds + OL_OFF + i * OL_STR + (32 * (2 * eq + e2) + 8 * a4 + 4 * hi) * 4) = (f32x4){acc2[e2][4 * a4], acc2[e2][4 * a4 + 1], acc2[e2][4 * a4 + 2], acc2[e2][4 * a4 + 3]};
        __syncthreads();
#pragma unroll
        for (int k = 0; k < 4; ++k) { const int q = tid + 512 * k, row = q >> 5, ch = q & 31;
            const float tot = (SSQ[row * 4 + 0] + SSQ[row * 4 + 1]) + (SSQ[row * 4 + 2] + SSQ[row * 4 + 3]); const float rstd = 1.f / sqrtf(tot * (1.f / 256.f) + RMS_EPS);
            const f32x4 oa = *(const LAS f32x4*)(lds + OL_OFF + row * OL_STR + ch * 32), ob = *(const LAS f32x4*)(lds + OL_OFF + row * OL_STR + ch * 32 + 16);
            const v4u gg = ggr[k];
            const f32x4 na = *(const GAS f32x4*)(hng + h * 256 + ch * 8), nb = *(const GAS f32x4*)(hng + h * 256 + ch * 8 + 4);
            const float g0 = __uint_as_float(gg.x << 16), g1 = __uint_as_float(gg.x & 0xffff0000u), g2 = __uint_as_float(gg.y << 16), g3 = __uint_as_float(gg.y & 0xffff0000u);
            const float g4 = __uint_as_float(gg.z << 16), g5 = __uint_as_float(gg.z & 0xffff0000u), g6 = __uint_as_float(gg.w << 16), g7 = __uint_as_float(gg.w & 0xffff0000u);
            v4u wv; wv.x = pg8::cvtpk_c(oa[0] * rstd * na[0] * pg8::silu1(g0), oa[1] * rstd * na[1] * pg8::silu1(g1)); wv.y = pg8::cvtpk_c(oa[2] * rstd * na[2] * pg8::silu1(g2), oa[3] * rstd * na[3] * pg8::silu1(g3));
            wv.z = pg8::cvtpk_c(ob[0] * rstd * nb[0] * pg8::silu1(g4), ob[1] * rstd * nb[1] * pg8::silu1(g5)); wv.w = pg8::cvtpk_c(ob[2] * rstd * nb[2] * pg8::silu1(g6), ob[3] * rstd * nb[3] * pg8::silu1(g7));
            *(GAS v4u*)(o1 + (m0 + row) * 1024 + h * 256 + ch * 8) = wv; }
    }
}
__device__ __forceinline__ void ln_router(Frame& F, const bf16* tin, const float* gain, const float* bias, bf16* xb) {
    LAS unsigned char* lds = F.lds + RING_OFF; const int lane = F.lane, w = F.wave;
    unsigned char* ws = F.ws; const float* wr = inptr(F, 22);
    int* toke = (int*)(ws + WS_TOKE); float* tokw = (float*)(ws + WS_TOKW); int* tokp = (int*)(ws + WS_TOKP); int* cntl = (int*)(ws + WS_CNTL);
    const int RPW = M / F.G, RPV = RPW / NWAVES;
    LAS int* EL = (LAS int*)lds;
    f32x4 gv[4], bv[4];
#pragma unroll
    for (int j = 0; j < 4; ++j) { gv[j] = *((const GAS f32x4*)gain + lane + 64 * j); bv[j] = *((const GAS f32x4*)bias + lane + 64 * j); }
    LAS float* WL = (LAS float*)(lds + 1024); LAS float* WL1 = WL + 4096;
    __syncthreads();
    for (int c = F.tid; c < D; c += NWAVES * 64) { const f32x4 w0 = *(const GAS f32x4*)(wr + (size_t)c * 8), w1 = *(const GAS f32x4*)(wr + (size_t)c * 8 + 4);
        const int rec = (4 * (c >> 8) + (c & 3)) * 64 + ((c & 255) >> 2); *(LAS f32x4*)(WL + rec * 4) = w0; *(LAS f32x4*)(WL1 + rec * 4) = w1; }
    v2u raw[8][4];
#pragma unroll
    for (int rr = 0; rr < 8; ++rr) if (rr < RPV) { const GAS v2u* xr = (const GAS v2u*)(tin + (size_t)(F.wg * RPW + w * RPV + rr) * D) + lane;
#pragma unroll
        for (int j = 0; j < 4; ++j) raw[rr][j] = xr[64 * j]; }
    __syncthreads();
#pragma unroll
    for (int rr = 0; rr < 8; rr += 2) { if (rr >= RPV) break;
        f32x4 v[2][4]; float rstd[2]; float lg[2][8];
#pragma unroll
        for (int h = 0; h < 2; ++h) { float s = 0.f;
#pragma unroll
            for (int j = 0; j < 4; ++j) { v[h][j] = bf4(raw[rr + h][j]); s += (v[h][j].x + v[h][j].y) + (v[h][j].z + v[h][j].w); }
            const float mean = wave_sum(s) * (1.f / D); float s2 = 0.f;
#pragma unroll
            for (int j = 0; j < 4; ++j) { v[h][j] = v[h][j] - mean; s2 += (v[h][j].x * v[h][j].x + v[h][j].y * v[h][j].y) + (v[h][j].z * v[h][j].z + v[h][j].w * v[h][j].w); }
            rstd[h] = 1.f / sqrtf(wave_sum(s2) * (1.f / D) + LN_EPS);
#pragma unroll
            for (int e = 0; e < 8; ++e) lg[h][e] = 0.f; }
#pragma unroll
        for (int j = 0; j < 4; ++j) { f32x4 y[2];
#pragma unroll
            for (int h = 0; h < 2; ++h) { const int m = F.wg * RPW + w * RPV + rr + h; y[h] = v[h][j] * rstd[h] * gv[j] + bv[j];
                if (rr + h < RPV) ((GAS unsigned long long*)(xb + (size_t)m * D) + lane)[64 * j] = (unsigned long long)pk2(y[h].x, y[h].y) | ((unsigned long long)pk2(y[h].z, y[h].w) << 32); }
#pragma unroll
            for (int k = 0; k < 4; ++k) { const int ro = ((4 * j + k) * 64 + lane) * 4; const f32x4 w0 = *(const LAS f32x4*)(WL + ro), w1 = *(const LAS f32x4*)(WL1 + ro);
#pragma unroll
                for (int h = 0; h < 2; ++h) { const float yk = y[h][k];
                    lg[h][0] += yk * w0[0]; lg[h][1] += yk * w0[1]; lg[h][2] += yk * w0[2]; lg[h][3] += yk * w0[3]; lg[h][4] += yk * w1[0]; lg[h][5] += yk * w1[1]; lg[h][6] += yk * w1[2]; lg[h][7] += yk * w1[3]; } } }
#pragma unroll
        for (int h = 0; h < 2; ++h) { if (rr + h >= RPV) break;
            const int lr = w * RPV + rr + h, m = F.wg * RPW + lr;
#pragma unroll
            for (int e = 0; e < 8; ++e) lg[h][e] = wave_sum(lg[h][e]);
            int e1 = 0; float v1 = lg[h][0];
#pragma unroll
            for (int e = 1; e < 8; ++e) if (lg[h][e] > v1) { v1 = lg[h][e]; e1 = e; }
            int e2 = -1; float v2 = -3.4e38f;
#pragma unroll
            for (int e = 0; e < 8; ++e) if (e != e1 && lg[h][e] > v2) { v2 = lg[h][e]; e2 = e; }
            const float w2 = 1.f / (1.f + __expf(v1 - v2)), w1 = 1.f - w2;
            if (lane == 0) { toke[m * 2] = e1; toke[m * 2 + 1] = e2; tokw[m * 2] = w1; tokw[m * 2 + 1] = w2; EL[lr] = e1; EL[RPW + lr] = e2; } }
    }
    __syncthreads();
    if (w == 0) {
        const bool act = lane < RPW; int base[8];
#pragma unroll
        for (int e = 0; e < 8; ++e) base[e] = 0;
        const unsigned long long ltm = (1ull << lane) - 1ull;
#pragma unroll
        for (int k = 0; k < 2; ++k) { const int ek = act ? EL[k * RPW + lane] : -1; int pos = 0;
#pragma unroll
            for (int e = 0; e < 8; ++e) { const unsigned long long mk = __ballot(ek == e); if (ek == e) pos = base[e] + __popcll(mk & ltm); base[e] += __popcll(mk); }
            if (act) tokp[(F.wg * RPW + lane) * 2 + k] = pos; }
        if (lane < 8) { int cv = 0;
#pragma unroll
            for (int e = 0; e < 8; ++e) if (lane == e) cv = base[e];
            cntl[F.wg * 8 + lane] = cv; }
    }
}
__device__ __forceinline__ void moe_tables(Frame& F) {
    LAS int* TP = (LAS int*)(F.lds + LDSCTL_OFF); LAS int* BASE = TP + 16; LAS int* ACC = TP + 32;
    const int* cntl = (const int*)(F.ws + WS_CNTL);
    __syncthreads();
    if (F.tid < 16) ACC[F.tid] = 0;
    __syncthreads();
    int tot = 0, pre = 0; const int e = F.tid & 7;
    for (int wq = F.tid >> 3; wq < F.G; wq += 64) { const int cv = __hip_atomic_load(cntl + wq * 8 + e, __ATOMIC_RELAXED, __HIP_MEMORY_SCOPE_AGENT); tot += cv; if (wq < F.wg) pre += cv; }
    __hip_atomic_fetch_add(ACC + e, tot, __ATOMIC_RELAXED, __HIP_MEMORY_SCOPE_WORKGROUP); __hip_atomic_fetch_add(ACC + 8 + e, pre, __ATOMIC_RELAXED, __HIP_MEMORY_SCOPE_WORKGROUP);
    __syncthreads();
    if (F.tid == 0) { int tp = 0;
        for (int k = 0; k < 8; ++k) { TP[k] = tp; BASE[k] = tp * 256 + ACC[8 + k]; tp += (ACC[k] + 255) >> 8; }
        TP[8] = tp; }
    __syncthreads();
}
__device__ __forceinline__ void moe_gather(Frame& F) {
    moe_tables(F);
    LAS int* BASE = (LAS int*)(F.lds + LDSCTL_OFF) + 16;
    unsigned char* ws = F.ws; const int* toke = (const int*)(ws + WS_TOKE); const int* tokp = (const int*)(ws + WS_TOKP); int* toks = (int*)(ws + WS_TOKS);
    const bf16* xb = (const bf16*)(ws + WS_XB); bf16* xg = (bf16*)(ws + WS_XG);
    const int RPW = M / F.G;
    for (int q0 = F.wave; q0 < 2 * RPW; q0 += 4 * NWAVES) {
        int mm[4], sl[4]; v4u ra[4], rb[4];
#pragma unroll
        for (int u = 0; u < 4; ++u) { const int q = q0 + u * NWAVES; const bool ok = q < 2 * RPW; const int m = F.wg * RPW + (q >> 1), k = q & 1; mm[u] = ok ? m * 2 + k : -1;
            const int e = ok ? toke[m * 2 + k] : 0; sl[u] = BASE[e] + (ok ? tokp[m * 2 + k] : 0); }
#pragma unroll
        for (int u = 0; u < 4; ++u) if (mm[u] >= 0) { const GAS v4u* src = (const GAS v4u*)(xb + (size_t)(mm[u] >> 1) * D) + F.lane; ra[u] = src[0]; rb[u] = src[64]; }
#pragma unroll
        for (int u = 0; u < 4; ++u) if (mm[u] >= 0) { if (F.lane == 0) toks[mm[u]] = sl[u]; GAS v4u* dst = (GAS v4u*)(xg + (size_t)sl[u] * D) + F.lane; dst[0] = ra[u]; dst[64] = rb[u]; }
    }
}
__device__ __forceinline__ void moe_final(Frame& F) {
    const int gw = F.vcu * NWAVES + F.wave, NGW = F.G * NWAVES, lane = F.lane;
    unsigned char* ws = F.ws; const bf16* xres = (const bf16*)(ws + WS_XB); const bf16* yb = (const bf16*)(ws + WS_YB); constexpr size_t KSTR = (WS_YB1 - WS_YB) / 2;
    const int* toks = (const int*)(ws + WS_TOKS); const float* tokw = (const float*)(ws + WS_TOKW); const float* gain = inptr(F, 25); const float* bias = inptr(F, 26);
    f32x4 gv[4], bv[4];
#pragma unroll
    for (int j = 0; j < 4; ++j) { gv[j] = *((const GAS f32x4*)gain + lane + 64 * j); bv[j] = *((const GAS f32x4*)bias + lane + 64 * j); }
    for (int m0 = gw; m0 < M; m0 += 4 * NGW) {
        int s1[4], s2[4]; float w1[4], w2[4];
#pragma unroll
        for (int k = 0; k < 4; ++k) { const int m = m0 + k * NGW; const bool ok = m < M; s1[k] = ok ? toks[m * 2] : 0; s2[k] = ok ? toks[m * 2 + 1] : 0; w1[k] = ok ? tokw[m * 2] : 0.f; w2[k] = ok ? tokw[m * 2 + 1] : 0.f; }
        v2u xr_[4][4], ya_[4][4], yc_[4][4];
#pragma unroll
        for (int k = 0; k < 4; ++k) { const int m = m0 + k * NGW; if (m < M) {
            const GAS v2u* xr = (const GAS v2u*)(xres + (size_t)m * D) + lane;
            const GAS v2u* y1 = (const GAS v2u*)(s1[k] < 32768 ? yb + (size_t)s1[k] * D : yb + KSTR + (size_t)(s1[k] - 32768) * D) + lane;
            const GAS v2u* y2 = (const GAS v2u*)(s2[k] < 32768 ? yb + (size_t)s2[k] * D : yb + KSTR + (size_t)(s2[k] - 32768) * D) + lane;
#pragma unroll
            for (int j = 0; j < 4; ++j) { xr_[k][j] = xr[64 * j]; ya_[k][j] = y1[64 * j]; yc_[k][j] = y2[64 * j]; } } }
#pragma unroll
        for (int k = 0; k < 4; ++k) { const int m = m0 + k * NGW; if (m >= M) break;
            f32x4 v[4], ya[4], yc[4];
#pragma unroll
            for (int j = 0; j < 4; ++j) { ya[j] = bf4(ya_[k][j]); yc[j] = bf4(yc_[k][j]); }
            if (s1[k] >= 32768) { for (int ks = 1; ks < 7; ++ks) { const GAS v2u* y1 = (const GAS v2u*)(yb + KSTR + ((size_t)ks * 2048 + (s1[k] - 32768)) * D) + lane;
#pragma unroll
                for (int j = 0; j < 4; ++j) ya[j] += bf4(y1[64 * j]); } }
            if (s2[k] >= 32768) { for (int ks = 1; ks < 7; ++ks) { const GAS v2u* y2 = (const GAS v2u*)(yb + KSTR + ((size_t)ks * 2048 + (s2[k] - 32768)) * D) + lane;
#pragma unroll
                for (int j = 0; j < 4; ++j) yc[j] += bf4(y2[64 * j]); } }
            float s = 0.f;
#pragma unroll
            for (int j = 0; j < 4; ++j) { const f32x4 x = bf4(xr_[k][j]); v[j] = x * ALPHA + (ya[j] * w1[k] + yc[j] * w2[k]); s += (v[j].x + v[j].y) + (v[j].z + v[j].w); }
            const float mean = wave_sum(s) * (1.f / D); float q2 = 0.f;
#pragma unroll
            for (int j = 0; j < 4; ++j) { v[j] = v[j] - mean; q2 += (v[j].x * v[j].x + v[j].y * v[j].y) + (v[j].z * v[j].z + v[j].w * v[j].w); }
            const float rstd = 1.f / sqrtf(wave_sum(q2) * (1.f / D) + LN_EPS);
            GAS f32x4* xo = (GAS f32x4*)(F.out + (size_t)m * D) + lane;
#pragma unroll
            for (int j = 0; j < 4; ++j) xo[64 * j] = v[j] * rstd * gv[j] + bv[j];
        }
    }
}
__global__ void __launch_bounds__(NWAVES * 64, 2) fwd(Args args) {
    extern __shared__ __attribute__((aligned(16))) unsigned char lds[];
    Frame F;
    F.A = &args;
    F.lds = (LAS unsigned char*)lds;
    F.MISC = (volatile LAS unsigned*)(F.lds + MISC_OFF);
    F.tid = threadIdx.x; F.lane = F.tid & 63; F.wave = __builtin_amdgcn_readfirstlane(F.tid >> 6);
    F.G = gridDim.x; F.wg = blockIdx.x; { const int bx = blockIdx.x; F.vcu = (F.G % 8 == 0) ? (bx % 8) * (F.G / 8) + bx / 8 : bx; }
    F.ws = args.ws; F.out = args.out;
    unsigned char* ws = args.ws;
    F.ctl = (gu32*)(ws + WS_CTL);
    for (int u = F.tid; u < (LDS_BYTES - LDSCTL_OFF) / 4; u += NWAVES * 64) ((LAS unsigned*)(F.lds + LDSCTL_OFF))[u] = 0u;
    __syncthreads();
    XcdBarrier bar; bar.bar = (unsigned*)(F.ctl + CW_BAR); bar.x = 0; bar.st = nullptr;
    if (!MK_PER_PHASE) bar = xcd_barrier_post((unsigned*)(F.ctl + CW_BAR), F.MISC + 8);
#define GRID_BAR() do { if (!MK_PER_PHASE) xcd_barrier(bar); } while (0)
    const int lo = args.ph_lo, hi = args.ph_hi;
#define IN(k) (lo <= (k) && (k) < hi)
#define SEAM(k) do { if (IN((k) + 1)) GRID_BAR(); } while (0)
    bf16* XB = (bf16*)(ws + WS_XB); bf16* T0 = (bf16*)(ws + WS_T0);
    const int cwg = (int)blockIdx.x;

#ifndef HANDOFF
#define HANDOFF 0
#endif
#ifndef PROBE_REP
#define PROBE_REP -1
#endif
#define REP(k) (PROBE_REP == (k) ? 2 : 1)
    if (IN(0)) { for (int rep = 0; rep < REP(0); ++rep) { if (rep) GRID_BAR(); p0_prologue(F); } SEAM(0); }
    if (IN(1)) { pg8::Gemm g{XB, (const bf16*)(ws + WS_WIN0), M, NSA_IN_PAD, D, D}; pg8::StaticOrder S; S.init(M, NSA_IN_PAD, F.G, cwg);
        pg8::EpiNsaIn E{(bf16*)(ws + WS_Q), (bf16*)(ws + WS_KV2), (bf16*)(ws + WS_KS), (bf16*)(ws + WS_VS), (bf16*)(ws + WS_KW), (bf16*)(ws + WS_VW), (float*)(ws + WS_GT), 0.125f * LOG2E};
        pg8::gemm_phase<pg8::EpiNsaIn, pg8::StaticOrder, PG8_ALIGN, PG8_SP2>(F.lds + RING_OFF, g, S, E); SEAM(1); }
    if (IN(2)) { pg8::Gemm g{(const bf16*)(ws + WS_KV2), (const bf16*)(ws + WS_W1C), 8192, 1024, 1024, 1024}; pg8::CmpOrder S{F.G, cwg}; pg8::EpiF32Cmp E{(float*)(ws + WS_UL)};
        pg8::gemm_phase<pg8::EpiF32Cmp, pg8::CmpOrder, PG8_ALIGN, PG8_SP2>(F.lds + RING_OFF, g, S, E);
        SEAM(2); }
    if (IN(3)) { cmp_finish(F); SEAM(3); }
    if (IN(4)) { for (int rep = 0; rep < REP(4); ++rep) { if (rep) GRID_BAR(); nsa_attn_phase(F); } SEAM(4); }
    if (IN(5)) { pg8::Gemm g{(const bf16*)(ws + WS_O), (const bf16*)(ws + WS_WO0), M, D, D, D}; pg8::StaticOrder S; S.init(M, D, F.G, cwg); pg8::EpiResBf16<true> E{XB, T0, ALPHA};
        pg8::gemm_phase<pg8::EpiResBf16<true>, pg8::StaticOrder, PG8_ALIGN, PG8_SP2>(F.lds + RING_OFF, g, S, E); SEAM(5); }
    if (IN(6)) { ln_rows(F, T0, inptr(F, 9), inptr(F, 10), XB); SEAM(6); }
#if HANDOFF
    if (IN(7)) { pg8::Gemm g{XB, (const bf16*)(ws + WS_WGU0), M, 2 * FF0, D, D}; pg8::PubOrder<pg8::StaticOrder> S; S.init(M, 2 * FF0, F.G, cwg); S.cnt = (unsigned*)(F.ctl + CW_PANEL0); S.pend = -1; pg8::EpiSwiGLU<true> E{(bf16*)(ws + WS_H0), FF0, 2 * FF0 / 256};
        pg8::gemm_phase<pg8::EpiSwiGLU<true>, pg8::PubOrder<pg8::StaticOrder>, PG8_ALIGN, PG8_SP2>(F.lds + RING_OFF, g, S, E); S.publish(); }
    if (IN(8)) { pg8::Gemm g{(const bf16*)(ws + WS_H0), (const bf16*)(ws + WS_WD0), M, D, FF0, FF0}; pg8::WaitOrder<pg8::StaticOrder> S; S.init(M, D, F.G, (cwg + F.G - (M / 256 * (2 * FF0 / 256)) % F.G) % F.G); S.ready = (const unsigned*)(F.ctl + CW_PANEL0); S.need = 8u * (2 * FF0 / 256); S.tmo = (unsigned*)(F.ctl + CW_TMO);
        pg8::EpiResBf16<true> E{XB, T0, ALPHA};
        pg8::gemm_phase<pg8::EpiResBf16<true>, pg8::WaitOrder<pg8::StaticOrder>, PG8_ALIGN, PG8_SP2>(F.lds + RING_OFF, g, S, E); SEAM(8); }
#else
    if (IN(7)) { for (int rep = 0; rep < REP(7); ++rep) { if (rep) GRID_BAR(); pg8::Gemm g{XB, (const bf16*)(ws + WS_WGU0), M, 2 * FF0, D, D}; pg8::StaticOrder S; S.init(M, 2 * FF0, F.G, cwg); pg8::EpiSwiGLU<false> E{(bf16*)(ws + WS_H0), FF0, 2 * FF0 / 256};
        pg8::gemm_phase<pg8::EpiSwiGLU<false>, pg8::StaticOrder, PG8_ALIGN, PG8_SP2>(F.lds + RING_OFF, g, S, E);
#if defined(PROBE_NULL) && PROBE_NULL == 7
        GRID_BAR(); { pg8::EpiNull EN{(float*)(ws + WS_CTL + 65536)}; pg8::gemm_phase<pg8::EpiNull, pg8::StaticOrder, PG8_ALIGN, PG8_SP2>(F.lds + RING_OFF, g, S, EN); }
#endif
        } SEAM(7); }
    if (IN(8)) { for (int rep = 0; rep < REP(8); ++rep) { if (rep) GRID_BAR(); pg8::Gemm g{(const bf16*)(ws + WS_H0), (const bf16*)(ws + WS_WD0), M, D, FF0, FF0}; pg8::StaticOrder S; S.init(M, D, F.G, cwg); pg8::EpiResBf16<true> E{XB, T0, ALPHA};
        pg8::gemm_phase<pg8::EpiResBf16<true>, pg8::StaticOrder, PG8_ALIGN, PG8_SP2>(F.lds + RING_OFF, g, S, E); } SEAM(8); }
#endif
    if (IN(9)) { ln_rows(F, T0, inptr(F, 13), inptr(F, 14), XB); SEAM(9); }
    if (IN(10)) { pg8::Gemm g{XB, (const bf16*)(ws + WS_WIN1), M, 3072, D, D}; pg8::StaticOrder S; S.init(M, 3072, F.G, cwg);     pg8::EpiGlaIn E{(bf16*)(ws + WS_QKVG), (float*)(ws + WS_ALOW), 0.08838834764831845f};
        pg8::gemm_phase<pg8::EpiGlaIn, pg8::StaticOrder, PG8_ALIGN, PG8_SP2>(F.lds + RING_OFF, g, S, E); SEAM(10); }
    for (int rep = 0; rep < REP(11); ++rep) { if (rep) GRID_BAR();
    if (IN(11)) { gla_g1(F); SEAM(11); }
    if (IN(12)) { gla_g2(F); SEAM(12); }
    if (IN(13)) { gla_g3(F); if (rep + 1 == REP(11)) SEAM(13); }
    }
    if (IN(14)) { pg8::Gemm g{(const bf16*)(ws + WS_O1), (const bf16*)(ws + WS_WO1), M, D, D, D}; pg8::StaticOrder S; S.init(M, D, F.G, cwg); pg8::EpiResBf16<true> E{XB, T0, ALPHA};
        pg8::gemm_phase<pg8::EpiResBf16<true>, pg8::StaticOrder, PG8_ALIGN, PG8_SP2>(F.lds + RING_OFF, g, S, E); SEAM(14); }
    if (IN(15)) { ln_router(F, T0, inptr(F, 20), inptr(F, 21), XB); SEAM(15); }
    if (IN(16)) { moe_gather(F); SEAM(16); }
#if 0
    if (IN(17)) { moe_tables(F); pg8::Gemm g{(const bf16*)(ws + WS_XG), (const bf16*)(ws + WS_WGU1), MAXSLOTS, NE * 2 * FFE, D, D};
        pg8::PubOrder<pg8::GroupedOrder> S; S.G = F.G; S.c = cwg; S.NT = 2 * FFE / 256; S.KS = 1; S.KL = 0; S.tp = (const PG8_LAS int*)(F.lds + LDSCTL_OFF); S.cnt = (unsigned*)(F.ctl + CW_PANEL1); S.pend = -1;
        pg8::EpiSwiGLU<true> E{(bf16*)(ws + WS_H2), FFE, 2 * FFE / 256};
        pg8::gemm_phase<pg8::EpiSwiGLU<true>, pg8::PubOrder<pg8::GroupedOrder>, PG8_ALIGN, PG8_SP2>(F.lds + RING_OFF, g, S, E); S.publish(); }
    if (IN(18)) { moe_tables(F); pg8::Gemm g{(const bf16*)(ws + WS_H2), (const bf16*)(ws + WS_WD1), MAXSLOTS, NE * D, FFE / MOE_KS, FFE};
        pg8::WaitOrder<pg8::GroupedOrder> S; S.G = F.G; S.NT = D / 256; S.KS = MOE_KS; S.KL = FFE / MOE_KS; S.tp = (const PG8_LAS int*)(F.lds + LDSCTL_OFF);
        { const int n17 = S.tp[8] * (2 * FFE / 256); S.c = (cwg + F.G - ((n17 % F.G) & ~7)) % F.G; }
        S.ready = (const unsigned*)(F.ctl + CW_PANEL1); S.need = 8u * (2 * FFE / 256); S.tmo = (unsigned*)(F.ctl + CW_TMO); pg8::EpiBf16Y E{(bf16*)(ws + WS_YB), (size_t)(WS_YB1 - WS_YB) / 2};
        pg8::gemm_phase<pg8::EpiBf16Y, pg8::WaitOrder<pg8::GroupedOrder>, PG8_ALIGN, PG8_SP2>(F.lds + RING_OFF, g, S, E); SEAM(18); }
#else
#ifndef STAGGER_US
#define STAGGER_US 0
#endif
    if (IN(17)) { for (int rep = 0; rep < REP(17); ++rep) { if (rep) GRID_BAR(); moe_tables(F);
        if (STAGGER_US) { const unsigned long long t0 = __builtin_amdgcn_s_memrealtime(), dl = (unsigned long long)((cwg >> 3) & 3) * (STAGGER_US * 100ull); while (__builtin_amdgcn_s_memrealtime() - t0 < dl) __builtin_amdgcn_s_sleep(8); }
        pg8::Gemm g{(const bf16*)(ws + WS_XG), (const bf16*)(ws + WS_WGU1), MAXSLOTS, NE * 2 * FFE, D, D};
        pg8::GroupedOrder S{F.G, cwg, 2 * FFE / 256, 1, 0, (const PG8_LAS int*)(F.lds + LDSCTL_OFF)}; pg8::EpiSwiGLU<false> E{(bf16*)(ws + WS_H2), FFE, 2 * FFE / 256};
        pg8::gemm_phase<pg8::EpiSwiGLU<false>, pg8::GroupedOrder, PG8_ALIGN, PG8_SP2>(F.lds + RING_OFF, g, S, E);
#if defined(PROBE_NULL) && PROBE_NULL == 177
        GRID_BAR(); { pg8::Gemm g7{XB, (const bf16*)(ws + WS_WGU0), M, 2 * FF0, D, D}; pg8::StaticOrder S7; S7.init(M, 2 * FF0, F.G, cwg); pg8::EpiNull EN{(float*)(ws + WS_CTL + 65536)};
          pg8::gemm_phase<pg8::EpiNull, pg8::StaticOrder, PG8_ALIGN, PG8_SP2>(F.lds + RING_OFF, g7, S7, EN); }
#endif
#if defined(PROBE_NULL) && PROBE_NULL == 178
        GRID_BAR(); { pg8::Gemm g7{XB, (const bf16*)(ws + WS_WGU1), M, 2 * FFE, D, D}; pg8::StaticOrder S7; S7.init(M, 2 * FFE, F.G, cwg); pg8::EpiNull EN{(float*)(ws + WS_CTL + 65536)};
          pg8::gemm_phase<pg8::EpiNull, pg8::StaticOrder, PG8_ALIGN, PG8_SP2>(F.lds + RING_OFF, g7, S7, EN); GRID_BAR(); g7.Bt += (size_t)2 * FFE * D;
          pg8::gemm_phase<pg8::EpiNull, pg8::StaticOrder, PG8_ALIGN, PG8_SP2>(F.lds + RING_OFF, g7, S7, EN); }
#endif
#if defined(PROBE_NULL) && PROBE_NULL == 17
        GRID_BAR(); { pg8::EpiNull EN{(float*)(ws + WS_CTL + 65536)};
#if defined(PROBE_SAMEB)
          S.KL = -1;
#endif
          pg8::gemm_phase<pg8::EpiNull, pg8::GroupedOrder, PG8_ALIGN, PG8_SP2>(F.lds + RING_OFF, g, S, EN); }
#endif
        } SEAM(17); }
    if (IN(18)) { for (int rep = 0; rep < REP(18); ++rep) { if (rep) GRID_BAR(); moe_tables(F);
        { pg8::Gemm g{(const bf16*)(ws + WS_H2), (const bf16*)(ws + WS_WD1), MAXSLOTS, NE * D, FFE, FFE}; pg8::MoeDownOrder S{F.G, cwg, 0, (const PG8_LAS int*)(F.lds + LDSCTL_OFF)};
          pg8::EpiBf16Y2 E{(bf16*)(ws + WS_YB), (bf16*)(ws + WS_YB1), 0}; pg8::gemm_phase<pg8::EpiBf16Y2, pg8::MoeDownOrder, PG8_ALIGN, PG8_SP2>(F.lds + RING_OFF, g, S, E); }
        { pg8::Gemm g{(const bf16*)(ws + WS_H2), (const bf16*)(ws + WS_WD1), MAXSLOTS, NE * D, 512, FFE}; pg8::MoeDownOrder S{F.G, cwg, 1, (const PG8_LAS int*)(F.lds + LDSCTL_OFF)};
          pg8::EpiBf16Y2 E{(bf16*)(ws + WS_YB), (bf16*)(ws + WS_YB1), 1}; pg8::gemm_phase<pg8::EpiBf16Y2, pg8::MoeDownOrder, PG8_ALIGN, PG8_SP2>(F.lds + RING_OFF, g, S, E); } } SEAM(18); }
#endif
    if (IN(19)) { moe_final(F); }
#undef IN
#undef SEAM
#undef GRID_BAR
}

extern "C" void kernel_launch(void* const* d_in, const int* in_sizes, int n_in, void* d_out, int out_size, void* d_ws, size_t ws_size, hipStream_t stream) {
    static int grid = 0;
    if (grid == 0) {
        if (n_in != 27 || in_sizes[0] != M * D || out_size != M * D || ws_size < WS_END) { fprintf(stderr, "kernel_launch: unexpected problem shape (n_in %d, in0 %d, out %d, ws %zu); nothing launched\n", n_in, n_in > 0 ? in_sizes[0] : -1, out_size, ws_size); grid = -1; return; }
        if (hipFuncSetAttribute((const void*)fwd, hipFuncAttributeMaxDynamicSharedMemorySize, LDS_BYTES) != hipSuccess) { fprintf(stderr, "kernel_launch: hipFuncSetAttribute failed\n"); grid = -1; return; }
        int dev = 0, cus = 0, per_cu = 0;
        (void)hipGetDevice(&dev); (void)hipDeviceGetAttribute(&cus, hipDeviceAttributeMultiprocessorCount, dev);
        if (hipOccupancyMaxActiveBlocksPerMultiprocessor(&per_cu, (const void*)fwd, NWAVES * 64, LDS_BYTES) != hipSuccess || per_cu < 1) fprintf(stderr, "kernel_launch: note: occupancy query reports %d workgroups per CU\n", per_cu);
        (void)hipGetLastError();
        grid = 256;
        if (cus < 256) fprintf(stderr, "kernel_launch: device has %d CUs; this kernel needs 256 resident workgroups\n", cus);
    }
    if (grid < 0) return;
    if (hipMemsetAsync((char*)d_ws + WS_CTL, 0, CTL_ZERO_BYTES, stream) != hipSuccess) { fprintf(stderr, "kernel_launch: hipMemsetAsync failed\n"); return; }
    Args a{};
    for (int i = 0; i < 27; ++i) a.in[i] = (const float*)d_in[i];
    a.out = (float*)d_out; a.ws = (unsigned char*)d_ws;
#if MK_PER_PHASE
    for (int p = 0; p < N_PHASES; ++p) { a.ph_lo = p; a.ph_hi = p + 1; hipLaunchKernelGGL(fwd, dim3(grid), dim3(NWAVES * 64), LDS_BYTES, stream, a); }
#else
    a.ph_lo = 0; a.ph_hi = N_PHASES;
    hipLaunchKernelGGL(fwd, dim3(grid), dim3(NWAVES * 64), LDS_BYTES, stream, a);
#endif
    const hipError_t le = hipPeekAtLastError();
    if (le != hipSuccess) fprintf(stderr, "kernel_launch: launch failed: %s\n", hipGetErrorName(le));
}
```
